# Optimizing an MI355X kernel written in HIP

```python
import functools
import jax, jax.numpy as jnp
from jax import lax
import numpy as np

D_MODEL = 1024
BATCH = 2
SEQ = 16384
DEPTH = 2
DEC_BATCH = 16
DEC_SEQ = 2048
PAST_LEN = 128

D_FF = 2816
N_SUB = 3
N_MOD = 3
MIX_WIDTH = D_MODEL
CHUNK = 128
HEADS_A = 4
WIDTH_A = MIX_WIDTH // 2
DH_A = WIDTH_A // HEADS_A
GROUPS_B = 4
WIDTH_B = MIX_WIDTH - WIDTH_A
DH_B = WIDTH_B // GROUPS_B
POOL_WINDOWS = (2, 4, 8, 16)
GROUPS_C = 4
WIDTH_C = MIX_WIDTH // 2
CONV_WIDTH = 3
GROUPS_D = 4
WIDTH_D = MIX_WIDTH - WIDTH_C
DH_D = WIDTH_D // GROUPS_D
IN_EVEN = 2 * WIDTH_A + WIDTH_B
IN_ODD = 3 * WIDTH_C + WIDTH_D
N_EVEN = (DEPTH + 1) // 2
N_ODD = DEPTH // 2
RMS_EPS = 1e-6
LN_EPS = 1e-5
ADA_SCALE = 0.25

kernel_name = 'hybrid_bidir_gmlp_pool_conv_fourier_encoder'


def _rmsnorm(x, g):
    xf = x.astype(jnp.float32)
    y = xf * lax.rsqrt(jnp.mean(xf * xf, axis=-1, keepdims=True) + RMS_EPS)
    return (y * g.astype(jnp.float32)).astype(x.dtype)


def _layernorm(x, g, b):
    xf = x.astype(jnp.float32)
    mu = jnp.mean(xf, axis=-1, keepdims=True)
    var = jnp.mean(jnp.square(xf - mu), axis=-1, keepdims=True)
    y = (xf - mu) * lax.rsqrt(var + LN_EPS)
    return (y * g.astype(jnp.float32) + b.astype(jnp.float32)).astype(x.dtype)


def _swiglu(h, w_up, w_down):
    gate, up = jnp.split(h @ w_up, 2, axis=-1)
    return (jax.nn.silu(gate) * up) @ w_down


def _spatial_gating(u, v, ln_g, ln_b, w_s, b_s):
    b, s, _ = v.shape
    n = s // CHUNK
    vn = _layernorm(v, ln_g, ln_b).reshape(b, n, CHUNK, HEADS_A, DH_A)
    sv = jnp.einsum('hpq,bnqhd->bnphd', w_s, vn) + b_s.T[None, None, :, :, None]
    return u * sv.reshape(b, s, WIDTH_A)


def _multiscale_pool(z, w_pool, pool_scale):
    b, s, _ = z.shape
    zf = z.astype(jnp.float32)
    prefix = jnp.concatenate([jnp.zeros((b, 1, WIDTH_B), jnp.float32), jnp.cumsum(zf, axis=1)], axis=1)
    t = np.arange(s)
    outs = []
    for g, w in enumerate(POOL_WINDOWS):
        lo = np.clip(t - w // 2, 0, s)
        hi = np.clip(t + w // 2, 0, s)
        cnt = jnp.asarray((hi - lo).astype(np.float32))
        pg = prefix[..., g * DH_B:(g + 1) * DH_B]
        mean = (jnp.take(pg, jnp.asarray(hi), axis=1) - jnp.take(pg, jnp.asarray(lo), axis=1)) / cnt[None, :, None]
        outs.append(mean - zf[..., g * DH_B:(g + 1) * DH_B])
    d = jnp.stack(outs, axis=2).astype(z.dtype)
    y = jnp.einsum('bsgd,gde->bsge', d, w_pool) * pool_scale.reshape(GROUPS_B, DH_B)
    return y.reshape(b, s, WIDTH_B)


def _short_conv(c_gate, b_gate, xin, conv_w):
    z = c_gate * xin
    s = z.shape[1]
    pad = CONV_WIDTH // 2
    zp = jnp.pad(z, ((0, 0), (pad, CONV_WIDTH - 1 - pad), (0, 0)))
    conv = zp[:, 0:s] * conv_w[0]
    for k in range(1, CONV_WIDTH):
        conv = conv + zp[:, k:k + s] * conv_w[k]
    return b_gate * conv


def _fourier(z, fourier_g, fourier_w):
    b, s, _ = z.shape
    zg = _rmsnorm(z.reshape(b, s, GROUPS_D, DH_D), fourier_g)
    f = jnp.fft.fft2(zg.astype(jnp.float32), axes=(1, 3), norm='ortho').real.astype(z.dtype)
    y = jnp.einsum('bsgd,gde->bsge', f, fourier_w)
    return y.reshape(b, s, WIDTH_D)


def _mixer_even(h, w_in, ln_g, ln_b, w_s, b_s, w_pool, pool_scale, w_out):
    proj = h @ w_in
    u, v = jnp.split(jax.nn.gelu(proj[..., :2 * WIDTH_A], approximate=False), 2, axis=-1)
    ya = _spatial_gating(u, v, ln_g, ln_b, w_s, b_s)
    yb = _multiscale_pool(proj[..., 2 * WIDTH_A:], w_pool, pool_scale)
    return jnp.concatenate([ya, yb], axis=-1) @ w_out


def _mixer_odd(h, w_in, conv_w, fourier_g, fourier_w, w_out):
    proj = h @ w_in
    c_gate = proj[..., :WIDTH_C]
    b_gate = proj[..., WIDTH_C:2 * WIDTH_C]
    xin = proj[..., 2 * WIDTH_C:3 * WIDTH_C]
    yc = _short_conv(c_gate, b_gate, xin, conv_w)
    yd = _fourier(proj[..., 3 * WIDTH_C:], fourier_g, fourier_w)
    return jnp.concatenate([yc, yd], axis=-1) @ w_out


def _sublayer(x, mod_k, g_pre, g_post, fn, res_weight):
    shift, scale, gate = mod_k[:, 0, None], mod_k[:, 1, None], mod_k[:, 2, None]
    h = _rmsnorm(x, g_pre) * (1 + scale) + shift
    y = _rmsnorm(fn(h), g_post)
    return x + res_weight * (1 + gate) * y


def _trunk(x, c, ada_w, ada_b, norm_pre, norm_post, ffn1_w_up, ffn1_w_down, ffn2_w_up, ffn2_w_down,
           ev_w_in, ev_ln_g, ev_ln_b, ev_w_spatial, ev_b_spatial, ev_w_pool, ev_pool_scale, ev_w_out,
           od_w_in, od_conv_w, od_fourier_g, od_fourier_w, od_w_out):
    nb = c.shape[0]
    for l in range(DEPTH):
        mod = (jax.nn.silu(c) @ ada_w[l] + ada_b[l]).reshape(nb, N_SUB, N_MOD, D_MODEL)
        ffn1 = functools.partial(_swiglu, w_up=ffn1_w_up[l], w_down=ffn1_w_down[l])
        ffn2 = functools.partial(_swiglu, w_up=ffn2_w_up[l], w_down=ffn2_w_down[l])
        j = l // 2
        if l % 2 == 0:
            mixer = functools.partial(_mixer_even, w_in=ev_w_in[j], ln_g=ev_ln_g[j], ln_b=ev_ln_b[j],
                                      w_s=ev_w_spatial[j], b_s=ev_b_spatial[j], w_pool=ev_w_pool[j],
                                      pool_scale=ev_pool_scale[j], w_out=ev_w_out[j])
        else:
            mixer = functools.partial(_mixer_odd, w_in=od_w_in[j], conv_w=od_conv_w[j],
                                      fourier_g=od_fourier_g[j], fourier_w=od_fourier_w[j], w_out=od_w_out[j])
        x = _sublayer(x, mod[:, 0], norm_pre[l, 0], norm_post[l, 0], ffn1, 0.5)
        x = _sublayer(x, mod[:, 1], norm_pre[l, 1], norm_post[l, 1], mixer, 1.0)
        x = _sublayer(x, mod[:, 2], norm_pre[l, 2], norm_post[l, 2], ffn2, 0.5)
    return x


def setup_inputs(seed: int = 0) -> dict:
    key = jax.random.key(seed)
    ks = jax.random.split(key, 32)
    f32 = jnp.float32

    def nrm(k, shape, scale):
        return jax.random.normal(k, shape, f32) * scale

    d = D_MODEL
    return {
        'x_prompt': nrm(ks[0], (BATCH, SEQ, d), 1.0),
        'x_sample': nrm(ks[1], (DEC_BATCH, DEC_SEQ, d), 1.0),
        'c_prompt': nrm(ks[2], (BATCH, d), 1.0),
        'c_sample': nrm(ks[3], (DEC_BATCH, d), 1.0),
        'ada_w': nrm(ks[4], (DEPTH, d, N_SUB * N_MOD * d), ADA_SCALE * d ** -0.5),
        'ada_b': nrm(ks[5], (DEPTH, N_SUB * N_MOD * d), 0.02),
        'norm_pre': 1.0 + nrm(ks[6], (DEPTH, N_SUB, d), 0.1),
        'norm_post': 1.0 + nrm(ks[7], (DEPTH, N_SUB, d), 0.1),
        'ffn1_w_up': nrm(ks[8], (DEPTH, d, 2 * D_FF), d ** -0.5),
        'ffn1_w_down': nrm(ks[9], (DEPTH, D_FF, d), D_FF ** -0.5),
        'ffn2_w_up': nrm(ks[10], (DEPTH, d, 2 * D_FF), d ** -0.5),
        'ffn2_w_down': nrm(ks[11], (DEPTH, D_FF, d), D_FF ** -0.5),
        'ev_w_in': nrm(ks[12], (N_EVEN, d, IN_EVEN), d ** -0.5),
        'ev_ln_g': 1.0 + nrm(ks[13], (N_EVEN, WIDTH_A), 0.1),
        'ev_ln_b': nrm(ks[14], (N_EVEN, WIDTH_A), 0.02),
        'ev_w_spatial': nrm(ks[15], (N_EVEN, HEADS_A, CHUNK, CHUNK), CHUNK ** -0.5),
        'ev_b_spatial': 1.0 + nrm(ks[16], (N_EVEN, HEADS_A, CHUNK), 0.1),
        'ev_w_pool': nrm(ks[17], (N_EVEN, GROUPS_B, DH_B, DH_B), DH_B ** -0.5),
        'ev_pool_scale': 1.0 + nrm(ks[18], (N_EVEN, WIDTH_B), 0.1),
        'ev_w_out': nrm(ks[19], (N_EVEN, MIX_WIDTH, d), MIX_WIDTH ** -0.5),
        'od_w_in': nrm(ks[20], (N_ODD, d, IN_ODD), d ** -0.5),
        'od_conv_w': nrm(ks[21], (N_ODD, CONV_WIDTH, WIDTH_C), CONV_WIDTH ** -0.5),
        'od_fourier_g': 1.0 + nrm(ks[22], (N_ODD, GROUPS_D, DH_D), 0.1),
        'od_fourier_w': nrm(ks[23], (N_ODD, GROUPS_D, DH_D, DH_D), DH_D ** -0.5),
        'od_w_out': nrm(ks[24], (N_ODD, MIX_WIDTH, d), MIX_WIDTH ** -0.5),
    }


def reference(x_prompt, x_sample, c_prompt, c_sample, ada_w, ada_b, norm_pre, norm_post,
              ffn1_w_up, ffn1_w_down, ffn2_w_up, ffn2_w_down,
              ev_w_in, ev_ln_g, ev_ln_b, ev_w_spatial, ev_b_spatial, ev_w_pool, ev_pool_scale, ev_w_out,
              od_w_in, od_conv_w, od_fourier_g, od_fourier_w, od_w_out):
    y_prompt = _trunk(x_prompt, c_prompt, ada_w, ada_b, norm_pre, norm_post, ffn1_w_up, ffn1_w_down,
                      ffn2_w_up, ffn2_w_down, ev_w_in, ev_ln_g, ev_ln_b, ev_w_spatial, ev_b_spatial,
                      ev_w_pool, ev_pool_scale, ev_w_out, od_w_in, od_conv_w, od_fourier_g, od_fourier_w, od_w_out)
    y_sample = _trunk(x_sample, c_sample, ada_w, ada_b, norm_pre, norm_post, ffn1_w_up, ffn1_w_down,
                      ffn2_w_up, ffn2_w_down, ev_w_in, ev_ln_g, ev_ln_b, ev_w_spatial, ev_b_spatial,
                      ev_w_pool, ev_pool_scale, ev_w_out, od_w_in, od_conv_w, od_fourier_g, od_fourier_w, od_w_out)
    return (y_prompt, y_sample)
```

```cpp
#include <hip/hip_runtime.h>
#include <hip/hip_cooperative_groups.h>
#include <cstdio>
namespace cg = cooperative_groups;
namespace pg8 {
#define PG8_LAS __attribute__((address_space(3)))
typedef unsigned short bf16_t;
typedef short bf16x8 __attribute__((ext_vector_type(8)));
typedef float f32x4 __attribute__((ext_vector_type(4)));
typedef unsigned u32x4 __attribute__((ext_vector_type(4)));
constexpr int BM = 256, BK = 64, HALF = 128, HTB = HALF * BK * 2  , STAGE_BYTES = 8 * HTB, NXCD = 8, WGM = 8;

__host__ __device__ __forceinline__ int lds_byte(int r, int c) { const int st = (r >> 4) * 2 + (c >> 5), rr = r & 15, cc = c & 31, ob = rr * 64 + cc * 2; return st * 1024 + (ob ^ (((ob >> 9) & 1) << 5)); }
__host__ __device__ __forceinline__ void stage_rc(int b, int& R, int& C) { const int st = b / 1024, sb = b % 1024, swz = sb ^ (((sb >> 9) & 1) << 5); R = (st >> 1) * 16 + swz / 64; C = (st & 1) * 32 + (swz % 64) / 2; }
__host__ __device__ __forceinline__ int perm32(int rho) { const int n = rho >> 4, i = rho & 15; return 8 * (i >> 2) + 4 * n + (i & 3); }

struct Unit { int pm, pn; };
struct Gemm { const bf16_t* A; const bf16_t* Bt; int M, N, K; };

struct StaticOrder {
    int nM, nN, nwg, G, c;
    __host__ __device__ void init(int M, int N, int G_, int c_) { nM = M / BM; nN = N / BM; nwg = nM * nN; G = G_; c = c_; }
    __host__ __device__ bool next(int i, Unit& u) const {
        const long L = (long)i * G + c; if (L >= nwg) return false;
        int wgid = (int)L; { const int q = nwg / NXCD, r = nwg % NXCD, xcd = wgid % NXCD, off = wgid / NXCD; wgid = (xcd < r ? xcd * (q + 1) : r * (q + 1) + (xcd - r) * q) + off; }
        const int nig = WGM * nN, gid = wgid / nig, fm = gid * WGM, gsz = (nM - fm) < WGM ? (nM - fm) : WGM;
        u.pm = fm + ((wgid % nig) % gsz); u.pn = (wgid % nig) / gsz; return true;
    }
    __device__ __forceinline__ void a_ready(const Unit&) const {}
    __device__ __forceinline__ void done(const Unit&) const {}
};
__device__ __forceinline__ unsigned cvt_pk_bf16(float lo, float hi) { unsigned r; asm volatile("v_cvt_pk_bf16_f32 %0, %1, %2" : "=v"(r) : "v"(lo), "v"(hi)); return r; }
typedef float f32x2 __attribute__((ext_vector_type(2)));
__device__ __forceinline__ f32x2 gelu_pk(f32x2 v) {
    const f32x2 av = __builtin_elementwise_abs(v), d = av * 0.2316418882f + 1.0f;
    f32x2 t; t.x = __builtin_amdgcn_rcpf(d.x); t.y = __builtin_amdgcn_rcpf(d.y);
    f32x2 q = t * 0.5307027145f + (-0.7265760135f); q = q * t + 0.7107068705f; q = q * t + (-0.142248368f); q = q * t + 0.127414796f; q = q * t;
    const f32x2 s = (v * v) * (-0.72134752044f);
    f32x2 e; e.x = __builtin_amdgcn_exp2f(s.x); e.y = __builtin_amdgcn_exp2f(s.y);
    const f32x2 m = v * (q * e), r = v - m;
    f32x2 o; o.x = v.x < 0.f ? m.x : r.x; o.y = v.y < 0.f ? m.y : r.y; return o;
}
template <class Epi, class Sched, bool STAMP = false>
__device__ __forceinline__ void gemm_phase(PG8_LAS unsigned char* lds, const Gemm g, const Sched& S, const Epi& E, unsigned long long* stamps) {
    int tid_o = threadIdx.x; asm volatile("" : "+v"(tid_o));
    const int tid = tid_o, wid = __builtin_amdgcn_readfirstlane(tid >> 6), lane = tid & 63, wr = wid >> 2, wc = wid & 3, fr = lane & 15, fq = lane >> 4;
    const int K = g.K, nt = K / BK;
    int ts_lo = 0, ts_hi = 0, nts = 0; const unsigned long long rt_entry = STAMP ? (unsigned long long)wall_clock64() : 0ull;
#define PG8_STAMP() do { if (STAMP && wid == 0 && nts < 64) { const unsigned long long _c = (unsigned long long)clock64(); \
        ts_lo = (lane == nts) ? (int)(unsigned)_c : ts_lo; ts_hi = (lane == nts) ? (int)(unsigned)(_c >> 32) : ts_hi; ++nts; } } while (0)
    PG8_STAMP();
    unsigned voffA[2], voffB[2];
#pragma unroll
    for (int i = 0; i < 2; ++i) { int R, C; stage_rc(tid * 16 + i * 8192, R, C); const int Rb = Epi::PERM ? ((R & ~31) + perm32(R & 31)) : R;
        voffA[i] = (unsigned)(R * K + C) * 2u; voffB[i] = (unsigned)(Rb * K + C) * 2u; }
    const size_t kstep = (size_t)(BK * 2);
    const size_t hstep = (size_t)HALF * K * 2;
    const size_t tstep = 2 * hstep;
    const unsigned ldsw = (unsigned)wid * 1024u;
    const int aoff = lds_byte(wr * 64 + fr, fq * 8), boff = lds_byte(wc * 32 + fr, fq * 8);
#define PG8_SA(b, h) (((b) * 2 + (h)) * HTB)
#define PG8_SB(b, h) ((4 + (b) * 2 + (h)) * HTB)
#define PG8_STAGE(bufoff, gbase, voff) do { _Pragma("unroll") for (int _i = 0; _i < 2; ++_i) \
        __builtin_amdgcn_global_load_lds((const unsigned*)((const char*)(gbase) + (voff)[_i]), (PG8_LAS unsigned*)(lds + (bufoff) + ldsw + _i * 8192), 16, 0, 0); } while (0)
#define PG8_LDA(dst, b, h) do { _Pragma("unroll") for (int m = 0; m < 4; ++m) _Pragma("unroll") for (int k = 0; k < 2; ++k) dst[m][k] = *(const PG8_LAS bf16x8*)(lds + PG8_SA(b, h) + aoff + m * 2048 + k * 1024); } while (0)
#define PG8_LDB(dst, b, h) do { _Pragma("unroll") for (int n = 0; n < 2; ++n) _Pragma("unroll") for (int k = 0; k < 2; ++k) dst[n][k] = *(const PG8_LAS bf16x8*)(lds + PG8_SB(b, h) + boff + n * 2048 + k * 1024); } while (0)
#define PG8_MMA(ai, bj, At, Bt) do { __builtin_amdgcn_s_setprio(1); _Pragma("unroll") for (int m = 0; m < 4; ++m) _Pragma("unroll") for (int n = 0; n < 2; ++n) _Pragma("unroll") for (int k = 0; k < 2; ++k) \
        acc[ai][bj][m][n] = __builtin_amdgcn_mfma_f32_16x16x32_bf16(Bt[n][k], At[m][k], acc[ai][bj][m][n], 0, 0, 0); __builtin_amdgcn_s_setprio(0); } while (0)
#define PG8_WAIT_V(n) asm volatile("s_waitcnt vmcnt(" #n ")" ::: "memory")
#define PG8_WAIT_L(n) asm volatile("s_waitcnt lgkmcnt(" #n ")" ::: "memory")
#define PG8_BAR __builtin_amdgcn_s_barrier()
#define PG8_SCHED __builtin_amdgcn_sched_barrier(0)
    Unit cur, nxt; int ui = 0;
    if (!S.next(0, cur)) return;
    f32x4 acc[2][2][4][2];
#pragma unroll
    for (int a = 0; a < 2; ++a)
#pragma unroll
        for (int b = 0; b < 2; ++b)
#pragma unroll
            for (int m = 0; m < 4; ++m)
#pragma unroll
                for (int n = 0; n < 2; ++n) acc[a][b][m][n] = (f32x4){0.f, 0.f, 0.f, 0.f};
    bf16x8 At[4][2], B0[2][2], B1[2][2];
    const char* cA = (const char*)g.A + (size_t)cur.pm * tstep; const char* cB = (const char*)g.Bt + (size_t)cur.pn * tstep;
    S.a_ready(cur);
    PG8_STAGE(PG8_SB(0, 0), cB, voffB); PG8_STAGE(PG8_SA(0, 0), cA, voffA); PG8_STAGE(PG8_SB(0, 1), cB + hstep, voffB); PG8_STAGE(PG8_SA(0, 1), cA + hstep, voffA);
    if (wr == 1) PG8_BAR;
    PG8_WAIT_V(4); PG8_BAR;
    PG8_STAGE(PG8_SB(1, 0), cB + kstep, voffB); PG8_STAGE(PG8_SA(1, 0), cA + kstep, voffA); PG8_STAGE(PG8_SB(1, 1), cB + hstep + kstep, voffB);
    PG8_WAIT_V(6); PG8_BAR;
    PG8_STAMP();
    for (;;) {
        const bool has_next = S.next(ui + 1, nxt);
        const char* nA = has_next ? (const char*)g.A + (size_t)nxt.pm * tstep : cA; const char* nB = has_next ? (const char*)g.Bt + (size_t)nxt.pn * tstep : cB;
        for (int t = 0; t < nt; t += 2) {
            const bool last = (t == nt - 2);
            const char* a1 = cA + (size_t)(t + 1) * kstep;
            const char* a2 = last ? nA : cA + (size_t)(t + 2) * kstep; const char* b2 = last ? nB : cB + (size_t)(t + 2) * kstep;
            const char* a3 = a2 + kstep; const char* b3 = b2 + kstep;
            if (last && has_next) S.a_ready(nxt);
            PG8_LDB(B0, 0, 0); PG8_SCHED; PG8_LDA(At, 0, 0); PG8_STAGE(PG8_SA(1, 1), a1 + hstep, voffA);
            PG8_WAIT_L(8); PG8_BAR; PG8_WAIT_L(0); PG8_MMA(0, 0, At, B0); PG8_BAR; PG8_SCHED;
            PG8_LDB(B1, 0, 1); PG8_STAGE(PG8_SB(0, 0), b2, voffB);
            PG8_BAR; PG8_WAIT_L(0); PG8_MMA(0, 1, At, B1); PG8_BAR;
            PG8_LDA(At, 0, 1); PG8_STAGE(PG8_SA(0, 0), a2, voffA);
            PG8_BAR; PG8_WAIT_L(0); PG8_MMA(1, 0, At, B0); PG8_BAR; PG8_SCHED;
            PG8_STAGE(PG8_SB(0, 1), b2 + hstep, voffB);
            PG8_WAIT_V(6); PG8_BAR; PG8_MMA(1, 1, At, B1); PG8_BAR;
            PG8_LDB(B0, 1, 0); PG8_SCHED; PG8_LDA(At, 1, 0); PG8_STAGE(PG8_SA(0, 1), a2 + hstep, voffA);
            PG8_WAIT_L(8); PG8_BAR; PG8_WAIT_L(0); PG8_MMA(0, 0, At, B0); PG8_BAR; PG8_SCHED;
            PG8_LDB(B1, 1, 1); PG8_STAGE(PG8_SB(1, 0), b3, voffB);
            PG8_BAR; PG8_WAIT_L(0); PG8_MMA(0, 1, At, B1); PG8_BAR;
            PG8_LDA(At, 1, 1); PG8_STAGE(PG8_SA(1, 0), a3, voffA);
            PG8_BAR; PG8_WAIT_L(0); PG8_MMA(1, 0, At, B0); PG8_BAR; PG8_SCHED;
            PG8_STAGE(PG8_SB(1, 1), b3 + hstep, voffB);
            PG8_WAIT_V(6); PG8_BAR; PG8_MMA(1, 1, At, B1); PG8_BAR;
        }
        PG8_STAMP();
        if constexpr (!Epi::AFTER_DRAIN) { E(acc, cur, wr, wc, fr, fq); S.done(cur); }
        PG8_STAMP();
        if (!has_next) break;
#pragma unroll
        for (int a = 0; a < 2; ++a)
#pragma unroll
            for (int b = 0; b < 2; ++b)
#pragma unroll
                for (int m = 0; m < 4; ++m)
#pragma unroll
                    for (int n = 0; n < 2; ++n) acc[a][b][m][n] = (f32x4){0.f, 0.f, 0.f, 0.f};
        cur = nxt; cA = nA; cB = nB; ++ui;
    }
    PG8_WAIT_V(0);
    if (wr == 0) PG8_BAR;
    PG8_BAR;
    if constexpr (Epi::AFTER_DRAIN) { E.fused(acc, cur, wr, wc, fr, fq, lds, wid, lane); S.done(cur); }
    PG8_STAMP();
    if (STAMP && wid == 0) { stamps[lane] = lane < nts ? (((unsigned long long)(unsigned)ts_hi << 32) | (unsigned)ts_lo) : 0ull;
        if (lane == 62) stamps[62] = rt_entry; if (lane == 63) stamps[63] = (unsigned long long)wall_clock64(); }
#undef PG8_STAMP
#undef PG8_SA
#undef PG8_SB
#undef PG8_STAGE
#undef PG8_LDA
#undef PG8_LDB
#undef PG8_MMA
#undef PG8_WAIT_V
#undef PG8_WAIT_L
#undef PG8_BAR
#undef PG8_SCHED
}
}

#ifndef PHMASK
#define PHMASK 63
#endif
using pg8::bf16_t; using pg8::bf16x8; using pg8::f32x4; using pg8::u32x4;
typedef unsigned u32x2 __attribute__((ext_vector_type(2)));
typedef short s16x4 __attribute__((ext_vector_type(4)));
typedef float f32x2 __attribute__((ext_vector_type(2)));
#define LAS __attribute__((address_space(3)))
#define DI __device__ __forceinline__

constexpr int D = 1024, DFF = 2816, GROWS = 32768, NTHR = 512;
constexpr int LDS_BYTES = 147456;
constexpr size_t MiB = 1u << 20, KiB = 1u << 10;
constexpr size_t WS_MODP = 0;
constexpr size_t WS_MOD = 6 * MiB;
constexpr size_t WS_WSP = 8 * MiB;
constexpr size_t WS_WPT = WS_WSP + 256 * KiB;
constexpr size_t WS_WF = WS_WPT + 256 * KiB;
constexpr size_t WS_FC1 = WS_WF + 256 * KiB;
constexpr size_t WS_FS1 = WS_FC1 + 256 * KiB;
constexpr size_t WS_FC16 = WS_FS1 + 256 * KiB;
constexpr size_t WS_FS16 = WS_FC16 + 256 * KiB;
constexpr size_t WS_FC2 = WS_FS16 + 256 * KiB;
constexpr size_t WS_FS2 = WS_FC2 + 256 * KiB;
constexpr size_t WS_TW128 = WS_FS2 + 256 * KiB;
constexpr size_t WS_TW16 = WS_TW128 + 256 * KiB;
constexpr size_t WS_WUP = 16 * MiB;
constexpr size_t WS_WDN = 60 * MiB;
constexpr size_t WS_EVIN = 82 * MiB, WS_ODIN = 85 * MiB, WS_EVOUT = 89 * MiB, WS_ODOUT = 91 * MiB;
constexpr size_t WS_H = 96 * MiB;
constexpr size_t WS_T = 160 * MiB;
constexpr size_t WS_BIG = 224 * MiB;
constexpr size_t WS_UB = WS_BIG + 96 * MiB;
constexpr size_t WS_END = 400 * MiB;

DI unsigned f2bf(float f) { unsigned u = __float_as_uint(f); return (u + 0x7fffu + ((u >> 16) & 1u)) >> 16; }
DI unsigned pk2(float lo, float hi) { return f2bf(lo) | (f2bf(hi) << 16); }
DI float bf_lo(unsigned w) { return __uint_as_float(w << 16); }
DI float bf_hi(unsigned w) { return __uint_as_float(w & 0xffff0000u); }
DI float wave_sum(float v) {
#pragma unroll
    for (int o = 1; o < 64; o <<= 1) v += __shfl_xor(v, o);
    return v;
}
DI float silu_f(float x) { return x * __builtin_amdgcn_rcpf(1.0f + __builtin_amdgcn_exp2f(-1.4426950408889634f * x)); }
DI f32x4 mfma16(bf16x8 a, bf16x8 b, f32x4 c) { return __builtin_amdgcn_mfma_f32_16x16x32_bf16(a, b, c, 0, 0, 0); }
typedef short v4i16_t __attribute__((ext_vector_type(4)));
DI s16x4 tr_read(LAS unsigned char* p) { return __builtin_bit_cast(s16x4, __builtin_amdgcn_ds_read_tr16_b64_v4i16((LAS v4i16_t*)p)); }
DI bf16x8 tr_frag(LAS unsigned char* p, int pitch4) {
    const s16x4 lo = tr_read(p), hi = tr_read(p + pitch4);
    bf16x8 r; r[0] = lo[0]; r[1] = lo[1]; r[2] = lo[2]; r[3] = lo[3]; r[4] = hi[0]; r[5] = hi[1]; r[6] = hi[2]; r[7] = hi[3]; return r;
}

struct Params { const float* in[25]; float* out; unsigned char* ws; int ph_lo, ph_hi; };

struct EpiGen {
    static constexpr bool PERM = true, AFTER_DRAIN = false;
    bf16_t* O; int ldc; int mode;
    __device__ __forceinline__ void operator()(const f32x4 (&acc)[2][2][4][2], const pg8::Unit& u, int wr, int wc, int fr, int fq) const {
        const int row0 = u.pm * 256 + wr * 64 + fr, cw = wc * 32 + 8 * fq;
        if (mode == 3 || (mode == 2 && u.pn < 4)) {
            const bool sw = (mode == 3);
#pragma unroll
            for (int ai = 0; ai < 2; ++ai)
#pragma unroll
                for (int m = 0; m < 4; ++m) {
                    bf16_t* rowp = O + (size_t)(row0 + ai * 128 + m * 16) * ldc + 128 * u.pn + cw;
                    f32x4 g0 = acc[ai][0][m][0], g1 = acc[ai][0][m][1]; const f32x4 u0 = acc[ai][1][m][0], u1 = acc[ai][1][m][1];
                    if (sw) {
#pragma unroll
                        for (int j = 0; j < 4; ++j) { g0[j] = silu_f(g0[j]); g1[j] = silu_f(g1[j]); }
                    }
                    const f32x4 v0 = g0 * u0, v1 = g1 * u1;
                    u32x4 w; w.x = pg8::cvt_pk_bf16(v0[0], v0[1]); w.y = pg8::cvt_pk_bf16(v0[2], v0[3]); w.z = pg8::cvt_pk_bf16(v1[0], v1[1]); w.w = pg8::cvt_pk_bf16(v1[2], v1[3]);
                    *(u32x4*)rowp = w;
                }
        } else {
            const int colbase = (mode == 2) ? 512 + 256 * (u.pn - 4) : 256 * u.pn;
            const bool ge = (mode == 1 && u.pn < 4);
#pragma unroll
            for (int ai = 0; ai < 2; ++ai)
#pragma unroll
                for (int m = 0; m < 4; ++m) {
                    bf16_t* rowp = O + (size_t)(row0 + ai * 128 + m * 16) * ldc + colbase + cw;
#pragma unroll
                    for (int bj = 0; bj < 2; ++bj) {
                        f32x4 v0 = acc[ai][bj][m][0], v1 = acc[ai][bj][m][1];
                        if (ge) { const pg8::f32x2 a = pg8::gelu_pk((pg8::f32x2){v0[0], v0[1]}), b = pg8::gelu_pk((pg8::f32x2){v0[2], v0[3]}), c = pg8::gelu_pk((pg8::f32x2){v1[0], v1[1]}), d = pg8::gelu_pk((pg8::f32x2){v1[2], v1[3]});
                            v0 = (f32x4){a.x, a.y, b.x, b.y}; v1 = (f32x4){c.x, c.y, d.x, d.y}; }
                        u32x4 w; w.x = pg8::cvt_pk_bf16(v0[0], v0[1]); w.y = pg8::cvt_pk_bf16(v0[2], v0[3]); w.z = pg8::cvt_pk_bf16(v1[0], v1[1]); w.w = pg8::cvt_pk_bf16(v1[2], v1[3]);
                        *(u32x4*)(rowp + bj * 128) = w;
                    }
                }
        }
    }
};

DI void run_gemm(LAS unsigned char* lds, const bf16_t* A, const bf16_t* Bt, int M, int N, int K, bf16_t* O, int ldc, int mode, int G) {
#if PHMASK & 4
    pg8::Gemm g{A, Bt, M, N, K}; pg8::StaticOrder S; S.init(M, N, G, (int)blockIdx.x);
    EpiGen E{O, ldc, mode};
    pg8::gemm_phase<EpiGen, pg8::StaticOrder, false>(lds, g, S, E, nullptr);
#endif
}

DI int dest_row(int n0, int mode) {
    if (mode == 1) { const int half = n0 >= DFF ? 1 : 0, n = n0 - half * DFF; return 256 * (n >> 7) + 128 * half + (n & 127); }
    if (mode == 2) { if (n0 < 512) return 256 * (n0 >> 7) + (n0 & 127); if (n0 < 1024) return 1024 + (n0 - 512); if (n0 < 1536) { const int n = n0 - 1024; return 256 * (n >> 7) + 128 + (n & 127); } return n0; }
    return n0;
}
DI void transpose_item(const float* W, int K, int N, bf16_t* WT, int mode, LAS float* scr, int item, int lane) {
    const int nblk = N / 32, kb = item / nblk, nb = item % nblk, k0 = 64 * kb, n0 = 32 * nb;
#pragma unroll 8
    for (int i = 0; i < 32; ++i) { const int kk = 2 * i + (lane >> 5); scr[kk * 33 + (lane & 31)] = W[(size_t)(k0 + kk) * N + n0 + (lane & 31)]; }
    asm volatile("s_waitcnt lgkmcnt(0)" ::: "memory");
    const int c = lane & 7, dr = dest_row(n0, mode);
#pragma unroll
    for (int j = 0; j < 4; ++j) { const int n = (lane >> 3) + 8 * j; const LAS float* s = scr + (8 * c) * 33 + n;
        u32x4 o; o.x = pk2(s[0 * 33], s[1 * 33]); o.y = pk2(s[2 * 33], s[3 * 33]); o.z = pk2(s[4 * 33], s[5 * 33]); o.w = pk2(s[6 * 33], s[7 * 33]);
        *(u32x4*)(WT + (size_t)(dr + n) * K + k0 + 8 * c) = o; }
    asm volatile("s_waitcnt lgkmcnt(0)" ::: "memory");
}

DI void setup_phase(const Params& p, LAS unsigned char* lds, int G, int tid, int wid, int lane) {
    unsigned char* ws = p.ws;
    for (int u = blockIdx.x; u < 288; u += G) {
        const int l = u / 144, rem = u % 144, cb = rem >> 2, ks = rem & 3;
        LAS float* sc = (LAS float*)lds; LAS float* red = sc + 18 * 256;
        for (int i = tid; i < 18 * 256; i += NTHR) { const int b = i >> 8, k = ks * 256 + (i & 255);
            const float c = (b < 2) ? p.in[2][b * 1024 + k] : p.in[3][(b - 2) * 1024 + k]; sc[i] = silu_f(c); }
        __syncthreads();
        const int col = tid & 255, kh = tid >> 8;
        float acc[18];
#pragma unroll
        for (int b = 0; b < 18; ++b) acc[b] = 0.f;
        const float* wp = p.in[4] + ((size_t)l * 1024 + ks * 256 + kh * 128) * 9216 + cb * 256 + col;
#pragma unroll 4
        for (int kk = 0; kk < 128; ++kk) { const float w = wp[(size_t)kk * 9216];
#pragma unroll
            for (int b = 0; b < 18; ++b) acc[b] += sc[b * 256 + kh * 128 + kk] * w; }
        if (kh == 1) {
#pragma unroll
            for (int b = 0; b < 18; ++b) red[b * 256 + col] = acc[b];
        }
        __syncthreads();
        if (kh == 0) { float* mp = (float*)(ws + WS_MODP) + ((size_t)(ks * 2 + l) * 18) * 9216 + cb * 256 + col;
#pragma unroll
            for (int b = 0; b < 18; ++b) mp[(size_t)b * 9216] = acc[b] + red[b * 256 + col]; }
        __syncthreads();
    }
    {
        LAS float* scr = (LAS float*)(lds + wid * 16384);
        const int gw = blockIdx.x * 8 + wid, NGW = G * 8;
        constexpr int I_UP = 16 * 176, I_DN = 44 * 32, I_EI = 16 * 48, I_OI = 16 * 64, I_O = 16 * 32;
        constexpr int NITEMS = 4 * I_UP + 4 * I_DN + I_EI + I_OI + 2 * I_O;
        for (int it = gw; it < NITEMS; it += NGW) {
            int r = it;
            if (r < 4 * I_UP) { const int i = r / I_UP; r -= i * I_UP; const int l = i >> 1, f = i & 1;
                transpose_item(p.in[f ? 10 : 8] + (size_t)l * 1024 * 5632, 1024, 5632, (bf16_t*)(ws + WS_WUP) + (size_t)i * 5632 * 1024, 1, scr, r, lane); continue; }
            r -= 4 * I_UP;
            if (r < 4 * I_DN) { const int i = r / I_DN; r -= i * I_DN; const int l = i >> 1, f = i & 1;
                transpose_item(p.in[f ? 11 : 9] + (size_t)l * 2816 * 1024, 2816, 1024, (bf16_t*)(ws + WS_WDN) + (size_t)i * 1024 * 2816, 0, scr, r, lane); continue; }
            r -= 4 * I_DN;
            if (r < I_EI) { transpose_item(p.in[12], 1024, 1536, (bf16_t*)(ws + WS_EVIN), 0, scr, r, lane); continue; }
            r -= I_EI;
            if (r < I_OI) { transpose_item(p.in[20], 1024, 2048, (bf16_t*)(ws + WS_ODIN), 2, scr, r, lane); continue; }
            r -= I_OI;
            if (r < I_O) { transpose_item(p.in[19], 1024, 1024, (bf16_t*)(ws + WS_EVOUT), 0, scr, r, lane); continue; }
            r -= I_O;
            transpose_item(p.in[24], 1024, 1024, (bf16_t*)(ws + WS_ODOUT), 0, scr, r, lane);
        }
    }
    {
        const int gt = blockIdx.x * NTHR + tid, NT = G * NTHR;
        bf16_t* WSP = (bf16_t*)(ws + WS_WSP); bf16_t* WPT = (bf16_t*)(ws + WS_WPT); bf16_t* WF = (bf16_t*)(ws + WS_WF);
        for (int i = gt; i < 65536; i += NT) {
            WSP[i] = (bf16_t)f2bf(p.in[15][i]);
            const int g = i >> 14, e = (i >> 7) & 127, d = i & 127;
            WPT[i] = (bf16_t)f2bf(p.in[17][(g * 128 + d) * 128 + e]);
        }
        for (int i = gt; i < 131072; i += NT) {
            const int g = i >> 15, n = (i >> 7) & 255, d = i & 127, comp = n >> 7, e = n & 127;
            const float* fw = p.in[23] + (size_t)g * 16384 + e; float s = 0.f;
            for (int m = 0; m < 128; ++m) { const float x = (float)((m * d) & 127) * (1.0f / 64.0f); s += (comp ? sinpif(x) : cospif(x)) * fw[m * 128]; }
            WF[i] = (bf16_t)f2bf(s * p.in[22][g * 128 + d]);
        }
        bf16_t* FC1 = (bf16_t*)(ws + WS_FC1); bf16_t* FS1 = (bf16_t*)(ws + WS_FS1); bf16_t* FC2 = (bf16_t*)(ws + WS_FC2); bf16_t* FS2 = (bf16_t*)(ws + WS_FS2);
        f32x2* TW128 = (f32x2*)(ws + WS_TW128);
        for (int i = gt; i < 16384; i += NT) {
            const int k1 = i >> 7, col = i & 127, s = col >> 5, j = col & 31, fqq = j >> 3, ii = j & 7;
            const int r = 32 * s + (ii < 4 ? fqq * 4 + ii : 16 + fqq * 4 + ii - 4);
            const float x = (float)((k1 * r) & 127) * (1.0f / 64.0f);
            FC1[i] = (bf16_t)f2bf(cospif(x)); FS1[i] = (bf16_t)f2bf(sinpif(x));
            const float y = (float)((k1 * col) & 127) * (1.0f / 64.0f);
            FC2[i] = (bf16_t)f2bf(cospif(y)); FS2[i] = (bf16_t)f2bf(sinpif(y));
            const float z = (float)(k1 * col) * (1.0f / 8192.0f);
            TW128[i] = (f32x2){cospif(z), sinpif(z)};
        }
        bf16_t* FC16 = (bf16_t*)(ws + WS_FC16); bf16_t* FS16 = (bf16_t*)(ws + WS_FS16);
        for (int i = gt; i < 512; i += NT) {
            const int k1 = i >> 5, j = i & 31, fqq = j >> 3, ii = j & 7;
            float c = 0.f, s = 0.f;
            if (ii < 4) { const int r = fqq * 4 + ii; const float x = (float)((k1 * r) & 15) * (1.0f / 8.0f); c = cospif(x); s = sinpif(x); }
            FC16[i] = (bf16_t)f2bf(c); FS16[i] = (bf16_t)f2bf(s);
        }
        f32x2* TW16 = (f32x2*)(ws + WS_TW16);
        for (int i = gt; i < 2048; i += NT) { const int q = i >> 4, k1 = i & 15; const float z = (float)(k1 * q) * (1.0f / 1024.0f); TW16[i] = (f32x2){cospif(z), sinpif(z)}; }
    }
}

DI void modreduce_phase(const Params& p, int G, int tid) {
    const float* mp = (const float*)(p.ws + WS_MODP); float* mod = (float*)(p.ws + WS_MOD);
    for (int i = blockIdx.x * NTHR + tid; i < 2 * 18 * 9216; i += G * NTHR) {
        const int l = i / (18 * 9216), j = i % 9216;
        float s = p.in[5][l * 9216 + j];
#pragma unroll
        for (int ks = 0; ks < 4; ++ks) s += mp[(size_t)ks * (2 * 18 * 9216) + i];
        mod[i] = s;
    }
}

DI void norm_phase(const float* xin, float* xout, const bf16_t* T, bf16_t* H, bool has_prev, bool has_next,
                   const float* gate_base, const float* gpost, float rw, const float* ss_base, const float* gpre, int gi, int G, int wid, int lane) {
    const int gw = blockIdx.x * 8 + wid, NGW = G * 8;
    for (int r = gw; r < GROWS; r += NGW) {
        const int bidx = (gi == 0) ? (r >> 14) : 2 + (r >> 11);
        const f32x4* xr = (const f32x4*)(xin + (size_t)r * D) + lane;
        f32x4 v[4];
#pragma unroll
        for (int j = 0; j < 4; ++j) v[j] = xr[64 * j];
        if (has_prev) {
            const u32x2* tr = (const u32x2*)(T + (size_t)r * D) + lane;
            f32x4 tv[4]; float ss = 0.f;
#pragma unroll
            for (int j = 0; j < 4; ++j) { const u32x2 w = tr[64 * j]; tv[j] = (f32x4){bf_lo(w.x), bf_hi(w.x), bf_lo(w.y), bf_hi(w.y)};
                ss += (tv[j][0] * tv[j][0] + tv[j][1] * tv[j][1]) + (tv[j][2] * tv[j][2] + tv[j][3] * tv[j][3]); }
            const float rstd = rsqrtf(wave_sum(ss) * (1.0f / D) + 1e-6f) * rw;
            const f32x4* gp = (const f32x4*)gpost + lane; const f32x4* gt = (const f32x4*)(gate_base + (size_t)bidx * 9216) + lane;
            f32x4* xo = (f32x4*)(xout + (size_t)r * D) + lane;
#pragma unroll
            for (int j = 0; j < 4; ++j) { v[j] = v[j] + (gt[64 * j] + 1.0f) * (tv[j] * rstd) * gp[64 * j]; xo[64 * j] = v[j]; }
        }
        if (has_next) {
            float ss = 0.f;
#pragma unroll
            for (int j = 0; j < 4; ++j) ss += (v[j][0] * v[j][0] + v[j][1] * v[j][1]) + (v[j][2] * v[j][2] + v[j][3] * v[j][3]);
            const float rstd = rsqrtf(wave_sum(ss) * (1.0f / D) + 1e-6f);
            const f32x4* gp = (const f32x4*)gpre + lane; const f32x4* sh = (const f32x4*)(ss_base + (size_t)bidx * 9216) + lane; const f32x4* sc = sh + 256;
            u32x2* ho = (u32x2*)(H + (size_t)r * D) + lane;
#pragma unroll
            for (int j = 0; j < 4; ++j) { const f32x4 h = (v[j] * rstd) * gp[64 * j] * (sc[64 * j] + 1.0f) + sh[64 * j];
                u32x2 w; w.x = pk2(h[0], h[1]); w.y = pk2(h[2], h[3]); ho[64 * j] = w; }
        }
    }
}

DI void even_core(LAS unsigned char* lds, const bf16_t* PR, bf16_t* YY, const bf16_t* WSP, const bf16_t* WPT, const float* ln_g, const float* ln_b,
                  const float* b_sp, const float* pool_scale, int S, int G, int tid, int wid, int lane) {
    const int fr = lane & 15, fq = lane >> 4;
    constexpr int PITCH = 1056;
    for (int ch = blockIdx.x; ch < GROWS / 128; ch += G) {
        const size_t tok0 = (size_t)ch * 128;
        {
            const f32x4 g0 = *(const f32x4*)(ln_g + lane * 8), g1 = *(const f32x4*)(ln_g + lane * 8 + 4), b0 = *(const f32x4*)(ln_b + lane * 8), b1 = *(const f32x4*)(ln_b + lane * 8 + 4);
            for (int i = 0; i < 16; ++i) {
                const int q = wid * 16 + i;
                const u32x4 w = *(const u32x4*)(PR + (tok0 + q) * 1536 + 512 + lane * 8);
                f32x4 a = (f32x4){bf_lo(w.x), bf_hi(w.x), bf_lo(w.y), bf_hi(w.y)}, b = (f32x4){bf_lo(w.z), bf_hi(w.z), bf_lo(w.w), bf_hi(w.w)};
                const float mean = wave_sum((a[0] + a[1]) + (a[2] + a[3]) + (b[0] + b[1]) + (b[2] + b[3])) * (1.0f / 512.0f);
                a = a - mean; b = b - mean;
                const float var = wave_sum((a[0] * a[0] + a[1] * a[1]) + (a[2] * a[2] + a[3] * a[3]) + (b[0] * b[0] + b[1] * b[1]) + (b[2] * b[2] + b[3] * b[3])) * (1.0f / 512.0f);
                const float rstd = rsqrtf(var + 1e-5f);
                a = a * rstd * g0 + b0; b = b * rstd * g1 + b1;
                u32x4 o; o.x = pk2(a[0], a[1]); o.y = pk2(a[2], a[3]); o.z = pk2(b[0], b[1]); o.w = pk2(b[2], b[3]);
                *(LAS u32x4*)(lds + q * PITCH + lane * 16) = o;
            }
        }
        __syncthreads();
        {
            const int h = wid >> 1, cw0 = wid * 64;
            for (int ph = 0; ph < 2; ++ph) {
                f32x4 acc[4][4];
#pragma unroll
                for (int a = 0; a < 4; ++a)
#pragma unroll
                    for (int b = 0; b < 4; ++b) acc[a][b] = (f32x4){0.f, 0.f, 0.f, 0.f};
#pragma unroll
                for (int ks = 0; ks < 4; ++ks) {
                    bf16x8 af[4], bw[4];
#pragma unroll
                    for (int ct = 0; ct < 4; ++ct) af[ct] = tr_frag(lds + (ks * 32 + fq * 8 + (fr >> 2)) * PITCH + (cw0 + ct * 16 + 4 * (fr & 3)) * 2, 4 * PITCH);
#pragma unroll
                    for (int pt = 0; pt < 4; ++pt) bw[pt] = *(const bf16x8*)(WSP + ((h * 128 + (ph * 4 + pt) * 16 + fr) * 128 + ks * 32 + fq * 8));
#pragma unroll
                    for (int ct = 0; ct < 4; ++ct)
#pragma unroll
                        for (int pt = 0; pt < 4; ++pt) acc[ct][pt] = mfma16(af[ct], bw[pt], acc[ct][pt]);
                }
#pragma unroll
                for (int pt = 0; pt < 4; ++pt) {
                    const int pp = (ph * 4 + pt) * 16 + fr; const float bs = b_sp[h * 128 + pp];
#pragma unroll
                    for (int ct = 0; ct < 4; ++ct) {
                        const int c = cw0 + ct * 16 + fq * 4;
                        const u32x2 uw = *(const u32x2*)(PR + (tok0 + pp) * 1536 + c);
                        u32x2 o; o.x = pk2(bf_lo(uw.x) * (acc[ct][pt][0] + bs), bf_hi(uw.x) * (acc[ct][pt][1] + bs)); o.y = pk2(bf_lo(uw.y) * (acc[ct][pt][2] + bs), bf_hi(uw.y) * (acc[ct][pt][3] + bs));
                        *(u32x2*)(YY + (tok0 + pp) * 1024 + c) = o;
                    }
                }
            }
        }
        {
            const int tl = wid * 16 + fr; const int pos = (int)(tok0 % (size_t)S) + tl;
            for (int g = 0; g < 4; ++g) {
                const int hw = 1 << g; const int lo = max(pos - hw, 0), hi = min(pos + hw, S); const float inv = 1.0f / (float)(hi - lo);
                f32x4 acc[8];
#pragma unroll
                for (int e = 0; e < 8; ++e) acc[e] = (f32x4){0.f, 0.f, 0.f, 0.f};
#pragma unroll
                for (int ks = 0; ks < 4; ++ks) {
                    const bf16_t* zc = PR + (tok0 + tl) * 1536 + 1024 + g * 128 + ks * 32 + fq * 8;
                    f32x4 s0 = (f32x4){0.f, 0.f, 0.f, 0.f}, s1 = s0;
                    for (int t2 = lo; t2 < hi; ++t2) { const u32x4 w = *(const u32x4*)(zc + (ptrdiff_t)(t2 - pos) * 1536);
                        s0 += (f32x4){bf_lo(w.x), bf_hi(w.x), bf_lo(w.y), bf_hi(w.y)}; s1 += (f32x4){bf_lo(w.z), bf_hi(w.z), bf_lo(w.w), bf_hi(w.w)}; }
                    const u32x4 cw = *(const u32x4*)zc;
                    s0 = s0 * inv - (f32x4){bf_lo(cw.x), bf_hi(cw.x), bf_lo(cw.y), bf_hi(cw.y)}; s1 = s1 * inv - (f32x4){bf_lo(cw.z), bf_hi(cw.z), bf_lo(cw.w), bf_hi(cw.w)};
                    u32x4 dw; dw.x = pk2(s0[0], s0[1]); dw.y = pk2(s0[2], s0[3]); dw.z = pk2(s1[0], s1[1]); dw.w = pk2(s1[2], s1[3]);
                    const bf16x8 df = __builtin_bit_cast(bf16x8, dw);
#pragma unroll
                    for (int et = 0; et < 8; ++et) { const bf16x8 wf = *(const bf16x8*)(WPT + ((g * 128 + et * 16 + fr) * 128 + ks * 32 + fq * 8)); acc[et] = mfma16(wf, df, acc[et]); }
                }
#pragma unroll
                for (int et = 0; et < 8; ++et) { const int e = g * 128 + et * 16 + fq * 4; const f32x4 ps = *(const f32x4*)(pool_scale + e); const f32x4 y = acc[et] * ps;
                    u32x2 o; o.x = pk2(y[0], y[1]); o.y = pk2(y[2], y[3]); *(u32x2*)(YY + (tok0 + tl) * 1024 + 512 + e) = o; }
            }
        }
        __syncthreads();
    }
}

DI void conv_part(const bf16_t* PR, bf16_t* YY, const float* conv_w, int S, int G, int wid, int lane) {
    const int gw = blockIdx.x * 8 + wid, NGW = G * 8;
    f32x4 w[3][2];
#pragma unroll
    for (int k = 0; k < 3; ++k) { w[k][0] = *(const f32x4*)(conv_w + k * 512 + lane * 8); w[k][1] = *(const f32x4*)(conv_w + k * 512 + lane * 8 + 4); }
    for (int r = gw; r < GROWS; r += NGW) {
        const int pos = r % S;
        const bf16_t* cz = PR + (size_t)r * 1536 + lane * 8;
        const u32x4 z = (u32x4){0u, 0u, 0u, 0u};
        const u32x4 c1 = *(const u32x4*)cz, c0 = (pos > 0) ? *(const u32x4*)(cz - 1536) : z, c2 = (pos < S - 1) ? *(const u32x4*)(cz + 1536) : z, bg = *(const u32x4*)(cz + 512);
        f32x4 a0 = (f32x4){bf_lo(c0.x), bf_hi(c0.x), bf_lo(c0.y), bf_hi(c0.y)} * w[0][0] + (f32x4){bf_lo(c1.x), bf_hi(c1.x), bf_lo(c1.y), bf_hi(c1.y)} * w[1][0] + (f32x4){bf_lo(c2.x), bf_hi(c2.x), bf_lo(c2.y), bf_hi(c2.y)} * w[2][0];
        f32x4 a1 = (f32x4){bf_lo(c0.z), bf_hi(c0.z), bf_lo(c0.w), bf_hi(c0.w)} * w[0][1] + (f32x4){bf_lo(c1.z), bf_hi(c1.z), bf_lo(c1.w), bf_hi(c1.w)} * w[1][1] + (f32x4){bf_lo(c2.z), bf_hi(c2.z), bf_lo(c2.w), bf_hi(c2.w)} * w[2][1];
        a0 = a0 * (f32x4){bf_lo(bg.x), bf_hi(bg.x), bf_lo(bg.y), bf_hi(bg.y)}; a1 = a1 * (f32x4){bf_lo(bg.z), bf_hi(bg.z), bf_lo(bg.w), bf_hi(bg.w)};
        u32x4 o; o.x = pk2(a0[0], a0[1]); o.y = pk2(a0[2], a0[3]); o.z = pk2(a1[0], a1[1]); o.w = pk2(a1[2], a1[3]);
        *(u32x4*)(YY + (size_t)r * 1024 + lane * 8) = o;
    }
}

template <int R>
DI void four_stage1(const bf16_t* PR, bf16_t* UB, const bf16_t* WF, const bf16_t* FCp, const bf16_t* FSp, const f32x2* TW, int nb, int G, int wid, int lane) {
    constexpr int NT = R / 16, KS = (R + 31) / 32, KW = KS * 32, S = R * 128;
    const int fr = lane & 15, fq = lane >> 4, e0 = wid * 16;
    const int nunits = nb * 4 * 128;
    for (int un = blockIdx.x; un < nunits; un += G) {
        const int q = un & 127, g = (un >> 7) & 3, b = un >> 9;
        bf16x8 wP[4], wQ[4];
#pragma unroll
        for (int ks = 0; ks < 4; ++ks) { wP[ks] = *(const bf16x8*)(WF + ((g * 256 + e0 + fr) * 128 + ks * 32 + fq * 8)); wQ[ks] = *(const bf16x8*)(WF + ((g * 256 + 128 + e0 + fr) * 128 + ks * 32 + fq * 8)); }
        unsigned pP[NT][2], pQ[NT][2];
#pragma unroll
        for (int rt = 0; rt < NT; ++rt) {
            const size_t tok = (size_t)b * S + 128 * (rt * 16 + fr) + q;
            const bf16_t* zp = PR + tok * 1536 + 1024 + g * 128 + fq * 8;
            bf16x8 a[4]; float ss = 0.f;
#pragma unroll
            for (int ks = 0; ks < 4; ++ks) { a[ks] = *(const bf16x8*)(zp + ks * 32);
#pragma unroll
                for (int k = 0; k < 8; ++k) { const float f = __uint_as_float(((unsigned)(unsigned short)a[ks][k]) << 16); ss += f * f; } }
            ss += __shfl_xor(ss, 16); ss += __shfl_xor(ss, 32);
            const float rs = rsqrtf(ss * (1.0f / 128.0f) + 1e-6f);
            f32x4 dP = (f32x4){0.f, 0.f, 0.f, 0.f}, dQ = dP;
#pragma unroll
            for (int ks = 0; ks < 4; ++ks) { dP = mfma16(a[ks], wP[ks], dP); dQ = mfma16(a[ks], wQ[ks], dQ); }
#pragma unroll
            for (int j = 0; j < 4; ++j) { const float sj = __shfl(rs, fq * 4 + j); dP[j] *= sj; dQ[j] *= sj; }
            pP[rt][0] = pk2(dP[0], dP[1]); pP[rt][1] = pk2(dP[2], dP[3]); pQ[rt][0] = pk2(dQ[0], dQ[1]); pQ[rt][1] = pk2(dQ[2], dQ[3]);
            asm volatile("" ::: "memory");
        }
#pragma unroll 1
        for (int k1t = 0; k1t < NT; ++k1t) {
            f32x4 Ur = (f32x4){0.f, 0.f, 0.f, 0.f}, V = Ur;
#pragma unroll
            for (int s = 0; s < KS; ++s) {
                u32x4 bp, bq;
                bp.x = pP[2 * s][0]; bp.y = pP[2 * s][1]; bq.x = pQ[2 * s][0]; bq.y = pQ[2 * s][1];
                if (2 * s + 1 < NT) { bp.z = pP[(2 * s + 1) % NT][0]; bp.w = pP[(2 * s + 1) % NT][1]; bq.z = pQ[(2 * s + 1) % NT][0]; bq.w = pQ[(2 * s + 1) % NT][1]; }
                else { bp.z = 0u; bp.w = 0u; bq.z = 0u; bq.w = 0u; }
                const u32x4 bnq = bq ^ 0x80008000u;
                const bf16x8 aC = *(const bf16x8*)(FCp + ((k1t * 16 + fr) * KW + s * 32 + fq * 8)), aS = *(const bf16x8*)(FSp + ((k1t * 16 + fr) * KW + s * 32 + fq * 8));
                const bf16x8 BP = __builtin_bit_cast(bf16x8, bp), BQ = __builtin_bit_cast(bf16x8, bq), BNQ = __builtin_bit_cast(bf16x8, bnq);
                Ur = mfma16(aC, BP, Ur); Ur = mfma16(aS, BNQ, Ur); V = mfma16(aS, BP, V); V = mfma16(aC, BQ, V);
            }
#pragma unroll
            for (int j = 0; j < 4; ++j) {
                const int k1 = k1t * 16 + fq * 4 + j; const f32x2 tw = TW[q * R + k1];
                const float upr = Ur[j] * tw.x - V[j] * tw.y, upi = -(V[j] * tw.x + Ur[j] * tw.y);
                bf16_t* o = UB + ((((size_t)b * R + k1) * 2) * 128 + q) * 512 + g * 128 + e0 + fr;
                o[0] = (bf16_t)f2bf(upr); o[(size_t)128 * 512] = (bf16_t)f2bf(upi);
            }
        }
    }
}

template <int R>
DI void four_stage2(LAS unsigned char* lds, const bf16_t* UB, bf16_t* YY, const bf16_t* FC2, const bf16_t* FS2, int nb, int G, int tid, int wid, int lane) {
    constexpr int PITCH2 = 544, S = R * 128;
    const float norm = rsqrtf((float)S * 128.0f);
    const int fr = lane & 15, fq = lane >> 4, c0 = wid * 32;
    const int nunits = nb * R * 2;
    for (int un = blockIdx.x; un < nunits; un += G) {
        const int ch2 = un & 1, k1 = (un >> 1) % R, b = (un >> 1) / R;
        const bf16_t* src = UB + (((size_t)b * R + k1) * 2) * 128 * 512 + ch2 * 256;
#pragma unroll 4
        for (int pass = 0; pass < 16; ++pass) { const int row = pass * 16 + (tid >> 5), seg = tid & 31;
            const u32x4 w = *(const u32x4*)(src + (size_t)row * 512 + seg * 8); *(LAS u32x4*)(lds + row * PITCH2 + seg * 16) = w; }
        __syncthreads();
        f32x4 acc[2][8];
#pragma unroll
        for (int a = 0; a < 2; ++a)
#pragma unroll
            for (int k = 0; k < 8; ++k) acc[a][k] = (f32x4){0.f, 0.f, 0.f, 0.f};
#pragma unroll 1
        for (int comp = 0; comp < 2; ++comp)
#pragma unroll 1
            for (int ks = 0; ks < 4; ++ks) {
                bf16x8 uf[2];
#pragma unroll
                for (int ct = 0; ct < 2; ++ct) uf[ct] = tr_frag(lds + (comp * 128 + ks * 32 + fq * 8 + (fr >> 2)) * PITCH2 + (c0 + ct * 16 + 4 * (fr & 3)) * 2, 4 * PITCH2);
                const bf16_t* Ft = comp ? FS2 : FC2;
#pragma unroll
                for (int k2t = 0; k2t < 8; ++k2t) { const bf16x8 fa = *(const bf16x8*)(Ft + ((k2t * 16 + fr) * 128 + ks * 32 + fq * 8));
#pragma unroll
                    for (int ct = 0; ct < 2; ++ct) acc[ct][k2t] = mfma16(uf[ct], fa, acc[ct][k2t]); }
            }
#pragma unroll
        for (int k2t = 0; k2t < 8; ++k2t) {
            const size_t tok = (size_t)b * S + (size_t)R * (k2t * 16 + fr) + k1;
#pragma unroll
            for (int ct = 0; ct < 2; ++ct) { const f32x4 y = acc[ct][k2t] * norm; u32x2 o; o.x = pk2(y[0], y[1]); o.y = pk2(y[2], y[3]);
                *(u32x2*)(YY + tok * 1024 + 512 + ch2 * 256 + c0 + ct * 16 + fq * 4) = o; }
        }
        __syncthreads();
    }
}

__global__ void __launch_bounds__(NTHR, 2) mega_fwd(Params p) {
    extern __shared__ __attribute__((aligned(16))) unsigned char lds_raw[];
    LAS unsigned char* lds = (LAS unsigned char*)lds_raw;
    cg::grid_group grid = cg::this_grid();
    const int tid = threadIdx.x, lane = tid & 63, wid = __builtin_amdgcn_readfirstlane(tid >> 6), G = gridDim.x;
    unsigned char* ws = p.ws;
    int pc = 0;
#define PH_BEGIN if (pc >= p.ph_lo && pc < p.ph_hi) {
#define PH_END } ++pc; if (pc > p.ph_lo && pc < p.ph_hi) grid.sync();

    PH_BEGIN
#if PHMASK & 1
 setup_phase(p, lds, G, tid, wid, lane);
#endif
 PH_END
    PH_BEGIN modreduce_phase(p, G, tid); PH_END

    bf16_t* H = (bf16_t*)(ws + WS_H); bf16_t* T = (bf16_t*)(ws + WS_T); bf16_t* BIG = (bf16_t*)(ws + WS_BIG); bf16_t* UB = (bf16_t*)(ws + WS_UB);
    const float* mod = (const float*)(ws + WS_MOD);
    for (int gi = 0; gi < 2; ++gi) {
        const int S = gi ? 2048 : 16384, nb = gi ? 16 : 2;
        const float* xsrc = p.in[gi];
        float* xo = p.out + (size_t)gi * GROWS * D;
        for (int ls = 0; ls < 7; ++ls) {
            const int l = ls / 3, sub = ls % 3;
            const bool odd = (l & 1), last = (ls == 6), first = (ls == 0);
            const int nsteps = last ? 1 : (sub != 1 ? 3 : (odd ? 5 : 4));
            for (int step = 0; step < nsteps; ++step) {
                int kind = 1;
                if (step == 0) kind = 0;
                else if (sub == 1 && step == 2) kind = odd ? 3 : 2;
                else if (sub == 1 && odd && step == 3) kind = 4;
                PH_BEGIN
                int tid = threadIdx.x; asm volatile("" : "+v"(tid));
                const int lane = tid & 63, wid = __builtin_amdgcn_readfirstlane(tid >> 6);
                if (kind == 0) {
#if PHMASK & 2
                    const int lp = sub > 0 ? l : l - 1, sp = sub > 0 ? sub - 1 : 2, lpp = first ? 0 : lp, lc = last ? 0 : l;
                    norm_phase(ls <= 1 ? xsrc : xo, xo, T, H, !first, !last,
                               mod + (size_t)lpp * 18 * 9216 + (sp * 3 + 2) * 1024, p.in[7] + (lpp * 3 + sp) * 1024, sp == 1 ? 1.0f : 0.5f,
                               mod + (size_t)lc * 18 * 9216 + (sub * 3) * 1024, p.in[6] + (lc * 3 + sub) * 1024, gi, G, wid, lane);
#endif
                } else if (kind == 1) {
                    const bf16_t* A; const bf16_t* Bt; bf16_t* O; int N, K, ldc, mode;
                    if (sub != 1) {
                        const int wi = l * 2 + (sub >> 1);
                        if (step == 1) { A = H; Bt = (const bf16_t*)(ws + WS_WUP) + (size_t)wi * 5632 * 1024; O = BIG; N = 5632; K = 1024; ldc = DFF; mode = 3; }
                        else { A = BIG; Bt = (const bf16_t*)(ws + WS_WDN) + (size_t)wi * 1024 * 2816; O = T; N = 1024; K = DFF; ldc = D; mode = 0; }
                    } else if (step == 1) { A = H; Bt = (const bf16_t*)(ws + (odd ? WS_ODIN : WS_EVIN)); O = BIG; N = odd ? 2048 : 1536; K = 1024; ldc = 1536; mode = odd ? 2 : 1; }
                    else { A = H; Bt = (const bf16_t*)(ws + (odd ? WS_ODOUT : WS_EVOUT)); O = T; N = 1024; K = 1024; ldc = D; mode = 0; }
                    run_gemm(lds, A, Bt, GROWS, N, K, O, ldc, mode, G);
                } else if (kind == 2) {
#if PHMASK & 8
                    even_core(lds, BIG, H, (const bf16_t*)(ws + WS_WSP), (const bf16_t*)(ws + WS_WPT), p.in[13], p.in[14], p.in[16], p.in[18], S, G, tid, wid, lane);
#endif
                } else if (kind == 3) {
#if PHMASK & 16
                    conv_part(BIG, H, p.in[21], S, G, wid, lane);
                    if (gi == 0) four_stage1<128>(BIG, UB, (const bf16_t*)(ws + WS_WF), (const bf16_t*)(ws + WS_FC1), (const bf16_t*)(ws + WS_FS1), (const f32x2*)(ws + WS_TW128), nb, G, wid, lane);
                    else four_stage1<16>(BIG, UB, (const bf16_t*)(ws + WS_WF), (const bf16_t*)(ws + WS_FC16), (const bf16_t*)(ws + WS_FS16), (const f32x2*)(ws + WS_TW16), nb, G, wid, lane);
#endif
                } else {
#if PHMASK & 32
                    if (gi == 0) four_stage2<128>(lds, UB, H, (const bf16_t*)(ws + WS_FC2), (const bf16_t*)(ws + WS_FS2), nb, G, tid, wid, lane);
                    else four_stage2<16>(lds, UB, H, (const bf16_t*)(ws + WS_FC2), (const bf16_t*)(ws + WS_FS2), nb, G, tid, wid, lane);
#endif
                }
                PH_END
            }
        }
    }
}

extern "C" void kernel_launch(void* const* d_in, const int* in_sizes, int n_in, void* d_out, int out_size, void* d_ws, size_t ws_size, hipStream_t stream) {
    static int grid = 0;
    if (grid == 0) {
        if (n_in != 25 || ws_size < WS_END || out_size != 2 * GROWS * D) { fprintf(stderr, "kernel_launch: unexpected shapes (n_in %d, out %d, ws %zu)\n", n_in, out_size, ws_size); grid = -1; return; }
        int dev = 0, cus = 0, per_cu = 0;
        hipGetDevice(&dev); hipDeviceGetAttribute(&cus, hipDeviceAttributeMultiprocessorCount, dev);
        hipFuncSetAttribute((const void*)mega_fwd, hipFuncAttributeMaxDynamicSharedMemorySize, LDS_BYTES);
        if (hipOccupancyMaxActiveBlocksPerMultiprocessor(&per_cu, (const void*)mega_fwd, NTHR, LDS_BYTES) != hipSuccess || per_cu < 1) per_cu = 1;
        (void)hipGetLastError();
        grid = cus * 1;
    }
    if (grid < 0) return;
    Params p{};
    for (int i = 0; i < 25; ++i) p.in[i] = (const float*)d_in[i];
    p.out = (float*)d_out; p.ws = (unsigned char*)d_ws; p.ph_lo = 0; p.ph_hi = 1 << 20;
    void* args[] = {&p};
    hipError_t e = hipLaunchCooperativeKernel((const void*)mega_fwd, dim3(grid), dim3(NTHR), args, LDS_BYTES, stream);
    if (e != hipSuccess) fprintf(stderr, "cooperative launch failed: %s (grid %d)\n", hipGetErrorString(e), grid);
}
```

```cpp
#include <hip/hip_runtime.h>
#include <hip/hip_cooperative_groups.h>
#include <cstdio>
namespace cg = cooperative_groups;
namespace pg8 {
#define PG8_LAS __attribute__((address_space(3)))
typedef unsigned short bf16_t;
typedef short bf16x8 __attribute__((ext_vector_type(8)));
typedef float f32x4 __attribute__((ext_vector_type(4)));
typedef unsigned u32x4 __attribute__((ext_vector_type(4)));
constexpr int BM = 256, BK = 64, HALF = 128, HTB = HALF * BK * 2  , STAGE_BYTES = 8 * HTB, NXCD = 8, WGM = 8;

__host__ __device__ __forceinline__ int lds_byte(int r, int c) { const int st = (r >> 4) * 2 + (c >> 5), rr = r & 15, cc = c & 31, ob = rr * 64 + cc * 2; return st * 1024 + (ob ^ (((ob >> 9) & 1) << 5)); }
__host__ __device__ __forceinline__ void stage_rc(int b, int& R, int& C) { const int st = b / 1024, sb = b % 1024, swz = sb ^ (((sb >> 9) & 1) << 5); R = (st >> 1) * 16 + swz / 64; C = (st & 1) * 32 + (swz % 64) / 2; }
__host__ __device__ __forceinline__ int perm32(int rho) { const int n = rho >> 4, i = rho & 15; return 8 * (i >> 2) + 4 * n + (i & 3); }

struct Unit { int pm, pn; };
struct Gemm { const bf16_t* A; const bf16_t* Bt; int M, N, K; };

struct StaticOrder {
    int nM, nN, nwg, G, c;
    __host__ __device__ void init(int M, int N, int G_, int c_) { nM = M / BM; nN = N / BM; nwg = nM * nN; G = G_; c = c_; }
    __host__ __device__ bool next(int i, Unit& u) const {
        const long L = (long)i * G + c; if (L >= nwg) return false;
        int wgid = (int)L; { const int q = nwg / NXCD, r = nwg % NXCD, xcd = wgid % NXCD, off = wgid / NXCD; wgid = (xcd < r ? xcd * (q + 1) : r * (q + 1) + (xcd - r) * q) + off; }
        const int nig = WGM * nN, gid = wgid / nig, fm = gid * WGM, gsz = (nM - fm) < WGM ? (nM - fm) : WGM;
        u.pm = fm + ((wgid % nig) % gsz); u.pn = (wgid % nig) / gsz; return true;
    }
    __device__ __forceinline__ void a_ready(const Unit&) const {}
    __device__ __forceinline__ void done(const Unit&) const {}
};
__device__ __forceinline__ unsigned cvt_pk_bf16(float lo, float hi) { unsigned r; asm volatile("v_cvt_pk_bf16_f32 %0, %1, %2" : "=v"(r) : "v"(lo), "v"(hi)); return r; }
typedef float f32x2 __attribute__((ext_vector_type(2)));
__device__ __forceinline__ f32x2 gelu_pk(f32x2 v) {
    const f32x2 av = __builtin_elementwise_abs(v), d = av * 0.2316418882f + 1.0f;
    f32x2 t; t.x = __builtin_amdgcn_rcpf(d.x); t.y = __builtin_amdgcn_rcpf(d.y);
    f32x2 q = t * 0.5307027145f + (-0.7265760135f); q = q * t + 0.7107068705f; q = q * t + (-0.142248368f); q = q * t + 0.127414796f; q = q * t;
    const f32x2 s = (v * v) * (-0.72134752044f);
    f32x2 e; e.x = __builtin_amdgcn_exp2f(s.x); e.y = __builtin_amdgcn_exp2f(s.y);
    const f32x2 m = v * (q * e), r = v - m;
    f32x2 o; o.x = v.x < 0.f ? m.x : r.x; o.y = v.y < 0.f ? m.y : r.y; return o;
}
template <class Epi, class Sched, bool STAMP = false>
__device__ __forceinline__ void gemm_phase(PG8_LAS unsigned char* lds, const Gemm g, const Sched& S, const Epi& E, unsigned long long* stamps) {
    int tid_o = threadIdx.x; asm volatile("" : "+v"(tid_o));
    const int tid = tid_o, wid = __builtin_amdgcn_readfirstlane(tid >> 6), lane = tid & 63, wr = wid >> 2, wc = wid & 3, fr = lane & 15, fq = lane >> 4;
    const int K = g.K, nt = K / BK;
    int ts_lo = 0, ts_hi = 0, nts = 0; const unsigned long long rt_entry = STAMP ? (unsigned long long)wall_clock64() : 0ull;
#define PG8_STAMP() do { if (STAMP && wid == 0 && nts < 64) { const unsigned long long _c = (unsigned long long)clock64(); \
        ts_lo = (lane == nts) ? (int)(unsigned)_c : ts_lo; ts_hi = (lane == nts) ? (int)(unsigned)(_c >> 32) : ts_hi; ++nts; } } while (0)
    PG8_STAMP();
    unsigned voffA[2], voffB[2];
#pragma unroll
    for (int i = 0; i < 2; ++i) { int R, C; stage_rc(tid * 16 + i * 8192, R, C); const int Rb = Epi::PERM ? ((R & ~31) + perm32(R & 31)) : R;
        voffA[i] = (unsigned)(R * K + C) * 2u; voffB[i] = (unsigned)(Rb * K + C) * 2u; }
    const size_t kstep = (size_t)(BK * 2);
    const size_t hstep = (size_t)HALF * K * 2;
    const size_t tstep = 2 * hstep;
    const unsigned ldsw = (unsigned)wid * 1024u;
    const int aoff = lds_byte(wr * 64 + fr, fq * 8), boff = lds_byte(wc * 32 + fr, fq * 8);
#define PG8_SA(b, h) (((b) * 2 + (h)) * HTB)
#define PG8_SB(b, h) ((4 + (b) * 2 + (h)) * HTB)
#define PG8_STAGE(bufoff, gbase, voff) do { _Pragma("unroll") for (int _i = 0; _i < 2; ++_i) \
        __builtin_amdgcn_global_load_lds((const unsigned*)((const char*)(gbase) + (voff)[_i]), (PG8_LAS unsigned*)(lds + (bufoff) + ldsw + _i * 8192), 16, 0, 0); } while (0)
#define PG8_LDA(dst, b, h) do { _Pragma("unroll") for (int m = 0; m < 4; ++m) _Pragma("unroll") for (int k = 0; k < 2; ++k) dst[m][k] = *(const PG8_LAS bf16x8*)(lds + PG8_SA(b, h) + aoff + m * 2048 + k * 1024); } while (0)
#define PG8_LDB(dst, b, h) do { _Pragma("unroll") for (int n = 0; n < 2; ++n) _Pragma("unroll") for (int k = 0; k < 2; ++k) dst[n][k] = *(const PG8_LAS bf16x8*)(lds + PG8_SB(b, h) + boff + n * 2048 + k * 1024); } while (0)
#define PG8_MMA(ai, bj, At, Bt) do { __builtin_amdgcn_s_setprio(1); _Pragma("unroll") for (int m = 0; m < 4; ++m) _Pragma("unroll") for (int n = 0; n < 2; ++n) _Pragma("unroll") for (int k = 0; k < 2; ++k) \
        acc[ai][bj][m][n] = __builtin_amdgcn_mfma_f32_16x16x32_bf16(Bt[n][k], At[m][k], acc[ai][bj][m][n], 0, 0, 0); __builtin_amdgcn_s_setprio(0); } while (0)
#define PG8_WAIT_V(n) asm volatile("s_waitcnt vmcnt(" #n ")" ::: "memory")
#define PG8_WAIT_L(n) asm volatile("s_waitcnt lgkmcnt(" #n ")" ::: "memory")
#define PG8_BAR __builtin_amdgcn_s_barrier()
#define PG8_SCHED __builtin_amdgcn_sched_barrier(0)
    Unit cur, nxt; int ui = 0;
    if (!S.next(0, cur)) return;
    f32x4 acc[2][2][4][2];
#pragma unroll
    for (int a = 0; a < 2; ++a)
#pragma unroll
        for (int b = 0; b < 2; ++b)
#pragma unroll
            for (int m = 0; m < 4; ++m)
#pragma unroll
                for (int n = 0; n < 2; ++n) acc[a][b][m][n] = (f32x4){0.f, 0.f, 0.f, 0.f};
    bf16x8 At[4][2], B0[2][2], B1[2][2];
    const char* cA = (const char*)g.A + (size_t)cur.pm * tstep; const char* cB = (const char*)g.Bt + (size_t)cur.pn * tstep;
    S.a_ready(cur);
    PG8_STAGE(PG8_SB(0, 0), cB, voffB); PG8_STAGE(PG8_SA(0, 0), cA, voffA); PG8_STAGE(PG8_SB(0, 1), cB + hstep, voffB); PG8_STAGE(PG8_SA(0, 1), cA + hstep, voffA);
    if (wr == 1) PG8_BAR;
    PG8_WAIT_V(4); PG8_BAR;
    PG8_STAGE(PG8_SB(1, 0), cB + kstep, voffB); PG8_STAGE(PG8_SA(1, 0), cA + kstep, voffA); PG8_STAGE(PG8_SB(1, 1), cB + hstep + kstep, voffB);
    PG8_WAIT_V(6); PG8_BAR;
    PG8_STAMP();
    for (;;) {
        const bool has_next = S.next(ui + 1, nxt);
        const char* nA = has_next ? (const char*)g.A + (size_t)nxt.pm * tstep : cA; const char* nB = has_next ? (const char*)g.Bt + (size_t)nxt.pn * tstep : cB;
        for (int t = 0; t < nt; t += 2) {
            const bool last = (t == nt - 2);
            const char* a1 = cA + (size_t)(t + 1) * kstep;
            const char* a2 = last ? nA : cA + (size_t)(t + 2) * kstep; const char* b2 = last ? nB : cB + (size_t)(t + 2) * kstep;
            const char* a3 = a2 + kstep; const char* b3 = b2 + kstep;
            if (last && has_next) S.a_ready(nxt);
            PG8_LDB(B0, 0, 0); PG8_SCHED; PG8_LDA(At, 0, 0); PG8_STAGE(PG8_SA(1, 1), a1 + hstep, voffA);
            PG8_WAIT_L(8); PG8_BAR; PG8_WAIT_L(0); PG8_MMA(0, 0, At, B0); PG8_BAR; PG8_SCHED;
            PG8_LDB(B1, 0, 1); PG8_STAGE(PG8_SB(0, 0), b2, voffB);
            PG8_BAR; PG8_WAIT_L(0); PG8_MMA(0, 1, At, B1); PG8_BAR;
            PG8_LDA(At, 0, 1); PG8_STAGE(PG8_SA(0, 0), a2, voffA);
            PG8_BAR; PG8_WAIT_L(0); PG8_MMA(1, 0, At, B0); PG8_BAR; PG8_SCHED;
            PG8_STAGE(PG8_SB(0, 1), b2 + hstep, voffB);
            PG8_WAIT_V(6); PG8_BAR; PG8_MMA(1, 1, At, B1); PG8_BAR;
            PG8_LDB(B0, 1, 0); PG8_SCHED; PG8_LDA(At, 1, 0); PG8_STAGE(PG8_SA(0, 1), a2 + hstep, voffA);
            PG8_WAIT_L(8); PG8_BAR; PG8_WAIT_L(0); PG8_MMA(0, 0, At, B0); PG8_BAR; PG8_SCHED;
            PG8_LDB(B1, 1, 1); PG8_STAGE(PG8_SB(1, 0), b3, voffB);
            PG8_BAR; PG8_WAIT_L(0); PG8_MMA(0, 1, At, B1); PG8_BAR;
            PG8_LDA(At, 1, 1); PG8_STAGE(PG8_SA(1, 0), a3, voffA);
            PG8_BAR; PG8_WAIT_L(0); PG8_MMA(1, 0, At, B0); PG8_BAR; PG8_SCHED;
            PG8_STAGE(PG8_SB(1, 1), b3 + hstep, voffB);
            PG8_WAIT_V(6); PG8_BAR; PG8_MMA(1, 1, At, B1); PG8_BAR;
        }
        PG8_STAMP();
        if constexpr (!Epi::AFTER_DRAIN) { E(acc, cur, wr, wc, fr, fq); S.done(cur); }
        PG8_STAMP();
        if (!has_next) break;
#pragma unroll
        for (int a = 0; a < 2; ++a)
#pragma unroll
            for (int b = 0; b < 2; ++b)
#pragma unroll
                for (int m = 0; m < 4; ++m)
#pragma unroll
                    for (int n = 0; n < 2; ++n) acc[a][b][m][n] = (f32x4){0.f, 0.f, 0.f, 0.f};
        cur = nxt; cA = nA; cB = nB; ++ui;
    }
    PG8_WAIT_V(0);
    if (wr == 0) PG8_BAR;
    PG8_BAR;
    if constexpr (Epi::AFTER_DRAIN) { E.fused(acc, cur, wr, wc, fr, fq, lds, wid, lane); S.done(cur); }
    PG8_STAMP();
    if (STAMP && wid == 0) { stamps[lane] = lane < nts ? (((unsigned long long)(unsigned)ts_hi << 32) | (unsigned)ts_lo) : 0ull;
        if (lane == 62) stamps[62] = rt_entry; if (lane == 63) stamps[63] = (unsigned long long)wall_clock64(); }
#undef PG8_STAMP
#undef PG8_SA
#undef PG8_SB
#undef PG8_STAGE
#undef PG8_LDA
#undef PG8_LDB
#undef PG8_MMA
#undef PG8_WAIT_V
#undef PG8_WAIT_L
#undef PG8_BAR
#undef PG8_SCHED
}
}

#ifndef PHMASK
#define PHMASK 63
#endif
#ifndef PROBE
#define PROBE 0
#endif
using pg8::bf16_t; using pg8::bf16x8; using pg8::f32x4; using pg8::u32x4;
typedef unsigned u32x2 __attribute__((ext_vector_type(2)));
typedef short s16x4 __attribute__((ext_vector_type(4)));
typedef float f32x2 __attribute__((ext_vector_type(2)));
#define LAS __attribute__((address_space(3)))
#define DI __device__ __forceinline__

#define XB_TMO      128
#define XB_XCNT(j)  (256  + 64 * (j))
#define XB_XSUB(j)  (1280 + 64 * (j))
#define XB_XGEN(j)  (2304 + 64 * (j))
#define XB_TOP      3328
#define XB_TOPGEN   3392
#define XCD_BAR_WORDS 3456
#define XB_SPIN_CAP (1u << 18)

__device__ __forceinline__ unsigned xb_ld(unsigned* p)              { return __hip_atomic_load(p, __ATOMIC_RELAXED, __HIP_MEMORY_SCOPE_AGENT); }
__device__ __forceinline__ unsigned xb_add(unsigned* p, unsigned v) { return __hip_atomic_fetch_add(p, v, __ATOMIC_RELAXED, __HIP_MEMORY_SCOPE_AGENT); }
__device__ __forceinline__ unsigned xb_xcc_id() { return (unsigned)__builtin_amdgcn_s_getreg((3 << 11) | 20) & 0xFu; }
#define XB_SPIN(cond, bar) do { unsigned _sp = 0; while (cond) { __builtin_amdgcn_s_sleep(1); \
    if ((++_sp & 255u) == 0u) { if (xb_ld(&(bar)[XB_TMO])) break; if (_sp > XB_SPIN_CAP) { atomicAdd(&(bar)[XB_TMO], 1u); break; } } } } while (0)

struct XcdBarrier {
    unsigned* bar; unsigned x;
    volatile LAS unsigned* st;
};

__device__ __forceinline__ XcdBarrier xcd_barrier_post(unsigned* bar, volatile LAS unsigned* st) {
    XcdBarrier b; b.bar = bar; b.x = xb_xcc_id(); b.st = st;
    if (threadIdx.x == 0) (void)xb_add(&bar[XB_XCNT(b.x)], 1u);
    return b;
}
__device__ __forceinline__ void xcd_barrier_complete(unsigned* bar, unsigned x, unsigned& nloc, unsigned& nx) {
    const unsigned G = gridDim.x * gridDim.y * gridDim.z;
    unsigned sum, cnt, mine, sp = 0u;
    for (;;) {
        sum = 0u; cnt = 0u; mine = 0u;
#pragma unroll
        for (unsigned j = 0; j < 16; ++j) { const unsigned c = xb_ld(&bar[XB_XCNT(j)]); sum += c; cnt += (c > 0u) ? 1u : 0u; mine = (j == x) ? c : mine; }
        if (sum == G) break;
        __builtin_amdgcn_s_sleep(1);
        if ((++sp & 255u) == 0u) { if (xb_ld(&bar[XB_TMO])) break; if (sp > XB_SPIN_CAP) { atomicAdd(&bar[XB_TMO], 1u); break; } }
    }
    nloc = mine > 0u ? mine : 1u; nx = cnt > 0u ? cnt : 1u;
}

__device__ __forceinline__ void xcd_barrier(const XcdBarrier& b) {
    asm volatile("s_waitcnt vmcnt(0)" ::: "memory");
    __syncthreads();
    if (threadIdx.x == 0) {
        unsigned* bar = b.bar;
        __builtin_amdgcn_s_waitcnt(0);
        unsigned nloc = b.st[0], nx = b.st[1];
        if (nloc == 0u) { xcd_barrier_complete(bar, b.x, nloc, nx); b.st[0] = nloc; b.st[1] = nx; }
        const unsigned old = xb_add(&bar[XB_XSUB(b.x)], 1u);
        const unsigned gen = old / nloc;
        if (old + 1u == (gen + 1u) * nloc) {
            __builtin_amdgcn_fence(__ATOMIC_RELEASE, "agent");
            asm volatile("s_waitcnt vmcnt(0)" ::: "memory");
            const unsigned og = xb_add(&bar[XB_TOP], 1u);
            const unsigned tg = og / nx;
            if (og + 1u == (tg + 1u) * nx) xb_add(&bar[XB_TOPGEN], 1u);
            else XB_SPIN(xb_ld(&bar[XB_TOPGEN]) == tg, bar);
            __builtin_amdgcn_fence(__ATOMIC_ACQUIRE, "agent");
            xb_add(&bar[XB_XGEN(b.x)], 1u);
            asm volatile("s_waitcnt vmcnt(0)" ::: "memory");
        } else {
            XB_SPIN(xb_ld(&bar[XB_XGEN(b.x)]) == gen, bar);
            __builtin_amdgcn_fence(__ATOMIC_ACQUIRE, "agent");
            asm volatile("s_waitcnt vmcnt(0)" ::: "memory");
        }
    }
    __syncthreads();
}


#define XB_LSUB(j)  (3456 + 64 * (j))
#define XB_LGEN(j)  (4480 + 64 * (j))
#define XB_CLS(j)   (5504 + 64 * (j))
#define XB_TSUB(k)  (6528 + 64 * (k))
#define XB_TGEN(k)  (10624 + 64 * (k))
#define XB_WORDS_ALL 14720
__device__ __forceinline__ void team_barrier(const XcdBarrier& b) {
    asm volatile("s_waitcnt vmcnt(0)" ::: "memory");
    __syncthreads();
    if (threadIdx.x == 0) {
        unsigned* bar = b.bar;
        __builtin_amdgcn_s_waitcnt(0);
        const unsigned team = (blockIdx.x & 7u) * 8u + ((blockIdx.x >> 3) & 7u);
        const unsigned old = xb_add(&bar[XB_TSUB(team)], 1u);
        const unsigned gen = old >> 2;
        if ((old & 3u) == 3u) xb_add(&bar[XB_TGEN(team)], 1u);
        else XB_SPIN(xb_ld(&bar[XB_TGEN(team)]) == gen, bar);
        __builtin_amdgcn_fence(__ATOMIC_ACQUIRE, "agent");
        asm volatile("s_waitcnt vmcnt(0)" ::: "memory");
    }
    __syncthreads();
}

constexpr int D = 1024, DFF = 2816, GROWS = 32768, NTHR = 512;
constexpr int PRP = 2816;
constexpr int LDS_BYTES = 147456;
constexpr size_t MiB = 1u << 20, KiB = 1u << 10;
constexpr size_t WS_MODP = 0;
constexpr size_t WS_MOD = 6 * MiB;
constexpr size_t WS_BAR = 7 * MiB + 512 * KiB;
constexpr size_t WS_WSP = 8 * MiB;
constexpr size_t WS_WPT = WS_WSP + 256 * KiB;
constexpr size_t WS_WF = WS_WPT + 256 * KiB;
constexpr size_t WS_FC1 = WS_WF + 256 * KiB;
constexpr size_t WS_FS1 = WS_FC1 + 256 * KiB;
constexpr size_t WS_FC16 = WS_FS1 + 256 * KiB;
constexpr size_t WS_FS16 = WS_FC16 + 256 * KiB;
constexpr size_t WS_FC2 = WS_FS16 + 256 * KiB;
constexpr size_t WS_FS2 = WS_FC2 + 256 * KiB;
constexpr size_t WS_TW128 = WS_FS2 + 256 * KiB;
constexpr size_t WS_TW16 = WS_TW128 + 256 * KiB;
constexpr size_t WS_WUP = 16 * MiB;
constexpr size_t WS_WDN = 60 * MiB;
constexpr size_t WS_EVIN = 82 * MiB, WS_ODIN = 85 * MiB, WS_EVOUT = 89 * MiB, WS_ODOUT = 91 * MiB;
constexpr size_t WS_H = 96 * MiB;
constexpr size_t WS_T = 160 * MiB;
constexpr size_t WS_BIG = 224 * MiB;
constexpr size_t WS_UB = WS_BIG + 96 * MiB;
constexpr size_t WS_XH = 400 * MiB;
constexpr size_t WS_END = 464 * MiB;

typedef __bf16 nbf16x2 __attribute__((ext_vector_type(2)));
DI unsigned f2bf(float f) { return (unsigned)__builtin_bit_cast(unsigned short, (__bf16)f); }
DI unsigned pk2(float lo, float hi) { const f32x2 v = {lo, hi}; return __builtin_bit_cast(unsigned, __builtin_convertvector(v, nbf16x2)); }
DI float bf_lo(unsigned w) { return __uint_as_float(w << 16); }
DI float bf_hi(unsigned w) { return __uint_as_float(w & 0xffff0000u); }
template <int CTRL> DI float dpp_mov(float v) { return __builtin_bit_cast(float, __builtin_amdgcn_update_dpp(0, __builtin_bit_cast(int, v), CTRL, 0xF, 0xF, true)); }
DI float wave_sum(float v) {
    v += dpp_mov<0xB1>(v); v += dpp_mov<0x4E>(v); v += dpp_mov<0x141>(v); v += dpp_mov<0x140>(v);
    const int iv = __builtin_bit_cast(int, v);
    const float a = __builtin_bit_cast(float, __builtin_amdgcn_readlane(iv, 0)), b = __builtin_bit_cast(float, __builtin_amdgcn_readlane(iv, 16)),
                c = __builtin_bit_cast(float, __builtin_amdgcn_readlane(iv, 32)), d = __builtin_bit_cast(float, __builtin_amdgcn_readlane(iv, 48));
    return (a + b) + (c + d);
}
DI float silu_f(float x) { return x * __builtin_amdgcn_rcpf(1.0f + __builtin_amdgcn_exp2f(-1.4426950408889634f * x)); }
DI f32x4 mfma16(bf16x8 a, bf16x8 b, f32x4 c) { return __builtin_amdgcn_mfma_f32_16x16x32_bf16(a, b, c, 0, 0, 0); }
typedef short v4i16_t __attribute__((ext_vector_type(4)));
DI s16x4 tr_read(LAS unsigned char* p) { return __builtin_bit_cast(s16x4, __builtin_amdgcn_ds_read_tr16_b64_v4i16((LAS v4i16_t*)p)); }
DI bf16x8 tr_frag(LAS unsigned char* p, int pitch4) {
    const s16x4 lo = tr_read(p), hi = tr_read(p + pitch4);
    bf16x8 r; r[0] = lo[0]; r[1] = lo[1]; r[2] = lo[2]; r[3] = lo[3]; r[4] = hi[0]; r[5] = hi[1]; r[6] = hi[2]; r[7] = hi[3]; return r;
}

DI void st16_wt(void* p, u32x4 v) { *(u32x4*)p = v; }
struct Params { const float* in[25]; float* out; unsigned char* ws; int ph_lo, ph_hi; };

struct EpiGen {
    static constexpr bool PERM = true, AFTER_DRAIN = false;
    bf16_t* O; int ldc; int mode;
    __device__ __forceinline__ void operator()(const f32x4 (&acc)[2][2][4][2], const pg8::Unit& u, int wr, int wc, int fr, int fq) const {
        const int row0 = u.pm * 256 + wr * 64 + fr, cw = wc * 32 + 8 * fq;
        if (mode == 3) {
#pragma unroll
            for (int ai = 0; ai < 2; ++ai)
#pragma unroll
                for (int m = 0; m < 4; ++m) {
                    bf16_t* rowp = O + (size_t)(row0 + ai * 128 + m * 16) * ldc + 128 * u.pn + cw;
                    f32x4 g0 = acc[ai][0][m][0], g1 = acc[ai][0][m][1]; const f32x4 u0 = acc[ai][1][m][0], u1 = acc[ai][1][m][1];
#pragma unroll
                    for (int j = 0; j < 4; ++j) { g0[j] = silu_f(g0[j]); g1[j] = silu_f(g1[j]); }
                    const f32x4 v0 = g0 * u0, v1 = g1 * u1;
                    u32x4 w; w.x = pg8::cvt_pk_bf16(v0[0], v0[1]); w.y = pg8::cvt_pk_bf16(v0[2], v0[3]); w.z = pg8::cvt_pk_bf16(v1[0], v1[1]); w.w = pg8::cvt_pk_bf16(v1[2], v1[3]);
                    st16_wt(rowp, w);
                }
        } else if (mode == 2 && u.pn < 4) {
#pragma unroll
            for (int ai = 0; ai < 2; ++ai)
#pragma unroll
                for (int m = 0; m < 4; ++m) {
                    bf16_t* rowp = O + (size_t)(row0 + ai * 128 + m * 16) * ldc + 128 * u.pn + cw;
                    const f32x4 v0 = acc[ai][0][m][0] * acc[ai][1][m][0], v1 = acc[ai][0][m][1] * acc[ai][1][m][1];
                    u32x4 w; w.x = pg8::cvt_pk_bf16(v0[0], v0[1]); w.y = pg8::cvt_pk_bf16(v0[2], v0[3]); w.z = pg8::cvt_pk_bf16(v1[0], v1[1]); w.w = pg8::cvt_pk_bf16(v1[2], v1[3]);
                    st16_wt(rowp, w);
                }
        } else {
            const int colbase = (mode == 2) ? 512 + 256 * (u.pn - 4) : 256 * u.pn;
            if (mode == 1 && u.pn < 4) {
#pragma unroll
                for (int ai = 0; ai < 2; ++ai)
#pragma unroll
                    for (int m = 0; m < 4; ++m) {
                        bf16_t* rowp = O + (size_t)(row0 + ai * 128 + m * 16) * ldc + colbase + cw;
#pragma unroll
                        for (int bj = 0; bj < 2; ++bj) {
                            f32x4 v0 = acc[ai][bj][m][0], v1 = acc[ai][bj][m][1];
                            const pg8::f32x2 a = pg8::gelu_pk((pg8::f32x2){v0[0], v0[1]}), b = pg8::gelu_pk((pg8::f32x2){v0[2], v0[3]}), c = pg8::gelu_pk((pg8::f32x2){v1[0], v1[1]}), d = pg8::gelu_pk((pg8::f32x2){v1[2], v1[3]});
                            u32x4 w; w.x = pg8::cvt_pk_bf16(a.x, a.y); w.y = pg8::cvt_pk_bf16(b.x, b.y); w.z = pg8::cvt_pk_bf16(c.x, c.y); w.w = pg8::cvt_pk_bf16(d.x, d.y);
                            st16_wt(rowp + bj * 128, w);
                        }
                    }
            } else {
#pragma unroll
                for (int ai = 0; ai < 2; ++ai)
#pragma unroll
                    for (int m = 0; m < 4; ++m) {
                        bf16_t* rowp = O + (size_t)(row0 + ai * 128 + m * 16) * ldc + colbase + cw;
#pragma unroll
                        for (int bj = 0; bj < 2; ++bj) {
                            const f32x4 v0 = acc[ai][bj][m][0], v1 = acc[ai][bj][m][1];
                            u32x4 w; w.x = pg8::cvt_pk_bf16(v0[0], v0[1]); w.y = pg8::cvt_pk_bf16(v0[2], v0[3]); w.z = pg8::cvt_pk_bf16(v1[0], v1[1]); w.w = pg8::cvt_pk_bf16(v1[2], v1[3]);
                            st16_wt(rowp + bj * 128, w);
                        }
                    }
            }
        }
    }
};

DI void run_gemm(LAS unsigned char* lds, const bf16_t* A, const bf16_t* Bt, int M, int N, int K, bf16_t* O, int ldc, int mode, int G) {
#if PHMASK & 4
#ifndef STAG
#define STAG 0
#endif
    if (STAG && mode != 0) {
        const int d = ((int)blockIdx.x >> 3) & 3;
        for (int i = 0; i < d * STAG; ++i) __builtin_amdgcn_s_sleep(64);
    }
    pg8::Gemm g{A, Bt, M, N, K}; pg8::StaticOrder S; S.init(M, N, G, (int)blockIdx.x);
    EpiGen E{O, ldc, mode};
    pg8::gemm_phase<EpiGen, pg8::StaticOrder, false>(lds, g, S, E, nullptr);
#endif
}

DI int dest_row(int n0, int mode) {
    if (mode == 1) { const int half = n0 >= DFF ? 1 : 0, n = n0 - half * DFF; return 256 * (n >> 7) + 128 * half + (n & 127); }
    if (mode == 2) { if (n0 < 512) return 256 * (n0 >> 7) + (n0 & 127); if (n0 < 1024) return 1024 + (n0 - 512); if (n0 < 1536) { const int n = n0 - 1024; return 256 * (n >> 7) + 128 + (n & 127); } return n0; }
    return n0;
}
DI void transpose_item(const float* W, int K, int N, bf16_t* WT, int mode, LAS float* scr, int item, int lane) {
    const int nblk = N / 32, kb = item / nblk, nb = item % nblk, k0 = 64 * kb, n0 = 32 * nb;
#pragma unroll
    for (int i = 0; i < 32; ++i) { const int kk = 2 * i + (lane >> 5); scr[kk * 33 + (lane & 31)] = __builtin_nontemporal_load(W + (size_t)(k0 + kk) * N + n0 + (lane & 31)); }
    asm volatile("s_waitcnt lgkmcnt(0)" ::: "memory");
    const int c = lane & 7, dr = dest_row(n0, mode);
#pragma unroll
    for (int j = 0; j < 4; ++j) { const int n = (lane >> 3) + 8 * j; const LAS float* s = scr + (8 * c) * 33 + n;
        u32x4 o; o.x = pk2(s[0 * 33], s[1 * 33]); o.y = pk2(s[2 * 33], s[3 * 33]); o.z = pk2(s[4 * 33], s[5 * 33]); o.w = pk2(s[6 * 33], s[7 * 33]);
        *(u32x4*)(WT + (size_t)(dr + n) * K + k0 + 8 * c) = o; }
    asm volatile("s_waitcnt lgkmcnt(0)" ::: "memory");
}

DI void setup_phase(const Params& p, LAS unsigned char* lds, int G, int tid, int wid, int lane) {
    unsigned char* ws = p.ws;
    {
        LAS float* sc = (LAS float*)lds;
        LAS float* red = sc + 18 * 1024;
        for (int i = tid; i < 18 * 1024; i += NTHR) { const int b = i >> 10, k = i & 1023;
            const float c = (b < 2) ? p.in[2][b * 1024 + k] : p.in[3][(b - 2) * 1024 + k]; sc[i] = silu_f(c); }
        __syncthreads();
        for (int u = blockIdx.x; u < 288; u += G) {
            const int l = u / 144, cb = u % 144, col = cb * 64 + lane;
            float acc[18];
#pragma unroll
            for (int b = 0; b < 18; ++b) acc[b] = 0.f;
            const float* wp = p.in[4] + ((size_t)l * 1024 + wid * 128) * 9216 + col;
            const LAS f32x4* sc4 = (const LAS f32x4*)sc + wid * 32;
#pragma unroll 4
            for (int k4 = 0; k4 < 32; ++k4) {
                const float w0 = __builtin_nontemporal_load(wp + (size_t)(4 * k4) * 9216), w1 = __builtin_nontemporal_load(wp + (size_t)(4 * k4 + 1) * 9216), w2 = __builtin_nontemporal_load(wp + (size_t)(4 * k4 + 2) * 9216), w3 = __builtin_nontemporal_load(wp + (size_t)(4 * k4 + 3) * 9216);
#pragma unroll
                for (int b = 0; b < 18; ++b) { const f32x4 sv = sc4[b * 256 + k4]; acc[b] += (sv[0] * w0 + sv[1] * w1) + (sv[2] * w2 + sv[3] * w3); }
            }
#pragma unroll
            for (int b = 0; b < 18; ++b) red[(wid * 18 + b) * 64 + lane] = acc[b];
            __syncthreads();
            for (int i = tid; i < 18 * 64; i += NTHR) { const int b = i >> 6, c = i & 63; float sm = p.in[5][l * 9216 + cb * 64 + c];
#pragma unroll
                for (int w = 0; w < 8; ++w) sm += red[(w * 18 + b) * 64 + c];
                ((float*)(ws + WS_MOD))[((size_t)l * 18 + b) * 9216 + cb * 64 + c] = sm; }
            __syncthreads();
        }
    }
    {
        LAS float* scr = (LAS float*)(lds + wid * 16384);
        const int nskip = (G > 64 && 288 - G > 0 && 288 - G < G / 2) ? 288 - G : 0;
        const int gw = ((int)blockIdx.x - nskip) * 8 + wid, NGW = (G - nskip) * 8;
        constexpr int I_UP = 16 * 176, I_DN = 44 * 32, I_EI = 16 * 48, I_OI = 16 * 64, I_O = 16 * 32;
        constexpr int NITEMS = 4 * I_UP + 4 * I_DN + I_EI + I_OI + 2 * I_O;
        for (int it = gw; it < NITEMS && gw >= 0; it += NGW) {
            int r = it;
            if (r < 4 * I_UP) { const int i = r / I_UP; r -= i * I_UP; const int l = i >> 1, f = i & 1;
                transpose_item(p.in[f ? 10 : 8] + (size_t)l * 1024 * 5632, 1024, 5632, (bf16_t*)(ws + WS_WUP) + (size_t)i * 5632 * 1024, 1, scr, r, lane); continue; }
            r -= 4 * I_UP;
            if (r < 4 * I_DN) { const int i = r / I_DN; r -= i * I_DN; const int l = i >> 1, f = i & 1;
                transpose_item(p.in[f ? 11 : 9] + (size_t)l * 2816 * 1024, 2816, 1024, (bf16_t*)(ws + WS_WDN) + (size_t)i * 1024 * 2816, 0, scr, r, lane); continue; }
            r -= 4 * I_DN;
            if (r < I_EI) { transpose_item(p.in[12], 1024, 1536, (bf16_t*)(ws + WS_EVIN), 0, scr, r, lane); continue; }
            r -= I_EI;
            if (r < I_OI) { transpose_item(p.in[20], 1024, 2048, (bf16_t*)(ws + WS_ODIN), 2, scr, r, lane); continue; }
            r -= I_OI;
            if (r < I_O) { transpose_item(p.in[19], 1024, 1024, (bf16_t*)(ws + WS_EVOUT), 0, scr, r, lane); continue; }
            r -= I_O;
            transpose_item(p.in[24], 1024, 1024, (bf16_t*)(ws + WS_ODOUT), 0, scr, r, lane);
        }
    }
    {
        const int gt = blockIdx.x * NTHR + tid, NT = G * NTHR;
        bf16_t* WSP = (bf16_t*)(ws + WS_WSP); bf16_t* WPT = (bf16_t*)(ws + WS_WPT); bf16_t* WF = (bf16_t*)(ws + WS_WF);
        for (int i = gt; i < 65536; i += NT) {
            WSP[i] = (bf16_t)f2bf(p.in[15][i]);
            const int g = i >> 14, e = (i >> 7) & 127, d = i & 127;
            WPT[i] = (bf16_t)f2bf(p.in[17][(g * 128 + d) * 128 + e]);
        }
        {
            LAS float* tab = (LAS float*)(lds + 132 * 1024);
            if (tid < 128) { const float x = (float)tid * (1.0f / 64.0f); tab[tid] = cospif(x); tab[128 + tid] = sinpif(x); }
            __syncthreads();
            for (int i = gt; i < 131072; i += NT) {
                const int g = i >> 15, n = (i >> 7) & 255, d = i & 127, comp = n >> 7, e = n & 127;
                const float* fw = p.in[23] + (size_t)g * 16384 + e; const LAS float* tb = tab + comp * 128; float sm = 0.f;
#pragma unroll 8
                for (int m = 0; m < 128; ++m) sm += tb[(m * d) & 127] * fw[m * 128];
                WF[i] = (bf16_t)f2bf(sm * p.in[22][g * 128 + d]);
            }
        }
        bf16_t* FC1 = (bf16_t*)(ws + WS_FC1); bf16_t* FS1 = (bf16_t*)(ws + WS_FS1); bf16_t* FC2 = (bf16_t*)(ws + WS_FC2); bf16_t* FS2 = (bf16_t*)(ws + WS_FS2);
        f32x2* TW128 = (f32x2*)(ws + WS_TW128);
        for (int i = gt; i < 16384; i += NT) {
            const int k1 = i >> 7, col = i & 127, s = col >> 5, j = col & 31, fqq = j >> 3, ii = j & 7;
            const int r = 32 * s + (ii < 4 ? fqq * 4 + ii : 16 + fqq * 4 + ii - 4);
            const float x = (float)((k1 * r) & 127) * (1.0f / 64.0f);
            FC1[i] = (bf16_t)f2bf(cospif(x)); FS1[i] = (bf16_t)f2bf(sinpif(x));
            const float y = (float)((k1 * col) & 127) * (1.0f / 64.0f);
            FC2[i] = (bf16_t)f2bf(cospif(y)); FS2[i] = (bf16_t)f2bf(sinpif(y));
            const float z = (float)(k1 * col) * (1.0f / 8192.0f);
            TW128[i] = (f32x2){cospif(z), sinpif(z)};
        }
        bf16_t* FC16 = (bf16_t*)(ws + WS_FC16); bf16_t* FS16 = (bf16_t*)(ws + WS_FS16);
        for (int i = gt; i < 512; i += NT) {
            const int k1 = i >> 5, j = i & 31, fqq = j >> 3, ii = j & 7;
            float c = 0.f, s = 0.f;
            if (ii < 4) { const int r = fqq * 4 + ii; const float x = (float)((k1 * r) & 15) * (1.0f / 8.0f); c = cospif(x); s = sinpif(x); }
            FC16[i] = (bf16_t)f2bf(c); FS16[i] = (bf16_t)f2bf(s);
        }
        f32x2* TW16 = (f32x2*)(ws + WS_TW16);
        for (int i = gt; i < 2048; i += NT) { const int q = i >> 4, k1 = i & 15; const float z = (float)(k1 * q) * (1.0f / 1024.0f); TW16[i] = (f32x2){cospif(z), sinpif(z)}; }
    }
}

DI void modreduce_phase(const Params& p, int G, int tid) {
    const float* mp = (const float*)(p.ws + WS_MODP); float* mod = (float*)(p.ws + WS_MOD);
    for (int i = blockIdx.x * NTHR + tid; i < 2 * 18 * 9216; i += G * NTHR) {
        const int l = i / (18 * 9216), j = i % 9216;
        float s = p.in[5][l * 9216 + j];
#pragma unroll
        for (int ks = 0; ks < 4; ++ks) s += mp[(size_t)ks * (2 * 18 * 9216) + i];
        mod[i] = s;
    }
}

typedef _Float16 h16x4 __attribute__((ext_vector_type(4)));
typedef _Float16 h16x8 __attribute__((ext_vector_type(8)));
template <bool IN32, bool PREV, bool NEXT, bool OUT32>
DI void norm_phase_t(const float* xin32, const _Float16* xin16, float* xout32, _Float16* xout16, const bf16_t* T, bf16_t* H,
                     const float* gate_base, const float* gpost, float rw, const float* ss_base, const float* gpre, int gi, int G, int wid, int lane) {
    const bool teamed = (G == 256);
    const int bx = (int)blockIdx.x & 7, bj = (int)blockIdx.x >> 3;
    const int nh = teamed ? 2 : (GROWS + G * 8 - 1) / (G * 8), rows_h = teamed ? 8 : 1;
    for (int hh = 0; hh < nh; ++hh) {
        const int r0 = teamed ? 256 * (16 * bx + 8 * hh + (bj & 7)) + 64 * (bj >> 3) + wid : (int)blockIdx.x * 8 + wid + hh * G * 8;
        if (r0 >= GROWS) break;
        const int bidx = (gi == 0) ? (r0 >> 14) : 2 + (r0 >> 11);
        f32x4 gpv[4], gtv[4], shv[4], scv[4], gnv[4];
        if (PREV) { const f32x4* gp = (const f32x4*)gpost + 2 * lane; const f32x4* gt = (const f32x4*)(gate_base + (size_t)bidx * 9216) + 2 * lane;
#pragma unroll
            for (int j = 0; j < 4; ++j) { const int o = 128 * (j >> 1) + (j & 1); gpv[j] = gp[o] * rw; gtv[j] = gt[o] + 1.0f; gpv[j] = gpv[j] * gtv[j]; } }
        if (NEXT) { const f32x4* gp = (const f32x4*)gpre + 2 * lane; const f32x4* sh = (const f32x4*)(ss_base + (size_t)bidx * 9216) + 2 * lane; const f32x4* sc = sh + 256;
#pragma unroll
            for (int j = 0; j < 4; ++j) { const int o = 128 * (j >> 1) + (j & 1); gnv[j] = gp[o] * (sc[o] + 1.0f); shv[j] = sh[o]; } }
#pragma unroll 2
        for (int i = 0; i < rows_h; ++i) {
            const int r = r0 + 8 * i;
            f32x4 v[4]; u32x4 tw[2];
            if (IN32) { const f32x4* xr = (const f32x4*)(xin32 + (size_t)r * D) + 2 * lane;
#pragma unroll
                for (int j = 0; j < 2; ++j) { v[2 * j] = xr[128 * j]; v[2 * j + 1] = xr[128 * j + 1]; } }
            else { const h16x8* xr = (const h16x8*)(xin16 + (size_t)r * D) + lane; h16x8 hv[2];
#pragma unroll
                for (int j = 0; j < 2; ++j) hv[j] = __builtin_nontemporal_load(xr + 64 * j);
                if (PREV) { const u32x4* tr = (const u32x4*)(T + (size_t)r * D) + lane;
#pragma unroll
                    for (int j = 0; j < 2; ++j) tw[j] = __builtin_nontemporal_load(tr + 64 * j); }
#pragma unroll
                for (int j = 0; j < 2; ++j) { v[2 * j] = (f32x4){(float)hv[j][0], (float)hv[j][1], (float)hv[j][2], (float)hv[j][3]}; v[2 * j + 1] = (f32x4){(float)hv[j][4], (float)hv[j][5], (float)hv[j][6], (float)hv[j][7]}; } }
            if (PREV) {
                if (IN32) { const u32x4* tr = (const u32x4*)(T + (size_t)r * D) + lane;
#pragma unroll
                    for (int j = 0; j < 2; ++j) tw[j] = __builtin_nontemporal_load(tr + 64 * j); }
                f32x4 tv[4]; float ss = 0.f;
#pragma unroll
                for (int j = 0; j < 2; ++j) { const u32x4 w = tw[j];
                    tv[2 * j] = (f32x4){bf_lo(w.x), bf_hi(w.x), bf_lo(w.y), bf_hi(w.y)}; tv[2 * j + 1] = (f32x4){bf_lo(w.z), bf_hi(w.z), bf_lo(w.w), bf_hi(w.w)}; }
#pragma unroll
                for (int j = 0; j < 4; ++j) ss += (tv[j][0] * tv[j][0] + tv[j][1] * tv[j][1]) + (tv[j][2] * tv[j][2] + tv[j][3] * tv[j][3]);
                const float rstd = rsqrtf(wave_sum(ss) * (1.0f / D) + 1e-6f);
#pragma unroll
                for (int j = 0; j < 4; ++j) v[j] = v[j] + (tv[j] * rstd) * gpv[j];
                if (OUT32) { f32x4* xo = (f32x4*)(xout32 + (size_t)r * D) + 2 * lane;
#pragma unroll
                    for (int j = 0; j < 4; ++j) __builtin_nontemporal_store(v[j], xo + 128 * (j >> 1) + (j & 1)); }
                else { h16x8* xo = (h16x8*)(xout16 + (size_t)r * D) + lane;
#pragma unroll
                    for (int j = 0; j < 2; ++j) { h16x8 hv;
#pragma unroll
                        for (int k = 0; k < 4; ++k) { hv[k] = (_Float16)v[2 * j][k]; hv[4 + k] = (_Float16)v[2 * j + 1][k]; }
                        __builtin_nontemporal_store(hv, xo + 64 * j);
#pragma unroll
                        for (int k = 0; k < 4; ++k) { v[2 * j][k] = (float)hv[k]; v[2 * j + 1][k] = (float)hv[4 + k]; } } }
            }
            if (NEXT) {
                float ss = 0.f;
#pragma unroll
                for (int j = 0; j < 4; ++j) ss += (v[j][0] * v[j][0] + v[j][1] * v[j][1]) + (v[j][2] * v[j][2] + v[j][3] * v[j][3]);
                const float rstd = rsqrtf(wave_sum(ss) * (1.0f / D) + 1e-6f);
                u32x4* ho = (u32x4*)(H + (size_t)r * D) + lane;
#pragma unroll
                for (int j = 0; j < 2; ++j) { const f32x4 h0 = (v[2 * j] * rstd) * gnv[2 * j] + shv[2 * j], h1 = (v[2 * j + 1] * rstd) * gnv[2 * j + 1] + shv[2 * j + 1];
                    u32x4 w; w.x = pk2(h0[0], h0[1]); w.y = pk2(h0[2], h0[3]); w.z = pk2(h1[0], h1[1]); w.w = pk2(h1[2], h1[3]); st16_wt(ho + 64 * j, w); }
            }
        }
    }
}
DI void norm_phase(const float* xin32, const _Float16* xin16, float* xout32, _Float16* xout16, const bf16_t* T, bf16_t* H, bool has_prev, bool has_next,
                   const float* gate_base, const float* gpost, float rw, const float* ss_base, const float* gpre, int gi, int G, int wid, int lane) {
    if (!has_prev)        norm_phase_t<true, false, true, false>(xin32, xin16, xout32, xout16, T, H, gate_base, gpost, rw, ss_base, gpre, gi, G, wid, lane);
    else if (xin32)       norm_phase_t<true, true, true, false>(xin32, xin16, xout32, xout16, T, H, gate_base, gpost, rw, ss_base, gpre, gi, G, wid, lane);
    else if (has_next)    norm_phase_t<false, true, true, false>(xin32, xin16, xout32, xout16, T, H, gate_base, gpost, rw, ss_base, gpre, gi, G, wid, lane);
    else                  norm_phase_t<false, true, false, true>(xin32, xin16, xout32, xout16, T, H, gate_base, gpost, rw, ss_base, gpre, gi, G, wid, lane);
}

template <int GI>
DI void pool_group(const bf16_t* PR, bf16_t* YY, const bf16_t* WPT, const float* pool_scale, size_t tok0, int tl, int pos, int S, int fr, int fq) {
    constexpr int hw = 1 << GI, g = GI;
    const int lo = max(pos - hw, 0), hi = min(pos + hw, S); const float inv = 1.0f / (float)(hi - lo);
    f32x4 acc[8];
#pragma unroll
    for (int e = 0; e < 8; ++e) acc[e] = (f32x4){0.f, 0.f, 0.f, 0.f};
#pragma unroll 1
    for (int ks = 0; ks < 4; ++ks) {
        const bf16_t* zc = PR + (tok0 + tl) * PRP + 1024 + g * 128 + ks * 32 + fq * 8;
        u32x4 w[2 * hw];
#pragma unroll
        for (int j = 0; j < 2 * hw; ++j) { const int t2 = pos + j - hw; const bool ok = (t2 >= 0) && (t2 < S); w[j] = (u32x4){0u, 0u, 0u, 0u}; if (ok) w[j] = *(const u32x4*)(zc + (ptrdiff_t)(j - hw) * PRP); }
        bf16x8 wf[8];
#pragma unroll
        for (int et = 0; et < 8; ++et) wf[et] = *(const bf16x8*)(WPT + ((g * 128 + et * 16 + fr) * 128 + ks * 32 + fq * 8));
        f32x4 s0 = (f32x4){0.f, 0.f, 0.f, 0.f}, s1 = s0;
#pragma unroll
        for (int j = 0; j < 2 * hw; ++j) { s0 += (f32x4){bf_lo(w[j].x), bf_hi(w[j].x), bf_lo(w[j].y), bf_hi(w[j].y)}; s1 += (f32x4){bf_lo(w[j].z), bf_hi(w[j].z), bf_lo(w[j].w), bf_hi(w[j].w)}; }
        const u32x4 cw = w[hw];
        s0 = s0 * inv - (f32x4){bf_lo(cw.x), bf_hi(cw.x), bf_lo(cw.y), bf_hi(cw.y)}; s1 = s1 * inv - (f32x4){bf_lo(cw.z), bf_hi(cw.z), bf_lo(cw.w), bf_hi(cw.w)};
        u32x4 dw; dw.x = pk2(s0[0], s0[1]); dw.y = pk2(s0[2], s0[3]); dw.z = pk2(s1[0], s1[1]); dw.w = pk2(s1[2], s1[3]);
        const bf16x8 df = __builtin_bit_cast(bf16x8, dw);
#pragma unroll
        for (int et = 0; et < 8; ++et) acc[et] = mfma16(wf[et], df, acc[et]);
    }
#pragma unroll
    for (int et = 0; et < 8; ++et) { const int e = g * 128 + et * 16 + fq * 4; const f32x4 ps = *(const f32x4*)(pool_scale + e); const f32x4 y = acc[et] * ps;
        u32x2 o; o.x = pk2(y[0], y[1]); o.y = pk2(y[2], y[3]); *(u32x2*)(YY + (tok0 + tl) * 1024 + 512 + e) = o; }
}

constexpr int PL_ZOFF = 0, PL_WOFF = 144 * 272, PL_PITCH = 272;
struct PoolStage { u32x4 z[5]; u32x4 w[4]; };
DI void pool_stage_load(PoolStage& ps, const bf16_t* PR, const bf16_t* WPT, size_t tok0, int pos0, int S, int g, int tid) {
#pragma unroll
    for (int i = 0; i < 5; ++i) { const int idx = tid + NTHR * i, row = idx >> 4, c = idx & 15; const int p = pos0 - 8 + row;
        ps.z[i] = (u32x4){0u, 0u, 0u, 0u};
        if (idx < 144 * 16 && p >= 0 && p < S) ps.z[i] = *(const u32x4*)(PR + (size_t)((ptrdiff_t)tok0 - 8 + row) * PRP + 1024 + g * 128 + c * 8); }
#pragma unroll
    for (int i = 0; i < 4; ++i) { const int idx = tid + NTHR * i; ps.w[i] = *(const u32x4*)(WPT + (g * 128 + (idx >> 4)) * 128 + (idx & 15) * 8); }
}
DI void pool_stage_store(const PoolStage& ps, LAS unsigned char* lds, int tid) {
#pragma unroll
    for (int i = 0; i < 5; ++i) { const int idx = tid + NTHR * i; if (idx < 144 * 16) *(LAS u32x4*)(lds + PL_ZOFF + (idx >> 4) * PL_PITCH + (idx & 15) * 16) = ps.z[i]; }
#pragma unroll
    for (int i = 0; i < 4; ++i) { const int idx = tid + NTHR * i; *(LAS u32x4*)(lds + PL_WOFF + (idx >> 4) * PL_PITCH + (idx & 15) * 16) = ps.w[i]; }
}
template <int GI>
DI void pool_compute(LAS unsigned char* lds, bf16_t* YY, const float* pool_scale, size_t tok0, int tl, int pos, int S, int fr, int fq) {
    constexpr int hw = 1 << GI, g = GI;
    const int lo = max(pos - hw, 0), hi = min(pos + hw, S); const float inv = 1.0f / (float)(hi - lo);
    f32x4 acc[8];
#pragma unroll
    for (int e = 0; e < 8; ++e) acc[e] = (f32x4){0.f, 0.f, 0.f, 0.f};
#pragma unroll 2
    for (int ks = 0; ks < 4; ++ks) {
        const LAS unsigned char* zb = lds + PL_ZOFF + (tl + 8) * PL_PITCH + (ks * 32 + fq * 8) * 2;
        f32x4 s0 = (f32x4){0.f, 0.f, 0.f, 0.f}, s1 = s0;
#pragma unroll
        for (int j = -hw; j < hw; ++j) { const u32x4 x = *(const LAS u32x4*)(zb + j * PL_PITCH);
            s0 += (f32x4){bf_lo(x.x), bf_hi(x.x), bf_lo(x.y), bf_hi(x.y)}; s1 += (f32x4){bf_lo(x.z), bf_hi(x.z), bf_lo(x.w), bf_hi(x.w)}; }
        const u32x4 cw = *(const LAS u32x4*)zb;
        s0 = s0 * inv - (f32x4){bf_lo(cw.x), bf_hi(cw.x), bf_lo(cw.y), bf_hi(cw.y)}; s1 = s1 * inv - (f32x4){bf_lo(cw.z), bf_hi(cw.z), bf_lo(cw.w), bf_hi(cw.w)};
        u32x4 dw; dw.x = pk2(s0[0], s0[1]); dw.y = pk2(s0[2], s0[3]); dw.z = pk2(s1[0], s1[1]); dw.w = pk2(s1[2], s1[3]);
        const bf16x8 df = __builtin_bit_cast(bf16x8, dw);
#pragma unroll
        for (int et = 0; et < 8; ++et) { const bf16x8 wf = *(const LAS bf16x8*)(lds + PL_WOFF + (et * 16 + fr) * PL_PITCH + (ks * 32 + fq * 8) * 2); acc[et] = mfma16(wf, df, acc[et]); }
    }
#pragma unroll
    for (int et = 0; et < 8; ++et) { const int e = g * 128 + et * 16 + fq * 4; const f32x4 ps = *(const f32x4*)(pool_scale + e); const f32x4 y = acc[et] * ps;
        u32x2 o; o.x = pk2(y[0], y[1]); o.y = pk2(y[2], y[3]); *(u32x2*)(YY + (tok0 + tl) * 1024 + 512 + e) = o; }
}

DI void even_core(LAS unsigned char* lds, const bf16_t* PR, bf16_t* YY, const bf16_t* WSP, const bf16_t* WPT, const float* ln_g, const float* ln_b,
                  const float* b_sp, const float* pool_scale, int S, int G, int tid, int wid, int lane) {
    const int fr = lane & 15, fq = lane >> 4;
    constexpr int PITCH = 1056;
    for (int ch0 = blockIdx.x; ch0 < GROWS / 128; ch0 += G) {
        const int ch = (G == 256) ? 2 * (16 * (ch0 & 7) + 8 * (ch0 >> 7) + ((ch0 >> 3) & 7)) + ((ch0 >> 6) & 1) : ch0;
        const size_t tok0 = (size_t)ch * 128;
        {
            const f32x4 g0 = *(const f32x4*)(ln_g + lane * 8), g1 = *(const f32x4*)(ln_g + lane * 8 + 4), b0 = *(const f32x4*)(ln_b + lane * 8), b1 = *(const f32x4*)(ln_b + lane * 8 + 4);
#pragma unroll 8
            for (int i = 0; i < 16; ++i) {
                const int q = wid * 16 + i;
                const u32x4 w = *(const u32x4*)(PR + (tok0 + q) * PRP + 512 + lane * 8);
                f32x4 a = (f32x4){bf_lo(w.x), bf_hi(w.x), bf_lo(w.y), bf_hi(w.y)}, b = (f32x4){bf_lo(w.z), bf_hi(w.z), bf_lo(w.w), bf_hi(w.w)};
                const float mean = wave_sum((a[0] + a[1]) + (a[2] + a[3]) + (b[0] + b[1]) + (b[2] + b[3])) * (1.0f / 512.0f);
                a = a - mean; b = b - mean;
                const float var = wave_sum((a[0] * a[0] + a[1] * a[1]) + (a[2] * a[2] + a[3] * a[3]) + (b[0] * b[0] + b[1] * b[1]) + (b[2] * b[2] + b[3] * b[3])) * (1.0f / 512.0f);
                const float rstd = rsqrtf(var + 1e-5f);
                a = a * rstd * g0 + b0; b = b * rstd * g1 + b1;
                u32x4 o; o.x = pk2(a[0], a[1]); o.y = pk2(a[2], a[3]); o.z = pk2(b[0], b[1]); o.w = pk2(b[2], b[3]);
                *(LAS u32x4*)(lds + q * PITCH + lane * 16) = o;
            }
        }
        __syncthreads();
        {
            const int h = wid >> 1, cw0 = wid * 64;
            for (int ph = 0; ph < 2; ++ph) {
                f32x4 acc[4][4];
#pragma unroll
                for (int a = 0; a < 4; ++a)
#pragma unroll
                    for (int b = 0; b < 4; ++b) acc[a][b] = (f32x4){0.f, 0.f, 0.f, 0.f};
#pragma unroll 1
                for (int kp = 0; kp < 2; ++kp) {
                    bf16x8 bw[2][4];
#pragma unroll
                    for (int k2 = 0; k2 < 2; ++k2)
#pragma unroll
                        for (int pt = 0; pt < 4; ++pt) bw[k2][pt] = *(const bf16x8*)(WSP + ((h * 128 + (ph * 4 + pt) * 16 + fr) * 128 + (kp * 2 + k2) * 32 + fq * 8));
#pragma unroll
                    for (int k2 = 0; k2 < 2; ++k2) {
                        const int ks = kp * 2 + k2;
                        bf16x8 af[4];
#pragma unroll
                        for (int ct = 0; ct < 4; ++ct) af[ct] = tr_frag(lds + (ks * 32 + fq * 8 + (fr >> 2)) * PITCH + (cw0 + ct * 16 + 4 * (fr & 3)) * 2, 4 * PITCH);
#pragma unroll
                        for (int ct = 0; ct < 4; ++ct)
#pragma unroll
                            for (int pt = 0; pt < 4; ++pt) acc[ct][pt] = mfma16(af[ct], bw[k2][pt], acc[ct][pt]);
                    }
                }
#pragma unroll
                for (int pt = 0; pt < 4; ++pt) {
                    const int pp = (ph * 4 + pt) * 16 + fr; const float bs = b_sp[h * 128 + pp];
#pragma unroll
                    for (int ct = 0; ct < 4; ++ct) {
                        const int c = cw0 + ct * 16 + fq * 4;
                        const u32x2 uw = *(const u32x2*)(PR + (tok0 + pp) * PRP + c);
                        u32x2 o; o.x = pk2(bf_lo(uw.x) * (acc[ct][pt][0] + bs), bf_hi(uw.x) * (acc[ct][pt][1] + bs)); o.y = pk2(bf_lo(uw.y) * (acc[ct][pt][2] + bs), bf_hi(uw.y) * (acc[ct][pt][3] + bs));
                        *(u32x2*)(YY + (tok0 + pp) * 1024 + c) = o;
                    }
                }
            }
        }
        {
            const int tl = wid * 16 + fr; const int pos = (int)(tok0 % (size_t)S) + tl;
            const int pos0 = (int)(tok0 % (size_t)S);
            PoolStage ps;
            pool_stage_load(ps, PR, WPT, tok0, pos0, S, 0, tid);
            __syncthreads();
            pool_stage_store(ps, lds, tid); pool_stage_load(ps, PR, WPT, tok0, pos0, S, 1, tid);
            __syncthreads();
            pool_compute<0>(lds, YY, pool_scale, tok0, tl, pos, S, fr, fq);
            __syncthreads();
            pool_stage_store(ps, lds, tid); pool_stage_load(ps, PR, WPT, tok0, pos0, S, 2, tid);
            __syncthreads();
            pool_compute<1>(lds, YY, pool_scale, tok0, tl, pos, S, fr, fq);
            __syncthreads();
            pool_stage_store(ps, lds, tid); pool_stage_load(ps, PR, WPT, tok0, pos0, S, 3, tid);
            __syncthreads();
            pool_compute<2>(lds, YY, pool_scale, tok0, tl, pos, S, fr, fq);
            __syncthreads();
            pool_stage_store(ps, lds, tid);
            __syncthreads();
            pool_compute<3>(lds, YY, pool_scale, tok0, tl, pos, S, fr, fq);
        }
        __syncthreads();
    }
}

DI void conv_part(const bf16_t* PR, bf16_t* YY, const float* conv_w, int S, int G, int wid, int lane) {
    const int gw = blockIdx.x * 8 + wid, NGW = G * 8;
    f32x4 w[3][2];
#pragma unroll
    for (int k = 0; k < 3; ++k) { w[k][0] = *(const f32x4*)(conv_w + k * 512 + lane * 8); w[k][1] = *(const f32x4*)(conv_w + k * 512 + lane * 8 + 4); }
#pragma unroll 4
    for (int r = gw; r < GROWS; r += NGW) {
        const int pos = r % S;
        const bf16_t* cz = PR + (size_t)r * PRP + lane * 8;
        const float m0 = (pos > 0) ? 1.0f : 0.0f, m2 = (pos < S - 1) ? 1.0f : 0.0f;
        const u32x4 c1 = *(const u32x4*)cz, c0 = *(const u32x4*)(cz - (pos > 0 ? PRP : 0)), c2 = *(const u32x4*)(cz + (pos < S - 1 ? PRP : 0)), bg = *(const u32x4*)(cz + 512);
        const f32x4 w00 = w[0][0] * m0, w01 = w[0][1] * m0, w20 = w[2][0] * m2, w21 = w[2][1] * m2;
        f32x4 a0 = (f32x4){bf_lo(c0.x), bf_hi(c0.x), bf_lo(c0.y), bf_hi(c0.y)} * w00 + (f32x4){bf_lo(c1.x), bf_hi(c1.x), bf_lo(c1.y), bf_hi(c1.y)} * w[1][0] + (f32x4){bf_lo(c2.x), bf_hi(c2.x), bf_lo(c2.y), bf_hi(c2.y)} * w20;
        f32x4 a1 = (f32x4){bf_lo(c0.z), bf_hi(c0.z), bf_lo(c0.w), bf_hi(c0.w)} * w01 + (f32x4){bf_lo(c1.z), bf_hi(c1.z), bf_lo(c1.w), bf_hi(c1.w)} * w[1][1] + (f32x4){bf_lo(c2.z), bf_hi(c2.z), bf_lo(c2.w), bf_hi(c2.w)} * w21;
        a0 = a0 * (f32x4){bf_lo(bg.x), bf_hi(bg.x), bf_lo(bg.y), bf_hi(bg.y)}; a1 = a1 * (f32x4){bf_lo(bg.z), bf_hi(bg.z), bf_lo(bg.w), bf_hi(bg.w)};
        u32x4 o; o.x = pk2(a0[0], a0[1]); o.y = pk2(a0[2], a0[3]); o.z = pk2(a1[0], a1[1]); o.w = pk2(a1[2], a1[3]);
        *(u32x4*)(YY + (size_t)r * 1024 + lane * 8) = o;
    }
}

template <int R, int QB>
DI void four_stage1(const bf16_t* PR, bf16_t* UB, const bf16_t* WF, const bf16_t* FCp, const bf16_t* FSp, const f32x2* TW, int nb, int G, int wid, int lane) {
    constexpr int NT = R / 16, KS = (R + 31) / 32, KW = KS * 32, S = R * 128, NQB = 128 / QB;
    const int fr = lane & 15, fq = lane >> 4, e0 = wid * 16;
    const int nunits = nb * 4 * NQB;
    for (int un = blockIdx.x; un < nunits; un += G) {
        const int q0 = (un % NQB) * QB, g = (un / NQB) & 3, b = un / (4 * NQB);
        bf16x8 wP[4], wQ[4];
#pragma unroll
        for (int ks = 0; ks < 4; ++ks) { wP[ks] = *(const bf16x8*)(WF + ((g * 256 + e0 + fr) * 128 + ks * 32 + fq * 8)); wQ[ks] = *(const bf16x8*)(WF + ((g * 256 + 128 + e0 + fr) * 128 + ks * 32 + fq * 8)); }
        unsigned pP[QB][NT][2], pQ[QB][NT][2];
#pragma unroll
        for (int rt = 0; rt < NT; ++rt) {
#pragma unroll
            for (int qi = 0; qi < QB; ++qi) {
                const size_t tok = (size_t)b * S + 128 * (rt * 16 + fr) + q0 + qi;
                const bf16_t* zp = PR + tok * PRP + 1024 + g * 128 + fq * 8;
                bf16x8 a[4]; float ss = 0.f;
#pragma unroll
                for (int ks = 0; ks < 4; ++ks) a[ks] = *(const bf16x8*)(zp + ks * 32);
#pragma unroll
                for (int ks = 0; ks < 4; ++ks)
#pragma unroll
                    for (int k = 0; k < 8; ++k) { const float f = __uint_as_float(((unsigned)(unsigned short)a[ks][k]) << 16); ss += f * f; }
                ss += __shfl_xor(ss, 16); ss += __shfl_xor(ss, 32);
                const float rs = rsqrtf(ss * (1.0f / 128.0f) + 1e-6f);
                f32x4 dP = (f32x4){0.f, 0.f, 0.f, 0.f}, dQ = dP;
#pragma unroll
                for (int ks = 0; ks < 4; ++ks) { dP = mfma16(a[ks], wP[ks], dP); dQ = mfma16(a[ks], wQ[ks], dQ); }
#pragma unroll
                for (int j = 0; j < 4; ++j) { const float sj = __shfl(rs, fq * 4 + j); dP[j] *= sj; dQ[j] *= sj; }
                pP[qi][rt][0] = pk2(dP[0], dP[1]); pP[qi][rt][1] = pk2(dP[2], dP[3]); pQ[qi][rt][0] = pk2(dQ[0], dQ[1]); pQ[qi][rt][1] = pk2(dQ[2], dQ[3]);
            }
            if ((rt & 3) == 3) asm volatile("" ::: "memory");
        }
#pragma unroll 2
        for (int k1t = 0; k1t < NT; ++k1t) {
            bf16x8 aC[KS], aS[KS];
#pragma unroll
            for (int s = 0; s < KS; ++s) { aC[s] = *(const bf16x8*)(FCp + ((k1t * 16 + fr) * KW + s * 32 + fq * 8)); aS[s] = *(const bf16x8*)(FSp + ((k1t * 16 + fr) * KW + s * 32 + fq * 8)); }
#pragma unroll
            for (int qi = 0; qi < QB; ++qi) {
                f32x4 Ur = (f32x4){0.f, 0.f, 0.f, 0.f}, V = Ur;
#pragma unroll
                for (int s = 0; s < KS; ++s) {
                    u32x4 bp, bq;
                    bp.x = pP[qi][2 * s][0]; bp.y = pP[qi][2 * s][1]; bq.x = pQ[qi][2 * s][0]; bq.y = pQ[qi][2 * s][1];
                    if (2 * s + 1 < NT) { bp.z = pP[qi][(2 * s + 1) % NT][0]; bp.w = pP[qi][(2 * s + 1) % NT][1]; bq.z = pQ[qi][(2 * s + 1) % NT][0]; bq.w = pQ[qi][(2 * s + 1) % NT][1]; }
                    else { bp.z = 0u; bp.w = 0u; bq.z = 0u; bq.w = 0u; }
                    const u32x4 bnq = bq ^ 0x80008000u;
                    const bf16x8 BP = __builtin_bit_cast(bf16x8, bp), BQ = __builtin_bit_cast(bf16x8, bq), BNQ = __builtin_bit_cast(bf16x8, bnq);
                    Ur = mfma16(aC[s], BP, Ur); Ur = mfma16(aS[s], BNQ, Ur); V = mfma16(aS[s], BP, V); V = mfma16(aC[s], BQ, V);
                }
                const int q = q0 + qi;
#pragma unroll
                for (int j = 0; j < 4; ++j) {
                    const int k1 = k1t * 16 + fq * 4 + j; const f32x2 tw = TW[q * R + k1];
                    const float upr = Ur[j] * tw.x - V[j] * tw.y, upi = -(V[j] * tw.x + Ur[j] * tw.y);
                    bf16_t* o = UB + ((((size_t)b * R + k1) * 2) * 128 + q) * 512 + g * 128 + e0 + fr;
                    o[0] = (bf16_t)f2bf(upr); o[(size_t)128 * 512] = (bf16_t)f2bf(upi);
                }
            }
        }
    }
}

DI void four_stage1_p(LAS unsigned char* lds, const bf16_t* PR, bf16_t* UB, const bf16_t* WF, const bf16_t* FCp, const bf16_t* FSp, const f32x2* TW, int nb, int G, int tid, int wid, int lane) {
    constexpr int R = 128, S = R * 128, PT = 272, TC_OFF = 0, TS_OFF = 128 * PT, Z_OFF = 256 * PT, TW_OFF = 384 * PT;
    const int fr = lane & 15, fq = lane >> 4, e0 = wid * 16;
    const int nunits = nb * 4 * 128;
    {
#pragma unroll
        for (int i = 0; i < 4; ++i) { const int idx = tid + NTHR * i; const u32x4 c = *(const u32x4*)(FCp + (idx >> 4) * 128 + (idx & 15) * 8), sn = *(const u32x4*)(FSp + (idx >> 4) * 128 + (idx & 15) * 8);
            *(LAS u32x4*)(lds + TC_OFF + (idx >> 4) * PT + (idx & 15) * 16) = c; *(LAS u32x4*)(lds + TS_OFF + (idx >> 4) * PT + (idx & 15) * 16) = sn; }
    }
    u32x4 zr[4]; u32x4 twr = (u32x4){0u, 0u, 0u, 0u};
    int un = blockIdx.x;
    if (un < nunits) { const int q = un & 127, g = (un >> 7) & 3, b = un >> 9;
#pragma unroll
        for (int i = 0; i < 4; ++i) { const int idx = tid + NTHR * i; zr[i] = *(const u32x4*)(PR + ((size_t)b * S + 128 * (idx >> 4) + q) * PRP + 1024 + g * 128 + (idx & 15) * 8); }
        if (tid < 64) twr = *(const u32x4*)((const float*)(TW + q * R) + tid * 4); }
    for (; un < nunits; un += G) {
        const int q = un & 127, g = (un >> 7) & 3, b = un >> 9;
        bf16x8 wP[4], wQ[4];
#pragma unroll
        for (int ks = 0; ks < 4; ++ks) { wP[ks] = *(const bf16x8*)(WF + ((g * 256 + e0 + fr) * 128 + ks * 32 + fq * 8)); wQ[ks] = *(const bf16x8*)(WF + ((g * 256 + 128 + e0 + fr) * 128 + ks * 32 + fq * 8)); }
        __syncthreads();
#pragma unroll
        for (int i = 0; i < 4; ++i) { const int idx = tid + NTHR * i; *(LAS u32x4*)(lds + Z_OFF + (idx >> 4) * PT + (idx & 15) * 16) = zr[i]; }
        if (tid < 64) *(LAS u32x4*)(lds + TW_OFF + tid * 16) = twr;
        { const int un2 = un + G;
          if (un2 < nunits) { const int q2 = un2 & 127, g2 = (un2 >> 7) & 3, b2 = un2 >> 9;
#pragma unroll
            for (int i = 0; i < 4; ++i) { const int idx = tid + NTHR * i; zr[i] = *(const u32x4*)(PR + ((size_t)b2 * S + 128 * (idx >> 4) + q2) * PRP + 1024 + g2 * 128 + (idx & 15) * 8); }
            if (tid < 64) twr = *(const u32x4*)((const float*)(TW + q2 * R) + tid * 4); } }
        __syncthreads();
        unsigned pP[8][2], pQ[8][2];
#pragma unroll
        for (int rt = 0; rt < 8; ++rt) {
            bf16x8 a[4]; float ss = 0.f;
#pragma unroll
            for (int ks = 0; ks < 4; ++ks) a[ks] = *(const LAS bf16x8*)(lds + Z_OFF + (rt * 16 + fr) * PT + (ks * 32 + fq * 8) * 2);
#pragma unroll
            for (int ks = 0; ks < 4; ++ks)
#pragma unroll
                for (int k = 0; k < 8; ++k) { const float f = __uint_as_float(((unsigned)(unsigned short)a[ks][k]) << 16); ss += f * f; }
            ss += __shfl_xor(ss, 16); ss += __shfl_xor(ss, 32);
            const float rs = rsqrtf(ss * (1.0f / 128.0f) + 1e-6f);
            f32x4 dP = (f32x4){0.f, 0.f, 0.f, 0.f}, dQ = dP;
#pragma unroll
            for (int ks = 0; ks < 4; ++ks) { dP = mfma16(a[ks], wP[ks], dP); dQ = mfma16(a[ks], wQ[ks], dQ); }
#pragma unroll
            for (int j = 0; j < 4; ++j) { const float sj = __shfl(rs, fq * 4 + j); dP[j] *= sj; dQ[j] *= sj; }
            pP[rt][0] = pk2(dP[0], dP[1]); pP[rt][1] = pk2(dP[2], dP[3]); pQ[rt][0] = pk2(dQ[0], dQ[1]); pQ[rt][1] = pk2(dQ[2], dQ[3]);
            if ((rt & 3) == 3) asm volatile("" ::: "memory");
        }
#pragma unroll 2
        for (int k1t = 0; k1t < 8; ++k1t) {
            bf16x8 aC[4], aS[4];
#pragma unroll
            for (int sx = 0; sx < 4; ++sx) { aC[sx] = *(const LAS bf16x8*)(lds + TC_OFF + (k1t * 16 + fr) * PT + (sx * 32 + fq * 8) * 2); aS[sx] = *(const LAS bf16x8*)(lds + TS_OFF + (k1t * 16 + fr) * PT + (sx * 32 + fq * 8) * 2); }
            const f32x4 twa = *(const LAS f32x4*)(lds + TW_OFF + (k1t * 16 + fq * 4) * 8), twb = *(const LAS f32x4*)(lds + TW_OFF + (k1t * 16 + fq * 4) * 8 + 16);
            f32x4 Ur = (f32x4){0.f, 0.f, 0.f, 0.f}, V = Ur;
#pragma unroll
            for (int sx = 0; sx < 4; ++sx) {
                u32x4 bp, bq;
                bp.x = pP[2 * sx][0]; bp.y = pP[2 * sx][1]; bq.x = pQ[2 * sx][0]; bq.y = pQ[2 * sx][1];
                bp.z = pP[2 * sx + 1][0]; bp.w = pP[2 * sx + 1][1]; bq.z = pQ[2 * sx + 1][0]; bq.w = pQ[2 * sx + 1][1];
                const u32x4 bnq = bq ^ 0x80008000u;
                const bf16x8 BP = __builtin_bit_cast(bf16x8, bp), BQ = __builtin_bit_cast(bf16x8, bq), BNQ = __builtin_bit_cast(bf16x8, bnq);
                Ur = mfma16(aC[sx], BP, Ur); Ur = mfma16(aS[sx], BNQ, Ur); V = mfma16(aS[sx], BP, V); V = mfma16(aC[sx], BQ, V);
            }
            const float tcs[4] = {twa[0], twa[2], twb[0], twb[2]}, tsn[4] = {twa[1], twa[3], twb[1], twb[3]};
#pragma unroll
            for (int j = 0; j < 4; ++j) {
                const int k1 = k1t * 16 + fq * 4 + j;
                const float upr = Ur[j] * tcs[j] - V[j] * tsn[j], upi = -(V[j] * tcs[j] + Ur[j] * tsn[j]);
                bf16_t* o = UB + ((((size_t)b * R + k1) * 2) * 128 + q) * 512 + g * 128 + e0 + fr;
                o[0] = (bf16_t)f2bf(upr); o[(size_t)128 * 512] = (bf16_t)f2bf(upi);
            }
        }
    }
    __syncthreads();
}

DI void four_stage1_s(LAS unsigned char* lds, const bf16_t* PR, bf16_t* UB, const bf16_t* WF, const bf16_t* FCp, const bf16_t* FSp, const f32x2* TW, int nb, int G, int tid, int wid, int lane) {
    constexpr int R = 16, S = R * 128, QB = 4, NQB = 32, PT = 272;
    const int fr = lane & 15, fq = lane >> 4, e0 = wid * 16;
    const int nunits = nb * 4 * NQB;
    const bool uniform = (G % 128) == 0;
    int un = blockIdx.x;
    if (un >= nunits) return;
    int q0 = (un % NQB) * QB, g = (un / NQB) & 3;
    bf16x8 wP[4], wQ[4], aC, aS; f32x4 twv[QB][2];
    u32x4 zr[2];
#define S1S_CONST() do { _Pragma("unroll") for (int ks = 0; ks < 4; ++ks) { wP[ks] = *(const bf16x8*)(WF + ((g * 256 + e0 + fr) * 128 + ks * 32 + fq * 8)); wQ[ks] = *(const bf16x8*)(WF + ((g * 256 + 128 + e0 + fr) * 128 + ks * 32 + fq * 8)); } \
        _Pragma("unroll") for (int qi = 0; qi < QB; ++qi) { const f32x4* tp = (const f32x4*)(TW + (q0 + qi) * R + fq * 4); twv[qi][0] = tp[0]; twv[qi][1] = tp[1]; } } while (0)
    aC = *(const bf16x8*)(FCp + (fr * 32 + fq * 8)); aS = *(const bf16x8*)(FSp + (fr * 32 + fq * 8));
    S1S_CONST();
    { const int b = un / (4 * NQB);
#pragma unroll
      for (int i = 0; i < 2; ++i) { const int idx = tid + NTHR * i, row = idx >> 4; zr[i] = *(const u32x4*)(PR + ((size_t)b * S + 128 * (row & 15) + q0 + (row >> 4)) * PRP + 1024 + g * 128 + (idx & 15) * 8); } }
    for (; un < nunits; un += G) {
        const int b = un / (4 * NQB);
        __syncthreads();
#pragma unroll
        for (int i = 0; i < 2; ++i) { const int idx = tid + NTHR * i; *(LAS u32x4*)(lds + (idx >> 4) * PT + (idx & 15) * 16) = zr[i]; }
        const int un2 = un + G; int q0n = q0, gn = g;
        if (un2 < nunits) { const int b2 = un2 / (4 * NQB); q0n = (un2 % NQB) * QB; gn = (un2 / NQB) & 3;
#pragma unroll
            for (int i = 0; i < 2; ++i) { const int idx = tid + NTHR * i, row = idx >> 4; zr[i] = *(const u32x4*)(PR + ((size_t)b2 * S + 128 * (row & 15) + q0n + (row >> 4)) * PRP + 1024 + gn * 128 + (idx & 15) * 8); } }
        __syncthreads();
#pragma unroll
        for (int qi = 0; qi < QB; ++qi) {
            bf16x8 a[4]; float ss = 0.f;
#pragma unroll
            for (int ks = 0; ks < 4; ++ks) a[ks] = *(const LAS bf16x8*)(lds + (qi * 16 + fr) * PT + (ks * 32 + fq * 8) * 2);
#pragma unroll
            for (int ks = 0; ks < 4; ++ks)
#pragma unroll
                for (int k = 0; k < 8; ++k) { const float f = __uint_as_float(((unsigned)(unsigned short)a[ks][k]) << 16); ss += f * f; }
            ss += __shfl_xor(ss, 16); ss += __shfl_xor(ss, 32);
            const float rs = rsqrtf(ss * (1.0f / 128.0f) + 1e-6f);
            f32x4 dP = (f32x4){0.f, 0.f, 0.f, 0.f}, dQ = dP;
#pragma unroll
            for (int ks = 0; ks < 4; ++ks) { dP = mfma16(a[ks], wP[ks], dP); dQ = mfma16(a[ks], wQ[ks], dQ); }
#pragma unroll
            for (int j = 0; j < 4; ++j) { const float sj = __shfl(rs, fq * 4 + j); dP[j] *= sj; dQ[j] *= sj; }
            u32x4 bp, bq; bp.x = pk2(dP[0], dP[1]); bp.y = pk2(dP[2], dP[3]); bp.z = 0u; bp.w = 0u; bq.x = pk2(dQ[0], dQ[1]); bq.y = pk2(dQ[2], dQ[3]); bq.z = 0u; bq.w = 0u;
            const u32x4 bnq = bq ^ 0x80008000u;
            const bf16x8 BP = __builtin_bit_cast(bf16x8, bp), BQ = __builtin_bit_cast(bf16x8, bq), BNQ = __builtin_bit_cast(bf16x8, bnq);
            f32x4 Ur = (f32x4){0.f, 0.f, 0.f, 0.f}, V = Ur;
            Ur = mfma16(aC, BP, Ur); Ur = mfma16(aS, BNQ, Ur); V = mfma16(aS, BP, V); V = mfma16(aC, BQ, V);
            const int q = q0 + qi;
            const float tcs[4] = {twv[qi][0][0], twv[qi][0][2], twv[qi][1][0], twv[qi][1][2]}, tsn[4] = {twv[qi][0][1], twv[qi][0][3], twv[qi][1][1], twv[qi][1][3]};
#pragma unroll
            for (int j = 0; j < 4; ++j) {
                const int k1 = fq * 4 + j;
                const float upr = Ur[j] * tcs[j] - V[j] * tsn[j], upi = -(V[j] * tcs[j] + Ur[j] * tsn[j]);
                bf16_t* o = UB + ((((size_t)b * R + k1) * 2) * 128 + q) * 512 + g * 128 + e0 + fr;
                o[0] = (bf16_t)f2bf(upr); o[(size_t)128 * 512] = (bf16_t)f2bf(upi);
            }
        }
        if (!uniform && un2 < nunits) { q0 = q0n; g = gn; S1S_CONST(); }
    }
#undef S1S_CONST
    __syncthreads();
}

template <int R>
DI void four_stage2(LAS unsigned char* lds, const bf16_t* UB, bf16_t* YY, const bf16_t* FC2, const bf16_t* FS2, int nb, int G, int tid, int wid, int lane) {
    constexpr int PITCH2 = 544, S = R * 128;
    const float norm = rsqrtf((float)S * 128.0f);
    const int fr = lane & 15, fq = lane >> 4, c0 = wid * 32;
    const int nunits = nb * R * 2;
    for (int un = blockIdx.x; un < nunits; un += G) {
        const int ch2 = un & 1, k1 = (un >> 1) % R, b = (un >> 1) / R;
        const bf16_t* src = UB + (((size_t)b * R + k1) * 2) * 128 * 512 + ch2 * 256;
#pragma unroll
        for (int pass = 0; pass < 16; ++pass) { const int row = pass * 16 + (tid >> 5), seg = tid & 31;
            const u32x4 w = *(const u32x4*)(src + (size_t)row * 512 + seg * 8); *(LAS u32x4*)(lds + row * PITCH2 + seg * 16) = w; }
        __syncthreads();
        f32x4 acc[2][8];
#pragma unroll
        for (int a = 0; a < 2; ++a)
#pragma unroll
            for (int k = 0; k < 8; ++k) acc[a][k] = (f32x4){0.f, 0.f, 0.f, 0.f};
        bf16x8 fa[8];
#pragma unroll
        for (int k2t = 0; k2t < 8; ++k2t) fa[k2t] = *(const bf16x8*)(FC2 + ((k2t * 16 + fr) * 128 + fq * 8));
#pragma unroll 2
        for (int it = 0; it < 8; ++it) {
            const int comp = it >> 2, ks = it & 3, itn = (it + 1) & 7;
            bf16x8 fn[8];
            { const bf16_t* Fn = (itn >> 2) ? FS2 : FC2;
#pragma unroll
              for (int k2t = 0; k2t < 8; ++k2t) fn[k2t] = *(const bf16x8*)(Fn + ((k2t * 16 + fr) * 128 + (itn & 3) * 32 + fq * 8)); }
            bf16x8 uf[2];
#pragma unroll
            for (int ct = 0; ct < 2; ++ct) uf[ct] = tr_frag(lds + (comp * 128 + ks * 32 + fq * 8 + (fr >> 2)) * PITCH2 + (c0 + ct * 16 + 4 * (fr & 3)) * 2, 4 * PITCH2);
#pragma unroll
            for (int k2t = 0; k2t < 8; ++k2t)
#pragma unroll
                for (int ct = 0; ct < 2; ++ct) acc[ct][k2t] = mfma16(uf[ct], fa[k2t], acc[ct][k2t]);
#pragma unroll
            for (int k2t = 0; k2t < 8; ++k2t) fa[k2t] = fn[k2t];
        }
#pragma unroll
        for (int k2t = 0; k2t < 8; ++k2t) {
            const size_t tok = (size_t)b * S + (size_t)R * (k2t * 16 + fr) + k1;
#pragma unroll
            for (int ct = 0; ct < 2; ++ct) { const f32x4 y = acc[ct][k2t] * norm; u32x2 o; o.x = pk2(y[0], y[1]); o.y = pk2(y[2], y[3]);
                *(u32x2*)(YY + tok * 1024 + 512 + ch2 * 256 + c0 + ct * 16 + fq * 4) = o; }
        }
        __syncthreads();
    }
}

__global__ void __launch_bounds__(NTHR, 2) mega_fwd(Params p) {
    extern __shared__ __attribute__((aligned(16))) unsigned char lds_raw[];
    LAS unsigned char* lds = (LAS unsigned char*)lds_raw;
    cg::grid_group grid = cg::this_grid();
    const int tid = threadIdx.x, lane = tid & 63, wid = __builtin_amdgcn_readfirstlane(tid >> 6), G = gridDim.x;
    unsigned char* ws = p.ws;
    int pc = 0;
#define PH_BEGIN if (pc >= p.ph_lo && pc < p.ph_hi) {
    volatile LAS unsigned* bst = (volatile LAS unsigned*)(lds + LDS_BYTES - 64);
    if (tid < 2) bst[tid] = 0u;
    __syncthreads();
    if (p.ph_lo > p.ph_hi) grid.sync();
    XcdBarrier xbar = xcd_barrier_post((unsigned*)(ws + WS_BAR), bst);
    if (tid == 0) { (void)__hip_atomic_fetch_max(&xbar.bar[XB_CLS(blockIdx.x & 7u)], xbar.x + 1u, __ATOMIC_RELAXED, __HIP_MEMORY_SCOPE_AGENT); (void)__hip_atomic_fetch_max(&xbar.bar[XB_CLS(8u + (blockIdx.x & 7u))], 16u - xbar.x, __ATOMIC_RELAXED, __HIP_MEMORY_SCOPE_AGENT); }
    bool local_ok = false, seam_local = false;
#define PH_END } ++pc; if (pc == 1) { xcd_barrier(xbar); \
        local_ok = (G == 256) && (bst[0] == 32u) && (bst[1] == 8u) && (xb_ld(&xbar.bar[XB_TMO]) == 0u); \
        for (unsigned cc = 0; cc < 8u; ++cc) local_ok = local_ok && (xb_ld(&xbar.bar[XB_CLS(cc)]) + xb_ld(&xbar.bar[XB_CLS(8u + cc)]) == 17u); } \
    else if (seam_local && local_ok) { team_barrier(xbar); } else { xcd_barrier(xbar); }

    PH_BEGIN
#if PHMASK & 1
#if PROBE & 16
 for (int rep = 0; rep < 2; ++rep)
#endif
 setup_phase(p, lds, G, tid, wid, lane);
#endif
 PH_END

    bf16_t* H = (bf16_t*)(ws + WS_H); bf16_t* T = (bf16_t*)(ws + WS_T); bf16_t* BIG = (bf16_t*)(ws + WS_BIG); bf16_t* UB = (bf16_t*)(ws + WS_T);     _Float16* XH = (_Float16*)(ws + WS_XH);
    const float* mod = (const float*)(ws + WS_MOD);
    for (int gi = 0; gi < 2; ++gi) {
        const int S = gi ? 2048 : 16384, nb = gi ? 16 : 2;
        const float* xsrc = p.in[gi];
        float* xo = p.out + (size_t)gi * GROWS * D;
        for (int ls = 0; ls < 7; ++ls) {
            const int l = ls / 3, sub = ls % 3;
            const bool odd = (l & 1), last = (ls == 6), first = (ls == 0);
            const int nsteps = last ? 1 : (sub != 1 ? 3 : (odd ? 5 : 4));
            for (int step = 0; step < nsteps; ++step) {
                int kind = 1;
                if (step == 0) kind = 0;
                else if (sub == 1 && step == 2) kind = odd ? 3 : 2;
                else if (sub == 1 && odd && step == 3) kind = 4;
                seam_local = !((kind == 1 && sub == 1) || kind == 3 || kind == 4);
                PH_BEGIN
                int tid = threadIdx.x; asm volatile("" : "+v"(tid));
                const int lane = tid & 63, wid = __builtin_amdgcn_readfirstlane(tid >> 6);
                if (kind == 0) {
#if PHMASK & 2
#ifndef STAG2
#define STAG2 0
#endif
                    if (STAG2 && local_ok && ((gi == 0 && ls == 0) || sub == 2) && ((blockIdx.x >> 3) & 1)) { for (int zz = 0; zz < STAG2; ++zz) __builtin_amdgcn_s_sleep(127); }
                    const int lp = sub > 0 ? l : l - 1, sp = sub > 0 ? sub - 1 : 2, lpp = first ? 0 : lp, lc = last ? 0 : l;
#if PROBE & 4
                    norm_phase(ls <= 1 ? xsrc : nullptr, XH, last ? (float*)BIG : nullptr, (_Float16*)BIG, T, H, !first, !last,
                               mod + (size_t)lpp * 18 * 9216 + (sp * 3 + 2) * 1024, p.in[7] + (lpp * 3 + sp) * 1024, sp == 1 ? 1.0f : 0.5f,
                               mod + (size_t)lc * 18 * 9216 + (sub * 3) * 1024, p.in[6] + (lc * 3 + sub) * 1024, gi, G, wid, lane);
#endif
                    norm_phase(ls <= 1 ? xsrc : nullptr, XH, last ? xo : nullptr, XH, T, H, !first, !last,
                               mod + (size_t)lpp * 18 * 9216 + (sp * 3 + 2) * 1024, p.in[7] + (lpp * 3 + sp) * 1024, sp == 1 ? 1.0f : 0.5f,
                               mod + (size_t)lc * 18 * 9216 + (sub * 3) * 1024, p.in[6] + (lc * 3 + sub) * 1024, gi, G, wid, lane);
#endif
                } else if (kind == 1) {
                    const bf16_t* A; const bf16_t* Bt; bf16_t* O; int N, K, ldc, mode;
                    if (sub != 1) {
                        const int wi = l * 2 + (sub >> 1);
                        if (step == 1) { A = H; Bt = (const bf16_t*)(ws + WS_WUP) + (size_t)wi * 5632 * 1024; O = BIG; N = 5632; K = 1024; ldc = DFF; mode = 3; }
                        else { A = BIG; Bt = (const bf16_t*)(ws + WS_WDN) + (size_t)wi * 1024 * 2816; O = T; N = 1024; K = DFF; ldc = D; mode = 0; }
                    } else if (step == 1) { A = H; Bt = (const bf16_t*)(ws + (odd ? WS_ODIN : WS_EVIN)); O = BIG; N = odd ? 2048 : 1536; K = 1024; ldc = PRP; mode = odd ? 2 : 1; }
                    else { A = H; Bt = (const bf16_t*)(ws + (odd ? WS_ODOUT : WS_EVOUT)); O = T; N = 1024; K = 1024; ldc = D; mode = 0; }
#if PROBE & 2
                    for (int rep = 0; rep < 2; ++rep)
#endif
                    run_gemm(lds, A, Bt, GROWS, N, K, O, ldc, mode, G);
                } else if (kind == 2) {
#if PHMASK & 8
#if PROBE & (8 | 32)
                    for (int rep = 0; rep < 2; ++rep)
#endif
                    even_core(lds, BIG, H, (const bf16_t*)(ws + WS_WSP), (const bf16_t*)(ws + WS_WPT), p.in[13], p.in[14], p.in[16], p.in[18], S, G, tid, wid, lane);
#endif
                } else if (kind == 3) {
#if PHMASK & 16
#if PROBE & (8 | 64)
                    for (int rep = 0; rep < 2; ++rep) {
#else
                    {
#endif
                    conv_part(BIG, H, p.in[21], S, G, wid, lane);
                    if (gi == 0) four_stage1_p(lds, BIG, UB, (const bf16_t*)(ws + WS_WF), (const bf16_t*)(ws + WS_FC1), (const bf16_t*)(ws + WS_FS1), (const f32x2*)(ws + WS_TW128), nb, G, tid, wid, lane);
                    else four_stage1_s(lds, BIG, UB, (const bf16_t*)(ws + WS_WF), (const bf16_t*)(ws + WS_FC16), (const bf16_t*)(ws + WS_FS16), (const f32x2*)(ws + WS_TW16), nb, G, tid, wid, lane);
                    }
#endif
                } else {
#if PHMASK & 32
#if PROBE & (8 | 128)
                    for (int rep = 0; rep < 2; ++rep) {
#else
                    {
#endif
                    if (gi == 0) four_stage2<128>(lds, UB, H, (const bf16_t*)(ws + WS_FC2), (const bf16_t*)(ws + WS_FS2), nb, G, tid, wid, lane);
                    else four_stage2<16>(lds, UB, H, (const bf16_t*)(ws + WS_FC2), (const bf16_t*)(ws + WS_FS2), nb, G, tid, wid, lane);
                    }
#endif
                }
                PH_END
            }
        }
    }
}

extern "C" void kernel_launch(void* const* d_in, const int* in_sizes, int n_in, void* d_out, int out_size, void* d_ws, size_t ws_size, hipStream_t stream) {
    static int grid = 0;
    if (grid == 0) {
        if (n_in != 25 || ws_size < WS_END || out_size != 2 * GROWS * D) { fprintf(stderr, "kernel_launch: unexpected shapes (n_in %d, out %d, ws %zu)\n", n_in, out_size, ws_size); grid = -1; return; }
        int dev = 0, cus = 0, per_cu = 0;
        hipGetDevice(&dev); hipDeviceGetAttribute(&cus, hipDeviceAttributeMultiprocessorCount, dev);
        hipFuncSetAttribute((const void*)mega_fwd, hipFuncAttributeMaxDynamicSharedMemorySize, LDS_BYTES);
        if (hipOccupancyMaxActiveBlocksPerMultiprocessor(&per_cu, (const void*)mega_fwd, NTHR, LDS_BYTES) != hipSuccess || per_cu < 1) per_cu = 1;
        (void)hipGetLastError();
        grid = cus * 1;
    }
    if (grid < 0) return;
    Params p{};
    for (int i = 0; i < 25; ++i) p.in[i] = (const float*)d_in[i];
    p.out = (float*)d_out; p.ws = (unsigned char*)d_ws; p.ph_lo = 0; p.ph_hi = 1 << 20;
    (void)hipMemsetAsync((unsigned char*)d_ws + WS_BAR, 0, XB_WORDS_ALL * sizeof(unsigned), stream);
    void* args[] = {&p};
    hipError_t e = hipLaunchCooperativeKernel((const void*)mega_fwd, dim3(grid), dim3(NTHR), args, LDS_BYTES, stream);
    if (e != hipSuccess) fprintf(stderr, "cooperative launch failed: %s (grid %d)\n", hipGetErrorString(e), grid);
}
```

```cpp
#include <hip/hip_runtime.h>
#include <hip/hip_cooperative_groups.h>
#include <cstdio>
namespace cg = cooperative_groups;
namespace pg8 {
#define PG8_LAS __attribute__((address_space(3)))
typedef unsigned short bf16_t;
typedef short bf16x8 __attribute__((ext_vector_type(8)));
typedef float f32x4 __attribute__((ext_vector_type(4)));
typedef unsigned u32x4 __attribute__((ext_vector_type(4)));
constexpr int BM = 256, BK = 64, HALF = 128, HTB = HALF * BK * 2  , STAGE_BYTES = 8 * HTB, NXCD = 8, WGM = 8;

__host__ __device__ __forceinline__ int lds_byte(int r, int c) { const int st = (r >> 4) * 2 + (c >> 5), rr = r & 15, cc = c & 31, ob = rr * 64 + cc * 2; return st * 1024 + (ob ^ (((ob >> 9) & 1) << 5)); }
__host__ __device__ __forceinline__ void stage_rc(int b, int& R, int& C) { const int st = b / 1024, sb = b % 1024, swz = sb ^ (((sb >> 9) & 1) << 5); R = (st >> 1) * 16 + swz / 64; C = (st & 1) * 32 + (swz % 64) / 2; }
__host__ __device__ __forceinline__ int perm32(int rho) { const int n = rho >> 4, i = rho & 15; return 8 * (i >> 2) + 4 * n + (i & 3); }

struct Unit { int pm, pn; };
struct Gemm { const bf16_t* A; const bf16_t* Bt; int M, N, K; };

struct StaticOrder {
    int nM, nN, nwg, G, c;
    __host__ __device__ void init(int M, int N, int G_, int c_) { nM = M / BM; nN = N / BM; nwg = nM * nN; G = G_; c = c_; }
    __host__ __device__ bool next(int i, Unit& u) const {
        const long L = (long)i * G + c; if (L >= nwg) return false;
        int wgid = (int)L; { const int q = nwg / NXCD, r = nwg % NXCD, xcd = wgid % NXCD, off = wgid / NXCD; wgid = (xcd < r ? xcd * (q + 1) : r * (q + 1) + (xcd - r) * q) + off; }
        const int nig = WGM * nN, gid = wgid / nig, fm = gid * WGM, gsz = (nM - fm) < WGM ? (nM - fm) : WGM;
        u.pm = fm + ((wgid % nig) % gsz); u.pn = (wgid % nig) / gsz; return true;
    }
    __device__ __forceinline__ void a_ready(const Unit&) const {}
    __device__ __forceinline__ void done(const Unit&) const {}
};
__device__ __forceinline__ unsigned cvt_pk_bf16(float lo, float hi) { unsigned r; asm volatile("v_cvt_pk_bf16_f32 %0, %1, %2" : "=v"(r) : "v"(lo), "v"(hi)); return r; }
typedef float f32x2 __attribute__((ext_vector_type(2)));
__device__ __forceinline__ f32x2 gelu_pk(f32x2 v) {
    const f32x2 av = __builtin_elementwise_abs(v), d = av * 0.2316418882f + 1.0f;
    f32x2 t; t.x = __builtin_amdgcn_rcpf(d.x); t.y = __builtin_amdgcn_rcpf(d.y);
    f32x2 q = t * 0.5307027145f + (-0.7265760135f); q = q * t + 0.7107068705f; q = q * t + (-0.142248368f); q = q * t + 0.127414796f; q = q * t;
    const f32x2 s = (v * v) * (-0.72134752044f);
    f32x2 e; e.x = __builtin_amdgcn_exp2f(s.x); e.y = __builtin_amdgcn_exp2f(s.y);
    const f32x2 m = v * (q * e), r = v - m;
    f32x2 o; o.x = v.x < 0.f ? m.x : r.x; o.y = v.y < 0.f ? m.y : r.y; return o;
}
template <class Epi, class Sched, bool ALIGN_EPI = false, bool SP2 = false>
__device__ __forceinline__ void gemm_phase(PG8_LAS unsigned char* lds, const Gemm g, const Sched& S, const Epi& E) {
    int tid_o = threadIdx.x; asm volatile("" : "+v"(tid_o));
    const int tid = tid_o, wid = __builtin_amdgcn_readfirstlane(tid >> 6), lane = tid & 63, wr = wid >> 2, wc = wid & 3, fr = lane & 15, fq = lane >> 4;
    const int K = g.K, nt = K / BK;
    unsigned voffA[2], voffB[2];
#pragma unroll
    for (int i = 0; i < 2; ++i) { int R, C; stage_rc(tid * 16 + i * 8192, R, C); const int Rb = Epi::PERM ? ((R & ~31) + perm32(R & 31)) : R;
        voffA[i] = (unsigned)(R * K + C) * 2u; voffB[i] = (unsigned)(Rb * K + C) * 2u; }
    const size_t kstep = (size_t)(BK * 2);
    const size_t hstep = (size_t)HALF * K * 2;
    const size_t tstep = 2 * hstep;
    const unsigned ldsw = (unsigned)wid * 1024u;
    const int aoff = lds_byte(wr * 64 + fr, fq * 8), boff = lds_byte(wc * 32 + fr, fq * 8);
#define PG8_SA(b, h) (((b) * 2 + (h)) * HTB)
#define PG8_SB(b, h) ((4 + (b) * 2 + (h)) * HTB)
#define PG8_STAGE(bufoff, gbase, voff) do { _Pragma("unroll") for (int _i = 0; _i < 2; ++_i) \
        __builtin_amdgcn_global_load_lds((const unsigned*)((const char*)(gbase) + (voff)[_i]), (PG8_LAS unsigned*)(lds + (bufoff) + ldsw + _i * 8192), 16, 0, 0); } while (0)
#define PG8_LDA(dst, b, h) do { _Pragma("unroll") for (int m = 0; m < 4; ++m) _Pragma("unroll") for (int k = 0; k < 2; ++k) dst[m][k] = *(const PG8_LAS bf16x8*)(lds + PG8_SA(b, h) + aoff + m * 2048 + k * 1024); } while (0)
#define PG8_LDB(dst, b, h) do { _Pragma("unroll") for (int n = 0; n < 2; ++n) _Pragma("unroll") for (int k = 0; k < 2; ++k) dst[n][k] = *(const PG8_LAS bf16x8*)(lds + PG8_SB(b, h) + boff + n * 2048 + k * 1024); } while (0)
#define PG8_MMA(ai, bj, At, Bt) do { __builtin_amdgcn_s_setprio(1); _Pragma("unroll") for (int m = 0; m < 4; ++m) _Pragma("unroll") for (int n = 0; n < 2; ++n) _Pragma("unroll") for (int k = 0; k < 2; ++k) \
        acc[ai][bj][m][n] = __builtin_amdgcn_mfma_f32_16x16x32_bf16(Bt[n][k], At[m][k], acc[ai][bj][m][n], 0, 0, 0); __builtin_amdgcn_s_setprio(0); } while (0)
#define PG8_WAIT_V(n) asm volatile("s_waitcnt vmcnt(" #n ")" ::: "memory")
#define PG8_WAIT_L(n) asm volatile("s_waitcnt lgkmcnt(" #n ")" ::: "memory")
#define PG8_BAR __builtin_amdgcn_s_barrier()
#define PG8_SCHED __builtin_amdgcn_sched_barrier(0)
    Unit cur, nxt; int ui = 0;
    if (!S.next(0, cur)) return;
    f32x4 acc[2][2][4][2];
#pragma unroll
    for (int a = 0; a < 2; ++a)
#pragma unroll
        for (int b = 0; b < 2; ++b)
#pragma unroll
            for (int m = 0; m < 4; ++m)
#pragma unroll
                for (int n = 0; n < 2; ++n) acc[a][b][m][n] = (f32x4){0.f, 0.f, 0.f, 0.f};
    bf16x8 At[4][2], B0[2][2], B1[2][2];
    const char* cA = (const char*)g.A + (size_t)cur.pm * tstep; const char* cB = (const char*)g.Bt + (size_t)cur.pn * tstep;
    S.a_ready(cur);
    if constexpr (SP2) {
        PG8_STAGE(PG8_SB(0, 0), cB, voffB); PG8_STAGE(PG8_SB(0, 1), cB + hstep, voffB); PG8_STAGE(PG8_SA(0, 0), cA, voffA); PG8_STAGE(PG8_SA(0, 1), cA + hstep, voffA);
        if (wr == 1) PG8_BAR;
        PG8_WAIT_V(2); PG8_BAR;
        PG8_STAGE(PG8_SB(1, 0), cB + kstep, voffB); PG8_STAGE(PG8_SA(1, 0), cA + kstep, voffA); PG8_STAGE(PG8_SB(1, 1), cB + hstep + kstep, voffB);
        PG8_WAIT_V(6); PG8_BAR;
    } else {
        PG8_STAGE(PG8_SB(0, 0), cB, voffB); PG8_STAGE(PG8_SA(0, 0), cA, voffA); PG8_STAGE(PG8_SB(0, 1), cB + hstep, voffB); PG8_STAGE(PG8_SA(0, 1), cA + hstep, voffA);
        if (wr == 1) PG8_BAR;
        PG8_WAIT_V(4); PG8_BAR;
        PG8_STAGE(PG8_SB(1, 0), cB + kstep, voffB); PG8_STAGE(PG8_SA(1, 0), cA + kstep, voffA); PG8_STAGE(PG8_SB(1, 1), cB + hstep + kstep, voffB);
        PG8_WAIT_V(6); PG8_BAR;
    }
    for (;;) {
        const bool has_next = S.next(ui + 1, nxt);
        const char* nA = has_next ? (const char*)g.A + (size_t)nxt.pm * tstep : cA; const char* nB = has_next ? (const char*)g.Bt + (size_t)nxt.pn * tstep : cB;
        for (int t = 0; t < nt; t += 2) {
            const bool last = (t == nt - 2);
            const char* a1 = cA + (size_t)(t + 1) * kstep;
            const char* a2 = last ? nA : cA + (size_t)(t + 2) * kstep; const char* b2 = last ? nB : cB + (size_t)(t + 2) * kstep;
            const char* a3 = a2 + kstep; const char* b3 = b2 + kstep;
            if (last && has_next) S.a_ready(nxt);
            if constexpr (SP2) {
            PG8_LDB(B0, 0, 0); PG8_LDB(B1, 0, 1); PG8_SCHED; PG8_LDA(At, 0, 0); PG8_STAGE(PG8_SA(1, 1), a1 + hstep, voffA);
            PG8_WAIT_V(8); PG8_WAIT_L(0); PG8_BAR; PG8_MMA(0, 0, At, B0); PG8_MMA(0, 1, At, B1); PG8_BAR; PG8_SCHED;
            PG8_LDA(At, 0, 1); PG8_STAGE(PG8_SB(0, 0), b2, voffB); PG8_STAGE(PG8_SB(0, 1), b2 + hstep, voffB); PG8_STAGE(PG8_SA(0, 0), a2, voffA);
            PG8_WAIT_V(8); PG8_WAIT_L(0); PG8_BAR; PG8_MMA(1, 0, At, B0); PG8_MMA(1, 1, At, B1); PG8_BAR; PG8_SCHED;
            PG8_LDB(B0, 1, 0); PG8_LDB(B1, 1, 1); PG8_SCHED; PG8_LDA(At, 1, 0); PG8_STAGE(PG8_SA(0, 1), a2 + hstep, voffA);
            PG8_WAIT_V(8); PG8_WAIT_L(0); PG8_BAR; PG8_MMA(0, 0, At, B0); PG8_MMA(0, 1, At, B1); PG8_BAR; PG8_SCHED;
            PG8_LDA(At, 1, 1); PG8_STAGE(PG8_SB(1, 0), b3, voffB); PG8_STAGE(PG8_SB(1, 1), b3 + hstep, voffB); PG8_STAGE(PG8_SA(1, 0), a3, voffA);
            PG8_WAIT_V(8); PG8_WAIT_L(0); PG8_BAR; PG8_MMA(1, 0, At, B0); PG8_MMA(1, 1, At, B1); PG8_BAR; PG8_SCHED;
            } else {
            PG8_LDB(B0, 0, 0); PG8_SCHED; PG8_LDA(At, 0, 0); PG8_STAGE(PG8_SA(1, 1), a1 + hstep, voffA);
            PG8_WAIT_L(8); PG8_BAR; PG8_WAIT_L(0); PG8_MMA(0, 0, At, B0); PG8_BAR; PG8_SCHED;
            PG8_LDB(B1, 0, 1); PG8_STAGE(PG8_SB(0, 0), b2, voffB);
            PG8_BAR; PG8_WAIT_L(0); PG8_MMA(0, 1, At, B1); PG8_BAR;
            PG8_LDA(At, 0, 1); PG8_STAGE(PG8_SA(0, 0), a2, voffA);
            PG8_BAR; PG8_WAIT_L(0); PG8_MMA(1, 0, At, B0); PG8_BAR; PG8_SCHED;
            PG8_STAGE(PG8_SB(0, 1), b2 + hstep, voffB);
            PG8_WAIT_V(6); PG8_BAR; PG8_MMA(1, 1, At, B1); PG8_BAR;
            PG8_LDB(B0, 1, 0); PG8_SCHED; PG8_LDA(At, 1, 0); PG8_STAGE(PG8_SA(0, 1), a2 + hstep, voffA);
            PG8_WAIT_L(8); PG8_BAR; PG8_WAIT_L(0); PG8_MMA(0, 0, At, B0); PG8_BAR; PG8_SCHED;
            PG8_LDB(B1, 1, 1); PG8_STAGE(PG8_SB(1, 0), b3, voffB);
            PG8_BAR; PG8_WAIT_L(0); PG8_MMA(0, 1, At, B1); PG8_BAR;
            PG8_LDA(At, 1, 1); PG8_STAGE(PG8_SA(1, 0), a3, voffA);
            PG8_BAR; PG8_WAIT_L(0); PG8_MMA(1, 0, At, B0); PG8_BAR; PG8_SCHED;
            PG8_STAGE(PG8_SB(1, 1), b3 + hstep, voffB);
            PG8_WAIT_V(6); PG8_BAR; PG8_MMA(1, 1, At, B1); PG8_BAR;
            }
        }
        if constexpr (ALIGN_EPI) { if (wr == 0) PG8_BAR; }
        if constexpr (!Epi::AFTER_DRAIN) { E(acc, cur, wr, wc, fr, fq); S.done(cur); }
        if (!has_next) break;
#pragma unroll
        for (int a = 0; a < 2; ++a)
#pragma unroll
            for (int b = 0; b < 2; ++b)
#pragma unroll
                for (int m = 0; m < 4; ++m)
#pragma unroll
                    for (int n = 0; n < 2; ++n) acc[a][b][m][n] = (f32x4){0.f, 0.f, 0.f, 0.f};
        cur = nxt; cA = nA; cB = nB; ++ui;
        if constexpr (ALIGN_EPI) { if (wr == 1) PG8_BAR; }
    }
    PG8_WAIT_V(0);
    if constexpr (!ALIGN_EPI) { if (wr == 0) PG8_BAR; }
    PG8_BAR;
    if constexpr (Epi::AFTER_DRAIN) { E.fused(acc, cur, wr, wc, fr, fq, lds, wid, lane); S.done(cur); }
#undef PG8_SA
#undef PG8_SB
#undef PG8_STAGE
#undef PG8_LDA
#undef PG8_LDB
#undef PG8_MMA
#undef PG8_WAIT_V
#undef PG8_WAIT_L
#undef PG8_BAR
#undef PG8_SCHED
}
}


#ifndef PHMASK
#define PHMASK 63
#endif
#ifndef PROBE
#define PROBE 0
#endif
using pg8::bf16_t; using pg8::bf16x8; using pg8::f32x4; using pg8::u32x4;
typedef unsigned u32x2 __attribute__((ext_vector_type(2)));
typedef short s16x4 __attribute__((ext_vector_type(4)));
typedef float f32x2 __attribute__((ext_vector_type(2)));
#define LAS __attribute__((address_space(3)))
#define DI __device__ __forceinline__

#define XB_TMO      128
#define XB_XCNT(j)  (256  + 64 * (j))
#define XB_XSUB(j)  (1280 + 64 * (j))
#define XB_XGEN(j)  (2304 + 64 * (j))
#define XB_TOP      3328
#define XB_TOPGEN   3392
#define XCD_BAR_WORDS 3456
#define XB_SPIN_CAP (1u << 18)

__device__ __forceinline__ unsigned xb_ld(unsigned* p)              { return __hip_atomic_load(p, __ATOMIC_RELAXED, __HIP_MEMORY_SCOPE_AGENT); }
__device__ __forceinline__ unsigned xb_add(unsigned* p, unsigned v) { return __hip_atomic_fetch_add(p, v, __ATOMIC_RELAXED, __HIP_MEMORY_SCOPE_AGENT); }
__device__ __forceinline__ unsigned xb_xcc_id() { return (unsigned)__builtin_amdgcn_s_getreg((3 << 11) | 20) & 0xFu; }
#define XB_SPIN(cond, bar) do { unsigned _sp = 0; while (cond) { __builtin_amdgcn_s_sleep(1); \
    if ((++_sp & 255u) == 0u) { if (xb_ld(&(bar)[XB_TMO])) break; if (_sp > XB_SPIN_CAP) { atomicAdd(&(bar)[XB_TMO], 1u); break; } } } } while (0)

struct XcdBarrier {
    unsigned* bar; unsigned x;
    volatile LAS unsigned* st;
};

__device__ __forceinline__ XcdBarrier xcd_barrier_post(unsigned* bar, volatile LAS unsigned* st) {
    XcdBarrier b; b.bar = bar; b.x = xb_xcc_id(); b.st = st;
    if (threadIdx.x == 0) (void)xb_add(&bar[XB_XCNT(b.x)], 1u);
    return b;
}
__device__ __forceinline__ void xcd_barrier_complete(unsigned* bar, unsigned x, unsigned& nloc, unsigned& nx) {
    const unsigned G = gridDim.x * gridDim.y * gridDim.z;
    unsigned sum, cnt, mine, sp = 0u;
    for (;;) {
        sum = 0u; cnt = 0u; mine = 0u;
#pragma unroll
        for (unsigned j = 0; j < 16; ++j) { const unsigned c = xb_ld(&bar[XB_XCNT(j)]); sum += c; cnt += (c > 0u) ? 1u : 0u; mine = (j == x) ? c : mine; }
        if (sum == G) break;
        __builtin_amdgcn_s_sleep(1);
        if ((++sp & 255u) == 0u) { if (xb_ld(&bar[XB_TMO])) break; if (sp > XB_SPIN_CAP) { atomicAdd(&bar[XB_TMO], 1u); break; } }
    }
    nloc = mine > 0u ? mine : 1u; nx = cnt > 0u ? cnt : 1u;
}

__device__ __forceinline__ void xcd_barrier(const XcdBarrier& b) {
    asm volatile("s_waitcnt vmcnt(0)" ::: "memory");
    __syncthreads();
    if (threadIdx.x == 0) {
        unsigned* bar = b.bar;
        __builtin_amdgcn_s_waitcnt(0);
        unsigned nloc = b.st[0], nx = b.st[1];
        if (nloc == 0u) { xcd_barrier_complete(bar, b.x, nloc, nx); b.st[0] = nloc; b.st[1] = nx; }
        const unsigned old = xb_add(&bar[XB_XSUB(b.x)], 1u);
        const unsigned gen = old / nloc;
        if (old + 1u == (gen + 1u) * nloc) {
            __builtin_amdgcn_fence(__ATOMIC_RELEASE, "agent");
            asm volatile("s_waitcnt vmcnt(0)" ::: "memory");
            const unsigned og = xb_add(&bar[XB_TOP], 1u);
            const unsigned tg = og / nx;
            if (og + 1u == (tg + 1u) * nx) xb_add(&bar[XB_TOPGEN], 1u);
            else XB_SPIN(xb_ld(&bar[XB_TOPGEN]) == tg, bar);
            __builtin_amdgcn_fence(__ATOMIC_ACQUIRE, "agent");
            xb_add(&bar[XB_XGEN(b.x)], 1u);
            asm volatile("s_waitcnt vmcnt(0)" ::: "memory");
        } else {
            XB_SPIN(xb_ld(&bar[XB_XGEN(b.x)]) == gen, bar);
            __builtin_amdgcn_fence(__ATOMIC_ACQUIRE, "agent");
            asm volatile("s_waitcnt vmcnt(0)" ::: "memory");
        }
    }
    __syncthreads();
}


#define XB_LSUB(j)  (3456 + 64 * (j))
#define XB_LGEN(j)  (4480 + 64 * (j))
#define XB_CLS(j)   (5504 + 64 * (j))
#define XB_TSUB(k)  (6528 + 64 * (k))
#define XB_TGEN(k)  (10624 + 64 * (k))
#define XB_WORDS_ALL 14720
__device__ __forceinline__ void team_barrier(const XcdBarrier& b) {
    asm volatile("s_waitcnt vmcnt(0)" ::: "memory");
    __syncthreads();
    if (threadIdx.x == 0) {
        unsigned* bar = b.bar;
        __builtin_amdgcn_s_waitcnt(0);
        const unsigned team = (blockIdx.x & 7u) * 8u + ((blockIdx.x >> 3) & 7u);
        const unsigned old = xb_add(&bar[XB_TSUB(team)], 1u);
        const unsigned gen = old >> 2;
        if ((old & 3u) == 3u) xb_add(&bar[XB_TGEN(team)], 1u);
        else XB_SPIN(xb_ld(&bar[XB_TGEN(team)]) == gen, bar);
        __builtin_amdgcn_fence(__ATOMIC_ACQUIRE, "agent");
        asm volatile("s_waitcnt vmcnt(0)" ::: "memory");
    }
    __syncthreads();
}

constexpr int D = 1024, DFF = 2816, GROWS = 32768, NTHR = 512;
constexpr int PRP = 2816;
constexpr int LDS_BYTES = 147456;
constexpr size_t MiB = 1u << 20, KiB = 1u << 10;
constexpr size_t WS_MODP = 0;
constexpr size_t WS_MOD = 6 * MiB;
constexpr size_t WS_BAR = 7 * MiB + 512 * KiB;
constexpr size_t WS_WSP = 8 * MiB;
constexpr size_t WS_WPT = WS_WSP + 256 * KiB;
constexpr size_t WS_WF = WS_WPT + 256 * KiB;
constexpr size_t WS_FC1 = WS_WF + 256 * KiB;
constexpr size_t WS_FS1 = WS_FC1 + 256 * KiB;
constexpr size_t WS_FC16 = WS_FS1 + 256 * KiB;
constexpr size_t WS_FS16 = WS_FC16 + 256 * KiB;
constexpr size_t WS_FC2 = WS_FS16 + 256 * KiB;
constexpr size_t WS_FS2 = WS_FC2 + 256 * KiB;
constexpr size_t WS_TW128 = WS_FS2 + 256 * KiB;
constexpr size_t WS_TW16 = WS_TW128 + 256 * KiB;
constexpr size_t WS_WUP = 16 * MiB;
constexpr size_t WS_WDN = 60 * MiB;
constexpr size_t WS_EVIN = 82 * MiB, WS_ODIN = 85 * MiB, WS_EVOUT = 89 * MiB, WS_ODOUT = 91 * MiB;
constexpr size_t WS_H = 96 * MiB;
constexpr size_t WS_T = 160 * MiB;
constexpr size_t WS_BIG = 224 * MiB;
constexpr size_t WS_UB = WS_BIG + 96 * MiB;
constexpr size_t WS_XH = 400 * MiB;
constexpr size_t WS_END = 464 * MiB;

typedef __bf16 nbf16x2 __attribute__((ext_vector_type(2)));
DI unsigned f2bf(float f) { return (unsigned)__builtin_bit_cast(unsigned short, (__bf16)f); }
DI unsigned pk2(float lo, float hi) { const f32x2 v = {lo, hi}; return __builtin_bit_cast(unsigned, __builtin_convertvector(v, nbf16x2)); }
DI float bf_lo(unsigned w) { return __uint_as_float(w << 16); }
DI float bf_hi(unsigned w) { return __uint_as_float(w & 0xffff0000u); }
template <int CTRL> DI float dpp_mov(float v) { return __builtin_bit_cast(float, __builtin_amdgcn_update_dpp(0, __builtin_bit_cast(int, v), CTRL, 0xF, 0xF, true)); }
DI float wave_sum(float v) {
    v += dpp_mov<0xB1>(v); v += dpp_mov<0x4E>(v); v += dpp_mov<0x141>(v); v += dpp_mov<0x140>(v);
    const int iv = __builtin_bit_cast(int, v);
    const float a = __builtin_bit_cast(float, __builtin_amdgcn_readlane(iv, 0)), b = __builtin_bit_cast(float, __builtin_amdgcn_readlane(iv, 16)),
                c = __builtin_bit_cast(float, __builtin_amdgcn_readlane(iv, 32)), d = __builtin_bit_cast(float, __builtin_amdgcn_readlane(iv, 48));
    return (a + b) + (c + d);
}
DI float silu_f(float x) { return x * __builtin_amdgcn_rcpf(1.0f + __builtin_amdgcn_exp2f(-1.4426950408889634f * x)); }
DI f32x4 mfma16(bf16x8 a, bf16x8 b, f32x4 c) { return __builtin_amdgcn_mfma_f32_16x16x32_bf16(a, b, c, 0, 0, 0); }
typedef short v4i16_t __attribute__((ext_vector_type(4)));
DI s16x4 tr_read(LAS unsigned char* p) { return __builtin_bit_cast(s16x4, __builtin_amdgcn_ds_read_tr16_b64_v4i16((LAS v4i16_t*)p)); }
DI bf16x8 tr_frag(LAS unsigned char* p, int pitch4) {
    const s16x4 lo = tr_read(p), hi = tr_read(p + pitch4);
    bf16x8 r; r[0] = lo[0]; r[1] = lo[1]; r[2] = lo[2]; r[3] = lo[3]; r[4] = hi[0]; r[5] = hi[1]; r[6] = hi[2]; r[7] = hi[3]; return r;
}

DI void st16_wt(void* p, u32x4 v) { *(u32x4*)p = v; }
struct Params { const float* in[25]; float* out; unsigned char* ws; int ph_lo, ph_hi; };

struct EpiGen {
    static constexpr bool PERM = true, AFTER_DRAIN = false;
    bf16_t* O; int ldc; int mode;
    __device__ __forceinline__ void operator()(const f32x4 (&acc)[2][2][4][2], const pg8::Unit& u, int wr, int wc, int fr, int fq) const {
        const int row0 = u.pm * 256 + wr * 64 + fr, cw = wc * 32 + 8 * fq;
        if (mode == 3) {
#pragma unroll
            for (int ai = 0; ai < 2; ++ai)
#pragma unroll
                for (int m = 0; m < 4; ++m) {
                    bf16_t* rowp = O + (size_t)(row0 + ai * 128 + m * 16) * ldc + 128 * u.pn + cw;
                    f32x4 g0 = acc[ai][0][m][0], g1 = acc[ai][0][m][1]; const f32x4 u0 = acc[ai][1][m][0], u1 = acc[ai][1][m][1];
#pragma unroll
                    for (int j = 0; j < 4; ++j) { g0[j] = silu_f(g0[j]); g1[j] = silu_f(g1[j]); }
                    const f32x4 v0 = g0 * u0, v1 = g1 * u1;
                    u32x4 w; w.x = pg8::cvt_pk_bf16(v0[0], v0[1]); w.y = pg8::cvt_pk_bf16(v0[2], v0[3]); w.z = pg8::cvt_pk_bf16(v1[0], v1[1]); w.w = pg8::cvt_pk_bf16(v1[2], v1[3]);
                    st16_wt(rowp, w);
                }
        } else if (mode == 2 && u.pn < 4) {
#pragma unroll
            for (int ai = 0; ai < 2; ++ai)
#pragma unroll
                for (int m = 0; m < 4; ++m) {
                    bf16_t* rowp = O + (size_t)(row0 + ai * 128 + m * 16) * ldc + 128 * u.pn + cw;
                    const f32x4 v0 = acc[ai][0][m][0] * acc[ai][1][m][0], v1 = acc[ai][0][m][1] * acc[ai][1][m][1];
                    u32x4 w; w.x = pg8::cvt_pk_bf16(v0[0], v0[1]); w.y = pg8::cvt_pk_bf16(v0[2], v0[3]); w.z = pg8::cvt_pk_bf16(v1[0], v1[1]); w.w = pg8::cvt_pk_bf16(v1[2], v1[3]);
                    st16_wt(rowp, w);
                }
        } else {
            const int colbase = (mode == 2) ? 512 + 256 * (u.pn - 4) : 256 * u.pn;
            if (mode == 1 && u.pn < 4) {
#pragma unroll
                for (int ai = 0; ai < 2; ++ai)
#pragma unroll
                    for (int m = 0; m < 4; ++m) {
                        bf16_t* rowp = O + (size_t)(row0 + ai * 128 + m * 16) * ldc + colbase + cw;
#pragma unroll
                        for (int bj = 0; bj < 2; ++bj) {
                            f32x4 v0 = acc[ai][bj][m][0], v1 = acc[ai][bj][m][1];
                            const pg8::f32x2 a = pg8::gelu_pk((pg8::f32x2){v0[0], v0[1]}), b = pg8::gelu_pk((pg8::f32x2){v0[2], v0[3]}), c = pg8::gelu_pk((pg8::f32x2){v1[0], v1[1]}), d = pg8::gelu_pk((pg8::f32x2){v1[2], v1[3]});
                            u32x4 w; w.x = pg8::cvt_pk_bf16(a.x, a.y); w.y = pg8::cvt_pk_bf16(b.x, b.y); w.z = pg8::cvt_pk_bf16(c.x, c.y); w.w = pg8::cvt_pk_bf16(d.x, d.y);
                            st16_wt(rowp + bj * 128, w);
                        }
                    }
            } else {
#pragma unroll
                for (int ai = 0; ai < 2; ++ai)
#pragma unroll
                    for (int m = 0; m < 4; ++m) {
                        bf16_t* rowp = O + (size_t)(row0 + ai * 128 + m * 16) * ldc + colbase + cw;
#pragma unroll
                        for (int bj = 0; bj < 2; ++bj) {
                            const f32x4 v0 = acc[ai][bj][m][0], v1 = acc[ai][bj][m][1];
                            u32x4 w; w.x = pg8::cvt_pk_bf16(v0[0], v0[1]); w.y = pg8::cvt_pk_bf16(v0[2], v0[3]); w.z = pg8::cvt_pk_bf16(v1[0], v1[1]); w.w = pg8::cvt_pk_bf16(v1[2], v1[3]);
                            st16_wt(rowp + bj * 128, w);
                        }
                    }
            }
        }
    }
};

DI void run_gemm(LAS unsigned char* lds, const bf16_t* A, const bf16_t* Bt, int M, int N, int K, bf16_t* O, int ldc, int mode, int G) {
#if PHMASK & 4
#ifndef STAG
#define STAG 0
#endif
    if (STAG && mode != 0) {
        const int d = ((int)blockIdx.x >> 3) & 3;
        for (int i = 0; i < d * STAG; ++i) __builtin_amdgcn_s_sleep(64);
    }
    pg8::Gemm g{A, Bt, M, N, K}; pg8::StaticOrder S; S.init(M, N, G, (int)blockIdx.x);
    EpiGen E{O, ldc, mode};
#ifndef G_ALIGN
#define G_ALIGN true
#endif
#ifndef G_SP2
#define G_SP2 true
#endif
    pg8::gemm_phase<EpiGen, pg8::StaticOrder, G_ALIGN, G_SP2>(lds, g, S, E);
#endif
}

DI int dest_row(int n0, int mode) {
    if (mode == 1) { const int half = n0 >= DFF ? 1 : 0, n = n0 - half * DFF; return 256 * (n >> 7) + 128 * half + (n & 127); }
    if (mode == 2) { if (n0 < 512) return 256 * (n0 >> 7) + (n0 & 127); if (n0 < 1024) return 1024 + (n0 - 512); if (n0 < 1536) { const int n = n0 - 1024; return 256 * (n >> 7) + 128 + (n & 127); } return n0; }
    return n0;
}
DI void transpose_item(const float* W, int K, int N, bf16_t* WT, int mode, LAS float* scr, int item, int lane) {
    const int nblk = N / 32, kb = item / nblk, nb = item % nblk, k0 = 64 * kb, n0 = 32 * nb;
#pragma unroll
    for (int i = 0; i < 32; ++i) { const int kk = 2 * i + (lane >> 5); scr[kk * 33 + (lane & 31)] = __builtin_nontemporal_load(W + (size_t)(k0 + kk) * N + n0 + (lane & 31)); }
    asm volatile("s_waitcnt lgkmcnt(0)" ::: "memory");
    const int c = lane & 7, dr = dest_row(n0, mode);
#pragma unroll
    for (int j = 0; j < 4; ++j) { const int n = (lane >> 3) + 8 * j; const LAS float* s = scr + (8 * c) * 33 + n;
        u32x4 o; o.x = pk2(s[0 * 33], s[1 * 33]); o.y = pk2(s[2 * 33], s[3 * 33]); o.z = pk2(s[4 * 33], s[5 * 33]); o.w = pk2(s[6 * 33], s[7 * 33]);
        *(u32x4*)(WT + (size_t)(dr + n) * K + k0 + 8 * c) = o; }
    asm volatile("s_waitcnt lgkmcnt(0)" ::: "memory");
}

DI void setup_phase(const Params& p, LAS unsigned char* lds, int G, int tid, int wid, int lane) {
    unsigned char* ws = p.ws;
    {
        LAS float* sc = (LAS float*)lds;
        LAS float* red = sc + 18 * 1024;
        for (int i = tid; i < 18 * 1024; i += NTHR) { const int b = i >> 10, k = i & 1023;
            const float c = (b < 2) ? p.in[2][b * 1024 + k] : p.in[3][(b - 2) * 1024 + k]; sc[i] = silu_f(c); }
        __syncthreads();
        for (int u = blockIdx.x; u < 288; u += G) {
            const int l = u / 144, cb = u % 144, col = cb * 64 + lane;
            float acc[18];
#pragma unroll
            for (int b = 0; b < 18; ++b) acc[b] = 0.f;
            const float* wp = p.in[4] + ((size_t)l * 1024 + wid * 128) * 9216 + col;
            const LAS f32x4* sc4 = (const LAS f32x4*)sc + wid * 32;
#pragma unroll 4
            for (int k4 = 0; k4 < 32; ++k4) {
                const float w0 = __builtin_nontemporal_load(wp + (size_t)(4 * k4) * 9216), w1 = __builtin_nontemporal_load(wp + (size_t)(4 * k4 + 1) * 9216), w2 = __builtin_nontemporal_load(wp + (size_t)(4 * k4 + 2) * 9216), w3 = __builtin_nontemporal_load(wp + (size_t)(4 * k4 + 3) * 9216);
#pragma unroll
                for (int b = 0; b < 18; ++b) { const f32x4 sv = sc4[b * 256 + k4]; acc[b] += (sv[0] * w0 + sv[1] * w1) + (sv[2] * w2 + sv[3] * w3); }
            }
#pragma unroll
            for (int b = 0; b < 18; ++b) red[(wid * 18 + b) * 64 + lane] = acc[b];
            __syncthreads();
            for (int i = tid; i < 18 * 64; i += NTHR) { const int b = i >> 6, c = i & 63; float sm = p.in[5][l * 9216 + cb * 64 + c];
#pragma unroll
                for (int w = 0; w < 8; ++w) sm += red[(w * 18 + b) * 64 + c];
                ((float*)(ws + WS_MOD))[((size_t)l * 18 + b) * 9216 + cb * 64 + c] = sm; }
            __syncthreads();
        }
    }
    {
        LAS float* scr = (LAS float*)(lds + wid * 16384);
        const int nskip = (G > 64 && 288 - G > 0 && 288 - G < G / 2) ? 288 - G : 0;
        const int gw = ((int)blockIdx.x - nskip) * 8 + wid, NGW = (G - nskip) * 8;
        constexpr int I_UP = 16 * 176, I_DN = 44 * 32, I_EI = 16 * 48, I_OI = 16 * 64, I_O = 16 * 32;
        constexpr int NITEMS = 4 * I_UP + 4 * I_DN + I_EI + I_OI + 2 * I_O;
        for (int it = gw; it < NITEMS && gw >= 0; it += NGW) {
            int r = it;
            if (r < 4 * I_UP) { const int i = r / I_UP; r -= i * I_UP; const int l = i >> 1, f = i & 1;
                transpose_item(p.in[f ? 10 : 8] + (size_t)l * 1024 * 5632, 1024, 5632, (bf16_t*)(ws + WS_WUP) + (size_t)i * 5632 * 1024, 1, scr, r, lane); continue; }
            r -= 4 * I_UP;
            if (r < 4 * I_DN) { const int i = r / I_DN; r -= i * I_DN; const int l = i >> 1, f = i & 1;
                transpose_item(p.in[f ? 11 : 9] + (size_t)l * 2816 * 1024, 2816, 1024, (bf16_t*)(ws + WS_WDN) + (size_t)i * 1024 * 2816, 0, scr, r, lane); continue; }
            r -= 4 * I_DN;
            if (r < I_EI) { transpose_item(p.in[12], 1024, 1536, (bf16_t*)(ws + WS_EVIN), 0, scr, r, lane); continue; }
            r -= I_EI;
            if (r < I_OI) { transpose_item(p.in[20], 1024, 2048, (bf16_t*)(ws + WS_ODIN), 2, scr, r, lane); continue; }
            r -= I_OI;
            if (r < I_O) { transpose_item(p.in[19], 1024, 1024, (bf16_t*)(ws + WS_EVOUT), 0, scr, r, lane); continue; }
            r -= I_O;
            transpose_item(p.in[24], 1024, 1024, (bf16_t*)(ws + WS_ODOUT), 0, scr, r, lane);
        }
    }
    {
        const int gt = blockIdx.x * NTHR + tid, NT = G * NTHR;
        bf16_t* WSP = (bf16_t*)(ws + WS_WSP); bf16_t* WPT = (bf16_t*)(ws + WS_WPT); bf16_t* WF = (bf16_t*)(ws + WS_WF);
        for (int i = gt; i < 65536; i += NT) {
            WSP[i] = (bf16_t)f2bf(p.in[15][i]);
            const int g = i >> 14, e = (i >> 7) & 127, d = i & 127;
            WPT[i] = (bf16_t)f2bf(p.in[17][(g * 128 + d) * 128 + e]);
        }
        {
            LAS float* tab = (LAS float*)(lds + 132 * 1024);
            if (tid < 128) { const float x = (float)tid * (1.0f / 64.0f); tab[tid] = cospif(x); tab[128 + tid] = sinpif(x); }
            __syncthreads();
            for (int i = gt; i < 131072; i += NT) {
                const int g = i >> 15, n = (i >> 7) & 255, d = i & 127, comp = n >> 7, e = n & 127;
                const float* fw = p.in[23] + (size_t)g * 16384 + e; const LAS float* tb = tab + comp * 128; float sm = 0.f;
#pragma unroll 8
                for (int m = 0; m < 128; ++m) sm += tb[(m * d) & 127] * fw[m * 128];
                WF[i] = (bf16_t)f2bf(sm * p.in[22][g * 128 + d]);
            }
        }
        bf16_t* FC1 = (bf16_t*)(ws + WS_FC1); bf16_t* FS1 = (bf16_t*)(ws + WS_FS1); bf16_t* FC2 = (bf16_t*)(ws + WS_FC2); bf16_t* FS2 = (bf16_t*)(ws + WS_FS2);
        f32x2* TW128 = (f32x2*)(ws + WS_TW128);
        for (int i = gt; i < 16384; i += NT) {
            const int k1 = i >> 7, col = i & 127, s = col >> 5, j = col & 31, fqq = j >> 3, ii = j & 7;
            const int r = 32 * s + (ii < 4 ? fqq * 4 + ii : 16 + fqq * 4 + ii - 4);
            const float x = (float)((k1 * r) & 127) * (1.0f / 64.0f);
            FC1[i] = (bf16_t)f2bf(cospif(x)); FS1[i] = (bf16_t)f2bf(sinpif(x));
            const float y = (float)((k1 * col) & 127) * (1.0f / 64.0f);
            FC2[i] = (bf16_t)f2bf(cospif(y)); FS2[i] = (bf16_t)f2bf(sinpif(y));
            const float z = (float)(k1 * col) * (1.0f / 8192.0f);
            TW128[i] = (f32x2){cospif(z), sinpif(z)};
        }
        bf16_t* FC16 = (bf16_t*)(ws + WS_FC16); bf16_t* FS16 = (bf16_t*)(ws + WS_FS16);
        for (int i = gt; i < 512; i += NT) {
            const int k1 = i >> 5, j = i & 31, fqq = j >> 3, ii = j & 7;
            float c = 0.f, s = 0.f;
            if (ii < 4) { const int r = fqq * 4 + ii; const float x = (float)((k1 * r) & 15) * (1.0f / 8.0f); c = cospif(x); s = sinpif(x); }
            FC16[i] = (bf16_t)f2bf(c); FS16[i] = (bf16_t)f2bf(s);
        }
        f32x2* TW16 = (f32x2*)(ws + WS_TW16);
        for (int i = gt; i < 2048; i += NT) { const int q = i >> 4, k1 = i & 15; const float z = (float)(k1 * q) * (1.0f / 1024.0f); TW16[i] = (f32x2){cospif(z), sinpif(z)}; }
    }
}

DI void modreduce_phase(const Params& p, int G, int tid) {
    const float* mp = (const float*)(p.ws + WS_MODP); float* mod = (float*)(p.ws + WS_MOD);
    for (int i = blockIdx.x * NTHR + tid; i < 2 * 18 * 9216; i += G * NTHR) {
        const int l = i / (18 * 9216), j = i % 9216;
        float s = p.in[5][l * 9216 + j];
#pragma unroll
        for (int ks = 0; ks < 4; ++ks) s += mp[(size_t)ks * (2 * 18 * 9216) + i];
        mod[i] = s;
    }
}

typedef _Float16 h16x4 __attribute__((ext_vector_type(4)));
typedef _Float16 h16x8 __attribute__((ext_vector_type(8)));
template <bool IN32, bool PREV, bool NEXT, bool OUT32>
DI void norm_phase_t(const float* xin32, const _Float16* xin16, float* xout32, _Float16* xout16, const bf16_t* T, bf16_t* H,
                     const float* gate_base, const float* gpost, float rw, const float* ss_base, const float* gpre, int gi, int G, int wid, int lane) {
    const bool teamed = (G == 256);
    const int bx = (int)blockIdx.x & 7, bj = (int)blockIdx.x >> 3;
    const int nh = teamed ? 2 : (GROWS + G * 8 - 1) / (G * 8), rows_h = teamed ? 8 : 1;
    for (int hh = 0; hh < nh; ++hh) {
        const int r0 = teamed ? 256 * (16 * bx + 8 * hh + (bj & 7)) + 64 * (bj >> 3) + wid : (int)blockIdx.x * 8 + wid + hh * G * 8;
        if (r0 >= GROWS) break;
        const int bidx = (gi == 0) ? (r0 >> 14) : 2 + (r0 >> 11);
        f32x4 gpv[4], gtv[4], shv[4], scv[4], gnv[4];
        if (PREV) { const f32x4* gp = (const f32x4*)gpost + 2 * lane; const f32x4* gt = (const f32x4*)(gate_base + (size_t)bidx * 9216) + 2 * lane;
#pragma unroll
            for (int j = 0; j < 4; ++j) { const int o = 128 * (j >> 1) + (j & 1); gpv[j] = gp[o] * rw; gtv[j] = gt[o] + 1.0f; gpv[j] = gpv[j] * gtv[j]; } }
        if (NEXT) { const f32x4* gp = (const f32x4*)gpre + 2 * lane; const f32x4* sh = (const f32x4*)(ss_base + (size_t)bidx * 9216) + 2 * lane; const f32x4* sc = sh + 256;
#pragma unroll
            for (int j = 0; j < 4; ++j) { const int o = 128 * (j >> 1) + (j & 1); gnv[j] = gp[o] * (sc[o] + 1.0f); shv[j] = sh[o]; } }
#pragma unroll 2
        for (int i = 0; i < rows_h; ++i) {
            const int r = r0 + 8 * i;
            f32x4 v[4]; u32x4 tw[2];
            if (IN32) { const f32x4* xr = (const f32x4*)(xin32 + (size_t)r * D) + 2 * lane;
#pragma unroll
                for (int j = 0; j < 2; ++j) { v[2 * j] = xr[128 * j]; v[2 * j + 1] = xr[128 * j + 1]; } }
            else { const h16x8* xr = (const h16x8*)(xin16 + (size_t)r * D) + lane; h16x8 hv[2];
#pragma unroll
                for (int j = 0; j < 2; ++j) hv[j] = __builtin_nontemporal_load(xr + 64 * j);
                if (PREV) { const u32x4* tr = (const u32x4*)(T + (size_t)r * D) + lane;
#pragma unroll
                    for (int j = 0; j < 2; ++j) tw[j] = __builtin_nontemporal_load(tr + 64 * j); }
#pragma unroll
                for (int j = 0; j < 2; ++j) { v[2 * j] = (f32x4){(float)hv[j][0], (float)hv[j][1], (float)hv[j][2], (float)hv[j][3]}; v[2 * j + 1] = (f32x4){(float)hv[j][4], (float)hv[j][5], (float)hv[j][6], (float)hv[j][7]}; } }
            if (PREV) {
                if (IN32) { const u32x4* tr = (const u32x4*)(T + (size_t)r * D) + lane;
#pragma unroll
                    for (int j = 0; j < 2; ++j) tw[j] = __builtin_nontemporal_load(tr + 64 * j); }
                f32x4 tv[4]; float ss = 0.f;
#pragma unroll
                for (int j = 0; j < 2; ++j) { const u32x4 w = tw[j];
                    tv[2 * j] = (f32x4){bf_lo(w.x), bf_hi(w.x), bf_lo(w.y), bf_hi(w.y)}; tv[2 * j + 1] = (f32x4){bf_lo(w.z), bf_hi(w.z), bf_lo(w.w), bf_hi(w.w)}; }
#pragma unroll
                for (int j = 0; j < 4; ++j) ss += (tv[j][0] * tv[j][0] + tv[j][1] * tv[j][1]) + (tv[j][2] * tv[j][2] + tv[j][3] * tv[j][3]);
                const float rstd = rsqrtf(wave_sum(ss) * (1.0f / D) + 1e-6f);
#pragma unroll
                for (int j = 0; j < 4; ++j) v[j] = v[j] + (tv[j] * rstd) * gpv[j];
                if (OUT32) { f32x4* xo = (f32x4*)(xout32 + (size_t)r * D) + 2 * lane;
#pragma unroll
                    for (int j = 0; j < 4; ++j) __builtin_nontemporal_store(v[j], xo + 128 * (j >> 1) + (j & 1)); }
                else { h16x8* xo = (h16x8*)(xout16 + (size_t)r * D) + lane;
#pragma unroll
                    for (int j = 0; j < 2; ++j) { h16x8 hv;
#pragma unroll
                        for (int k = 0; k < 4; ++k) { hv[k] = (_Float16)v[2 * j][k]; hv[4 + k] = (_Float16)v[2 * j + 1][k]; }
                        __builtin_nontemporal_store(hv, xo + 64 * j);
#pragma unroll
                        for (int k = 0; k < 4; ++k) { v[2 * j][k] = (float)hv[k]; v[2 * j + 1][k] = (float)hv[4 + k]; } } }
            }
            if (NEXT) {
                float ss = 0.f;
#pragma unroll
                for (int j = 0; j < 4; ++j) ss += (v[j][0] * v[j][0] + v[j][1] * v[j][1]) + (v[j][2] * v[j][2] + v[j][3] * v[j][3]);
                const float rstd = rsqrtf(wave_sum(ss) * (1.0f / D) + 1e-6f);
                u32x4* ho = (u32x4*)(H + (size_t)r * D) + lane;
#pragma unroll
                for (int j = 0; j < 2; ++j) { const f32x4 h0 = (v[2 * j] * rstd) * gnv[2 * j] + shv[2 * j], h1 = (v[2 * j + 1] * rstd) * gnv[2 * j + 1] + shv[2 * j + 1];
                    u32x4 w; w.x = pk2(h0[0], h0[1]); w.y = pk2(h0[2], h0[3]); w.z = pk2(h1[0], h1[1]); w.w = pk2(h1[2], h1[3]); st16_wt(ho + 64 * j, w); }
            }
        }
    }
}
DI void norm_phase(const float* xin32, const _Float16* xin16, float* xout32, _Float16* xout16, const bf16_t* T, bf16_t* H, bool has_prev, bool has_next,
                   const float* gate_base, const float* gpost, float rw, const float* ss_base, const float* gpre, int gi, int G, int wid, int lane) {
    if (!has_prev)        norm_phase_t<true, false, true, false>(xin32, xin16, xout32, xout16, T, H, gate_base, gpost, rw, ss_base, gpre, gi, G, wid, lane);
    else if (xin32)       norm_phase_t<true, true, true, false>(xin32, xin16, xout32, xout16, T, H, gate_base, gpost, rw, ss_base, gpre, gi, G, wid, lane);
    else if (has_next)    norm_phase_t<false, true, true, false>(xin32, xin16, xout32, xout16, T, H, gate_base, gpost, rw, ss_base, gpre, gi, G, wid, lane);
    else                  norm_phase_t<false, true, false, true>(xin32, xin16, xout32, xout16, T, H, gate_base, gpost, rw, ss_base, gpre, gi, G, wid, lane);
}

template <int GI>
DI void pool_group(const bf16_t* PR, bf16_t* YY, const bf16_t* WPT, const float* pool_scale, size_t tok0, int tl, int pos, int S, int fr, int fq) {
    constexpr int hw = 1 << GI, g = GI;
    const int lo = max(pos - hw, 0), hi = min(pos + hw, S); const float inv = 1.0f / (float)(hi - lo);
    f32x4 acc[8];
#pragma unroll
    for (int e = 0; e < 8; ++e) acc[e] = (f32x4){0.f, 0.f, 0.f, 0.f};
#pragma unroll 1
    for (int ks = 0; ks < 4; ++ks) {
        const bf16_t* zc = PR + (tok0 + tl) * PRP + 1024 + g * 128 + ks * 32 + fq * 8;
        u32x4 w[2 * hw];
#pragma unroll
        for (int j = 0; j < 2 * hw; ++j) { const int t2 = pos + j - hw; const bool ok = (t2 >= 0) && (t2 < S); w[j] = (u32x4){0u, 0u, 0u, 0u}; if (ok) w[j] = *(const u32x4*)(zc + (ptrdiff_t)(j - hw) * PRP); }
        bf16x8 wf[8];
#pragma unroll
        for (int et = 0; et < 8; ++et) wf[et] = *(const bf16x8*)(WPT + ((g * 128 + et * 16 + fr) * 128 + ks * 32 + fq * 8));
        f32x4 s0 = (f32x4){0.f, 0.f, 0.f, 0.f}, s1 = s0;
#pragma unroll
        for (int j = 0; j < 2 * hw; ++j) { s0 += (f32x4){bf_lo(w[j].x), bf_hi(w[j].x), bf_lo(w[j].y), bf_hi(w[j].y)}; s1 += (f32x4){bf_lo(w[j].z), bf_hi(w[j].z), bf_lo(w[j].w), bf_hi(w[j].w)}; }
        const u32x4 cw = w[hw];
        s0 = s0 * inv - (f32x4){bf_lo(cw.x), bf_hi(cw.x), bf_lo(cw.y), bf_hi(cw.y)}; s1 = s1 * inv - (f32x4){bf_lo(cw.z), bf_hi(cw.z), bf_lo(cw.w), bf_hi(cw.w)};
        u32x4 dw; dw.x = pk2(s0[0], s0[1]); dw.y = pk2(s0[2], s0[3]); dw.z = pk2(s1[0], s1[1]); dw.w = pk2(s1[2], s1[3]);
        const bf16x8 df = __builtin_bit_cast(bf16x8, dw);
#pragma unroll
        for (int et = 0; et < 8; ++et) acc[et] = mfma16(wf[et], df, acc[et]);
    }
#pragma unroll
    for (int et = 0; et < 8; ++et) { const int e = g * 128 + et * 16 + fq * 4; const f32x4 ps = *(const f32x4*)(pool_scale + e); const f32x4 y = acc[et] * ps;
        u32x2 o; o.x = pk2(y[0], y[1]); o.y = pk2(y[2], y[3]); *(u32x2*)(YY + (tok0 + tl) * 1024 + 512 + e) = o; }
}

constexpr int PL_ZOFF = 0, PL_WOFF = 144 * 272, PL_PITCH = 272;
struct PoolStage { u32x4 z[5]; u32x4 w[4]; };
DI void pool_stage_load(PoolStage& ps, const bf16_t* PR, const bf16_t* WPT, size_t tok0, int pos0, int S, int g, int tid) {
#pragma unroll
    for (int i = 0; i < 5; ++i) { const int idx = tid + NTHR * i, row = idx >> 4, c = idx & 15; const int p = pos0 - 8 + row;
        ps.z[i] = (u32x4){0u, 0u, 0u, 0u};
        if (idx < 144 * 16 && p >= 0 && p < S) ps.z[i] = *(const u32x4*)(PR + (size_t)((ptrdiff_t)tok0 - 8 + row) * PRP + 1024 + g * 128 + c * 8); }
#pragma unroll
    for (int i = 0; i < 4; ++i) { const int idx = tid + NTHR * i; ps.w[i] = *(const u32x4*)(WPT + (g * 128 + (idx >> 4)) * 128 + (idx & 15) * 8); }
}
DI void pool_stage_store(const PoolStage& ps, LAS unsigned char* lds, int tid) {
#pragma unroll
    for (int i = 0; i < 5; ++i) { const int idx = tid + NTHR * i; if (idx < 144 * 16) *(LAS u32x4*)(lds + PL_ZOFF + (idx >> 4) * PL_PITCH + (idx & 15) * 16) = ps.z[i]; }
#pragma unroll
    for (int i = 0; i < 4; ++i) { const int idx = tid + NTHR * i; *(LAS u32x4*)(lds + PL_WOFF + (idx >> 4) * PL_PITCH + (idx & 15) * 16) = ps.w[i]; }
}
template <int GI>
DI void pool_compute(LAS unsigned char* lds, bf16_t* YY, const float* pool_scale, size_t tok0, int tl, int pos, int S, int fr, int fq) {
    constexpr int hw = 1 << GI, g = GI;
    const int lo = max(pos - hw, 0), hi = min(pos + hw, S); const float inv = 1.0f / (float)(hi - lo);
    f32x4 acc[8];
#pragma unroll
    for (int e = 0; e < 8; ++e) acc[e] = (f32x4){0.f, 0.f, 0.f, 0.f};
#pragma unroll 2
    for (int ks = 0; ks < 4; ++ks) {
        const LAS unsigned char* zb = lds + PL_ZOFF + (tl + 8) * PL_PITCH + (ks * 32 + fq * 8) * 2;
        f32x4 s0 = (f32x4){0.f, 0.f, 0.f, 0.f}, s1 = s0;
#pragma unroll
        for (int j = -hw; j < hw; ++j) { const u32x4 x = *(const LAS u32x4*)(zb + j * PL_PITCH);
            s0 += (f32x4){bf_lo(x.x), bf_hi(x.x), bf_lo(x.y), bf_hi(x.y)}; s1 += (f32x4){bf_lo(x.z), bf_hi(x.z), bf_lo(x.w), bf_hi(x.w)}; }
        const u32x4 cw = *(const LAS u32x4*)zb;
        s0 = s0 * inv - (f32x4){bf_lo(cw.x), bf_hi(cw.x), bf_lo(cw.y), bf_hi(cw.y)}; s1 = s1 * inv - (f32x4){bf_lo(cw.z), bf_hi(cw.z), bf_lo(cw.w), bf_hi(cw.w)};
        u32x4 dw; dw.x = pk2(s0[0], s0[1]); dw.y = pk2(s0[2], s0[3]); dw.z = pk2(s1[0], s1[1]); dw.w = pk2(s1[2], s1[3]);
        const bf16x8 df = __builtin_bit_cast(bf16x8, dw);
#pragma unroll
        for (int et = 0; et < 8; ++et) { const bf16x8 wf = *(const LAS bf16x8*)(lds + PL_WOFF + (et * 16 + fr) * PL_PITCH + (ks * 32 + fq * 8) * 2); acc[et] = mfma16(wf, df, acc[et]); }
    }
#pragma unroll
    for (int et = 0; et < 8; ++et) { const int e = g * 128 + et * 16 + fq * 4; const f32x4 ps = *(const f32x4*)(pool_scale + e); const f32x4 y = acc[et] * ps;
        u32x2 o; o.x = pk2(y[0], y[1]); o.y = pk2(y[2], y[3]); *(u32x2*)(YY + (tok0 + tl) * 1024 + 512 + e) = o; }
}

DI void even_core(LAS unsigned char* lds, const bf16_t* PR, bf16_t* YY, const bf16_t* WSP, const bf16_t* WPT, const float* ln_g, const float* ln_b,
                  const float* b_sp, const float* pool_scale, int S, int G, int tid, int wid, int lane) {
    const int fr = lane & 15, fq = lane >> 4;
    constexpr int PITCH = 1056;
    for (int ch0 = blockIdx.x; ch0 < GROWS / 128; ch0 += G) {
        const int ch = (G == 256) ? 2 * (16 * (ch0 & 7) + 8 * (ch0 >> 7) + ((ch0 >> 3) & 7)) + ((ch0 >> 6) & 1) : ch0;
        const size_t tok0 = (size_t)ch * 128;
        {
            const f32x4 g0 = *(const f32x4*)(ln_g + lane * 8), g1 = *(const f32x4*)(ln_g + lane * 8 + 4), b0 = *(const f32x4*)(ln_b + lane * 8), b1 = *(const f32x4*)(ln_b + lane * 8 + 4);
#pragma unroll 8
            for (int i = 0; i < 16; ++i) {
                const int q = wid * 16 + i;
                const u32x4 w = *(const u32x4*)(PR + (tok0 + q) * PRP + 512 + lane * 8);
                f32x4 a = (f32x4){bf_lo(w.x), bf_hi(w.x), bf_lo(w.y), bf_hi(w.y)}, b = (f32x4){bf_lo(w.z), bf_hi(w.z), bf_lo(w.w), bf_hi(w.w)};
                const float mean = wave_sum((a[0] + a[1]) + (a[2] + a[3]) + (b[0] + b[1]) + (b[2] + b[3])) * (1.0f / 512.0f);
                a = a - mean; b = b - mean;
                const float var = wave_sum((a[0] * a[0] + a[1] * a[1]) + (a[2] * a[2] + a[3] * a[3]) + (b[0] * b[0] + b[1] * b[1]) + (b[2] * b[2] + b[3] * b[3])) * (1.0f / 512.0f);
                const float rstd = rsqrtf(var + 1e-5f);
                a = a * rstd * g0 + b0; b = b * rstd * g1 + b1;
                u32x4 o; o.x = pk2(a[0], a[1]); o.y = pk2(a[2], a[3]); o.z = pk2(b[0], b[1]); o.w = pk2(b[2], b[3]);
                *(LAS u32x4*)(lds + q * PITCH + lane * 16) = o;
            }
        }
        __syncthreads();
        {
            const int h = wid >> 1, cw0 = wid * 64;
            for (int ph = 0; ph < 2; ++ph) {
                f32x4 acc[4][4];
#pragma unroll
                for (int a = 0; a < 4; ++a)
#pragma unroll
                    for (int b = 0; b < 4; ++b) acc[a][b] = (f32x4){0.f, 0.f, 0.f, 0.f};
#pragma unroll 1
                for (int kp = 0; kp < 2; ++kp) {
                    bf16x8 bw[2][4];
#pragma unroll
                    for (int k2 = 0; k2 < 2; ++k2)
#pragma unroll
                        for (int pt = 0; pt < 4; ++pt) bw[k2][pt] = *(const bf16x8*)(WSP + ((h * 128 + (ph * 4 + pt) * 16 + fr) * 128 + (kp * 2 + k2) * 32 + fq * 8));
#pragma unroll
                    for (int k2 = 0; k2 < 2; ++k2) {
                        const int ks = kp * 2 + k2;
                        bf16x8 af[4];
#pragma unroll
                        for (int ct = 0; ct < 4; ++ct) af[ct] = tr_frag(lds + (ks * 32 + fq * 8 + (fr >> 2)) * PITCH + (cw0 + ct * 16 + 4 * (fr & 3)) * 2, 4 * PITCH);
#pragma unroll
                        for (int ct = 0; ct < 4; ++ct)
#pragma unroll
                            for (int pt = 0; pt < 4; ++pt) acc[ct][pt] = mfma16(af[ct], bw[k2][pt], acc[ct][pt]);
                    }
                }
#pragma unroll
                for (int pt = 0; pt < 4; ++pt) {
                    const int pp = (ph * 4 + pt) * 16 + fr; const float bs = b_sp[h * 128 + pp];
#pragma unroll
                    for (int ct = 0; ct < 4; ++ct) {
                        const int c = cw0 + ct * 16 + fq * 4;
                        const u32x2 uw = *(const u32x2*)(PR + (tok0 + pp) * PRP + c);
                        u32x2 o; o.x = pk2(bf_lo(uw.x) * (acc[ct][pt][0] + bs), bf_hi(uw.x) * (acc[ct][pt][1] + bs)); o.y = pk2(bf_lo(uw.y) * (acc[ct][pt][2] + bs), bf_hi(uw.y) * (acc[ct][pt][3] + bs));
                        *(u32x2*)(YY + (tok0 + pp) * 1024 + c) = o;
                    }
                }
            }
        }
        {
            const int tl = wid * 16 + fr; const int pos = (int)(tok0 % (size_t)S) + tl;
            const int pos0 = (int)(tok0 % (size_t)S);
            PoolStage ps;
            pool_stage_load(ps, PR, WPT, tok0, pos0, S, 0, tid);
            __syncthreads();
            pool_stage_store(ps, lds, tid); pool_stage_load(ps, PR, WPT, tok0, pos0, S, 1, tid);
            __syncthreads();
            pool_compute<0>(lds, YY, pool_scale, tok0, tl, pos, S, fr, fq);
            __syncthreads();
            pool_stage_store(ps, lds, tid); pool_stage_load(ps, PR, WPT, tok0, pos0, S, 2, tid);
            __syncthreads();
            pool_compute<1>(lds, YY, pool_scale, tok0, tl, pos, S, fr, fq);
            __syncthreads();
            pool_stage_store(ps, lds, tid); pool_stage_load(ps, PR, WPT, tok0, pos0, S, 3, tid);
            __syncthreads();
            pool_compute<2>(lds, YY, pool_scale, tok0, tl, pos, S, fr, fq);
            __syncthreads();
            pool_stage_store(ps, lds, tid);
            __syncthreads();
            pool_compute<3>(lds, YY, pool_scale, tok0, tl, pos, S, fr, fq);
        }
        __syncthreads();
    }
}

DI void conv_part(const bf16_t* PR, bf16_t* YY, const float* conv_w, int S, int G, int wid, int lane) {
    const int gw = blockIdx.x * 8 + wid, NGW = G * 8;
    f32x4 w[3][2];
#pragma unroll
    for (int k = 0; k < 3; ++k) { w[k][0] = *(const f32x4*)(conv_w + k * 512 + lane * 8); w[k][1] = *(const f32x4*)(conv_w + k * 512 + lane * 8 + 4); }
#pragma unroll 4
    for (int r = gw; r < GROWS; r += NGW) {
        const int pos = r % S;
        const bf16_t* cz = PR + (size_t)r * PRP + lane * 8;
        const float m0 = (pos > 0) ? 1.0f : 0.0f, m2 = (pos < S - 1) ? 1.0f : 0.0f;
        const u32x4 c1 = *(const u32x4*)cz, c0 = *(const u32x4*)(cz - (pos > 0 ? PRP : 0)), c2 = *(const u32x4*)(cz + (pos < S - 1 ? PRP : 0)), bg = *(const u32x4*)(cz + 512);
        const f32x4 w00 = w[0][0] * m0, w01 = w[0][1] * m0, w20 = w[2][0] * m2, w21 = w[2][1] * m2;
        f32x4 a0 = (f32x4){bf_lo(c0.x), bf_hi(c0.x), bf_lo(c0.y), bf_hi(c0.y)} * w00 + (f32x4){bf_lo(c1.x), bf_hi(c1.x), bf_lo(c1.y), bf_hi(c1.y)} * w[1][0] + (f32x4){bf_lo(c2.x), bf_hi(c2.x), bf_lo(c2.y), bf_hi(c2.y)} * w20;
        f32x4 a1 = (f32x4){bf_lo(c0.z), bf_hi(c0.z), bf_lo(c0.w), bf_hi(c0.w)} * w01 + (f32x4){bf_lo(c1.z), bf_hi(c1.z), bf_lo(c1.w), bf_hi(c1.w)} * w[1][1] + (f32x4){bf_lo(c2.z), bf_hi(c2.z), bf_lo(c2.w), bf_hi(c2.w)} * w21;
        a0 = a0 * (f32x4){bf_lo(bg.x), bf_hi(bg.x), bf_lo(bg.y), bf_hi(bg.y)}; a1 = a1 * (f32x4){bf_lo(bg.z), bf_hi(bg.z), bf_lo(bg.w), bf_hi(bg.w)};
        u32x4 o; o.x = pk2(a0[0], a0[1]); o.y = pk2(a0[2], a0[3]); o.z = pk2(a1[0], a1[1]); o.w = pk2(a1[2], a1[3]);
        *(u32x4*)(YY + (size_t)r * 1024 + lane * 8) = o;
    }
}

template <int R, int QB>
DI void four_stage1(const bf16_t* PR, bf16_t* UB, const bf16_t* WF, const bf16_t* FCp, const bf16_t* FSp, const f32x2* TW, int nb, int G, int wid, int lane) {
    constexpr int NT = R / 16, KS = (R + 31) / 32, KW = KS * 32, S = R * 128, NQB = 128 / QB;
    const int fr = lane & 15, fq = lane >> 4, e0 = wid * 16;
    const int nunits = nb * 4 * NQB;
    for (int un = blockIdx.x; un < nunits; un += G) {
        const int q0 = (un % NQB) * QB, g = (un / NQB) & 3, b = un / (4 * NQB);
        bf16x8 wP[4], wQ[4];
#pragma unroll
        for (int ks = 0; ks < 4; ++ks) { wP[ks] = *(const bf16x8*)(WF + ((g * 256 + e0 + fr) * 128 + ks * 32 + fq * 8)); wQ[ks] = *(const bf16x8*)(WF + ((g * 256 + 128 + e0 + fr) * 128 + ks * 32 + fq * 8)); }
        unsigned pP[QB][NT][2], pQ[QB][NT][2];
#pragma unroll
        for (int rt = 0; rt < NT; ++rt) {
#pragma unroll
            for (int qi = 0; qi < QB; ++qi) {
                const size_t tok = (size_t)b * S + 128 * (rt * 16 + fr) + q0 + qi;
                const bf16_t* zp = PR + tok * PRP + 1024 + g * 128 + fq * 8;
                bf16x8 a[4]; float ss = 0.f;
#pragma unroll
                for (int ks = 0; ks < 4; ++ks) a[ks] = *(const bf16x8*)(zp + ks * 32);
#pragma unroll
                for (int ks = 0; ks < 4; ++ks)
#pragma unroll
                    for (int k = 0; k < 8; ++k) { const float f = __uint_as_float(((unsigned)(unsigned short)a[ks][k]) << 16); ss += f * f; }
                ss += __shfl_xor(ss, 16); ss += __shfl_xor(ss, 32);
                const float rs = rsqrtf(ss * (1.0f / 128.0f) + 1e-6f);
                f32x4 dP = (f32x4){0.f, 0.f, 0.f, 0.f}, dQ = dP;
#pragma unroll
                for (int ks = 0; ks < 4; ++ks) { dP = mfma16(a[ks], wP[ks], dP); dQ = mfma16(a[ks], wQ[ks], dQ); }
#pragma unroll
                for (int j = 0; j < 4; ++j) { const float sj = __shfl(rs, fq * 4 + j); dP[j] *= sj; dQ[j] *= sj; }
                pP[qi][rt][0] = pk2(dP[0], dP[1]); pP[qi][rt][1] = pk2(dP[2], dP[3]); pQ[qi][rt][0] = pk2(dQ[0], dQ[1]); pQ[qi][rt][1] = pk2(dQ[2], dQ[3]);
            }
            if ((rt & 3) == 3) asm volatile("" ::: "memory");
        }
#pragma unroll 2
        for (int k1t = 0; k1t < NT; ++k1t) {
            bf16x8 aC[KS], aS[KS];
#pragma unroll
            for (int s = 0; s < KS; ++s) { aC[s] = *(const bf16x8*)(FCp + ((k1t * 16 + fr) * KW + s * 32 + fq * 8)); aS[s] = *(const bf16x8*)(FSp + ((k1t * 16 + fr) * KW + s * 32 + fq * 8)); }
#pragma unroll
            for (int qi = 0; qi < QB; ++qi) {
                f32x4 Ur = (f32x4){0.f, 0.f, 0.f, 0.f}, V = Ur;
#pragma unroll
                for (int s = 0; s < KS; ++s) {
                    u32x4 bp, bq;
                    bp.x = pP[qi][2 * s][0]; bp.y = pP[qi][2 * s][1]; bq.x = pQ[qi][2 * s][0]; bq.y = pQ[qi][2 * s][1];
                    if (2 * s + 1 < NT) { bp.z = pP[qi][(2 * s + 1) % NT][0]; bp.w = pP[qi][(2 * s + 1) % NT][1]; bq.z = pQ[qi][(2 * s + 1) % NT][0]; bq.w = pQ[qi][(2 * s + 1) % NT][1]; }
                    else { bp.z = 0u; bp.w = 0u; bq.z = 0u; bq.w = 0u; }
                    const u32x4 bnq = bq ^ 0x80008000u;
                    const bf16x8 BP = __builtin_bit_cast(bf16x8, bp), BQ = __builtin_bit_cast(bf16x8, bq), BNQ = __builtin_bit_cast(bf16x8, bnq);
                    Ur = mfma16(aC[s], BP, Ur); Ur = mfma16(aS[s], BNQ, Ur); V = mfma16(aS[s], BP, V); V = mfma16(aC[s], BQ, V);
                }
                const int q = q0 + qi;
#pragma unroll
                for (int j = 0; j < 4; ++j) {
                    const int k1 = k1t * 16 + fq * 4 + j; const f32x2 tw = TW[q * R + k1];
                    const float upr = Ur[j] * tw.x - V[j] * tw.y, upi = -(V[j] * tw.x + Ur[j] * tw.y);
                    bf16_t* o = UB + ((((size_t)b * R + k1) * 2) * 128 + q) * 512 + g * 128 + e0 + fr;
                    o[0] = (bf16_t)f2bf(upr); o[(size_t)128 * 512] = (bf16_t)f2bf(upi);
                }
            }
        }
    }
}

DI void four_stage1_p(LAS unsigned char* lds, const bf16_t* PR, bf16_t* UB, const bf16_t* WF, const bf16_t* FCp, const bf16_t* FSp, const f32x2* TW, int nb, int G, int tid, int wid, int lane) {
    constexpr int R = 128, S = R * 128, PT = 272, TC_OFF = 0, TS_OFF = 128 * PT, Z_OFF = 256 * PT, TW_OFF = 384 * PT;
    const int fr = lane & 15, fq = lane >> 4, e0 = wid * 16;
    const int nunits = nb * 4 * 128;
    {
#pragma unroll
        for (int i = 0; i < 4; ++i) { const int idx = tid + NTHR * i; const u32x4 c = *(const u32x4*)(FCp + (idx >> 4) * 128 + (idx & 15) * 8), sn = *(const u32x4*)(FSp + (idx >> 4) * 128 + (idx & 15) * 8);
            *(LAS u32x4*)(lds + TC_OFF + (idx >> 4) * PT + (idx & 15) * 16) = c; *(LAS u32x4*)(lds + TS_OFF + (idx >> 4) * PT + (idx & 15) * 16) = sn; }
    }
    u32x4 zr[4]; u32x4 twr = (u32x4){0u, 0u, 0u, 0u};
    int un = blockIdx.x;
    if (un < nunits) { const int q = un & 127, g = (un >> 7) & 3, b = un >> 9;
#pragma unroll
        for (int i = 0; i < 4; ++i) { const int idx = tid + NTHR * i; zr[i] = *(const u32x4*)(PR + ((size_t)b * S + 128 * (idx >> 4) + q) * PRP + 1024 + g * 128 + (idx & 15) * 8); }
        if (tid < 64) twr = *(const u32x4*)((const float*)(TW + q * R) + tid * 4); }
    for (; un < nunits; un += G) {
        const int q = un & 127, g = (un >> 7) & 3, b = un >> 9;
        bf16x8 wP[4], wQ[4];
#pragma unroll
        for (int ks = 0; ks < 4; ++ks) { wP[ks] = *(const bf16x8*)(WF + ((g * 256 + e0 + fr) * 128 + ks * 32 + fq * 8)); wQ[ks] = *(const bf16x8*)(WF + ((g * 256 + 128 + e0 + fr) * 128 + ks * 32 + fq * 8)); }
        __syncthreads();
#pragma unroll
        for (int i = 0; i < 4; ++i) { const int idx = tid + NTHR * i; *(LAS u32x4*)(lds + Z_OFF + (idx >> 4) * PT + (idx & 15) * 16) = zr[i]; }
        if (tid < 64) *(LAS u32x4*)(lds + TW_OFF + tid * 16) = twr;
        { const int un2 = un + G;
          if (un2 < nunits) { const int q2 = un2 & 127, g2 = (un2 >> 7) & 3, b2 = un2 >> 9;
#pragma unroll
            for (int i = 0; i < 4; ++i) { const int idx = tid + NTHR * i; zr[i] = *(const u32x4*)(PR + ((size_t)b2 * S + 128 * (idx >> 4) + q2) * PRP + 1024 + g2 * 128 + (idx & 15) * 8); }
            if (tid < 64) twr = *(const u32x4*)((const float*)(TW + q2 * R) + tid * 4); } }
        __syncthreads();
        unsigned pP[8][2], pQ[8][2];
#pragma unroll
        for (int rt = 0; rt < 8; ++rt) {
            bf16x8 a[4]; float ss = 0.f;
#pragma unroll
            for (int ks = 0; ks < 4; ++ks) a[ks] = *(const LAS bf16x8*)(lds + Z_OFF + (rt * 16 + fr) * PT + (ks * 32 + fq * 8) * 2);
#pragma unroll
            for (int ks = 0; ks < 4; ++ks)
#pragma unroll
                for (int k = 0; k < 8; ++k) { const float f = __uint_as_float(((unsigned)(unsigned short)a[ks][k]) << 16); ss += f * f; }
            ss += __shfl_xor(ss, 16); ss += __shfl_xor(ss, 32);
            const float rs = rsqrtf(ss * (1.0f / 128.0f) + 1e-6f);
            f32x4 dP = (f32x4){0.f, 0.f, 0.f, 0.f}, dQ = dP;
#pragma unroll
            for (int ks = 0; ks < 4; ++ks) { dP = mfma16(a[ks], wP[ks], dP); dQ = mfma16(a[ks], wQ[ks], dQ); }
#pragma unroll
            for (int j = 0; j < 4; ++j) { const float sj = __shfl(rs, fq * 4 + j); dP[j] *= sj; dQ[j] *= sj; }
            pP[rt][0] = pk2(dP[0], dP[1]); pP[rt][1] = pk2(dP[2], dP[3]); pQ[rt][0] = pk2(dQ[0], dQ[1]); pQ[rt][1] = pk2(dQ[2], dQ[3]);
            if ((rt & 3) == 3) asm volatile("" ::: "memory");
        }
#pragma unroll 2
        for (int k1t = 0; k1t < 8; ++k1t) {
            bf16x8 aC[4], aS[4];
#pragma unroll
            for (int sx = 0; sx < 4; ++sx) { aC[sx] = *(const LAS bf16x8*)(lds + TC_OFF + (k1t * 16 + fr) * PT + (sx * 32 + fq * 8) * 2); aS[sx] = *(const LAS bf16x8*)(lds + TS_OFF + (k1t * 16 + fr) * PT + (sx * 32 + fq * 8) * 2); }
            const f32x4 twa = *(const LAS f32x4*)(lds + TW_OFF + (k1t * 16 + fq * 4) * 8), twb = *(const LAS f32x4*)(lds + TW_OFF + (k1t * 16 + fq * 4) * 8 + 16);
            f32x4 Ur = (f32x4){0.f, 0.f, 0.f, 0.f}, V = Ur;
#pragma unroll
            for (int sx = 0; sx < 4; ++sx) {
                u32x4 bp, bq;
                bp.x = pP[2 * sx][0]; bp.y = pP[2 * sx][1]; bq.x = pQ[2 * sx][0]; bq.y = pQ[2 * sx][1];
                bp.z = pP[2 * sx + 1][0]; bp.w = pP[2 * sx + 1][1]; bq.z = pQ[2 * sx + 1][0]; bq.w = pQ[2 * sx + 1][1];
                const u32x4 bnq = bq ^ 0x80008000u;
                const bf16x8 BP = __builtin_bit_cast(bf16x8, bp), BQ = __builtin_bit_cast(bf16x8, bq), BNQ = __builtin_bit_cast(bf16x8, bnq);
                Ur = mfma16(aC[sx], BP, Ur); Ur = mfma16(aS[sx], BNQ, Ur); V = mfma16(aS[sx], BP, V); V = mfma16(aC[sx], BQ, V);
            }
            const float tcs[4] = {twa[0], twa[2], twb[0], twb[2]}, tsn[4] = {twa[1], twa[3], twb[1], twb[3]};
#pragma unroll
            for (int j = 0; j < 4; ++j) {
                const int k1 = k1t * 16 + fq * 4 + j;
                const float upr = Ur[j] * tcs[j] - V[j] * tsn[j], upi = -(V[j] * tcs[j] + Ur[j] * tsn[j]);
                bf16_t* o = UB + ((((size_t)b * R + k1) * 2) * 128 + q) * 512 + g * 128 + e0 + fr;
                o[0] = (bf16_t)f2bf(upr); o[(size_t)128 * 512] = (bf16_t)f2bf(upi);
            }
        }
    }
    __syncthreads();
}

DI void four_stage1_s(LAS unsigned char* lds, const bf16_t* PR, bf16_t* UB, const bf16_t* WF, const bf16_t* FCp, const bf16_t* FSp, const f32x2* TW, int nb, int G, int tid, int wid, int lane) {
    constexpr int R = 16, S = R * 128, QB = 4, NQB = 32, PT = 272;
    const int fr = lane & 15, fq = lane >> 4, e0 = wid * 16;
    const int nunits = nb * 4 * NQB;
    const bool uniform = (G % 128) == 0;
    int un = blockIdx.x;
    if (un >= nunits) return;
    int q0 = (un % NQB) * QB, g = (un / NQB) & 3;
    bf16x8 wP[4], wQ[4], aC, aS; f32x4 twv[QB][2];
    u32x4 zr[2];
#define S1S_CONST() do { _Pragma("unroll") for (int ks = 0; ks < 4; ++ks) { wP[ks] = *(const bf16x8*)(WF + ((g * 256 + e0 + fr) * 128 + ks * 32 + fq * 8)); wQ[ks] = *(const bf16x8*)(WF + ((g * 256 + 128 + e0 + fr) * 128 + ks * 32 + fq * 8)); } \
        _Pragma("unroll") for (int qi = 0; qi < QB; ++qi) { const f32x4* tp = (const f32x4*)(TW + (q0 + qi) * R + fq * 4); twv[qi][0] = tp[0]; twv[qi][1] = tp[1]; } } while (0)
    aC = *(const bf16x8*)(FCp + (fr * 32 + fq * 8)); aS = *(const bf16x8*)(FSp + (fr * 32 + fq * 8));
    S1S_CONST();
    { const int b = un / (4 * NQB);
#pragma unroll
      for (int i = 0; i < 2; ++i) { const int idx = tid + NTHR * i, row = idx >> 4; zr[i] = *(const u32x4*)(PR + ((size_t)b * S + 128 * (row & 15) + q0 + (row >> 4)) * PRP + 1024 + g * 128 + (idx & 15) * 8); } }
    for (; un < nunits; un += G) {
        const int b = un / (4 * NQB);
        __syncthreads();
#pragma unroll
        for (int i = 0; i < 2; ++i) { const int idx = tid + NTHR * i; *(LAS u32x4*)(lds + (idx >> 4) * PT + (idx & 15) * 16) = zr[i]; }
        const int un2 = un + G; int q0n = q0, gn = g;
        if (un2 < nunits) { const int b2 = un2 / (4 * NQB); q0n = (un2 % NQB) * QB; gn = (un2 / NQB) & 3;
#pragma unroll
            for (int i = 0; i < 2; ++i) { const int idx = tid + NTHR * i, row = idx >> 4; zr[i] = *(const u32x4*)(PR + ((size_t)b2 * S + 128 * (row & 15) + q0n + (row >> 4)) * PRP + 1024 + gn * 128 + (idx & 15) * 8); } }
        __syncthreads();
#pragma unroll
        for (int qi = 0; qi < QB; ++qi) {
            bf16x8 a[4]; float ss = 0.f;
#pragma unroll
            for (int ks = 0; ks < 4; ++ks) a[ks] = *(const LAS bf16x8*)(lds + (qi * 16 + fr) * PT + (ks * 32 + fq * 8) * 2);
#pragma unroll
            for (int ks = 0; ks < 4; ++ks)
#pragma unroll
                for (int k = 0; k < 8; ++k) { const float f = __uint_as_float(((unsigned)(unsigned short)a[ks][k]) << 16); ss += f * f; }
            ss += __shfl_xor(ss, 16); ss += __shfl_xor(ss, 32);
            const float rs = rsqrtf(ss * (1.0f / 128.0f) + 1e-6f);
            f32x4 dP = (f32x4){0.f, 0.f, 0.f, 0.f}, dQ = dP;
#pragma unroll
            for (int ks = 0; ks < 4; ++ks) { dP = mfma16(a[ks], wP[ks], dP); dQ = mfma16(a[ks], wQ[ks], dQ); }
#pragma unroll
            for (int j = 0; j < 4; ++j) { const float sj = __shfl(rs, fq * 4 + j); dP[j] *= sj; dQ[j] *= sj; }
            u32x4 bp, bq; bp.x = pk2(dP[0], dP[1]); bp.y = pk2(dP[2], dP[3]); bp.z = 0u; bp.w = 0u; bq.x = pk2(dQ[0], dQ[1]); bq.y = pk2(dQ[2], dQ[3]); bq.z = 0u; bq.w = 0u;
            const u32x4 bnq = bq ^ 0x80008000u;
            const bf16x8 BP = __builtin_bit_cast(bf16x8, bp), BQ = __builtin_bit_cast(bf16x8, bq), BNQ = __builtin_bit_cast(bf16x8, bnq);
            f32x4 Ur = (f32x4){0.f, 0.f, 0.f, 0.f}, V = Ur;
            Ur = mfma16(aC, BP, Ur); Ur = mfma16(aS, BNQ, Ur); V = mfma16(aS, BP, V); V = mfma16(aC, BQ, V);
            const int q = q0 + qi;
            const float tcs[4] = {twv[qi][0][0], twv[qi][0][2], twv[qi][1][0], twv[qi][1][2]}, tsn[4] = {twv[qi][0][1], twv[qi][0][3], twv[qi][1][1], twv[qi][1][3]};
#pragma unroll
            for (int j = 0; j < 4; ++j) {
                const int k1 = fq * 4 + j;
                const float upr = Ur[j] * tcs[j] - V[j] * tsn[j], upi = -(V[j] * tcs[j] + Ur[j] * tsn[j]);
                bf16_t* o = UB + ((((size_t)b * R + k1) * 2) * 128 + q) * 512 + g * 128 + e0 + fr;
                o[0] = (bf16_t)f2bf(upr); o[(size_t)128 * 512] = (bf16_t)f2bf(upi);
            }
        }
        if (!uniform && un2 < nunits) { q0 = q0n; g = gn; S1S_CONST(); }
    }
#undef S1S_CONST
    __syncthreads();
}

template <int R>
DI void four_stage2(LAS unsigned char* lds, const bf16_t* UB, bf16_t* YY, const bf16_t* FC2, const bf16_t* FS2, int nb, int G, int tid, int wid, int lane) {
    constexpr int PITCH2 = 544, S = R * 128;
    const float norm = rsqrtf((float)S * 128.0f);
    const int fr = lane & 15, fq = lane >> 4, c0 = wid * 32;
    const int nunits = nb * R * 2;
    for (int un = blockIdx.x; un < nunits; un += G) {
        const int ch2 = un & 1, k1 = (un >> 1) % R, b = (un >> 1) / R;
        const bf16_t* src = UB + (((size_t)b * R + k1) * 2) * 128 * 512 + ch2 * 256;
#pragma unroll
        for (int pass = 0; pass < 16; ++pass) { const int row = pass * 16 + (tid >> 5), seg = tid & 31;
            const u32x4 w = *(const u32x4*)(src + (size_t)row * 512 + seg * 8); *(LAS u32x4*)(lds + row * PITCH2 + seg * 16) = w; }
        __syncthreads();
        f32x4 acc[2][8];
#pragma unroll
        for (int a = 0; a < 2; ++a)
#pragma unroll
            for (int k = 0; k < 8; ++k) acc[a][k] = (f32x4){0.f, 0.f, 0.f, 0.f};
        bf16x8 fa[8];
#pragma unroll
        for (int k2t = 0; k2t < 8; ++k2t) fa[k2t] = *(const bf16x8*)(FC2 + ((k2t * 16 + fr) * 128 + fq * 8));
#pragma unroll 2
        for (int it = 0; it < 8; ++it) {
            const int comp = it >> 2, ks = it & 3, itn = (it + 1) & 7;
            bf16x8 fn[8];
            { const bf16_t* Fn = (itn >> 2) ? FS2 : FC2;
#pragma unroll
              for (int k2t = 0; k2t < 8; ++k2t) fn[k2t] = *(const bf16x8*)(Fn + ((k2t * 16 + fr) * 128 + (itn & 3) * 32 + fq * 8)); }
            bf16x8 uf[2];
#pragma unroll
            for (int ct = 0; ct < 2; ++ct) uf[ct] = tr_frag(lds + (comp * 128 + ks * 32 + fq * 8 + (fr >> 2)) * PITCH2 + (c0 + ct * 16 + 4 * (fr & 3)) * 2, 4 * PITCH2);
#pragma unroll
            for (int k2t = 0; k2t < 8; ++k2t)
#pragma unroll
                for (int ct = 0; ct < 2; ++ct) acc[ct][k2t] = mfma16(uf[ct], fa[k2t], acc[ct][k2t]);
#pragma unroll
            for (int k2t = 0; k2t < 8; ++k2t) fa[k2t] = fn[k2t];
        }
#pragma unroll
        for (int k2t = 0; k2t < 8; ++k2t) {
            const size_t tok = (size_t)b * S + (size_t)R * (k2t * 16 + fr) + k1;
#pragma unroll
            for (int ct = 0; ct < 2; ++ct) { const f32x4 y = acc[ct][k2t] * norm; u32x2 o; o.x = pk2(y[0], y[1]); o.y = pk2(y[2], y[3]);
                *(u32x2*)(YY + tok * 1024 + 512 + ch2 * 256 + c0 + ct * 16 + fq * 4) = o; }
        }
        __syncthreads();
    }
}

__global__ void __launch_bounds__(NTHR, 2) mega_fwd(Params p) {
    extern __shared__ __attribute__((aligned(16))) unsigned char lds_raw[];
    LAS unsigned char* lds = (LAS unsigned char*)lds_raw;
    cg::grid_group grid = cg::this_grid();
    const int tid = threadIdx.x, lane = tid & 63, wid = __builtin_amdgcn_readfirstlane(tid >> 6), G = gridDim.x;
    unsigned char* ws = p.ws;
    int pc = 0;
#define PH_BEGIN if (pc >= p.ph_lo && pc < p.ph_hi) {
    volatile LAS unsigned* bst = (volatile LAS unsigned*)(lds + LDS_BYTES - 64);
    if (tid < 2) bst[tid] = 0u;
    __syncthreads();
    if (p.ph_lo > p.ph_hi) grid.sync();
    XcdBarrier xbar = xcd_barrier_post((unsigned*)(ws + WS_BAR), bst);
    if (tid == 0) { (void)__hip_atomic_fetch_max(&xbar.bar[XB_CLS(blockIdx.x & 7u)], xbar.x + 1u, __ATOMIC_RELAXED, __HIP_MEMORY_SCOPE_AGENT); (void)__hip_atomic_fetch_max(&xbar.bar[XB_CLS(8u + (blockIdx.x & 7u))], 16u - xbar.x, __ATOMIC_RELAXED, __HIP_MEMORY_SCOPE_AGENT); }
    bool local_ok = false, seam_local = false;
#define PH_END } ++pc; if (pc == 1) { xcd_barrier(xbar); \
        local_ok = (G == 256) && (bst[0] == 32u) && (bst[1] == 8u) && (xb_ld(&xbar.bar[XB_TMO]) == 0u); \
        for (unsigned cc = 0; cc < 8u; ++cc) local_ok = local_ok && (xb_ld(&xbar.bar[XB_CLS(cc)]) + xb_ld(&xbar.bar[XB_CLS(8u + cc)]) == 17u); } \
    else if (seam_local && local_ok) { team_barrier(xbar); } else { xcd_barrier(xbar); }

    PH_BEGIN
#if PHMASK & 1
#if PROBE & 16
 for (int rep = 0; rep < 2; ++rep)
#endif
 setup_phase(p, lds, G, tid, wid, lane);
#endif
 PH_END

    bf16_t* H = (bf16_t*)(ws + WS_H); bf16_t* T = (bf16_t*)(ws + WS_T); bf16_t* BIG = (bf16_t*)(ws + WS_BIG); bf16_t* UB = (bf16_t*)(ws + WS_T);     _Float16* XH = (_Float16*)(ws + WS_XH);
    const float* mod = (const float*)(ws + WS_MOD);
    for (int gi = 0; gi < 2; ++gi) {
        const int S = gi ? 2048 : 16384, nb = gi ? 16 : 2;
        const float* xsrc = p.in[gi];
        float* xo = p.out + (size_t)gi * GROWS * D;
        for (int ls = 0; ls < 7; ++ls) {
            const int l = ls / 3, sub = ls % 3;
            const bool odd = (l & 1), last = (ls == 6), first = (ls == 0);
            const int nsteps = last ? 1 : (sub != 1 ? 3 : (odd ? 5 : 4));
            for (int step = 0; step < nsteps; ++step) {
                int kind = 1;
                if (step == 0) kind = 0;
                else if (sub == 1 && step == 2) kind = odd ? 3 : 2;
                else if (sub == 1 && odd && step == 3) kind = 4;
                seam_local = !((kind == 1 && sub == 1) || kind == 3 || kind == 4);
                PH_BEGIN
                int tid = threadIdx.x; asm volatile("" : "+v"(tid));
                const int lane = tid & 63, wid = __builtin_amdgcn_readfirstlane(tid >> 6);
                if (kind == 0) {
#if PHMASK & 2
#ifndef STAG2
#define STAG2 0
#endif
                    if (STAG2 && local_ok && ((gi == 0 && ls == 0) || sub == 2) && ((blockIdx.x >> 3) & 1)) { for (int zz = 0; zz < STAG2; ++zz) __builtin_amdgcn_s_sleep(127); }
                    const int lp = sub > 0 ? l : l - 1, sp = sub > 0 ? sub - 1 : 2, lpp = first ? 0 : lp, lc = last ? 0 : l;
#if PROBE & 4
                    norm_phase(ls <= 1 ? xsrc : nullptr, XH, last ? (float*)BIG : nullptr, (_Float16*)BIG, T, H, !first, !last,
                               mod + (size_t)lpp * 18 * 9216 + (sp * 3 + 2) * 1024, p.in[7] + (lpp * 3 + sp) * 1024, sp == 1 ? 1.0f : 0.5f,
                               mod + (size_t)lc * 18 * 9216 + (sub * 3) * 1024, p.in[6] + (lc * 3 + sub) * 1024, gi, G, wid, lane);
#endif
                    norm_phase(ls <= 1 ? xsrc : nullptr, XH, last ? xo : nullptr, XH, T, H, !first, !last,
                               mod + (size_t)lpp * 18 * 9216 + (sp * 3 + 2) * 1024, p.in[7] + (lpp * 3 + sp) * 1024, sp == 1 ? 1.0f : 0.5f,
                               mod + (size_t)lc * 18 * 9216 + (sub * 3) * 1024, p.in[6] + (lc * 3 + sub) * 1024, gi, G, wid, lane);
#endif
                } else if (kind == 1) {
                    const bf16_t* A; const bf16_t* Bt; bf16_t* O; int N, K, ldc, mode;
                    if (sub != 1) {
                        const int wi = l * 2 + (sub >> 1);
                        if (step == 1) { A = H; Bt = (const bf16_t*)(ws + WS_WUP) + (size_t)wi * 5632 * 1024; O = BIG; N = 5632; K = 1024; ldc = DFF; mode = 3; }
                        else { A = BIG; Bt = (const bf16_t*)(ws + WS_WDN) + (size_t)wi * 1024 * 2816; O = T; N = 1024; K = DFF; ldc = D; mode = 0; }
                    } else if (step == 1) { A = H; Bt = (const bf16_t*)(ws + (odd ? WS_ODIN : WS_EVIN)); O = BIG; N = odd ? 2048 : 1536; K = 1024; ldc = PRP; mode = odd ? 2 : 1; }
                    else { A = H; Bt = (const bf16_t*)(ws + (odd ? WS_ODOUT : WS_EVOUT)); O = T; N = 1024; K = 1024; ldc = D; mode = 0; }
#if PROBE & 2
                    for (int rep = 0; rep < 2; ++rep)
#endif
                    run_gemm(lds, A, Bt, GROWS, N, K, O, ldc, mode, G);
                } else if (kind == 2) {
#if PHMASK & 8
#if PROBE & (8 | 32)
                    for (int rep = 0; rep < 2; ++rep)
#endif
                    even_core(lds, BIG, H, (const bf16_t*)(ws + WS_WSP), (const bf16_t*)(ws + WS_WPT), p.in[13], p.in[14], p.in[16], p.in[18], S, G, tid, wid, lane);
#endif
                } else if (kind == 3) {
#if PHMASK & 16
#if PROBE & (8 | 64)
                    for (int rep = 0; rep < 2; ++rep) {
#else
                    {
#endif
                    conv_part(BIG, H, p.in[21], S, G, wid, lane);
                    if (gi == 0) four_stage1_p(lds, BIG, UB, (const bf16_t*)(ws + WS_WF), (const bf16_t*)(ws + WS_FC1), (const bf16_t*)(ws + WS_FS1), (const f32x2*)(ws + WS_TW128), nb, G, tid, wid, lane);
                    else four_stage1_s(lds, BIG, UB, (const bf16_t*)(ws + WS_WF), (const bf16_t*)(ws + WS_FC16), (const bf16_t*)(ws + WS_FS16), (const f32x2*)(ws + WS_TW16), nb, G, tid, wid, lane);
                    }
#endif
                } else {
#if PHMASK & 32
#if PROBE & (8 | 128)
                    for (int rep = 0; rep < 2; ++rep) {
#else
                    {
#endif
                    if (gi == 0) four_stage2<128>(lds, UB, H, (const bf16_t*)(ws + WS_FC2), (const bf16_t*)(ws + WS_FS2), nb, G, tid, wid, lane);
                    else four_stage2<16>(lds, UB, H, (const bf16_t*)(ws + WS_FC2), (const bf16_t*)(ws + WS_FS2), nb, G, tid, wid, lane);
                    }
#endif
                }
                PH_END
            }
        }
    }
}

extern "C" void kernel_launch(void* const* d_in, const int* in_sizes, int n_in, void* d_out, int out_size, void* d_ws, size_t ws_size, hipStream_t stream) {
    static int grid = 0;
    if (grid == 0) {
        if (n_in != 25 || ws_size < WS_END || out_size != 2 * GROWS * D) { fprintf(stderr, "kernel_launch: unexpected shapes (n_in %d, out %d, ws %zu)\n", n_in, out_size, ws_size); grid = -1; return; }
        int dev = 0, cus = 0, per_cu = 0;
        hipGetDevice(&dev); hipDeviceGetAttribute(&cus, hipDeviceAttributeMultiprocessorCount, dev);
        hipFuncSetAttribute((const void*)mega_fwd, hipFuncAttributeMaxDynamicSharedMemorySize, LDS_BYTES);
        if (hipOccupancyMaxActiveBlocksPerMultiprocessor(&per_cu, (const void*)mega_fwd, NTHR, LDS_BYTES) != hipSuccess || per_cu < 1) per_cu = 1;
        (void)hipGetLastError();
        grid = cus * 1;
    }
    if (grid < 0) return;
    Params p{};
    for (int i = 0; i < 25; ++i) p.in[i] = (const float*)d_in[i];
    p.out = (float*)d_out; p.ws = (unsigned char*)d_ws; p.ph_lo = 0; p.ph_hi = 1 << 20;
    (void)hipMemsetAsync((unsigned char*)d_ws + WS_BAR, 0, XB_WORDS_ALL * sizeof(unsigned), stream);
    void* args[] = {&p};
    hipError_t e = hipLaunchCooperativeKernel((const void*)mega_fwd, dim3(grid), dim3(NTHR), args, LDS_BYTES, stream);
    if (e != hipSuccess) fprintf(stderr, "cooperative launch failed: %s (grid %d)\n", hipGetErrorString(e), grid);
}
```

```cpp
#include <hip/hip_runtime.h>
#include <hip/hip_cooperative_groups.h>
#include <cstdio>
namespace cg = cooperative_groups;
namespace pg8 {
#define PG8_LAS __attribute__((address_space(3)))
typedef unsigned short bf16_t;
typedef short bf16x8 __attribute__((ext_vector_type(8)));
typedef float f32x4 __attribute__((ext_vector_type(4)));
typedef unsigned u32x4 __attribute__((ext_vector_type(4)));
constexpr int BM = 256, BK = 64, HALF = 128, HTB = HALF * BK * 2  , STAGE_BYTES = 8 * HTB, NXCD = 8, WGM = 8;

__host__ __device__ __forceinline__ int lds_byte(int r, int c) { const int st = (r >> 4) * 2 + (c >> 5), rr = r & 15, cc = c & 31, ob = rr * 64 + cc * 2; return st * 1024 + (ob ^ (((ob >> 9) & 1) << 5)); }
__host__ __device__ __forceinline__ void stage_rc(int b, int& R, int& C) { const int st = b / 1024, sb = b % 1024, swz = sb ^ (((sb >> 9) & 1) << 5); R = (st >> 1) * 16 + swz / 64; C = (st & 1) * 32 + (swz % 64) / 2; }
__host__ __device__ __forceinline__ int perm32(int rho) { const int n = rho >> 4, i = rho & 15; return 8 * (i >> 2) + 4 * n + (i & 3); }

struct Unit { int pm, pn; };
struct Gemm { const bf16_t* A; const bf16_t* Bt; int M, N, K; };

struct StaticOrder {
    int nM, nN, nwg, G, c;
    __host__ __device__ void init(int M, int N, int G_, int c_) { nM = M / BM; nN = N / BM; nwg = nM * nN; G = G_; c = c_; }
    __host__ __device__ bool next(int i, Unit& u) const {
        const long L = (long)i * G + c; if (L >= nwg) return false;
        int wgid = (int)L; { const int q = nwg / NXCD, r = nwg % NXCD, xcd = wgid % NXCD, off = wgid / NXCD; wgid = (xcd < r ? xcd * (q + 1) : r * (q + 1) + (xcd - r) * q) + off; }
        const int nig = WGM * nN, gid = wgid / nig, fm = gid * WGM, gsz = (nM - fm) < WGM ? (nM - fm) : WGM;
        u.pm = fm + ((wgid % nig) % gsz); u.pn = (wgid % nig) / gsz; return true;
    }
    __device__ __forceinline__ void a_ready(const Unit&) const {}
    __device__ __forceinline__ void done(const Unit&) const {}
};
__device__ __forceinline__ unsigned cvt_pk_bf16(float lo, float hi) { unsigned r; asm volatile("v_cvt_pk_bf16_f32 %0, %1, %2" : "=v"(r) : "v"(lo), "v"(hi)); return r; }
typedef float f32x2 __attribute__((ext_vector_type(2)));
__device__ __forceinline__ f32x2 gelu_pk(f32x2 v) {
    const f32x2 av = __builtin_elementwise_abs(v), d = av * 0.2316418882f + 1.0f;
    f32x2 t; t.x = __builtin_amdgcn_rcpf(d.x); t.y = __builtin_amdgcn_rcpf(d.y);
    f32x2 q = t * 0.5307027145f + (-0.7265760135f); q = q * t + 0.7107068705f; q = q * t + (-0.142248368f); q = q * t + 0.127414796f; q = q * t;
    const f32x2 s = (v * v) * (-0.72134752044f);
    f32x2 e; e.x = __builtin_amdgcn_exp2f(s.x); e.y = __builtin_amdgcn_exp2f(s.y);
    const f32x2 m = v * (q * e), r = v - m;
    f32x2 o; o.x = v.x < 0.f ? m.x : r.x; o.y = v.y < 0.f ? m.y : r.y; return o;
}
template <class Epi, class Sched, bool ALIGN_EPI = false, bool SP2 = false>
__device__ __forceinline__ void gemm_phase(PG8_LAS unsigned char* lds, const Gemm g, const Sched& S, const Epi& E) {
    int tid_o = threadIdx.x; asm volatile("" : "+v"(tid_o));
    const int tid = tid_o, wid = __builtin_amdgcn_readfirstlane(tid >> 6), lane = tid & 63, wr = wid >> 2, wc = wid & 3, fr = lane & 15, fq = lane >> 4;
    const int K = g.K, nt = K / BK;
    unsigned voffA[2], voffB[2];
#pragma unroll
    for (int i = 0; i < 2; ++i) { int R, C; stage_rc(tid * 16 + i * 8192, R, C); const int Rb = Epi::PERM ? ((R & ~31) + perm32(R & 31)) : R;
        voffA[i] = (unsigned)(R * K + C) * 2u; voffB[i] = (unsigned)(Rb * K + C) * 2u; }
    const size_t kstep = (size_t)(BK * 2);
    const size_t hstep = (size_t)HALF * K * 2;
    const size_t tstep = 2 * hstep;
    const unsigned ldsw = (unsigned)wid * 1024u;
    const int aoff = lds_byte(wr * 64 + fr, fq * 8), boff = lds_byte(wc * 32 + fr, fq * 8);
#define PG8_SA(b, h) (((b) * 2 + (h)) * HTB)
#define PG8_SB(b, h) ((4 + (b) * 2 + (h)) * HTB)
#define PG8_STAGE(bufoff, gbase, voff) do { _Pragma("unroll") for (int _i = 0; _i < 2; ++_i) \
        __builtin_amdgcn_global_load_lds((const unsigned*)((const char*)(gbase) + (voff)[_i]), (PG8_LAS unsigned*)(lds + (bufoff) + ldsw + _i * 8192), 16, 0, 0); } while (0)
#define PG8_LDA(dst, b, h) do { _Pragma("unroll") for (int m = 0; m < 4; ++m) _Pragma("unroll") for (int k = 0; k < 2; ++k) dst[m][k] = *(const PG8_LAS bf16x8*)(lds + PG8_SA(b, h) + aoff + m * 2048 + k * 1024); } while (0)
#define PG8_LDB(dst, b, h) do { _Pragma("unroll") for (int n = 0; n < 2; ++n) _Pragma("unroll") for (int k = 0; k < 2; ++k) dst[n][k] = *(const PG8_LAS bf16x8*)(lds + PG8_SB(b, h) + boff + n * 2048 + k * 1024); } while (0)
#define PG8_MMA(ai, bj, At, Bt) do { __builtin_amdgcn_s_setprio(1); _Pragma("unroll") for (int m = 0; m < 4; ++m) _Pragma("unroll") for (int n = 0; n < 2; ++n) _Pragma("unroll") for (int k = 0; k < 2; ++k) \
        acc[ai][bj][m][n] = __builtin_amdgcn_mfma_f32_16x16x32_bf16(Bt[n][k], At[m][k], acc[ai][bj][m][n], 0, 0, 0); __builtin_amdgcn_s_setprio(0); } while (0)
#define PG8_WAIT_V(n) asm volatile("s_waitcnt vmcnt(" #n ")" ::: "memory")
#define PG8_WAIT_L(n) asm volatile("s_waitcnt lgkmcnt(" #n ")" ::: "memory")
#define PG8_BAR __builtin_amdgcn_s_barrier()
#define PG8_SCHED __builtin_amdgcn_sched_barrier(0)
    Unit cur, nxt; int ui = 0;
    if (!S.next(0, cur)) return;
    f32x4 acc[2][2][4][2];
#pragma unroll
    for (int a = 0; a < 2; ++a)
#pragma unroll
        for (int b = 0; b < 2; ++b)
#pragma unroll
            for (int m = 0; m < 4; ++m)
#pragma unroll
                for (int n = 0; n < 2; ++n) acc[a][b][m][n] = (f32x4){0.f, 0.f, 0.f, 0.f};
    bf16x8 At[4][2], B0[2][2], B1[2][2];
    const char* cA = (const char*)g.A + (size_t)cur.pm * tstep; const char* cB = (const char*)g.Bt + (size_t)cur.pn * tstep;
    S.a_ready(cur);
    if constexpr (SP2) {
        PG8_STAGE(PG8_SB(0, 0), cB, voffB); PG8_STAGE(PG8_SB(0, 1), cB + hstep, voffB); PG8_STAGE(PG8_SA(0, 0), cA, voffA); PG8_STAGE(PG8_SA(0, 1), cA + hstep, voffA);
        if (wr == 1) PG8_BAR;
        PG8_WAIT_V(2); PG8_BAR;
        PG8_STAGE(PG8_SB(1, 0), cB + kstep, voffB); PG8_STAGE(PG8_SA(1, 0), cA + kstep, voffA); PG8_STAGE(PG8_SB(1, 1), cB + hstep + kstep, voffB);
        PG8_WAIT_V(6); PG8_BAR;
    } else {
        PG8_STAGE(PG8_SB(0, 0), cB, voffB); PG8_STAGE(PG8_SA(0, 0), cA, voffA); PG8_STAGE(PG8_SB(0, 1), cB + hstep, voffB); PG8_STAGE(PG8_SA(0, 1), cA + hstep, voffA);
        if (wr == 1) PG8_BAR;
        PG8_WAIT_V(4); PG8_BAR;
        PG8_STAGE(PG8_SB(1, 0), cB + kstep, voffB); PG8_STAGE(PG8_SA(1, 0), cA + kstep, voffA); PG8_STAGE(PG8_SB(1, 1), cB + hstep + kstep, voffB);
        PG8_WAIT_V(6); PG8_BAR;
    }
    for (;;) {
        const bool has_next = S.next(ui + 1, nxt);
        const char* nA = has_next ? (const char*)g.A + (size_t)nxt.pm * tstep : cA; const char* nB = has_next ? (const char*)g.Bt + (size_t)nxt.pn * tstep : cB;
        for (int t = 0; t < nt; t += 2) {
            const bool last = (t == nt - 2);
            const char* a1 = cA + (size_t)(t + 1) * kstep;
            const char* a2 = last ? nA : cA + (size_t)(t + 2) * kstep; const char* b2 = last ? nB : cB + (size_t)(t + 2) * kstep;
            const char* a3 = a2 + kstep; const char* b3 = b2 + kstep;
            if (last && has_next) S.a_ready(nxt);
            if constexpr (SP2) {
            PG8_LDB(B0, 0, 0); PG8_LDB(B1, 0, 1); PG8_SCHED; PG8_LDA(At, 0, 0); PG8_STAGE(PG8_SA(1, 1), a1 + hstep, voffA);
            PG8_WAIT_V(8); PG8_WAIT_L(0); PG8_BAR; PG8_MMA(0, 0, At, B0); PG8_MMA(0, 1, At, B1); PG8_BAR; PG8_SCHED;
            PG8_LDA(At, 0, 1); PG8_STAGE(PG8_SB(0, 0), b2, voffB); PG8_STAGE(PG8_SB(0, 1), b2 + hstep, voffB); PG8_STAGE(PG8_SA(0, 0), a2, voffA);
            PG8_WAIT_V(8); PG8_WAIT_L(0); PG8_BAR; PG8_MMA(1, 0, At, B0); PG8_MMA(1, 1, At, B1); PG8_BAR; PG8_SCHED;
            PG8_LDB(B0, 1, 0); PG8_LDB(B1, 1, 1); PG8_SCHED; PG8_LDA(At, 1, 0); PG8_STAGE(PG8_SA(0, 1), a2 + hstep, voffA);
            PG8_WAIT_V(8); PG8_WAIT_L(0); PG8_BAR; PG8_MMA(0, 0, At, B0); PG8_MMA(0, 1, At, B1); PG8_BAR; PG8_SCHED;
            PG8_LDA(At, 1, 1); PG8_STAGE(PG8_SB(1, 0), b3, voffB); PG8_STAGE(PG8_SB(1, 1), b3 + hstep, voffB); PG8_STAGE(PG8_SA(1, 0), a3, voffA);
            PG8_WAIT_V(8); PG8_WAIT_L(0); PG8_BAR; PG8_MMA(1, 0, At, B0); PG8_MMA(1, 1, At, B1); PG8_BAR; PG8_SCHED;
            } else {
            PG8_LDB(B0, 0, 0); PG8_SCHED; PG8_LDA(At, 0, 0); PG8_STAGE(PG8_SA(1, 1), a1 + hstep, voffA);
            PG8_WAIT_L(8); PG8_BAR; PG8_WAIT_L(0); PG8_MMA(0, 0, At, B0); PG8_BAR; PG8_SCHED;
            PG8_LDB(B1, 0, 1); PG8_STAGE(PG8_SB(0, 0), b2, voffB);
            PG8_BAR; PG8_WAIT_L(0); PG8_MMA(0, 1, At, B1); PG8_BAR;
            PG8_LDA(At, 0, 1); PG8_STAGE(PG8_SA(0, 0), a2, voffA);
            PG8_BAR; PG8_WAIT_L(0); PG8_MMA(1, 0, At, B0); PG8_BAR; PG8_SCHED;
            PG8_STAGE(PG8_SB(0, 1), b2 + hstep, voffB);
            PG8_WAIT_V(6); PG8_BAR; PG8_MMA(1, 1, At, B1); PG8_BAR;
            PG8_LDB(B0, 1, 0); PG8_SCHED; PG8_LDA(At, 1, 0); PG8_STAGE(PG8_SA(0, 1), a2 + hstep, voffA);
            PG8_WAIT_L(8); PG8_BAR; PG8_WAIT_L(0); PG8_MMA(0, 0, At, B0); PG8_BAR; PG8_SCHED;
            PG8_LDB(B1, 1, 1); PG8_STAGE(PG8_SB(1, 0), b3, voffB);
            PG8_BAR; PG8_WAIT_L(0); PG8_MMA(0, 1, At, B1); PG8_BAR;
            PG8_LDA(At, 1, 1); PG8_STAGE(PG8_SA(1, 0), a3, voffA);
            PG8_BAR; PG8_WAIT_L(0); PG8_MMA(1, 0, At, B0); PG8_BAR; PG8_SCHED;
            PG8_STAGE(PG8_SB(1, 1), b3 + hstep, voffB);
            PG8_WAIT_V(6); PG8_BAR; PG8_MMA(1, 1, At, B1); PG8_BAR;
            }
        }
        if constexpr (ALIGN_EPI) { if (wr == 0) PG8_BAR; }
        if constexpr (!Epi::AFTER_DRAIN) { E(acc, cur, wr, wc, fr, fq); S.done(cur); }
        if (!has_next) break;
#pragma unroll
        for (int a = 0; a < 2; ++a)
#pragma unroll
            for (int b = 0; b < 2; ++b)
#pragma unroll
                for (int m = 0; m < 4; ++m)
#pragma unroll
                    for (int n = 0; n < 2; ++n) acc[a][b][m][n] = (f32x4){0.f, 0.f, 0.f, 0.f};
        cur = nxt; cA = nA; cB = nB; ++ui;
        if constexpr (ALIGN_EPI) { if (wr == 1) PG8_BAR; }
    }
    PG8_WAIT_V(0);
    if constexpr (!ALIGN_EPI) { if (wr == 0) PG8_BAR; }
    PG8_BAR;
    if constexpr (Epi::AFTER_DRAIN) { E.fused(acc, cur, wr, wc, fr, fq, lds, wid, lane); S.done(cur); }
#undef PG8_SA
#undef PG8_SB
#undef PG8_STAGE
#undef PG8_LDA
#undef PG8_LDB
#undef PG8_MMA
#undef PG8_WAIT_V
#undef PG8_WAIT_L
#undef PG8_BAR
#undef PG8_SCHED
}
}


#ifndef PHMASK
#define PHMASK 63
#endif
#ifndef PROBE
#define PROBE 0
#endif
using pg8::bf16_t; using pg8::bf16x8; using pg8::f32x4; using pg8::u32x4;
typedef unsigned u32x2 __attribute__((ext_vector_type(2)));
typedef short s16x4 __attribute__((ext_vector_type(4)));
typedef float f32x2 __attribute__((ext_vector_type(2)));
#define LAS __attribute__((address_space(3)))
#define DI __device__ __forceinline__

#define XB_TMO      128
#define XB_XCNT(j)  (256  + 64 * (j))
#define XB_XSUB(j)  (1280 + 64 * (j))
#define XB_XGEN(j)  (2304 + 64 * (j))
#define XB_TOP      3328
#define XB_TOPGEN   3392
#define XCD_BAR_WORDS 3456
#define XB_SPIN_CAP (1u << 18)

__device__ __forceinline__ unsigned xb_ld(unsigned* p)              { return __hip_atomic_load(p, __ATOMIC_RELAXED, __HIP_MEMORY_SCOPE_AGENT); }
__device__ __forceinline__ unsigned xb_add(unsigned* p, unsigned v) { return __hip_atomic_fetch_add(p, v, __ATOMIC_RELAXED, __HIP_MEMORY_SCOPE_AGENT); }
__device__ __forceinline__ unsigned xb_xcc_id() { return (unsigned)__builtin_amdgcn_s_getreg((3 << 11) | 20) & 0xFu; }
#define XB_SPIN(cond, bar) do { unsigned _sp = 0; while (cond) { __builtin_amdgcn_s_sleep(1); \
    if ((++_sp & 255u) == 0u) { if (xb_ld(&(bar)[XB_TMO])) break; if (_sp > XB_SPIN_CAP) { atomicAdd(&(bar)[XB_TMO], 1u); break; } } } } while (0)

struct XcdBarrier {
    unsigned* bar; unsigned x;
    volatile LAS unsigned* st;
};

__device__ __forceinline__ XcdBarrier xcd_barrier_post(unsigned* bar, volatile LAS unsigned* st) {
    XcdBarrier b; b.bar = bar; b.x = xb_xcc_id(); b.st = st;
    if (threadIdx.x == 0) (void)xb_add(&bar[XB_XCNT(b.x)], 1u);
    return b;
}
__device__ __forceinline__ void xcd_barrier_complete(unsigned* bar, unsigned x, unsigned& nloc, unsigned& nx) {
    const unsigned G = gridDim.x * gridDim.y * gridDim.z;
    unsigned sum, cnt, mine, sp = 0u;
    for (;;) {
        sum = 0u; cnt = 0u; mine = 0u;
#pragma unroll
        for (unsigned j = 0; j < 16; ++j) { const unsigned c = xb_ld(&bar[XB_XCNT(j)]); sum += c; cnt += (c > 0u) ? 1u : 0u; mine = (j == x) ? c : mine; }
        if (sum == G) break;
        __builtin_amdgcn_s_sleep(1);
        if ((++sp & 255u) == 0u) { if (xb_ld(&bar[XB_TMO])) break; if (sp > XB_SPIN_CAP) { atomicAdd(&bar[XB_TMO], 1u); break; } }
    }
    nloc = mine > 0u ? mine : 1u; nx = cnt > 0u ? cnt : 1u;
}

__device__ __forceinline__ void xcd_barrier(const XcdBarrier& b) {
    asm volatile("s_waitcnt vmcnt(0)" ::: "memory");
    __syncthreads();
    if (threadIdx.x == 0) {
        unsigned* bar = b.bar;
        __builtin_amdgcn_s_waitcnt(0);
        unsigned nloc = b.st[0], nx = b.st[1];
        if (nloc == 0u) { xcd_barrier_complete(bar, b.x, nloc, nx); b.st[0] = nloc; b.st[1] = nx; }
        const unsigned old = xb_add(&bar[XB_XSUB(b.x)], 1u);
        const unsigned gen = old / nloc;
        if (old + 1u == (gen + 1u) * nloc) {
            __builtin_amdgcn_fence(__ATOMIC_RELEASE, "agent");
            asm volatile("s_waitcnt vmcnt(0)" ::: "memory");
            const unsigned og = xb_add(&bar[XB_TOP], 1u);
            const unsigned tg = og / nx;
            if (og + 1u == (tg + 1u) * nx) xb_add(&bar[XB_TOPGEN], 1u);
            else XB_SPIN(xb_ld(&bar[XB_TOPGEN]) == tg, bar);
            __builtin_amdgcn_fence(__ATOMIC_ACQUIRE, "agent");
            xb_add(&bar[XB_XGEN(b.x)], 1u);
            asm volatile("s_waitcnt vmcnt(0)" ::: "memory");
        } else {
            XB_SPIN(xb_ld(&bar[XB_XGEN(b.x)]) == gen, bar);
            __builtin_amdgcn_fence(__ATOMIC_ACQUIRE, "agent");
            asm volatile("s_waitcnt vmcnt(0)" ::: "memory");
        }
    }
    __syncthreads();
}


#define XB_LSUB(j)  (3456 + 64 * (j))
#define XB_LGEN(j)  (4480 + 64 * (j))
#define XB_CLS(j)   (5504 + 64 * (j))
#define XB_TSUB(k)  (6528 + 64 * (k))
#define XB_TGEN(k)  (10624 + 64 * (k))
#define XB_WORDS_ALL 14720
__device__ __forceinline__ void team_barrier(const XcdBarrier& b, bool acquire) {
    asm volatile("s_waitcnt vmcnt(0)" ::: "memory");
    __syncthreads();
    if (threadIdx.x == 0) {
        unsigned* bar = b.bar;
        __builtin_amdgcn_s_waitcnt(0);
        const unsigned team = (blockIdx.x & 7u) * 8u + ((blockIdx.x >> 3) & 7u);
        const unsigned old = xb_add(&bar[XB_TSUB(team)], 1u);
        const unsigned gen = old >> 2;
        if ((old & 3u) == 3u) xb_add(&bar[XB_TGEN(team)], 1u);
        else XB_SPIN(xb_ld(&bar[XB_TGEN(team)]) == gen, bar);
        if (acquire) {
            __builtin_amdgcn_fence(__ATOMIC_ACQUIRE, "agent");
            asm volatile("s_waitcnt vmcnt(0)" ::: "memory"); }
    }
    __syncthreads();
}

constexpr int D = 1024, DFF = 2816, GROWS = 32768, NTHR = 512;
constexpr int PRP = 2816;
constexpr int LDS_BYTES = 147456;
constexpr size_t MiB = 1u << 20, KiB = 1u << 10;
constexpr size_t WS_MODP = 0;
constexpr size_t WS_MOD = 6 * MiB;
constexpr size_t WS_BAR = 7 * MiB + 512 * KiB;
constexpr size_t WS_WSP = 8 * MiB;
constexpr size_t WS_WPT = WS_WSP + 256 * KiB;
constexpr size_t WS_WF = WS_WPT + 256 * KiB;
constexpr size_t WS_FC1 = WS_WF + 256 * KiB;
constexpr size_t WS_FS1 = WS_FC1 + 256 * KiB;
constexpr size_t WS_FC16 = WS_FS1 + 256 * KiB;
constexpr size_t WS_FS16 = WS_FC16 + 256 * KiB;
constexpr size_t WS_FC2 = WS_FS16 + 256 * KiB;
constexpr size_t WS_FS2 = WS_FC2 + 256 * KiB;
constexpr size_t WS_TW128 = WS_FS2 + 256 * KiB;
constexpr size_t WS_TW16 = WS_TW128 + 256 * KiB;
constexpr size_t WS_WUP = 16 * MiB;
constexpr size_t WS_WDN = 60 * MiB;
constexpr size_t WS_EVIN = 82 * MiB, WS_ODIN = 85 * MiB, WS_EVOUT = 89 * MiB, WS_ODOUT = 91 * MiB;
constexpr size_t WS_H = 96 * MiB;
constexpr size_t WS_T = 160 * MiB;
constexpr size_t WS_BIG = 224 * MiB;
constexpr size_t WS_UB = WS_BIG + 96 * MiB;
constexpr size_t WS_XH = 400 * MiB;
constexpr size_t WS_END = 464 * MiB;

typedef __bf16 nbf16x2 __attribute__((ext_vector_type(2)));
DI unsigned f2bf(float f) { return (unsigned)__builtin_bit_cast(unsigned short, (__bf16)f); }
DI unsigned pk2(float lo, float hi) { const f32x2 v = {lo, hi}; return __builtin_bit_cast(unsigned, __builtin_convertvector(v, nbf16x2)); }
DI float bf_lo(unsigned w) { return __uint_as_float(w << 16); }
DI float bf_hi(unsigned w) { return __uint_as_float(w & 0xffff0000u); }
template <int CTRL> DI float dpp_mov(float v) { return __builtin_bit_cast(float, __builtin_amdgcn_update_dpp(0, __builtin_bit_cast(int, v), CTRL, 0xF, 0xF, true)); }
DI float wave_sum(float v) {
    v += dpp_mov<0xB1>(v); v += dpp_mov<0x4E>(v); v += dpp_mov<0x141>(v); v += dpp_mov<0x140>(v);
    const int iv = __builtin_bit_cast(int, v);
    const float a = __builtin_bit_cast(float, __builtin_amdgcn_readlane(iv, 0)), b = __builtin_bit_cast(float, __builtin_amdgcn_readlane(iv, 16)),
                c = __builtin_bit_cast(float, __builtin_amdgcn_readlane(iv, 32)), d = __builtin_bit_cast(float, __builtin_amdgcn_readlane(iv, 48));
    return (a + b) + (c + d);
}
DI float silu_f(float x) { return x * __builtin_amdgcn_rcpf(1.0f + __builtin_amdgcn_exp2f(-1.4426950408889634f * x)); }
DI f32x4 mfma16(bf16x8 a, bf16x8 b, f32x4 c) { return __builtin_amdgcn_mfma_f32_16x16x32_bf16(a, b, c, 0, 0, 0); }
typedef short v4i16_t __attribute__((ext_vector_type(4)));
DI s16x4 tr_read(LAS unsigned char* p) { return __builtin_bit_cast(s16x4, __builtin_amdgcn_ds_read_tr16_b64_v4i16((LAS v4i16_t*)p)); }
DI bf16x8 tr_frag(LAS unsigned char* p, int pitch4) {
    const s16x4 lo = tr_read(p), hi = tr_read(p + pitch4);
    bf16x8 r; r[0] = lo[0]; r[1] = lo[1]; r[2] = lo[2]; r[3] = lo[3]; r[4] = hi[0]; r[5] = hi[1]; r[6] = hi[2]; r[7] = hi[3]; return r;
}

DI void st16_wt(void* p, u32x4 v) { *(u32x4*)p = v; }
struct Params { const float* in[25]; float* out; unsigned char* ws; int ph_lo, ph_hi; };

struct EpiGen {
    static constexpr bool PERM = true, AFTER_DRAIN = false;
    bf16_t* O; int ldc; int mode;
    __device__ __forceinline__ void operator()(const f32x4 (&acc)[2][2][4][2], const pg8::Unit& u, int wr, int wc, int fr, int fq) const {
        const int row0 = u.pm * 256 + wr * 64 + fr, cw = wc * 32 + 8 * fq;
        if (mode == 3) {
#pragma unroll
            for (int ai = 0; ai < 2; ++ai)
#pragma unroll
                for (int m = 0; m < 4; ++m) {
                    bf16_t* rowp = O + (size_t)(row0 + ai * 128 + m * 16) * ldc + 128 * u.pn + cw;
                    f32x4 g0 = acc[ai][0][m][0], g1 = acc[ai][0][m][1]; const f32x4 u0 = acc[ai][1][m][0], u1 = acc[ai][1][m][1];
#pragma unroll
                    for (int j = 0; j < 4; ++j) { g0[j] = silu_f(g0[j]); g1[j] = silu_f(g1[j]); }
                    const f32x4 v0 = g0 * u0, v1 = g1 * u1;
                    u32x4 w; w.x = pg8::cvt_pk_bf16(v0[0], v0[1]); w.y = pg8::cvt_pk_bf16(v0[2], v0[3]); w.z = pg8::cvt_pk_bf16(v1[0], v1[1]); w.w = pg8::cvt_pk_bf16(v1[2], v1[3]);
                    st16_wt(rowp, w);
                }
        } else if (mode == 2 && u.pn < 4) {
#pragma unroll
            for (int ai = 0; ai < 2; ++ai)
#pragma unroll
                for (int m = 0; m < 4; ++m) {
                    bf16_t* rowp = O + (size_t)(row0 + ai * 128 + m * 16) * ldc + 128 * u.pn + cw;
                    const f32x4 v0 = acc[ai][0][m][0] * acc[ai][1][m][0], v1 = acc[ai][0][m][1] * acc[ai][1][m][1];
                    u32x4 w; w.x = pg8::cvt_pk_bf16(v0[0], v0[1]); w.y = pg8::cvt_pk_bf16(v0[2], v0[3]); w.z = pg8::cvt_pk_bf16(v1[0], v1[1]); w.w = pg8::cvt_pk_bf16(v1[2], v1[3]);
                    st16_wt(rowp, w);
                }
        } else {
            const int colbase = (mode == 2) ? 512 + 256 * (u.pn - 4) : 256 * u.pn;
            if (mode == 1 && u.pn < 4) {
#pragma unroll
                for (int ai = 0; ai < 2; ++ai)
#pragma unroll
                    for (int m = 0; m < 4; ++m) {
                        bf16_t* rowp = O + (size_t)(row0 + ai * 128 + m * 16) * ldc + colbase + cw;
#pragma unroll
                        for (int bj = 0; bj < 2; ++bj) {
                            f32x4 v0 = acc[ai][bj][m][0], v1 = acc[ai][bj][m][1];
                            const pg8::f32x2 a = pg8::gelu_pk((pg8::f32x2){v0[0], v0[1]}), b = pg8::gelu_pk((pg8::f32x2){v0[2], v0[3]}), c = pg8::gelu_pk((pg8::f32x2){v1[0], v1[1]}), d = pg8::gelu_pk((pg8::f32x2){v1[2], v1[3]});
                            u32x4 w; w.x = pg8::cvt_pk_bf16(a.x, a.y); w.y = pg8::cvt_pk_bf16(b.x, b.y); w.z = pg8::cvt_pk_bf16(c.x, c.y); w.w = pg8::cvt_pk_bf16(d.x, d.y);
                            st16_wt(rowp + bj * 128, w);
                        }
                    }
            } else {
#pragma unroll
                for (int ai = 0; ai < 2; ++ai)
#pragma unroll
                    for (int m = 0; m < 4; ++m) {
                        bf16_t* rowp = O + (size_t)(row0 + ai * 128 + m * 16) * ldc + colbase + cw;
#pragma unroll
                        for (int bj = 0; bj < 2; ++bj) {
                            const f32x4 v0 = acc[ai][bj][m][0], v1 = acc[ai][bj][m][1];
                            u32x4 w; w.x = pg8::cvt_pk_bf16(v0[0], v0[1]); w.y = pg8::cvt_pk_bf16(v0[2], v0[3]); w.z = pg8::cvt_pk_bf16(v1[0], v1[1]); w.w = pg8::cvt_pk_bf16(v1[2], v1[3]);
                            st16_wt(rowp + bj * 128, w);
                        }
                    }
            }
        }
    }
};

DI void run_gemm(LAS unsigned char* lds, const bf16_t* A, const bf16_t* Bt, int M, int N, int K, bf16_t* O, int ldc, int mode, int G) {
#if PHMASK & 4
#ifndef STAG
#define STAG 0
#endif
    if (STAG && mode != 0) {
        const int d = ((int)blockIdx.x >> 3) & 3;
        for (int i = 0; i < d * STAG; ++i) __builtin_amdgcn_s_sleep(64);
    }
    pg8::Gemm g{A, Bt, M, N, K}; pg8::StaticOrder S; S.init(M, N, G, (int)blockIdx.x);
    EpiGen E{O, ldc, mode};
#ifndef G_ALIGN
#define G_ALIGN true
#endif
#ifndef G_SP2
#define G_SP2 true
#endif
    pg8::gemm_phase<EpiGen, pg8::StaticOrder, G_ALIGN, G_SP2>(lds, g, S, E);
#endif
}

DI int dest_row(int n0, int mode) {
    if (mode == 1) { const int half = n0 >= DFF ? 1 : 0, n = n0 - half * DFF; return 256 * (n >> 7) + 128 * half + (n & 127); }
    if (mode == 2) { if (n0 < 512) return 256 * (n0 >> 7) + (n0 & 127); if (n0 < 1024) return 1024 + (n0 - 512); if (n0 < 1536) { const int n = n0 - 1024; return 256 * (n >> 7) + 128 + (n & 127); } return n0; }
    return n0;
}
DI void transpose_item(const float* W, int K, int N, bf16_t* WT, int mode, LAS float* scr, int item, int lane) {
    const int nblk = N / 32, kb = item / nblk, nb = item % nblk, k0 = 64 * kb, n0 = 32 * nb;
#pragma unroll
    for (int i = 0; i < 32; ++i) { const int kk = 2 * i + (lane >> 5); scr[kk * 33 + (lane & 31)] = __builtin_nontemporal_load(W + (size_t)(k0 + kk) * N + n0 + (lane & 31)); }
    asm volatile("s_waitcnt lgkmcnt(0)" ::: "memory");
    const int c = lane & 7, dr = dest_row(n0, mode);
#pragma unroll
    for (int j = 0; j < 4; ++j) { const int n = (lane >> 3) + 8 * j; const LAS float* s = scr + (8 * c) * 33 + n;
        u32x4 o; o.x = pk2(s[0 * 33], s[1 * 33]); o.y = pk2(s[2 * 33], s[3 * 33]); o.z = pk2(s[4 * 33], s[5 * 33]); o.w = pk2(s[6 * 33], s[7 * 33]);
        *(u32x4*)(WT + (size_t)(dr + n) * K + k0 + 8 * c) = o; }
    asm volatile("s_waitcnt lgkmcnt(0)" ::: "memory");
}

DI void setup_phase(const Params& p, LAS unsigned char* lds, int G, int tid, int wid, int lane) {
    unsigned char* ws = p.ws;
    {
        LAS float* sc = (LAS float*)lds;
        LAS float* red = sc + 18 * 1024;
        for (int i = tid; i < 18 * 1024; i += NTHR) { const int b = i >> 10, k = i & 1023;
            const float c = (b < 2) ? p.in[2][b * 1024 + k] : p.in[3][(b - 2) * 1024 + k]; sc[i] = silu_f(c); }
        __syncthreads();
        for (int u = blockIdx.x; u < 288; u += G) {
            const int l = u / 144, cb = u % 144, col = cb * 64 + lane;
            float acc[18];
#pragma unroll
            for (int b = 0; b < 18; ++b) acc[b] = 0.f;
            const float* wp = p.in[4] + ((size_t)l * 1024 + wid * 128) * 9216 + col;
            const LAS f32x4* sc4 = (const LAS f32x4*)sc + wid * 32;
#pragma unroll 4
            for (int k4 = 0; k4 < 32; ++k4) {
                const float w0 = __builtin_nontemporal_load(wp + (size_t)(4 * k4) * 9216), w1 = __builtin_nontemporal_load(wp + (size_t)(4 * k4 + 1) * 9216), w2 = __builtin_nontemporal_load(wp + (size_t)(4 * k4 + 2) * 9216), w3 = __builtin_nontemporal_load(wp + (size_t)(4 * k4 + 3) * 9216);
#pragma unroll
                for (int b = 0; b < 18; ++b) { const f32x4 sv = sc4[b * 256 + k4]; acc[b] += (sv[0] * w0 + sv[1] * w1) + (sv[2] * w2 + sv[3] * w3); }
            }
#pragma unroll
            for (int b = 0; b < 18; ++b) red[(wid * 18 + b) * 64 + lane] = acc[b];
            __syncthreads();
            for (int i = tid; i < 18 * 64; i += NTHR) { const int b = i >> 6, c = i & 63; float sm = p.in[5][l * 9216 + cb * 64 + c];
#pragma unroll
                for (int w = 0; w < 8; ++w) sm += red[(w * 18 + b) * 64 + c];
                ((float*)(ws + WS_MOD))[((size_t)l * 18 + b) * 9216 + cb * 64 + c] = sm; }
            __syncthreads();
        }
    }
    {
        LAS float* scr = (LAS float*)(lds + wid * 16384);
        const int nskip = (G > 64 && 288 - G > 0 && 288 - G < G / 2) ? 288 - G : 0;
        const int gw = ((int)blockIdx.x - nskip) * 8 + wid, NGW = (G - nskip) * 8;
        constexpr int I_UP = 16 * 176, I_DN = 44 * 32, I_EI = 16 * 48, I_OI = 16 * 64, I_O = 16 * 32;
        constexpr int NITEMS = 4 * I_UP + 4 * I_DN + I_EI + I_OI + 2 * I_O;
        for (int it = gw; it < NITEMS && gw >= 0; it += NGW) {
            int r = it;
            if (r < 4 * I_UP) { const int i = r / I_UP; r -= i * I_UP; const int l = i >> 1, f = i & 1;
                transpose_item(p.in[f ? 10 : 8] + (size_t)l * 1024 * 5632, 1024, 5632, (bf16_t*)(ws + WS_WUP) + (size_t)i * 5632 * 1024, 1, scr, r, lane); continue; }
            r -= 4 * I_UP;
            if (r < 4 * I_DN) { const int i = r / I_DN; r -= i * I_DN; const int l = i >> 1, f = i & 1;
                transpose_item(p.in[f ? 11 : 9] + (size_t)l * 2816 * 1024, 2816, 1024, (bf16_t*)(ws + WS_WDN) + (size_t)i * 1024 * 2816, 0, scr, r, lane); continue; }
            r -= 4 * I_DN;
            if (r < I_EI) { transpose_item(p.in[12], 1024, 1536, (bf16_t*)(ws + WS_EVIN), 0, scr, r, lane); continue; }
            r -= I_EI;
            if (r < I_OI) { transpose_item(p.in[20], 1024, 2048, (bf16_t*)(ws + WS_ODIN), 2, scr, r, lane); continue; }
            r -= I_OI;
            if (r < I_O) { transpose_item(p.in[19], 1024, 1024, (bf16_t*)(ws + WS_EVOUT), 0, scr, r, lane); continue; }
            r -= I_O;
            transpose_item(p.in[24], 1024, 1024, (bf16_t*)(ws + WS_ODOUT), 0, scr, r, lane);
        }
    }
    {
        const int gt = blockIdx.x * NTHR + tid, NT = G * NTHR;
        bf16_t* WSP = (bf16_t*)(ws + WS_WSP); bf16_t* WPT = (bf16_t*)(ws + WS_WPT); bf16_t* WF = (bf16_t*)(ws + WS_WF);
        for (int i = gt; i < 65536; i += NT) {
            WSP[i] = (bf16_t)f2bf(p.in[15][i]);
            const int g = i >> 14, e = (i >> 7) & 127, d = i & 127;
            WPT[i] = (bf16_t)f2bf(p.in[17][(g * 128 + d) * 128 + e]);
        }
        {
            LAS float* tab = (LAS float*)(lds + 132 * 1024);
            if (tid < 128) { const float x = (float)tid * (1.0f / 64.0f); tab[tid] = cospif(x); tab[128 + tid] = sinpif(x); }
            __syncthreads();
            for (int i = gt; i < 131072; i += NT) {
                const int g = i >> 15, n = (i >> 7) & 255, d = i & 127, comp = n >> 7, e = n & 127;
                const float* fw = p.in[23] + (size_t)g * 16384 + e; const LAS float* tb = tab + comp * 128; float sm = 0.f;
#pragma unroll 8
                for (int m = 0; m < 128; ++m) sm += tb[(m * d) & 127] * fw[m * 128];
                WF[i] = (bf16_t)f2bf(sm * p.in[22][g * 128 + d]);
            }
        }
        bf16_t* FC1 = (bf16_t*)(ws + WS_FC1); bf16_t* FS1 = (bf16_t*)(ws + WS_FS1); bf16_t* FC2 = (bf16_t*)(ws + WS_FC2); bf16_t* FS2 = (bf16_t*)(ws + WS_FS2);
        f32x2* TW128 = (f32x2*)(ws + WS_TW128);
        for (int i = gt; i < 16384; i += NT) {
            const int k1 = i >> 7, col = i & 127, s = col >> 5, j = col & 31, fqq = j >> 3, ii = j & 7;
            const int r = 32 * s + (ii < 4 ? fqq * 4 + ii : 16 + fqq * 4 + ii - 4);
            const float x = (float)((k1 * r) & 127) * (1.0f / 64.0f);
            FC1[i] = (bf16_t)f2bf(cospif(x)); FS1[i] = (bf16_t)f2bf(sinpif(x));
            const float y = (float)((k1 * col) & 127) * (1.0f / 64.0f);
            FC2[i] = (bf16_t)f2bf(cospif(y)); FS2[i] = (bf16_t)f2bf(sinpif(y));
            const float z = (float)(k1 * col) * (1.0f / 8192.0f);
            TW128[i] = (f32x2){cospif(z), sinpif(z)};
        }
        bf16_t* FC16 = (bf16_t*)(ws + WS_FC16); bf16_t* FS16 = (bf16_t*)(ws + WS_FS16);
        for (int i = gt; i < 512; i += NT) {
            const int k1 = i >> 5, j = i & 31, fqq = j >> 3, ii = j & 7;
            float c = 0.f, s = 0.f;
            if (ii < 4) { const int r = fqq * 4 + ii; const float x = (float)((k1 * r) & 15) * (1.0f / 8.0f); c = cospif(x); s = sinpif(x); }
            FC16[i] = (bf16_t)f2bf(c); FS16[i] = (bf16_t)f2bf(s);
        }
        f32x2* TW16 = (f32x2*)(ws + WS_TW16);
        for (int i = gt; i < 2048; i += NT) { const int q = i >> 4, k1 = i & 15; const float z = (float)(k1 * q) * (1.0f / 1024.0f); TW16[i] = (f32x2){cospif(z), sinpif(z)}; }
    }
}

DI void modreduce_phase(const Params& p, int G, int tid) {
    const float* mp = (const float*)(p.ws + WS_MODP); float* mod = (float*)(p.ws + WS_MOD);
    for (int i = blockIdx.x * NTHR + tid; i < 2 * 18 * 9216; i += G * NTHR) {
        const int l = i / (18 * 9216), j = i % 9216;
        float s = p.in[5][l * 9216 + j];
#pragma unroll
        for (int ks = 0; ks < 4; ++ks) s += mp[(size_t)ks * (2 * 18 * 9216) + i];
        mod[i] = s;
    }
}

typedef _Float16 h16x4 __attribute__((ext_vector_type(4)));
typedef _Float16 h16x8 __attribute__((ext_vector_type(8)));
template <bool IN32, bool PREV, bool NEXT, bool OUT32>
DI void norm_phase_t(const float* xin32, const _Float16* xin16, float* xout32, _Float16* xout16, const bf16_t* T, bf16_t* H,
                     const float* gate_base, const float* gpost, float rw, const float* ss_base, const float* gpre, int gi, int G, int wid, int lane) {
    const bool teamed = (G == 256);
    const int bx = (int)blockIdx.x & 7, bj = (int)blockIdx.x >> 3;
    const int nh = teamed ? 2 : (GROWS + G * 8 - 1) / (G * 8), rows_h = teamed ? 8 : 1;
    for (int hh = 0; hh < nh; ++hh) {
        const int r0 = teamed ? 256 * (16 * bx + 8 * hh + (bj & 7)) + 64 * (bj >> 3) + wid : (int)blockIdx.x * 8 + wid + hh * G * 8;
        if (r0 >= GROWS) break;
        const int bidx = (gi == 0) ? (r0 >> 14) : 2 + (r0 >> 11);
        f32x4 gpv[4], gtv[4], shv[4], scv[4], gnv[4];
        if (PREV) { const f32x4* gp = (const f32x4*)gpost + 2 * lane; const f32x4* gt = (const f32x4*)(gate_base + (size_t)bidx * 9216) + 2 * lane;
#pragma unroll
            for (int j = 0; j < 4; ++j) { const int o = 128 * (j >> 1) + (j & 1); gpv[j] = gp[o] * rw; gtv[j] = gt[o] + 1.0f; gpv[j] = gpv[j] * gtv[j]; } }
        if (NEXT) { const f32x4* gp = (const f32x4*)gpre + 2 * lane; const f32x4* sh = (const f32x4*)(ss_base + (size_t)bidx * 9216) + 2 * lane; const f32x4* sc = sh + 256;
#pragma unroll
            for (int j = 0; j < 4; ++j) { const int o = 128 * (j >> 1) + (j & 1); gnv[j] = gp[o] * (sc[o] + 1.0f); shv[j] = sh[o]; } }
#pragma unroll 2
        for (int i = 0; i < rows_h; ++i) {
            const int r = r0 + 8 * i;
            f32x4 v[4]; u32x4 tw[2];
            if (IN32) { const f32x4* xr = (const f32x4*)(xin32 + (size_t)r * D) + 2 * lane;
#pragma unroll
                for (int j = 0; j < 2; ++j) { v[2 * j] = xr[128 * j]; v[2 * j + 1] = xr[128 * j + 1]; } }
            else { const h16x8* xr = (const h16x8*)(xin16 + (size_t)r * D) + lane; h16x8 hv[2];
#pragma unroll
                for (int j = 0; j < 2; ++j) hv[j] = __builtin_nontemporal_load(xr + 64 * j);
                if (PREV) { const u32x4* tr = (const u32x4*)(T + (size_t)r * D) + lane;
#pragma unroll
                    for (int j = 0; j < 2; ++j) tw[j] = __builtin_nontemporal_load(tr + 64 * j); }
#pragma unroll
                for (int j = 0; j < 2; ++j) { v[2 * j] = (f32x4){(float)hv[j][0], (float)hv[j][1], (float)hv[j][2], (float)hv[j][3]}; v[2 * j + 1] = (f32x4){(float)hv[j][4], (float)hv[j][5], (float)hv[j][6], (float)hv[j][7]}; } }
            if (PREV) {
                if (IN32) { const u32x4* tr = (const u32x4*)(T + (size_t)r * D) + lane;
#pragma unroll
                    for (int j = 0; j < 2; ++j) tw[j] = __builtin_nontemporal_load(tr + 64 * j); }
                f32x4 tv[4]; float ss = 0.f;
#pragma unroll
                for (int j = 0; j < 2; ++j) { const u32x4 w = tw[j];
                    tv[2 * j] = (f32x4){bf_lo(w.x), bf_hi(w.x), bf_lo(w.y), bf_hi(w.y)}; tv[2 * j + 1] = (f32x4){bf_lo(w.z), bf_hi(w.z), bf_lo(w.w), bf_hi(w.w)}; }
#pragma unroll
                for (int j = 0; j < 4; ++j) ss += (tv[j][0] * tv[j][0] + tv[j][1] * tv[j][1]) + (tv[j][2] * tv[j][2] + tv[j][3] * tv[j][3]);
                const float rstd = rsqrtf(wave_sum(ss) * (1.0f / D) + 1e-6f);
#pragma unroll
                for (int j = 0; j < 4; ++j) v[j] = v[j] + (tv[j] * rstd) * gpv[j];
                if (OUT32) { f32x4* xo = (f32x4*)(xout32 + (size_t)r * D) + 2 * lane;
#pragma unroll
                    for (int j = 0; j < 4; ++j) __builtin_nontemporal_store(v[j], xo + 128 * (j >> 1) + (j & 1)); }
                else { h16x8* xo = (h16x8*)(xout16 + (size_t)r * D) + lane;
#pragma unroll
                    for (int j = 0; j < 2; ++j) { h16x8 hv;
#pragma unroll
                        for (int k = 0; k < 4; ++k) { hv[k] = (_Float16)v[2 * j][k]; hv[4 + k] = (_Float16)v[2 * j + 1][k]; }
                        __builtin_nontemporal_store(hv, xo + 64 * j);
#pragma unroll
                        for (int k = 0; k < 4; ++k) { v[2 * j][k] = (float)hv[k]; v[2 * j + 1][k] = (float)hv[4 + k]; } } }
            }
            if (NEXT) {
                float ss = 0.f;
#pragma unroll
                for (int j = 0; j < 4; ++j) ss += (v[j][0] * v[j][0] + v[j][1] * v[j][1]) + (v[j][2] * v[j][2] + v[j][3] * v[j][3]);
                const float rstd = rsqrtf(wave_sum(ss) * (1.0f / D) + 1e-6f);
                u32x4* ho = (u32x4*)(H + (size_t)r * D) + lane;
#pragma unroll
                for (int j = 0; j < 2; ++j) { const f32x4 h0 = (v[2 * j] * rstd) * gnv[2 * j] + shv[2 * j], h1 = (v[2 * j + 1] * rstd) * gnv[2 * j + 1] + shv[2 * j + 1];
                    u32x4 w; w.x = pk2(h0[0], h0[1]); w.y = pk2(h0[2], h0[3]); w.z = pk2(h1[0], h1[1]); w.w = pk2(h1[2], h1[3]); st16_wt(ho + 64 * j, w); }
            }
        }
    }
}
DI void norm_phase(const float* xin32, const _Float16* xin16, float* xout32, _Float16* xout16, const bf16_t* T, bf16_t* H, bool has_prev, bool has_next,
                   const float* gate_base, const float* gpost, float rw, const float* ss_base, const float* gpre, int gi, int G, int wid, int lane) {
    if (!has_prev)        norm_phase_t<true, false, true, false>(xin32, xin16, xout32, xout16, T, H, gate_base, gpost, rw, ss_base, gpre, gi, G, wid, lane);
    else if (xin32)       norm_phase_t<true, true, true, false>(xin32, xin16, xout32, xout16, T, H, gate_base, gpost, rw, ss_base, gpre, gi, G, wid, lane);
    else if (has_next)    norm_phase_t<false, true, true, false>(xin32, xin16, xout32, xout16, T, H, gate_base, gpost, rw, ss_base, gpre, gi, G, wid, lane);
    else                  norm_phase_t<false, true, false, true>(xin32, xin16, xout32, xout16, T, H, gate_base, gpost, rw, ss_base, gpre, gi, G, wid, lane);
}

template <int GI>
DI void pool_group(const bf16_t* PR, bf16_t* YY, const bf16_t* WPT, const float* pool_scale, size_t tok0, int tl, int pos, int S, int fr, int fq) {
    constexpr int hw = 1 << GI, g = GI;
    const int lo = max(pos - hw, 0), hi = min(pos + hw, S); const float inv = 1.0f / (float)(hi - lo);
    f32x4 acc[8];
#pragma unroll
    for (int e = 0; e < 8; ++e) acc[e] = (f32x4){0.f, 0.f, 0.f, 0.f};
#pragma unroll 1
    for (int ks = 0; ks < 4; ++ks) {
        const bf16_t* zc = PR + (tok0 + tl) * PRP + 1024 + g * 128 + ks * 32 + fq * 8;
        u32x4 w[2 * hw];
#pragma unroll
        for (int j = 0; j < 2 * hw; ++j) { const int t2 = pos + j - hw; const bool ok = (t2 >= 0) && (t2 < S); w[j] = (u32x4){0u, 0u, 0u, 0u}; if (ok) w[j] = *(const u32x4*)(zc + (ptrdiff_t)(j - hw) * PRP); }
        bf16x8 wf[8];
#pragma unroll
        for (int et = 0; et < 8; ++et) wf[et] = *(const bf16x8*)(WPT + ((g * 128 + et * 16 + fr) * 128 + ks * 32 + fq * 8));
        f32x4 s0 = (f32x4){0.f, 0.f, 0.f, 0.f}, s1 = s0;
#pragma unroll
        for (int j = 0; j < 2 * hw; ++j) { s0 += (f32x4){bf_lo(w[j].x), bf_hi(w[j].x), bf_lo(w[j].y), bf_hi(w[j].y)}; s1 += (f32x4){bf_lo(w[j].z), bf_hi(w[j].z), bf_lo(w[j].w), bf_hi(w[j].w)}; }
        const u32x4 cw = w[hw];
        s0 = s0 * inv - (f32x4){bf_lo(cw.x), bf_hi(cw.x), bf_lo(cw.y), bf_hi(cw.y)}; s1 = s1 * inv - (f32x4){bf_lo(cw.z), bf_hi(cw.z), bf_lo(cw.w), bf_hi(cw.w)};
        u32x4 dw; dw.x = pk2(s0[0], s0[1]); dw.y = pk2(s0[2], s0[3]); dw.z = pk2(s1[0], s1[1]); dw.w = pk2(s1[2], s1[3]);
        const bf16x8 df = __builtin_bit_cast(bf16x8, dw);
#pragma unroll
        for (int et = 0; et < 8; ++et) acc[et] = mfma16(wf[et], df, acc[et]);
    }
#pragma unroll
    for (int et = 0; et < 8; ++et) { const int e = g * 128 + et * 16 + fq * 4; const f32x4 ps = *(const f32x4*)(pool_scale + e); const f32x4 y = acc[et] * ps;
        u32x2 o; o.x = pk2(y[0], y[1]); o.y = pk2(y[2], y[3]); *(u32x2*)(YY + (tok0 + tl) * 1024 + 512 + e) = o; }
}

constexpr int PL_ZOFF = 0, PL_WOFF = 144 * 272, PL_PITCH = 272;
struct PoolStage { u32x4 z[5]; u32x4 w[4]; };
DI void pool_stage_load(PoolStage& ps, const bf16_t* PR, const bf16_t* WPT, size_t tok0, int pos0, int S, int g, int tid) {
#pragma unroll
    for (int i = 0; i < 5; ++i) { const int idx = tid + NTHR * i, row = idx >> 4, c = idx & 15; const int p = pos0 - 8 + row;
        ps.z[i] = (u32x4){0u, 0u, 0u, 0u};
        if (idx < 144 * 16 && p >= 0 && p < S) ps.z[i] = *(const u32x4*)(PR + (size_t)((ptrdiff_t)tok0 - 8 + row) * PRP + 1024 + g * 128 + c * 8); }
#pragma unroll
    for (int i = 0; i < 4; ++i) { const int idx = tid + NTHR * i; ps.w[i] = *(const u32x4*)(WPT + (g * 128 + (idx >> 4)) * 128 + (idx & 15) * 8); }
}
DI void pool_stage_store(const PoolStage& ps, LAS unsigned char* lds, int tid) {
#pragma unroll
    for (int i = 0; i < 5; ++i) { const int idx = tid + NTHR * i; if (idx < 144 * 16) *(LAS u32x4*)(lds + PL_ZOFF + (idx >> 4) * PL_PITCH + (idx & 15) * 16) = ps.z[i]; }
#pragma unroll
    for (int i = 0; i < 4; ++i) { const int idx = tid + NTHR * i; *(LAS u32x4*)(lds + PL_WOFF + (idx >> 4) * PL_PITCH + (idx & 15) * 16) = ps.w[i]; }
}
template <int GI>
DI void pool_compute(LAS unsigned char* lds, bf16_t* YY, const float* pool_scale, size_t tok0, int tl, int pos, int S, int fr, int fq) {
    constexpr int hw = 1 << GI, g = GI;
    const int lo = max(pos - hw, 0), hi = min(pos + hw, S); const float inv = 1.0f / (float)(hi - lo);
    f32x4 acc[8];
#pragma unroll
    for (int e = 0; e < 8; ++e) acc[e] = (f32x4){0.f, 0.f, 0.f, 0.f};
#pragma unroll 2
    for (int ks = 0; ks < 4; ++ks) {
        const LAS unsigned char* zb = lds + PL_ZOFF + (tl + 8) * PL_PITCH + (ks * 32 + fq * 8) * 2;
        f32x4 s0 = (f32x4){0.f, 0.f, 0.f, 0.f}, s1 = s0;
#pragma unroll
        for (int j = -hw; j < hw; ++j) { const u32x4 x = *(const LAS u32x4*)(zb + j * PL_PITCH);
            s0 += (f32x4){bf_lo(x.x), bf_hi(x.x), bf_lo(x.y), bf_hi(x.y)}; s1 += (f32x4){bf_lo(x.z), bf_hi(x.z), bf_lo(x.w), bf_hi(x.w)}; }
        const u32x4 cw = *(const LAS u32x4*)zb;
        s0 = s0 * inv - (f32x4){bf_lo(cw.x), bf_hi(cw.x), bf_lo(cw.y), bf_hi(cw.y)}; s1 = s1 * inv - (f32x4){bf_lo(cw.z), bf_hi(cw.z), bf_lo(cw.w), bf_hi(cw.w)};
        u32x4 dw; dw.x = pk2(s0[0], s0[1]); dw.y = pk2(s0[2], s0[3]); dw.z = pk2(s1[0], s1[1]); dw.w = pk2(s1[2], s1[3]);
        const bf16x8 df = __builtin_bit_cast(bf16x8, dw);
#pragma unroll
        for (int et = 0; et < 8; ++et) { const bf16x8 wf = *(const LAS bf16x8*)(lds + PL_WOFF + (et * 16 + fr) * PL_PITCH + (ks * 32 + fq * 8) * 2); acc[et] = mfma16(wf, df, acc[et]); }
    }
#pragma unroll
    for (int et = 0; et < 8; ++et) { const int e = g * 128 + et * 16 + fq * 4; const f32x4 ps = *(const f32x4*)(pool_scale + e); const f32x4 y = acc[et] * ps;
        u32x2 o; o.x = pk2(y[0], y[1]); o.y = pk2(y[2], y[3]); *(u32x2*)(YY + (tok0 + tl) * 1024 + 512 + e) = o; }
}

DI void even_core(LAS unsigned char* lds, const bf16_t* PR, bf16_t* YY, const bf16_t* WSP, const bf16_t* WPT, const float* ln_g, const float* ln_b,
                  const float* b_sp, const float* pool_scale, int S, int G, int tid, int wid, int lane) {
    const int fr = lane & 15, fq = lane >> 4;
    constexpr int PITCH = 1056;
    for (int ch0 = blockIdx.x; ch0 < GROWS / 128; ch0 += G) {
        const int ch = (G == 256) ? 2 * (16 * (ch0 & 7) + 8 * (ch0 >> 7) + ((ch0 >> 3) & 7)) + ((ch0 >> 6) & 1) : ch0;
        const size_t tok0 = (size_t)ch * 128;
        {
            const f32x4 g0 = *(const f32x4*)(ln_g + lane * 8), g1 = *(const f32x4*)(ln_g + lane * 8 + 4), b0 = *(const f32x4*)(ln_b + lane * 8), b1 = *(const f32x4*)(ln_b + lane * 8 + 4);
#pragma unroll 8
            for (int i = 0; i < 16; ++i) {
                const int q = wid * 16 + i;
                const u32x4 w = *(const u32x4*)(PR + (tok0 + q) * PRP + 512 + lane * 8);
                f32x4 a = (f32x4){bf_lo(w.x), bf_hi(w.x), bf_lo(w.y), bf_hi(w.y)}, b = (f32x4){bf_lo(w.z), bf_hi(w.z), bf_lo(w.w), bf_hi(w.w)};
                const float mean = wave_sum((a[0] + a[1]) + (a[2] + a[3]) + (b[0] + b[1]) + (b[2] + b[3])) * (1.0f / 512.0f);
                a = a - mean; b = b - mean;
                const float var = wave_sum((a[0] * a[0] + a[1] * a[1]) + (a[2] * a[2] + a[3] * a[3]) + (b[0] * b[0] + b[1] * b[1]) + (b[2] * b[2] + b[3] * b[3])) * (1.0f / 512.0f);
                const float rstd = rsqrtf(var + 1e-5f);
                a = a * rstd * g0 + b0; b = b * rstd * g1 + b1;
                u32x4 o; o.x = pk2(a[0], a[1]); o.y = pk2(a[2], a[3]); o.z = pk2(b[0], b[1]); o.w = pk2(b[2], b[3]);
                *(LAS u32x4*)(lds + q * PITCH + lane * 16) = o;
            }
        }
        __syncthreads();
        {
            const int h = wid >> 1, cw0 = wid * 64;
            for (int ph = 0; ph < 2; ++ph) {
                f32x4 acc[4][4];
#pragma unroll
                for (int a = 0; a < 4; ++a)
#pragma unroll
                    for (int b = 0; b < 4; ++b) acc[a][b] = (f32x4){0.f, 0.f, 0.f, 0.f};
#pragma unroll 1
                for (int kp = 0; kp < 2; ++kp) {
                    bf16x8 bw[2][4];
#pragma unroll
                    for (int k2 = 0; k2 < 2; ++k2)
#pragma unroll
                        for (int pt = 0; pt < 4; ++pt) bw[k2][pt] = *(const bf16x8*)(WSP + ((h * 128 + (ph * 4 + pt) * 16 + fr) * 128 + (kp * 2 + k2) * 32 + fq * 8));
#pragma unroll
                    for (int k2 = 0; k2 < 2; ++k2) {
                        const int ks = kp * 2 + k2;
                        bf16x8 af[4];
#pragma unroll
                        for (int ct = 0; ct < 4; ++ct) af[ct] = tr_frag(lds + (ks * 32 + fq * 8 + (fr >> 2)) * PITCH + (cw0 + ct * 16 + 4 * (fr & 3)) * 2, 4 * PITCH);
#pragma unroll
                        for (int ct = 0; ct < 4; ++ct)
#pragma unroll
                            for (int pt = 0; pt < 4; ++pt) acc[ct][pt] = mfma16(af[ct], bw[k2][pt], acc[ct][pt]);
                    }
                }
#pragma unroll
                for (int pt = 0; pt < 4; ++pt) {
                    const int pp = (ph * 4 + pt) * 16 + fr; const float bs = b_sp[h * 128 + pp];
#pragma unroll
                    for (int ct = 0; ct < 4; ++ct) {
                        const int c = cw0 + ct * 16 + fq * 4;
                        const u32x2 uw = *(const u32x2*)(PR + (tok0 + pp) * PRP + c);
                        u32x2 o; o.x = pk2(bf_lo(uw.x) * (acc[ct][pt][0] + bs), bf_hi(uw.x) * (acc[ct][pt][1] + bs)); o.y = pk2(bf_lo(uw.y) * (acc[ct][pt][2] + bs), bf_hi(uw.y) * (acc[ct][pt][3] + bs));
                        *(u32x2*)(YY + (tok0 + pp) * 1024 + c) = o;
                    }
                }
            }
        }
        {
            const int tl = wid * 16 + fr; const int pos = (int)(tok0 % (size_t)S) + tl;
            const int pos0 = (int)(tok0 % (size_t)S);
            PoolStage ps;
            pool_stage_load(ps, PR, WPT, tok0, pos0, S, 0, tid);
            __syncthreads();
            pool_stage_store(ps, lds, tid); pool_stage_load(ps, PR, WPT, tok0, pos0, S, 1, tid);
            __syncthreads();
            pool_compute<0>(lds, YY, pool_scale, tok0, tl, pos, S, fr, fq);
            __syncthreads();
            pool_stage_store(ps, lds, tid); pool_stage_load(ps, PR, WPT, tok0, pos0, S, 2, tid);
            __syncthreads();
            pool_compute<1>(lds, YY, pool_scale, tok0, tl, pos, S, fr, fq);
            __syncthreads();
            pool_stage_store(ps, lds, tid); pool_stage_load(ps, PR, WPT, tok0, pos0, S, 3, tid);
            __syncthreads();
            pool_compute<2>(lds, YY, pool_scale, tok0, tl, pos, S, fr, fq);
            __syncthreads();
            pool_stage_store(ps, lds, tid);
            __syncthreads();
            pool_compute<3>(lds, YY, pool_scale, tok0, tl, pos, S, fr, fq);
        }
        __syncthreads();
    }
}

DI void conv_part(const bf16_t* PR, bf16_t* YY, const float* conv_w, int S, int G, int wid, int lane) {
    const int gw = blockIdx.x * 8 + wid, NGW = G * 8;
    f32x4 w[3][2];
#pragma unroll
    for (int k = 0; k < 3; ++k) { w[k][0] = *(const f32x4*)(conv_w + k * 512 + lane * 8); w[k][1] = *(const f32x4*)(conv_w + k * 512 + lane * 8 + 4); }
#pragma unroll 4
    for (int r = gw; r < GROWS; r += NGW) {
        const int pos = r % S;
        const bf16_t* cz = PR + (size_t)r * PRP + lane * 8;
        const float m0 = (pos > 0) ? 1.0f : 0.0f, m2 = (pos < S - 1) ? 1.0f : 0.0f;
        const u32x4 c1 = *(const u32x4*)cz, c0 = *(const u32x4*)(cz - (pos > 0 ? PRP : 0)), c2 = *(const u32x4*)(cz + (pos < S - 1 ? PRP : 0)), bg = *(const u32x4*)(cz + 512);
        const f32x4 w00 = w[0][0] * m0, w01 = w[0][1] * m0, w20 = w[2][0] * m2, w21 = w[2][1] * m2;
        f32x4 a0 = (f32x4){bf_lo(c0.x), bf_hi(c0.x), bf_lo(c0.y), bf_hi(c0.y)} * w00 + (f32x4){bf_lo(c1.x), bf_hi(c1.x), bf_lo(c1.y), bf_hi(c1.y)} * w[1][0] + (f32x4){bf_lo(c2.x), bf_hi(c2.x), bf_lo(c2.y), bf_hi(c2.y)} * w20;
        f32x4 a1 = (f32x4){bf_lo(c0.z), bf_hi(c0.z), bf_lo(c0.w), bf_hi(c0.w)} * w01 + (f32x4){bf_lo(c1.z), bf_hi(c1.z), bf_lo(c1.w), bf_hi(c1.w)} * w[1][1] + (f32x4){bf_lo(c2.z), bf_hi(c2.z), bf_lo(c2.w), bf_hi(c2.w)} * w21;
        a0 = a0 * (f32x4){bf_lo(bg.x), bf_hi(bg.x), bf_lo(bg.y), bf_hi(bg.y)}; a1 = a1 * (f32x4){bf_lo(bg.z), bf_hi(bg.z), bf_lo(bg.w), bf_hi(bg.w)};
        u32x4 o; o.x = pk2(a0[0], a0[1]); o.y = pk2(a0[2], a0[3]); o.z = pk2(a1[0], a1[1]); o.w = pk2(a1[2], a1[3]);
        *(u32x4*)(YY + (size_t)r * 1024 + lane * 8) = o;
    }
}

template <int R, int QB>
DI void four_stage1(const bf16_t* PR, bf16_t* UB, const bf16_t* WF, const bf16_t* FCp, const bf16_t* FSp, const f32x2* TW, int nb, int G, int wid, int lane) {
    constexpr int NT = R / 16, KS = (R + 31) / 32, KW = KS * 32, S = R * 128, NQB = 128 / QB;
    const int fr = lane & 15, fq = lane >> 4, e0 = wid * 16;
    const int nunits = nb * 4 * NQB;
    for (int un = blockIdx.x; un < nunits; un += G) {
        const int q0 = (un % NQB) * QB, g = (un / NQB) & 3, b = un / (4 * NQB);
        bf16x8 wP[4], wQ[4];
#pragma unroll
        for (int ks = 0; ks < 4; ++ks) { wP[ks] = *(const bf16x8*)(WF + ((g * 256 + e0 + fr) * 128 + ks * 32 + fq * 8)); wQ[ks] = *(const bf16x8*)(WF + ((g * 256 + 128 + e0 + fr) * 128 + ks * 32 + fq * 8)); }
        unsigned pP[QB][NT][2], pQ[QB][NT][2];
#pragma unroll
        for (int rt = 0; rt < NT; ++rt) {
#pragma unroll
            for (int qi = 0; qi < QB; ++qi) {
                const size_t tok = (size_t)b * S + 128 * (rt * 16 + fr) + q0 + qi;
                const bf16_t* zp = PR + tok * PRP + 1024 + g * 128 + fq * 8;
                bf16x8 a[4]; float ss = 0.f;
#pragma unroll
                for (int ks = 0; ks < 4; ++ks) a[ks] = *(const bf16x8*)(zp + ks * 32);
#pragma unroll
                for (int ks = 0; ks < 4; ++ks)
#pragma unroll
                    for (int k = 0; k < 8; ++k) { const float f = __uint_as_float(((unsigned)(unsigned short)a[ks][k]) << 16); ss += f * f; }
                ss += __shfl_xor(ss, 16); ss += __shfl_xor(ss, 32);
                const float rs = rsqrtf(ss * (1.0f / 128.0f) + 1e-6f);
                f32x4 dP = (f32x4){0.f, 0.f, 0.f, 0.f}, dQ = dP;
#pragma unroll
                for (int ks = 0; ks < 4; ++ks) { dP = mfma16(a[ks], wP[ks], dP); dQ = mfma16(a[ks], wQ[ks], dQ); }
#pragma unroll
                for (int j = 0; j < 4; ++j) { const float sj = __shfl(rs, fq * 4 + j); dP[j] *= sj; dQ[j] *= sj; }
                pP[qi][rt][0] = pk2(dP[0], dP[1]); pP[qi][rt][1] = pk2(dP[2], dP[3]); pQ[qi][rt][0] = pk2(dQ[0], dQ[1]); pQ[qi][rt][1] = pk2(dQ[2], dQ[3]);
            }
            if ((rt & 3) == 3) asm volatile("" ::: "memory");
        }
#pragma unroll 2
        for (int k1t = 0; k1t < NT; ++k1t) {
            bf16x8 aC[KS], aS[KS];
#pragma unroll
            for (int s = 0; s < KS; ++s) { aC[s] = *(const bf16x8*)(FCp + ((k1t * 16 + fr) * KW + s * 32 + fq * 8)); aS[s] = *(const bf16x8*)(FSp + ((k1t * 16 + fr) * KW + s * 32 + fq * 8)); }
#pragma unroll
            for (int qi = 0; qi < QB; ++qi) {
                f32x4 Ur = (f32x4){0.f, 0.f, 0.f, 0.f}, V = Ur;
#pragma unroll
                for (int s = 0; s < KS; ++s) {
                    u32x4 bp, bq;
                    bp.x = pP[qi][2 * s][0]; bp.y = pP[qi][2 * s][1]; bq.x = pQ[qi][2 * s][0]; bq.y = pQ[qi][2 * s][1];
                    if (2 * s + 1 < NT) { bp.z = pP[qi][(2 * s + 1) % NT][0]; bp.w = pP[qi][(2 * s + 1) % NT][1]; bq.z = pQ[qi][(2 * s + 1) % NT][0]; bq.w = pQ[qi][(2 * s + 1) % NT][1]; }
                    else { bp.z = 0u; bp.w = 0u; bq.z = 0u; bq.w = 0u; }
                    const u32x4 bnq = bq ^ 0x80008000u;
                    const bf16x8 BP = __builtin_bit_cast(bf16x8, bp), BQ = __builtin_bit_cast(bf16x8, bq), BNQ = __builtin_bit_cast(bf16x8, bnq);
                    Ur = mfma16(aC[s], BP, Ur); Ur = mfma16(aS[s], BNQ, Ur); V = mfma16(aS[s], BP, V); V = mfma16(aC[s], BQ, V);
                }
                const int q = q0 + qi;
#pragma unroll
                for (int j = 0; j < 4; ++j) {
                    const int k1 = k1t * 16 + fq * 4 + j; const f32x2 tw = TW[q * R + k1];
                    const float upr = Ur[j] * tw.x - V[j] * tw.y, upi = -(V[j] * tw.x + Ur[j] * tw.y);
                    bf16_t* o = UB + ((((size_t)b * R + k1) * 2) * 128 + q) * 512 + g * 128 + e0 + fr;
                    o[0] = (bf16_t)f2bf(upr); o[(size_t)128 * 512] = (bf16_t)f2bf(upi);
                }
            }
        }
    }
}

DI void four_stage1_p(LAS unsigned char* lds, const bf16_t* PR, bf16_t* UB, const bf16_t* WF, const bf16_t* FCp, const bf16_t* FSp, const f32x2* TW, int nb, int G, int tid, int wid, int lane) {
    constexpr int R = 128, S = R * 128, PT = 272, TC_OFF = 0, TS_OFF = 128 * PT, Z_OFF = 256 * PT, TW_OFF = 384 * PT;
    const int fr = lane & 15, fq = lane >> 4, e0 = wid * 16;
    const int nunits = nb * 4 * 128;
    {
#pragma unroll
        for (int i = 0; i < 4; ++i) { const int idx = tid + NTHR * i; const u32x4 c = *(const u32x4*)(FCp + (idx >> 4) * 128 + (idx & 15) * 8), sn = *(const u32x4*)(FSp + (idx >> 4) * 128 + (idx & 15) * 8);
            *(LAS u32x4*)(lds + TC_OFF + (idx >> 4) * PT + (idx & 15) * 16) = c; *(LAS u32x4*)(lds + TS_OFF + (idx >> 4) * PT + (idx & 15) * 16) = sn; }
    }
    u32x4 zr[4]; u32x4 twr = (u32x4){0u, 0u, 0u, 0u};
    int un = blockIdx.x;
    if (un < nunits) { const int q = un & 127, g = (un >> 7) & 3, b = un >> 9;
#pragma unroll
        for (int i = 0; i < 4; ++i) { const int idx = tid + NTHR * i; zr[i] = *(const u32x4*)(PR + ((size_t)b * S + 128 * (idx >> 4) + q) * PRP + 1024 + g * 128 + (idx & 15) * 8); }
        if (tid < 64) twr = *(const u32x4*)((const float*)(TW + q * R) + tid * 4); }
    for (; un < nunits; un += G) {
        const int q = un & 127, g = (un >> 7) & 3, b = un >> 9;
        bf16x8 wP[4], wQ[4];
#pragma unroll
        for (int ks = 0; ks < 4; ++ks) { wP[ks] = *(const bf16x8*)(WF + ((g * 256 + e0 + fr) * 128 + ks * 32 + fq * 8)); wQ[ks] = *(const bf16x8*)(WF + ((g * 256 + 128 + e0 + fr) * 128 + ks * 32 + fq * 8)); }
        __syncthreads();
#pragma unroll
        for (int i = 0; i < 4; ++i) { const int idx = tid + NTHR * i; *(LAS u32x4*)(lds + Z_OFF + (idx >> 4) * PT + (idx & 15) * 16) = zr[i]; }
        if (tid < 64) *(LAS u32x4*)(lds + TW_OFF + tid * 16) = twr;
        { const int un2 = un + G;
          if (un2 < nunits) { const int q2 = un2 & 127, g2 = (un2 >> 7) & 3, b2 = un2 >> 9;
#pragma unroll
            for (int i = 0; i < 4; ++i) { const int idx = tid + NTHR * i; zr[i] = *(const u32x4*)(PR + ((size_t)b2 * S + 128 * (idx >> 4) + q2) * PRP + 1024 + g2 * 128 + (idx & 15) * 8); }
            if (tid < 64) twr = *(const u32x4*)((const float*)(TW + q2 * R) + tid * 4); } }
        __syncthreads();
        unsigned pP[8][2], pQ[8][2];
#pragma unroll
        for (int rt = 0; rt < 8; ++rt) {
            bf16x8 a[4]; float ss = 0.f;
#pragma unroll
            for (int ks = 0; ks < 4; ++ks) a[ks] = *(const LAS bf16x8*)(lds + Z_OFF + (rt * 16 + fr) * PT + (ks * 32 + fq * 8) * 2);
#pragma unroll
            for (int ks = 0; ks < 4; ++ks)
#pragma unroll
                for (int k = 0; k < 8; ++k) { const float f = __uint_as_float(((unsigned)(unsigned short)a[ks][k]) << 16); ss += f * f; }
            ss += __shfl_xor(ss, 16); ss += __shfl_xor(ss, 32);
            const float rs = rsqrtf(ss * (1.0f / 128.0f) + 1e-6f);
            f32x4 dP = (f32x4){0.f, 0.f, 0.f, 0.f}, dQ = dP;
#pragma unroll
            for (int ks = 0; ks < 4; ++ks) { dP = mfma16(a[ks], wP[ks], dP); dQ = mfma16(a[ks], wQ[ks], dQ); }
#pragma unroll
            for (int j = 0; j < 4; ++j) { const float sj = __shfl(rs, fq * 4 + j); dP[j] *= sj; dQ[j] *= sj; }
            pP[rt][0] = pk2(dP[0], dP[1]); pP[rt][1] = pk2(dP[2], dP[3]); pQ[rt][0] = pk2(dQ[0], dQ[1]); pQ[rt][1] = pk2(dQ[2], dQ[3]);
            if ((rt & 3) == 3) asm volatile("" ::: "memory");
        }
#pragma unroll 2
        for (int k1t = 0; k1t < 8; ++k1t) {
            bf16x8 aC[4], aS[4];
#pragma unroll
            for (int sx = 0; sx < 4; ++sx) { aC[sx] = *(const LAS bf16x8*)(lds + TC_OFF + (k1t * 16 + fr) * PT + (sx * 32 + fq * 8) * 2); aS[sx] = *(const LAS bf16x8*)(lds + TS_OFF + (k1t * 16 + fr) * PT + (sx * 32 + fq * 8) * 2); }
            const f32x4 twa = *(const LAS f32x4*)(lds + TW_OFF + (k1t * 16 + fq * 4) * 8), twb = *(const LAS f32x4*)(lds + TW_OFF + (k1t * 16 + fq * 4) * 8 + 16);
            f32x4 Ur = (f32x4){0.f, 0.f, 0.f, 0.f}, V = Ur;
#pragma unroll
            for (int sx = 0; sx < 4; ++sx) {
                u32x4 bp, bq;
                bp.x = pP[2 * sx][0]; bp.y = pP[2 * sx][1]; bq.x = pQ[2 * sx][0]; bq.y = pQ[2 * sx][1];
                bp.z = pP[2 * sx + 1][0]; bp.w = pP[2 * sx + 1][1]; bq.z = pQ[2 * sx + 1][0]; bq.w = pQ[2 * sx + 1][1];
                const u32x4 bnq = bq ^ 0x80008000u;
                const bf16x8 BP = __builtin_bit_cast(bf16x8, bp), BQ = __builtin_bit_cast(bf16x8, bq), BNQ = __builtin_bit_cast(bf16x8, bnq);
                Ur = mfma16(aC[sx], BP, Ur); Ur = mfma16(aS[sx], BNQ, Ur); V = mfma16(aS[sx], BP, V); V = mfma16(aC[sx], BQ, V);
            }
            const float tcs[4] = {twa[0], twa[2], twb[0], twb[2]}, tsn[4] = {twa[1], twa[3], twb[1], twb[3]};
#pragma unroll
            for (int j = 0; j < 4; ++j) {
                const int k1 = k1t * 16 + fq * 4 + j;
                const float upr = Ur[j] * tcs[j] - V[j] * tsn[j], upi = -(V[j] * tcs[j] + Ur[j] * tsn[j]);
                bf16_t* o = UB + ((((size_t)b * R + k1) * 2) * 128 + q) * 512 + g * 128 + e0 + fr;
                o[0] = (bf16_t)f2bf(upr); o[(size_t)128 * 512] = (bf16_t)f2bf(upi);
            }
        }
    }
    __syncthreads();
}

DI void four_stage1_s(LAS unsigned char* lds, const bf16_t* PR, bf16_t* UB, const bf16_t* WF, const bf16_t* FCp, const bf16_t* FSp, const f32x2* TW, int nb, int G, int tid, int wid, int lane) {
    constexpr int R = 16, S = R * 128, QB = 4, NQB = 32, PT = 272;
    const int fr = lane & 15, fq = lane >> 4, e0 = wid * 16;
    const int nunits = nb * 4 * NQB;
    const bool uniform = (G % 128) == 0;
    int un = blockIdx.x;
    if (un >= nunits) return;
    int q0 = (un % NQB) * QB, g = (un / NQB) & 3;
    bf16x8 wP[4], wQ[4], aC, aS; f32x4 twv[QB][2];
    u32x4 zr[2];
#define S1S_CONST() do { _Pragma("unroll") for (int ks = 0; ks < 4; ++ks) { wP[ks] = *(const bf16x8*)(WF + ((g * 256 + e0 + fr) * 128 + ks * 32 + fq * 8)); wQ[ks] = *(const bf16x8*)(WF + ((g * 256 + 128 + e0 + fr) * 128 + ks * 32 + fq * 8)); } \
        _Pragma("unroll") for (int qi = 0; qi < QB; ++qi) { const f32x4* tp = (const f32x4*)(TW + (q0 + qi) * R + fq * 4); twv[qi][0] = tp[0]; twv[qi][1] = tp[1]; } } while (0)
    aC = *(const bf16x8*)(FCp + (fr * 32 + fq * 8)); aS = *(const bf16x8*)(FSp + (fr * 32 + fq * 8));
    S1S_CONST();
    { const int b = un / (4 * NQB);
#pragma unroll
      for (int i = 0; i < 2; ++i) { const int idx = tid + NTHR * i, row = idx >> 4; zr[i] = *(const u32x4*)(PR + ((size_t)b * S + 128 * (row & 15) + q0 + (row >> 4)) * PRP + 1024 + g * 128 + (idx & 15) * 8); } }
    for (; un < nunits; un += G) {
        const int b = un / (4 * NQB);
        __syncthreads();
#pragma unroll
        for (int i = 0; i < 2; ++i) { const int idx = tid + NTHR * i; *(LAS u32x4*)(lds + (idx >> 4) * PT + (idx & 15) * 16) = zr[i]; }
        const int un2 = un + G; int q0n = q0, gn = g;
        if (un2 < nunits) { const int b2 = un2 / (4 * NQB); q0n = (un2 % NQB) * QB; gn = (un2 / NQB) & 3;
#pragma unroll
            for (int i = 0; i < 2; ++i) { const int idx = tid + NTHR * i, row = idx >> 4; zr[i] = *(const u32x4*)(PR + ((size_t)b2 * S + 128 * (row & 15) + q0n + (row >> 4)) * PRP + 1024 + gn * 128 + (idx & 15) * 8); } }
        __syncthreads();
#pragma unroll
        for (int qi = 0; qi < QB; ++qi) {
            bf16x8 a[4]; float ss = 0.f;
#pragma unroll
            for (int ks = 0; ks < 4; ++ks) a[ks] = *(const LAS bf16x8*)(lds + (qi * 16 + fr) * PT + (ks * 32 + fq * 8) * 2);
#pragma unroll
            for (int ks = 0; ks < 4; ++ks)
#pragma unroll
                for (int k = 0; k < 8; ++k) { const float f = __uint_as_float(((unsigned)(unsigned short)a[ks][k]) << 16); ss += f * f; }
            ss += __shfl_xor(ss, 16); ss += __shfl_xor(ss, 32);
            const float rs = rsqrtf(ss * (1.0f / 128.0f) + 1e-6f);
            f32x4 dP = (f32x4){0.f, 0.f, 0.f, 0.f}, dQ = dP;
#pragma unroll
            for (int ks = 0; ks < 4; ++ks) { dP = mfma16(a[ks], wP[ks], dP); dQ = mfma16(a[ks], wQ[ks], dQ); }
#pragma unroll
            for (int j = 0; j < 4; ++j) { const float sj = __shfl(rs, fq * 4 + j); dP[j] *= sj; dQ[j] *= sj; }
            u32x4 bp, bq; bp.x = pk2(dP[0], dP[1]); bp.y = pk2(dP[2], dP[3]); bp.z = 0u; bp.w = 0u; bq.x = pk2(dQ[0], dQ[1]); bq.y = pk2(dQ[2], dQ[3]); bq.z = 0u; bq.w = 0u;
            const u32x4 bnq = bq ^ 0x80008000u;
            const bf16x8 BP = __builtin_bit_cast(bf16x8, bp), BQ = __builtin_bit_cast(bf16x8, bq), BNQ = __builtin_bit_cast(bf16x8, bnq);
            f32x4 Ur = (f32x4){0.f, 0.f, 0.f, 0.f}, V = Ur;
            Ur = mfma16(aC, BP, Ur); Ur = mfma16(aS, BNQ, Ur); V = mfma16(aS, BP, V); V = mfma16(aC, BQ, V);
            const int q = q0 + qi;
            const float tcs[4] = {twv[qi][0][0], twv[qi][0][2], twv[qi][1][0], twv[qi][1][2]}, tsn[4] = {twv[qi][0][1], twv[qi][0][3], twv[qi][1][1], twv[qi][1][3]};
#pragma unroll
            for (int j = 0; j < 4; ++j) {
                const int k1 = fq * 4 + j;
                const float upr = Ur[j] * tcs[j] - V[j] * tsn[j], upi = -(V[j] * tcs[j] + Ur[j] * tsn[j]);
                bf16_t* o = UB + ((((size_t)b * R + k1) * 2) * 128 + q) * 512 + g * 128 + e0 + fr;
                o[0] = (bf16_t)f2bf(upr); o[(size_t)128 * 512] = (bf16_t)f2bf(upi);
            }
        }
        if (!uniform && un2 < nunits) { q0 = q0n; g = gn; S1S_CONST(); }
    }
#undef S1S_CONST
    __syncthreads();
}

template <int R>
DI void four_stage2(LAS unsigned char* lds, const bf16_t* UB, bf16_t* YY, const bf16_t* FC2, const bf16_t* FS2, int nb, int G, int tid, int wid, int lane) {
    constexpr int PITCH2 = 544, S = R * 128;
    const float norm = rsqrtf((float)S * 128.0f);
    const int fr = lane & 15, fq = lane >> 4, c0 = wid * 32;
    const int nunits = nb * R * 2;
    for (int un = blockIdx.x; un < nunits; un += G) {
        const int ch2 = un & 1, k1 = (un >> 1) % R, b = (un >> 1) / R;
        const bf16_t* src = UB + (((size_t)b * R + k1) * 2) * 128 * 512 + ch2 * 256;
#pragma unroll
        for (int pass = 0; pass < 16; ++pass) { const int row = pass * 16 + (tid >> 5), seg = tid & 31;
            const u32x4 w = *(const u32x4*)(src + (size_t)row * 512 + seg * 8); *(LAS u32x4*)(lds + row * PITCH2 + seg * 16) = w; }
        __syncthreads();
        f32x4 acc[2][8];
#pragma unroll
        for (int a = 0; a < 2; ++a)
#pragma unroll
            for (int k = 0; k < 8; ++k) acc[a][k] = (f32x4){0.f, 0.f, 0.f, 0.f};
        bf16x8 fa[8];
#pragma unroll
        for (int k2t = 0; k2t < 8; ++k2t) fa[k2t] = *(const bf16x8*)(FC2 + ((k2t * 16 + fr) * 128 + fq * 8));
#pragma unroll 2
        for (int it = 0; it < 8; ++it) {
            const int comp = it >> 2, ks = it & 3, itn = (it + 1) & 7;
            bf16x8 fn[8];
            { const bf16_t* Fn = (itn >> 2) ? FS2 : FC2;
#pragma unroll
              for (int k2t = 0; k2t < 8; ++k2t) fn[k2t] = *(const bf16x8*)(Fn + ((k2t * 16 + fr) * 128 + (itn & 3) * 32 + fq * 8)); }
            bf16x8 uf[2];
#pragma unroll
            for (int ct = 0; ct < 2; ++ct) uf[ct] = tr_frag(lds + (comp * 128 + ks * 32 + fq * 8 + (fr >> 2)) * PITCH2 + (c0 + ct * 16 + 4 * (fr & 3)) * 2, 4 * PITCH2);
#pragma unroll
            for (int k2t = 0; k2t < 8; ++k2t)
#pragma unroll
                for (int ct = 0; ct < 2; ++ct) acc[ct][k2t] = mfma16(uf[ct], fa[k2t], acc[ct][k2t]);
#pragma unroll
            for (int k2t = 0; k2t < 8; ++k2t) fa[k2t] = fn[k2t];
        }
#pragma unroll
        for (int k2t = 0; k2t < 8; ++k2t) {
            const size_t tok = (size_t)b * S + (size_t)R * (k2t * 16 + fr) + k1;
#pragma unroll
            for (int ct = 0; ct < 2; ++ct) { const f32x4 y = acc[ct][k2t] * norm; u32x2 o; o.x = pk2(y[0], y[1]); o.y = pk2(y[2], y[3]);
                *(u32x2*)(YY + tok * 1024 + 512 + ch2 * 256 + c0 + ct * 16 + fq * 4) = o; }
        }
        __syncthreads();
    }
}

__global__ void __launch_bounds__(NTHR, 2) mega_fwd(Params p) {
    extern __shared__ __attribute__((aligned(16))) unsigned char lds_raw[];
    LAS unsigned char* lds = (LAS unsigned char*)lds_raw;
    cg::grid_group grid = cg::this_grid();
    const int tid = threadIdx.x, lane = tid & 63, wid = __builtin_amdgcn_readfirstlane(tid >> 6), G = gridDim.x;
    unsigned char* ws = p.ws;
    int pc = 0;
#define PH_BEGIN if (pc >= p.ph_lo && pc < p.ph_hi) {
    volatile LAS unsigned* bst = (volatile LAS unsigned*)(lds + LDS_BYTES - 64);
    if (tid < 2) bst[tid] = 0u;
    __syncthreads();
    if (p.ph_lo > p.ph_hi) grid.sync();
    XcdBarrier xbar = xcd_barrier_post((unsigned*)(ws + WS_BAR), bst);
    if (tid == 0) { (void)__hip_atomic_fetch_max(&xbar.bar[XB_CLS(blockIdx.x & 7u)], xbar.x + 1u, __ATOMIC_RELAXED, __HIP_MEMORY_SCOPE_AGENT); (void)__hip_atomic_fetch_max(&xbar.bar[XB_CLS(8u + (blockIdx.x & 7u))], 16u - xbar.x, __ATOMIC_RELAXED, __HIP_MEMORY_SCOPE_AGENT); }
    bool local_ok = false, seam_local = false, seam_noacq = false, seam_skip = false;
#define PH_END } ++pc; if (pc == 1) { xcd_barrier(xbar); \
        local_ok = (G == 256) && (bst[0] == 32u) && (bst[1] == 8u) && (xb_ld(&xbar.bar[XB_TMO]) == 0u); \
        for (unsigned cc = 0; cc < 8u; ++cc) local_ok = local_ok && (xb_ld(&xbar.bar[XB_CLS(cc)]) + xb_ld(&xbar.bar[XB_CLS(8u + cc)]) == 17u); } \
    else if (seam_skip && local_ok) { } else if (seam_local && local_ok) { team_barrier(xbar, !seam_noacq); } else { xcd_barrier(xbar); }

    PH_BEGIN
#if PHMASK & 1
#if PROBE & 16
 for (int rep = 0; rep < 2; ++rep)
#endif
 setup_phase(p, lds, G, tid, wid, lane);
#endif
 PH_END

    bf16_t* H = (bf16_t*)(ws + WS_H); bf16_t* T = (bf16_t*)(ws + WS_T); bf16_t* BIG = (bf16_t*)(ws + WS_BIG); bf16_t* UB = (bf16_t*)(ws + WS_T);     _Float16* XH = (_Float16*)(ws + WS_XH);
    const float* mod = (const float*)(ws + WS_MOD);
    for (int gi = 0; gi < 2; ++gi) {
        const int S = gi ? 2048 : 16384, nb = gi ? 16 : 2;
        const float* xsrc = p.in[gi];
        float* xo = p.out + (size_t)gi * GROWS * D;
        for (int ls = 0; ls < 7; ++ls) {
            const int l = ls / 3, sub = ls % 3;
            const bool odd = (l & 1), last = (ls == 6), first = (ls == 0);
            const int nsteps = last ? 1 : (sub != 1 ? 3 : (odd ? 5 : 4));
            for (int step = 0; step < nsteps; ++step) {
                int kind = 1;
                if (step == 0) kind = 0;
                else if (sub == 1 && step == 2) kind = odd ? 3 : 2;
                else if (sub == 1 && odd && step == 3) kind = 4;
                seam_noacq = (kind == 1 && sub != 1 && step == 2);
                seam_skip = (kind == 0 && last);
                seam_local = !((kind == 1 && sub == 1) || kind == 3 || kind == 4);
                PH_BEGIN
                int tid = threadIdx.x; asm volatile("" : "+v"(tid));
                const int lane = tid & 63, wid = __builtin_amdgcn_readfirstlane(tid >> 6);
                if (kind == 0) {
#if PHMASK & 2
#ifndef STAG2
#define STAG2 0
#endif
                    if (STAG2 && local_ok && ((gi == 0 && ls == 0) || sub == 2) && ((blockIdx.x >> 3) & 1)) { for (int zz = 0; zz < STAG2; ++zz) __builtin_amdgcn_s_sleep(127); }
                    const int lp = sub > 0 ? l : l - 1, sp = sub > 0 ? sub - 1 : 2, lpp = first ? 0 : lp, lc = last ? 0 : l;
#if PROBE & 4
                    norm_phase(ls <= 1 ? xsrc : nullptr, XH, last ? (float*)BIG : nullptr, (_Float16*)BIG, T, H, !first, !last,
                               mod + (size_t)lpp * 18 * 9216 + (sp * 3 + 2) * 1024, p.in[7] + (lpp * 3 + sp) * 1024, sp == 1 ? 1.0f : 0.5f,
                               mod + (size_t)lc * 18 * 9216 + (sub * 3) * 1024, p.in[6] + (lc * 3 + sub) * 1024, gi, G, wid, lane);
#endif
                    norm_phase(ls <= 1 ? xsrc : nullptr, XH, last ? xo : nullptr, XH, T, H, !first, !last,
                               mod + (size_t)lpp * 18 * 9216 + (sp * 3 + 2) * 1024, p.in[7] + (lpp * 3 + sp) * 1024, sp == 1 ? 1.0f : 0.5f,
                               mod + (size_t)lc * 18 * 9216 + (sub * 3) * 1024, p.in[6] + (lc * 3 + sub) * 1024, gi, G, wid, lane);
#endif
                } else if (kind == 1) {
                    const bf16_t* A; const bf16_t* Bt; bf16_t* O; int N, K, ldc, mode;
                    if (sub != 1) {
                        const int wi = l * 2 + (sub >> 1);
                        if (step == 1) { A = H; Bt = (const bf16_t*)(ws + WS_WUP) + (size_t)wi * 5632 * 1024; O = BIG; N = 5632; K = 1024; ldc = DFF; mode = 3; }
                        else { A = BIG; Bt = (const bf16_t*)(ws + WS_WDN) + (size_t)wi * 1024 * 2816; O = T; N = 1024; K = DFF; ldc = D; mode = 0; }
                    } else if (step == 1) { A = H; Bt = (const bf16_t*)(ws + (odd ? WS_ODIN : WS_EVIN)); O = BIG; N = odd ? 2048 : 1536; K = 1024; ldc = PRP; mode = odd ? 2 : 1; }
                    else { A = H; Bt = (const bf16_t*)(ws + (odd ? WS_ODOUT : WS_EVOUT)); O = T; N = 1024; K = 1024; ldc = D; mode = 0; }
#if PROBE & 2
                    for (int rep = 0; rep < 2; ++rep)
#endif
                    run_gemm(lds, A, Bt, GROWS, N, K, O, ldc, mode, G);
                } else if (kind == 2) {
#if PHMASK & 8
#if PROBE & (8 | 32)
                    for (int rep = 0; rep < 2; ++rep)
#endif
                    even_core(lds, BIG, H, (const bf16_t*)(ws + WS_WSP), (const bf16_t*)(ws + WS_WPT), p.in[13], p.in[14], p.in[16], p.in[18], S, G, tid, wid, lane);
#endif
                } else if (kind == 3) {
#if PHMASK & 16
#if PROBE & (8 | 64)
                    for (int rep = 0; rep < 2; ++rep) {
#else
                    {
#endif
                    conv_part(BIG, H, p.in[21], S, G, wid, lane);
                    if (gi == 0) four_stage1_p(lds, BIG, UB, (const bf16_t*)(ws + WS_WF), (const bf16_t*)(ws + WS_FC1), (const bf16_t*)(ws + WS_FS1), (const f32x2*)(ws + WS_TW128), nb, G, tid, wid, lane);
                    else four_stage1_s(lds, BIG, UB, (const bf16_t*)(ws + WS_WF), (const bf16_t*)(ws + WS_FC16), (const bf16_t*)(ws + WS_FS16), (const f32x2*)(ws + WS_TW16), nb, G, tid, wid, lane);
                    }
#endif
                } else {
#if PHMASK & 32
#if PROBE & (8 | 128)
                    for (int rep = 0; rep < 2; ++rep) {
#else
                    {
#endif
                    if (gi == 0) four_stage2<128>(lds, UB, H, (const bf16_t*)(ws + WS_FC2), (const bf16_t*)(ws + WS_FS2), nb, G, tid, wid, lane);
                    else four_stage2<16>(lds, UB, H, (const bf16_t*)(ws + WS_FC2), (const bf16_t*)(ws + WS_FS2), nb, G, tid, wid, lane);
                    }
#endif
                }
                PH_END
            }
        }
    }
}

extern "C" void kernel_launch(void* const* d_in, const int* in_sizes, int n_in, void* d_out, int out_size, void* d_ws, size_t ws_size, hipStream_t stream) {
    static int grid = 0;
    if (grid == 0) {
        if (n_in != 25 || ws_size < WS_END || out_size != 2 * GROWS * D) { fprintf(stderr, "kernel_launch: unexpected shapes (n_in %d, out %d, ws %zu)\n", n_in, out_size, ws_size); grid = -1; return; }
        int dev = 0, cus = 0, per_cu = 0;
        hipGetDevice(&dev); hipDeviceGetAttribute(&cus, hipDeviceAttributeMultiprocessorCount, dev);
        hipFuncSetAttribute((const void*)mega_fwd, hipFuncAttributeMaxDynamicSharedMemorySize, LDS_BYTES);
        if (hipOccupancyMaxActiveBlocksPerMultiprocessor(&per_cu, (const void*)mega_fwd, NTHR, LDS_BYTES) != hipSuccess || per_cu < 1) per_cu = 1;
        (void)hipGetLastError();
        grid = cus * 1;
    }
    if (grid < 0) return;
    Params p{};
    for (int i = 0; i < 25; ++i) p.in[i] = (const float*)d_in[i];
    p.out = (float*)d_out; p.ws = (unsigned char*)d_ws; p.ph_lo = 0; p.ph_hi = 1 << 20;
    (void)hipMemsetAsync((unsigned char*)d_ws + WS_BAR, 0, XB_WORDS_ALL * sizeof(unsigned), stream);
    void* args[] = {&p};
    hipError_t e = hipLaunchCooperativeKernel((const void*)mega_fwd, dim3(grid), dim3(NTHR), args, LDS_BYTES, stream);
    if (e != hipSuccess) fprintf(stderr, "cooperative launch failed: %s (grid %d)\n", hipGetErrorString(e), grid);
}
```

```cpp
#include <hip/hip_runtime.h>
#include <hip/hip_cooperative_groups.h>
#include <cstdio>
namespace cg = cooperative_groups;
namespace pg8 {
#define PG8_LAS __attribute__((address_space(3)))
typedef unsigned short bf16_t;
typedef short bf16x8 __attribute__((ext_vector_type(8)));
typedef float f32x4 __attribute__((ext_vector_type(4)));
typedef unsigned u32x4 __attribute__((ext_vector_type(4)));
constexpr int BM = 256, BK = 64, HALF = 128, HTB = HALF * BK * 2  , STAGE_BYTES = 8 * HTB, NXCD = 8, WGM = 8;

__host__ __device__ __forceinline__ int lds_byte(int r, int c) { const int st = (r >> 4) * 2 + (c >> 5), rr = r & 15, cc = c & 31, ob = rr * 64 + cc * 2; return st * 1024 + (ob ^ (((ob >> 9) & 1) << 5)); }
__host__ __device__ __forceinline__ void stage_rc(int b, int& R, int& C) { const int st = b / 1024, sb = b % 1024, swz = sb ^ (((sb >> 9) & 1) << 5); R = (st >> 1) * 16 + swz / 64; C = (st & 1) * 32 + (swz % 64) / 2; }
__host__ __device__ __forceinline__ int perm32(int rho) { const int n = rho >> 4, i = rho & 15; return 8 * (i >> 2) + 4 * n + (i & 3); }

struct Unit { int pm, pn; };
struct Gemm { const bf16_t* A; const bf16_t* Bt; int M, N, K; };

struct StaticOrder {
    int nM, nN, nwg, G, c;
    __host__ __device__ void init(int M, int N, int G_, int c_) { nM = M / BM; nN = N / BM; nwg = nM * nN; G = G_; c = c_; }
    __host__ __device__ bool next(int i, Unit& u) const {
        const long L = (long)i * G + c; if (L >= nwg) return false;
        int wgid = (int)L; { const int q = nwg / NXCD, r = nwg % NXCD, xcd = wgid % NXCD, off = wgid / NXCD; wgid = (xcd < r ? xcd * (q + 1) : r * (q + 1) + (xcd - r) * q) + off; }
        const int nig = WGM * nN, gid = wgid / nig, fm = gid * WGM, gsz = (nM - fm) < WGM ? (nM - fm) : WGM;
        u.pm = fm + ((wgid % nig) % gsz); u.pn = (wgid % nig) / gsz; return true;
    }
    __device__ __forceinline__ void a_ready(const Unit&) const {}
    __device__ __forceinline__ void done(const Unit&) const {}
};
__device__ __forceinline__ unsigned cvt_pk_bf16(float lo, float hi) { unsigned r; asm volatile("v_cvt_pk_bf16_f32 %0, %1, %2" : "=v"(r) : "v"(lo), "v"(hi)); return r; }
typedef float f32x2 __attribute__((ext_vector_type(2)));
__device__ __forceinline__ f32x2 gelu_pk(f32x2 v) {
    const f32x2 av = __builtin_elementwise_abs(v), d = av * 0.2316418882f + 1.0f;
    f32x2 t; t.x = __builtin_amdgcn_rcpf(d.x); t.y = __builtin_amdgcn_rcpf(d.y);
    f32x2 q = t * 0.5307027145f + (-0.7265760135f); q = q * t + 0.7107068705f; q = q * t + (-0.142248368f); q = q * t + 0.127414796f; q = q * t;
    const f32x2 s = (v * v) * (-0.72134752044f);
    f32x2 e; e.x = __builtin_amdgcn_exp2f(s.x); e.y = __builtin_amdgcn_exp2f(s.y);
    const f32x2 m = v * (q * e), r = v - m;
    f32x2 o; o.x = v.x < 0.f ? m.x : r.x; o.y = v.y < 0.f ? m.y : r.y; return o;
}
template <class Epi, class Sched, bool ALIGN_EPI = false, bool SP2 = false>
__device__ __forceinline__ void gemm_phase(PG8_LAS unsigned char* lds, const Gemm g, const Sched& S, const Epi& E) {
    int tid_o = threadIdx.x; asm volatile("" : "+v"(tid_o));
    const int tid = tid_o, wid = __builtin_amdgcn_readfirstlane(tid >> 6), lane = tid & 63, wr = wid >> 2, wc = wid & 3, fr = lane & 15, fq = lane >> 4;
    const int K = g.K, nt = K / BK;
    unsigned voffA[2], voffB[2];
#pragma unroll
    for (int i = 0; i < 2; ++i) { int R, C; stage_rc(tid * 16 + i * 8192, R, C); const int Rb = Epi::PERM ? ((R & ~31) + perm32(R & 31)) : R;
        voffA[i] = (unsigned)(R * K + C) * 2u; voffB[i] = (unsigned)(Rb * K + C) * 2u; }
    const size_t kstep = (size_t)(BK * 2);
    const size_t hstep = (size_t)HALF * K * 2;
    const size_t tstep = 2 * hstep;
    const unsigned ldsw = (unsigned)wid * 1024u;
    const int aoff = lds_byte(wr * 64 + fr, fq * 8), boff = lds_byte(wc * 32 + fr, fq * 8);
#define PG8_SA(b, h) (((b) * 2 + (h)) * HTB)
#define PG8_SB(b, h) ((4 + (b) * 2 + (h)) * HTB)
#define PG8_STAGE(bufoff, gbase, voff) do { _Pragma("unroll") for (int _i = 0; _i < 2; ++_i) \
        __builtin_amdgcn_global_load_lds((const unsigned*)((const char*)(gbase) + (voff)[_i]), (PG8_LAS unsigned*)(lds + (bufoff) + ldsw + _i * 8192), 16, 0, 0); } while (0)
#define PG8_LDA(dst, b, h) do { _Pragma("unroll") for (int m = 0; m < 4; ++m) _Pragma("unroll") for (int k = 0; k < 2; ++k) dst[m][k] = *(const PG8_LAS bf16x8*)(lds + PG8_SA(b, h) + aoff + m * 2048 + k * 1024); } while (0)
#define PG8_LDB(dst, b, h) do { _Pragma("unroll") for (int n = 0; n < 2; ++n) _Pragma("unroll") for (int k = 0; k < 2; ++k) dst[n][k] = *(const PG8_LAS bf16x8*)(lds + PG8_SB(b, h) + boff + n * 2048 + k * 1024); } while (0)
#define PG8_MMA(ai, bj, At, Bt) do { __builtin_amdgcn_s_setprio(1); _Pragma("unroll") for (int m = 0; m < 4; ++m) _Pragma("unroll") for (int n = 0; n < 2; ++n) _Pragma("unroll") for (int k = 0; k < 2; ++k) \
        acc[ai][bj][m][n] = __builtin_amdgcn_mfma_f32_16x16x32_bf16(Bt[n][k], At[m][k], acc[ai][bj][m][n], 0, 0, 0); __builtin_amdgcn_s_setprio(0); } while (0)
#define PG8_WAIT_V(n) asm volatile("s_waitcnt vmcnt(" #n ")" ::: "memory")
#define PG8_WAIT_L(n) asm volatile("s_waitcnt lgkmcnt(" #n ")" ::: "memory")
#define PG8_BAR __builtin_amdgcn_s_barrier()
#define PG8_SCHED __builtin_amdgcn_sched_barrier(0)
    Unit cur, nxt; int ui = 0;
    if (!S.next(0, cur)) return;
    f32x4 acc[2][2][4][2];
#pragma unroll
    for (int a = 0; a < 2; ++a)
#pragma unroll
        for (int b = 0; b < 2; ++b)
#pragma unroll
            for (int m = 0; m < 4; ++m)
#pragma unroll
                for (int n = 0; n < 2; ++n) acc[a][b][m][n] = (f32x4){0.f, 0.f, 0.f, 0.f};
    bf16x8 At[4][2], B0[2][2], B1[2][2];
    const char* cA = (const char*)g.A + (size_t)cur.pm * tstep; const char* cB = (const char*)g.Bt + (size_t)cur.pn * tstep;
    S.a_ready(cur);
    if constexpr (SP2) {
        PG8_STAGE(PG8_SB(0, 0), cB, voffB); PG8_STAGE(PG8_SB(0, 1), cB + hstep, voffB); PG8_STAGE(PG8_SA(0, 0), cA, voffA); PG8_STAGE(PG8_SA(0, 1), cA + hstep, voffA);
        if (wr == 1) PG8_BAR;
        PG8_WAIT_V(2); PG8_BAR;
        PG8_STAGE(PG8_SB(1, 0), cB + kstep, voffB); PG8_STAGE(PG8_SA(1, 0), cA + kstep, voffA); PG8_STAGE(PG8_SB(1, 1), cB + hstep + kstep, voffB);
        PG8_WAIT_V(6); PG8_BAR;
    } else {
        PG8_STAGE(PG8_SB(0, 0), cB, voffB); PG8_STAGE(PG8_SA(0, 0), cA, voffA); PG8_STAGE(PG8_SB(0, 1), cB + hstep, voffB); PG8_STAGE(PG8_SA(0, 1), cA + hstep, voffA);
        if (wr == 1) PG8_BAR;
        PG8_WAIT_V(4); PG8_BAR;
        PG8_STAGE(PG8_SB(1, 0), cB + kstep, voffB); PG8_STAGE(PG8_SA(1, 0), cA + kstep, voffA); PG8_STAGE(PG8_SB(1, 1), cB + hstep + kstep, voffB);
        PG8_WAIT_V(6); PG8_BAR;
    }
    for (;;) {
        const bool has_next = S.next(ui + 1, nxt);
        const char* nA = has_next ? (const char*)g.A + (size_t)nxt.pm * tstep : cA; const char* nB = has_next ? (const char*)g.Bt + (size_t)nxt.pn * tstep : cB;
        for (int t = 0; t < nt; t += 2) {
            const bool last = (t == nt - 2);
            const char* a1 = cA + (size_t)(t + 1) * kstep;
            const char* a2 = last ? nA : cA + (size_t)(t + 2) * kstep; const char* b2 = last ? nB : cB + (size_t)(t + 2) * kstep;
            const char* a3 = a2 + kstep; const char* b3 = b2 + kstep;
            if (last && has_next) S.a_ready(nxt);
            if constexpr (SP2) {
            PG8_LDB(B0, 0, 0); PG8_LDB(B1, 0, 1); PG8_SCHED; PG8_LDA(At, 0, 0); PG8_STAGE(PG8_SA(1, 1), a1 + hstep, voffA);
            PG8_WAIT_V(8); PG8_WAIT_L(0); PG8_BAR; PG8_MMA(0, 0, At, B0); PG8_MMA(0, 1, At, B1); PG8_BAR; PG8_SCHED;
            PG8_LDA(At, 0, 1); PG8_STAGE(PG8_SB(0, 0), b2, voffB); PG8_STAGE(PG8_SB(0, 1), b2 + hstep, voffB); PG8_STAGE(PG8_SA(0, 0), a2, voffA);
            PG8_WAIT_V(8); PG8_WAIT_L(0); PG8_BAR; PG8_MMA(1, 0, At, B0); PG8_MMA(1, 1, At, B1); PG8_BAR; PG8_SCHED;
            PG8_LDB(B0, 1, 0); PG8_LDB(B1, 1, 1); PG8_SCHED; PG8_LDA(At, 1, 0); PG8_STAGE(PG8_SA(0, 1), a2 + hstep, voffA);
            PG8_WAIT_V(8); PG8_WAIT_L(0); PG8_BAR; PG8_MMA(0, 0, At, B0); PG8_MMA(0, 1, At, B1); PG8_BAR; PG8_SCHED;
            PG8_LDA(At, 1, 1); PG8_STAGE(PG8_SB(1, 0), b3, voffB); PG8_STAGE(PG8_SB(1, 1), b3 + hstep, voffB); PG8_STAGE(PG8_SA(1, 0), a3, voffA);
            PG8_WAIT_V(8); PG8_WAIT_L(0); PG8_BAR; PG8_MMA(1, 0, At, B0); PG8_MMA(1, 1, At, B1); PG8_BAR; PG8_SCHED;
            } else {
            PG8_LDB(B0, 0, 0); PG8_SCHED; PG8_LDA(At, 0, 0); PG8_STAGE(PG8_SA(1, 1), a1 + hstep, voffA);
            PG8_WAIT_L(8); PG8_BAR; PG8_WAIT_L(0); PG8_MMA(0, 0, At, B0); PG8_BAR; PG8_SCHED;
            PG8_LDB(B1, 0, 1); PG8_STAGE(PG8_SB(0, 0), b2, voffB);
            PG8_BAR; PG8_WAIT_L(0); PG8_MMA(0, 1, At, B1); PG8_BAR;
            PG8_LDA(At, 0, 1); PG8_STAGE(PG8_SA(0, 0), a2, voffA);
            PG8_BAR; PG8_WAIT_L(0); PG8_MMA(1, 0, At, B0); PG8_BAR; PG8_SCHED;
            PG8_STAGE(PG8_SB(0, 1), b2 + hstep, voffB);
            PG8_WAIT_V(6); PG8_BAR; PG8_MMA(1, 1, At, B1); PG8_BAR;
            PG8_LDB(B0, 1, 0); PG8_SCHED; PG8_LDA(At, 1, 0); PG8_STAGE(PG8_SA(0, 1), a2 + hstep, voffA);
            PG8_WAIT_L(8); PG8_BAR; PG8_WAIT_L(0); PG8_MMA(0, 0, At, B0); PG8_BAR; PG8_SCHED;
            PG8_LDB(B1, 1, 1); PG8_STAGE(PG8_SB(1, 0), b3, voffB);
            PG8_BAR; PG8_WAIT_L(0); PG8_MMA(0, 1, At, B1); PG8_BAR;
            PG8_LDA(At, 1, 1); PG8_STAGE(PG8_SA(1, 0), a3, voffA);
            PG8_BAR; PG8_WAIT_L(0); PG8_MMA(1, 0, At, B0); PG8_BAR; PG8_SCHED;
            PG8_STAGE(PG8_SB(1, 1), b3 + hstep, voffB);
            PG8_WAIT_V(6); PG8_BAR; PG8_MMA(1, 1, At, B1); PG8_BAR;
            }
        }
        if constexpr (ALIGN_EPI) { if (wr == 0) PG8_BAR; }
        if constexpr (!Epi::AFTER_DRAIN) { E(acc, cur, wr, wc, fr, fq); S.done(cur); }
        if (!has_next) break;
#pragma unroll
        for (int a = 0; a < 2; ++a)
#pragma unroll
            for (int b = 0; b < 2; ++b)
#pragma unroll
                for (int m = 0; m < 4; ++m)
#pragma unroll
                    for (int n = 0; n < 2; ++n) acc[a][b][m][n] = (f32x4){0.f, 0.f, 0.f, 0.f};
        cur = nxt; cA = nA; cB = nB; ++ui;
        if constexpr (ALIGN_EPI) { if (wr == 1) PG8_BAR; }
    }
    PG8_WAIT_V(0);
    if constexpr (!ALIGN_EPI) { if (wr == 0) PG8_BAR; }
    PG8_BAR;
    if constexpr (Epi::AFTER_DRAIN) { E.fused(acc, cur, wr, wc, fr, fq, lds, wid, lane); S.done(cur); }
#undef PG8_SA
#undef PG8_SB
#undef PG8_STAGE
#undef PG8_LDA
#undef PG8_LDB
#undef PG8_MMA
#undef PG8_WAIT_V
#undef PG8_WAIT_L
#undef PG8_BAR
#undef PG8_SCHED
}
}


#ifndef PHMASK
#define PHMASK 63
#endif
#ifndef PROBE
#define PROBE 0
#endif
using pg8::bf16_t; using pg8::bf16x8; using pg8::f32x4; using pg8::u32x4;
typedef unsigned u32x2 __attribute__((ext_vector_type(2)));
typedef short s16x4 __attribute__((ext_vector_type(4)));
typedef float f32x2 __attribute__((ext_vector_type(2)));
#define LAS __attribute__((address_space(3)))
#define DI __device__ __forceinline__

#define XB_TMO      128
#define XB_XCNT(j)  (256  + 64 * (j))
#define XB_XSUB(j)  (1280 + 64 * (j))
#define XB_XGEN(j)  (2304 + 64 * (j))
#define XB_TOP      3328
#define XB_TOPGEN   3392
#define XCD_BAR_WORDS 3456
#define XB_SPIN_CAP (1u << 18)

__device__ __forceinline__ unsigned xb_ld(unsigned* p)              { return __hip_atomic_load(p, __ATOMIC_RELAXED, __HIP_MEMORY_SCOPE_AGENT); }
__device__ __forceinline__ unsigned xb_add(unsigned* p, unsigned v) { return __hip_atomic_fetch_add(p, v, __ATOMIC_RELAXED, __HIP_MEMORY_SCOPE_AGENT); }
__device__ __forceinline__ unsigned xb_xcc_id() { return (unsigned)__builtin_amdgcn_s_getreg((3 << 11) | 20) & 0xFu; }
#define XB_SPIN(cond, bar) do { unsigned _sp = 0; while (cond) { __builtin_amdgcn_s_sleep(1); \
    if ((++_sp & 255u) == 0u) { if (xb_ld(&(bar)[XB_TMO])) break; if (_sp > XB_SPIN_CAP) { atomicAdd(&(bar)[XB_TMO], 1u); break; } } } } while (0)

struct XcdBarrier {
    unsigned* bar; unsigned x;
    volatile LAS unsigned* st;
};

__device__ __forceinline__ XcdBarrier xcd_barrier_post(unsigned* bar, volatile LAS unsigned* st) {
    XcdBarrier b; b.bar = bar; b.x = xb_xcc_id(); b.st = st;
    if (threadIdx.x == 0) (void)xb_add(&bar[XB_XCNT(b.x)], 1u);
    return b;
}
__device__ __forceinline__ void xcd_barrier_complete(unsigned* bar, unsigned x, unsigned& nloc, unsigned& nx) {
    const unsigned G = gridDim.x * gridDim.y * gridDim.z;
    unsigned sum, cnt, mine, sp = 0u;
    for (;;) {
        sum = 0u; cnt = 0u; mine = 0u;
#pragma unroll
        for (unsigned j = 0; j < 16; ++j) { const unsigned c = xb_ld(&bar[XB_XCNT(j)]); sum += c; cnt += (c > 0u) ? 1u : 0u; mine = (j == x) ? c : mine; }
        if (sum == G) break;
        __builtin_amdgcn_s_sleep(1);
        if ((++sp & 255u) == 0u) { if (xb_ld(&bar[XB_TMO])) break; if (sp > XB_SPIN_CAP) { atomicAdd(&bar[XB_TMO], 1u); break; } }
    }
    nloc = mine > 0u ? mine : 1u; nx = cnt > 0u ? cnt : 1u;
}

__device__ __forceinline__ void xcd_barrier(const XcdBarrier& b) {
    asm volatile("s_waitcnt vmcnt(0)" ::: "memory");
    __syncthreads();
    if (threadIdx.x == 0) {
        unsigned* bar = b.bar;
        __builtin_amdgcn_s_waitcnt(0);
        unsigned nloc = b.st[0], nx = b.st[1];
        if (nloc == 0u) { xcd_barrier_complete(bar, b.x, nloc, nx); b.st[0] = nloc; b.st[1] = nx; }
        const unsigned old = xb_add(&bar[XB_XSUB(b.x)], 1u);
        const unsigned gen = old / nloc;
        if (old + 1u == (gen + 1u) * nloc) {
            __builtin_amdgcn_fence(__ATOMIC_RELEASE, "agent");
            asm volatile("s_waitcnt vmcnt(0)" ::: "memory");
            const unsigned og = xb_add(&bar[XB_TOP], 1u);
            const unsigned tg = og / nx;
            if (og + 1u == (tg + 1u) * nx) xb_add(&bar[XB_TOPGEN], 1u);
            else XB_SPIN(xb_ld(&bar[XB_TOPGEN]) == tg, bar);
            __builtin_amdgcn_fence(__ATOMIC_ACQUIRE, "agent");
            xb_add(&bar[XB_XGEN(b.x)], 1u);
            asm volatile("s_waitcnt vmcnt(0)" ::: "memory");
        } else {
            XB_SPIN(xb_ld(&bar[XB_XGEN(b.x)]) == gen, bar);
            __builtin_amdgcn_fence(__ATOMIC_ACQUIRE, "agent");
            asm volatile("s_waitcnt vmcnt(0)" ::: "memory");
        }
    }
    __syncthreads();
}


#define XB_LSUB(j)  (3456 + 64 * (j))
#define XB_LGEN(j)  (4480 + 64 * (j))
#define XB_CLS(j)   (5504 + 64 * (j))
#define XB_TSUB(k)  (6528 + 64 * (k))
#define XB_TGEN(k)  (10624 + 64 * (k))
#define XB_WORDS_ALL 14720
__device__ __forceinline__ void team_barrier(const XcdBarrier& b, bool acquire) {
    asm volatile("s_waitcnt vmcnt(0)" ::: "memory");
    __syncthreads();
    if (threadIdx.x == 0) {
        unsigned* bar = b.bar;
        __builtin_amdgcn_s_waitcnt(0);
        const unsigned team = (blockIdx.x & 7u) * 8u + ((blockIdx.x >> 3) & 7u);
        const unsigned old = xb_add(&bar[XB_TSUB(team)], 1u);
        const unsigned gen = old >> 2;
        if ((old & 3u) == 3u) xb_add(&bar[XB_TGEN(team)], 1u);
        else XB_SPIN(xb_ld(&bar[XB_TGEN(team)]) == gen, bar);
        if (acquire) {
            __builtin_amdgcn_fence(__ATOMIC_ACQUIRE, "agent");
            asm volatile("s_waitcnt vmcnt(0)" ::: "memory"); }
    }
    __syncthreads();
}

constexpr int D = 1024, DFF = 2816, GROWS = 32768, NTHR = 512;
constexpr int PRP = 2816;
constexpr int LDS_BYTES = 147456;
constexpr size_t MiB = 1u << 20, KiB = 1u << 10;
constexpr size_t WS_MODP = 0;
constexpr size_t WS_MOD = 6 * MiB;
constexpr size_t WS_BAR = 7 * MiB + 512 * KiB;
constexpr size_t WS_WSP = 8 * MiB;
constexpr size_t WS_WPT = WS_WSP + 256 * KiB;
constexpr size_t WS_WF = WS_WPT + 256 * KiB;
constexpr size_t WS_FC1 = WS_WF + 256 * KiB;
constexpr size_t WS_FS1 = WS_FC1 + 256 * KiB;
constexpr size_t WS_FC16 = WS_FS1 + 256 * KiB;
constexpr size_t WS_FS16 = WS_FC16 + 256 * KiB;
constexpr size_t WS_FC2 = WS_FS16 + 256 * KiB;
constexpr size_t WS_FS2 = WS_FC2 + 256 * KiB;
constexpr size_t WS_TW128 = WS_FS2 + 256 * KiB;
constexpr size_t WS_TW16 = WS_TW128 + 256 * KiB;
constexpr size_t WS_WUP = 16 * MiB;
constexpr size_t WS_WDN = 60 * MiB;
constexpr size_t WS_EVIN = 82 * MiB, WS_ODIN = 85 * MiB, WS_EVOUT = 89 * MiB, WS_ODOUT = 91 * MiB;
constexpr size_t WS_H = 96 * MiB;
constexpr size_t WS_T = 160 * MiB;
constexpr size_t WS_BIG = 224 * MiB;
constexpr size_t WS_UB = WS_BIG + 96 * MiB;
constexpr size_t WS_XH = 400 * MiB;
constexpr size_t WS_END = 464 * MiB;

typedef __bf16 nbf16x2 __attribute__((ext_vector_type(2)));
DI unsigned f2bf(float f) { return (unsigned)__builtin_bit_cast(unsigned short, (__bf16)f); }
DI unsigned pk2(float lo, float hi) { const f32x2 v = {lo, hi}; return __builtin_bit_cast(unsigned, __builtin_convertvector(v, nbf16x2)); }
DI float bf_lo(unsigned w) { return __uint_as_float(w << 16); }
DI float bf_hi(unsigned w) { return __uint_as_float(w & 0xffff0000u); }
template <int CTRL> DI float dpp_mov(float v) { return __builtin_bit_cast(float, __builtin_amdgcn_update_dpp(0, __builtin_bit_cast(int, v), CTRL, 0xF, 0xF, true)); }
DI float wave_sum(float v) {
    v += dpp_mov<0xB1>(v); v += dpp_mov<0x4E>(v); v += dpp_mov<0x141>(v); v += dpp_mov<0x140>(v);
    const int iv = __builtin_bit_cast(int, v);
    const float a = __builtin_bit_cast(float, __builtin_amdgcn_readlane(iv, 0)), b = __builtin_bit_cast(float, __builtin_amdgcn_readlane(iv, 16)),
                c = __builtin_bit_cast(float, __builtin_amdgcn_readlane(iv, 32)), d = __builtin_bit_cast(float, __builtin_amdgcn_readlane(iv, 48));
    return (a + b) + (c + d);
}
DI float silu_f(float x) { return x * __builtin_amdgcn_rcpf(1.0f + __builtin_amdgcn_exp2f(-1.4426950408889634f * x)); }
DI f32x4 mfma16(bf16x8 a, bf16x8 b, f32x4 c) { return __builtin_amdgcn_mfma_f32_16x16x32_bf16(a, b, c, 0, 0, 0); }
typedef short v4i16_t __attribute__((ext_vector_type(4)));
DI s16x4 tr_read(LAS unsigned char* p) { return __builtin_bit_cast(s16x4, __builtin_amdgcn_ds_read_tr16_b64_v4i16((LAS v4i16_t*)p)); }
DI bf16x8 tr_frag(LAS unsigned char* p, int pitch4) {
    const s16x4 lo = tr_read(p), hi = tr_read(p + pitch4);
    bf16x8 r; r[0] = lo[0]; r[1] = lo[1]; r[2] = lo[2]; r[3] = lo[3]; r[4] = hi[0]; r[5] = hi[1]; r[6] = hi[2]; r[7] = hi[3]; return r;
}

DI void st16_wt(void* p, u32x4 v) { *(u32x4*)p = v; }
struct Params { const float* in[25]; float* out; unsigned char* ws; int ph_lo, ph_hi; };

struct EpiGen {
    static constexpr bool PERM = true, AFTER_DRAIN = false;
    bf16_t* O; int ldc; int mode;
    __device__ __forceinline__ void operator()(const f32x4 (&acc)[2][2][4][2], const pg8::Unit& u, int wr, int wc, int fr, int fq) const {
        const int row0 = u.pm * 256 + wr * 64 + fr, cw = wc * 32 + 8 * fq;
        if (mode == 3) {
#pragma unroll
            for (int ai = 0; ai < 2; ++ai)
#pragma unroll
                for (int m = 0; m < 4; ++m) {
                    bf16_t* rowp = O + (size_t)(row0 + ai * 128 + m * 16) * ldc + 128 * u.pn + cw;
                    f32x4 g0 = acc[ai][0][m][0], g1 = acc[ai][0][m][1]; const f32x4 u0 = acc[ai][1][m][0], u1 = acc[ai][1][m][1];
#pragma unroll
                    for (int j = 0; j < 4; ++j) { g0[j] = silu_f(g0[j]); g1[j] = silu_f(g1[j]); }
                    const f32x4 v0 = g0 * u0, v1 = g1 * u1;
                    u32x4 w; w.x = pg8::cvt_pk_bf16(v0[0], v0[1]); w.y = pg8::cvt_pk_bf16(v0[2], v0[3]); w.z = pg8::cvt_pk_bf16(v1[0], v1[1]); w.w = pg8::cvt_pk_bf16(v1[2], v1[3]);
                    st16_wt(rowp, w);
                }
        } else if (mode == 2 && u.pn < 4) {
#pragma unroll
            for (int ai = 0; ai < 2; ++ai)
#pragma unroll
                for (int m = 0; m < 4; ++m) {
                    bf16_t* rowp = O + (size_t)(row0 + ai * 128 + m * 16) * ldc + 128 * u.pn + cw;
                    const f32x4 v0 = acc[ai][0][m][0] * acc[ai][1][m][0], v1 = acc[ai][0][m][1] * acc[ai][1][m][1];
                    u32x4 w; w.x = pg8::cvt_pk_bf16(v0[0], v0[1]); w.y = pg8::cvt_pk_bf16(v0[2], v0[3]); w.z = pg8::cvt_pk_bf16(v1[0], v1[1]); w.w = pg8::cvt_pk_bf16(v1[2], v1[3]);
                    st16_wt(rowp, w);
                }
        } else {
            const int colbase = (mode == 2) ? 512 + 256 * (u.pn - 4) : 256 * u.pn;
            if (mode == 1 && u.pn < 4) {
#pragma unroll
                for (int ai = 0; ai < 2; ++ai)
#pragma unroll
                    for (int m = 0; m < 4; ++m) {
                        bf16_t* rowp = O + (size_t)(row0 + ai * 128 + m * 16) * ldc + colbase + cw;
#pragma unroll
                        for (int bj = 0; bj < 2; ++bj) {
                            f32x4 v0 = acc[ai][bj][m][0], v1 = acc[ai][bj][m][1];
                            const pg8::f32x2 a = pg8::gelu_pk((pg8::f32x2){v0[0], v0[1]}), b = pg8::gelu_pk((pg8::f32x2){v0[2], v0[3]}), c = pg8::gelu_pk((pg8::f32x2){v1[0], v1[1]}), d = pg8::gelu_pk((pg8::f32x2){v1[2], v1[3]});
                            u32x4 w; w.x = pg8::cvt_pk_bf16(a.x, a.y); w.y = pg8::cvt_pk_bf16(b.x, b.y); w.z = pg8::cvt_pk_bf16(c.x, c.y); w.w = pg8::cvt_pk_bf16(d.x, d.y);
                            st16_wt(rowp + bj * 128, w);
                        }
                    }
            } else {
#pragma unroll
                for (int ai = 0; ai < 2; ++ai)
#pragma unroll
                    for (int m = 0; m < 4; ++m) {
                        bf16_t* rowp = O + (size_t)(row0 + ai * 128 + m * 16) * ldc + colbase + cw;
#pragma unroll
                        for (int bj = 0; bj < 2; ++bj) {
                            const f32x4 v0 = acc[ai][bj][m][0], v1 = acc[ai][bj][m][1];
                            u32x4 w; w.x = pg8::cvt_pk_bf16(v0[0], v0[1]); w.y = pg8::cvt_pk_bf16(v0[2], v0[3]); w.z = pg8::cvt_pk_bf16(v1[0], v1[1]); w.w = pg8::cvt_pk_bf16(v1[2], v1[3]);
                            st16_wt(rowp + bj * 128, w);
                        }
                    }
            }
        }
    }
};

DI void run_gemm(LAS unsigned char* lds, const bf16_t* A, const bf16_t* Bt, int M, int N, int K, bf16_t* O, int ldc, int mode, int G) {
#if PHMASK & 4
#ifndef STAG
#define STAG 0
#endif
    if (STAG && mode != 0) {
        const int d = ((int)blockIdx.x >> 3) & 3;
        for (int i = 0; i < d * STAG; ++i) __builtin_amdgcn_s_sleep(64);
    }
    pg8::Gemm g{A, Bt, M, N, K}; pg8::StaticOrder S; S.init(M, N, G, (int)blockIdx.x);
    EpiGen E{O, ldc, mode};
#ifndef G_ALIGN
#define G_ALIGN true
#endif
#ifndef G_SP2
#define G_SP2 true
#endif
    pg8::gemm_phase<EpiGen, pg8::StaticOrder, G_ALIGN, G_SP2>(lds, g, S, E);
#endif
}

DI int dest_row(int n0, int mode) {
    if (mode == 1) { const int half = n0 >= DFF ? 1 : 0, n = n0 - half * DFF; return 256 * (n >> 7) + 128 * half + (n & 127); }
    if (mode == 2) { if (n0 < 512) return 256 * (n0 >> 7) + (n0 & 127); if (n0 < 1024) return 1024 + (n0 - 512); if (n0 < 1536) { const int n = n0 - 1024; return 256 * (n >> 7) + 128 + (n & 127); } return n0; }
    return n0;
}
DI void transpose_item(const float* W, int K, int N, bf16_t* WT, int mode, LAS float* scr, int item, int lane) {
    const int nblk = N / 32, kb = item / nblk, nb = item % nblk, k0 = 64 * kb, n0 = 32 * nb;
#pragma unroll
    for (int i = 0; i < 32; ++i) { const int kk = 2 * i + (lane >> 5); scr[kk * 33 + (lane & 31)] = __builtin_nontemporal_load(W + (size_t)(k0 + kk) * N + n0 + (lane & 31)); }
    asm volatile("s_waitcnt lgkmcnt(0)" ::: "memory");
    const int c = lane & 7, dr = dest_row(n0, mode);
#pragma unroll
    for (int j = 0; j < 4; ++j) { const int n = (lane >> 3) + 8 * j; const LAS float* s = scr + (8 * c) * 33 + n;
        u32x4 o; o.x = pk2(s[0 * 33], s[1 * 33]); o.y = pk2(s[2 * 33], s[3 * 33]); o.z = pk2(s[4 * 33], s[5 * 33]); o.w = pk2(s[6 * 33], s[7 * 33]);
        *(u32x4*)(WT + (size_t)(dr + n) * K + k0 + 8 * c) = o; }
    asm volatile("s_waitcnt lgkmcnt(0)" ::: "memory");
}

DI void setup_phase(const Params& p, LAS unsigned char* lds, int G, int tid, int wid, int lane) {
    unsigned char* ws = p.ws;
    {
        LAS float* sc = (LAS float*)lds;
        LAS float* red = sc + 18 * 1024;
        for (int i = tid; i < 18 * 1024; i += NTHR) { const int b = i >> 10, k = i & 1023;
            const float c = (b < 2) ? p.in[2][b * 1024 + k] : p.in[3][(b - 2) * 1024 + k]; sc[i] = silu_f(c); }
        __syncthreads();
        for (int u = blockIdx.x; u < 288; u += G) {
            const int l = u / 144, cb = u % 144, col = cb * 64 + lane;
            float acc[18];
#pragma unroll
            for (int b = 0; b < 18; ++b) acc[b] = 0.f;
            const float* wp = p.in[4] + ((size_t)l * 1024 + wid * 128) * 9216 + col;
            const LAS f32x4* sc4 = (const LAS f32x4*)sc + wid * 32;
#pragma unroll 4
            for (int k4 = 0; k4 < 32; ++k4) {
                const float w0 = __builtin_nontemporal_load(wp + (size_t)(4 * k4) * 9216), w1 = __builtin_nontemporal_load(wp + (size_t)(4 * k4 + 1) * 9216), w2 = __builtin_nontemporal_load(wp + (size_t)(4 * k4 + 2) * 9216), w3 = __builtin_nontemporal_load(wp + (size_t)(4 * k4 + 3) * 9216);
#pragma unroll
                for (int b = 0; b < 18; ++b) { const f32x4 sv = sc4[b * 256 + k4]; acc[b] += (sv[0] * w0 + sv[1] * w1) + (sv[2] * w2 + sv[3] * w3); }
            }
#pragma unroll
            for (int b = 0; b < 18; ++b) red[(wid * 18 + b) * 64 + lane] = acc[b];
            __syncthreads();
            for (int i = tid; i < 18 * 64; i += NTHR) { const int b = i >> 6, c = i & 63; float sm = p.in[5][l * 9216 + cb * 64 + c];
#pragma unroll
                for (int w = 0; w < 8; ++w) sm += red[(w * 18 + b) * 64 + c];
                ((float*)(ws + WS_MOD))[((size_t)l * 18 + b) * 9216 + cb * 64 + c] = sm; }
            __syncthreads();
        }
    }
    {
        LAS float* scr = (LAS float*)(lds + wid * 16384);
        const int nskip = (G > 64 && 288 - G > 0 && 288 - G < G / 2) ? 288 - G : 0;
        const int gw = ((int)blockIdx.x - nskip) * 8 + wid, NGW = (G - nskip) * 8;
        constexpr int I_UP = 16 * 176, I_DN = 44 * 32, I_EI = 16 * 48, I_OI = 16 * 64, I_O = 16 * 32;
        constexpr int NITEMS = 4 * I_UP + 4 * I_DN + I_EI + I_OI + 2 * I_O;
        for (int it = gw; it < NITEMS && gw >= 0; it += NGW) {
            int r = it;
            if (r < 4 * I_UP) { const int i = r / I_UP; r -= i * I_UP; const int l = i >> 1, f = i & 1;
                transpose_item(p.in[f ? 10 : 8] + (size_t)l * 1024 * 5632, 1024, 5632, (bf16_t*)(ws + WS_WUP) + (size_t)i * 5632 * 1024, 1, scr, r, lane); continue; }
            r -= 4 * I_UP;
            if (r < 4 * I_DN) { const int i = r / I_DN; r -= i * I_DN; const int l = i >> 1, f = i & 1;
                transpose_item(p.in[f ? 11 : 9] + (size_t)l * 2816 * 1024, 2816, 1024, (bf16_t*)(ws + WS_WDN) + (size_t)i * 1024 * 2816, 0, scr, r, lane); continue; }
            r -= 4 * I_DN;
            if (r < I_EI) { transpose_item(p.in[12], 1024, 1536, (bf16_t*)(ws + WS_EVIN), 0, scr, r, lane); continue; }
            r -= I_EI;
            if (r < I_OI) { transpose_item(p.in[20], 1024, 2048, (bf16_t*)(ws + WS_ODIN), 2, scr, r, lane); continue; }
            r -= I_OI;
            if (r < I_O) { transpose_item(p.in[19], 1024, 1024, (bf16_t*)(ws + WS_EVOUT), 0, scr, r, lane); continue; }
            r -= I_O;
            transpose_item(p.in[24], 1024, 1024, (bf16_t*)(ws + WS_ODOUT), 0, scr, r, lane);
        }
    }
    {
        const int gt = blockIdx.x * NTHR + tid, NT = G * NTHR;
        bf16_t* WSP = (bf16_t*)(ws + WS_WSP); bf16_t* WPT = (bf16_t*)(ws + WS_WPT); bf16_t* WF = (bf16_t*)(ws + WS_WF);
        for (int i = gt; i < 65536; i += NT) {
            WSP[i] = (bf16_t)f2bf(p.in[15][i]);
            const int g = i >> 14, e = (i >> 7) & 127, d = i & 127;
            WPT[i] = (bf16_t)f2bf(p.in[17][(g * 128 + d) * 128 + e]);
        }
        {
            LAS float* tab = (LAS float*)(lds + 132 * 1024);
            if (tid < 128) { const float x = (float)tid * (1.0f / 64.0f); tab[tid] = cospif(x); tab[128 + tid] = sinpif(x); }
            __syncthreads();
            for (int i = gt; i < 131072; i += NT) {
                const int g = i >> 15, n = (i >> 7) & 255, d = i & 127, comp = n >> 7, e = n & 127;
                const float* fw = p.in[23] + (size_t)g * 16384 + e; const LAS float* tb = tab + comp * 128; float sm = 0.f;
#pragma unroll 8
                for (int m = 0; m < 128; ++m) sm += tb[(m * d) & 127] * fw[m * 128];
                WF[i] = (bf16_t)f2bf(sm * p.in[22][g * 128 + d]);
            }
        }
        bf16_t* FC1 = (bf16_t*)(ws + WS_FC1); bf16_t* FS1 = (bf16_t*)(ws + WS_FS1); bf16_t* FC2 = (bf16_t*)(ws + WS_FC2); bf16_t* FS2 = (bf16_t*)(ws + WS_FS2);
        f32x2* TW128 = (f32x2*)(ws + WS_TW128);
        for (int i = gt; i < 16384; i += NT) {
            const int k1 = i >> 7, col = i & 127, s = col >> 5, j = col & 31, fqq = j >> 3, ii = j & 7;
            const int r = 32 * s + (ii < 4 ? fqq * 4 + ii : 16 + fqq * 4 + ii - 4);
            const float x = (float)((k1 * r) & 127) * (1.0f / 64.0f);
            FC1[i] = (bf16_t)f2bf(cospif(x)); FS1[i] = (bf16_t)f2bf(sinpif(x));
            const float y = (float)((k1 * col) & 127) * (1.0f / 64.0f);
            FC2[i] = (bf16_t)f2bf(cospif(y)); FS2[i] = (bf16_t)f2bf(sinpif(y));
            const float z = (float)(k1 * col) * (1.0f / 8192.0f);
            TW128[i] = (f32x2){cospif(z), sinpif(z)};
        }
        bf16_t* FC16 = (bf16_t*)(ws + WS_FC16); bf16_t* FS16 = (bf16_t*)(ws + WS_FS16);
        for (int i = gt; i < 512; i += NT) {
            const int k1 = i >> 5, j = i & 31, fqq = j >> 3, ii = j & 7;
            float c = 0.f, s = 0.f;
            if (ii < 4) { const int r = fqq * 4 + ii; const float x = (float)((k1 * r) & 15) * (1.0f / 8.0f); c = cospif(x); s = sinpif(x); }
            FC16[i] = (bf16_t)f2bf(c); FS16[i] = (bf16_t)f2bf(s);
        }
        f32x2* TW16 = (f32x2*)(ws + WS_TW16);
        for (int i = gt; i < 2048; i += NT) { const int q = i >> 4, k1 = i & 15; const float z = (float)(k1 * q) * (1.0f / 1024.0f); TW16[i] = (f32x2){cospif(z), sinpif(z)}; }
    }
}

DI void modreduce_phase(const Params& p, int G, int tid) {
    const float* mp = (const float*)(p.ws + WS_MODP); float* mod = (float*)(p.ws + WS_MOD);
    for (int i = blockIdx.x * NTHR + tid; i < 2 * 18 * 9216; i += G * NTHR) {
        const int l = i / (18 * 9216), j = i % 9216;
        float s = p.in[5][l * 9216 + j];
#pragma unroll
        for (int ks = 0; ks < 4; ++ks) s += mp[(size_t)ks * (2 * 18 * 9216) + i];
        mod[i] = s;
    }
}

typedef _Float16 h16x4 __attribute__((ext_vector_type(4)));
typedef _Float16 h16x8 __attribute__((ext_vector_type(8)));
template <bool IN32, bool PREV, bool NEXT, bool OUT32>
DI void norm_phase_t(const float* xin32, const _Float16* xin16, float* xout32, _Float16* xout16, const bf16_t* T, bf16_t* H,
                     const float* gate_base, const float* gpost, float rw, const float* ss_base, const float* gpre, int gi, int G, int wid, int lane) {
    const bool teamed = (G == 256);
    const int bx = (int)blockIdx.x & 7, bj = (int)blockIdx.x >> 3;
    const int nh = teamed ? 2 : (GROWS + G * 8 - 1) / (G * 8), rows_h = teamed ? 8 : 1;
    for (int hh = 0; hh < nh; ++hh) {
        const int r0 = teamed ? 256 * (16 * bx + 8 * hh + (bj & 7)) + 64 * (bj >> 3) + wid : (int)blockIdx.x * 8 + wid + hh * G * 8;
        if (r0 >= GROWS) break;
        const int bidx = (gi == 0) ? (r0 >> 14) : 2 + (r0 >> 11);
        f32x4 gpv[4], gtv[4], shv[4], scv[4], gnv[4];
        if (PREV) { const f32x4* gp = (const f32x4*)gpost + 2 * lane; const f32x4* gt = (const f32x4*)(gate_base + (size_t)bidx * 9216) + 2 * lane;
#pragma unroll
            for (int j = 0; j < 4; ++j) { const int o = 128 * (j >> 1) + (j & 1); gpv[j] = gp[o] * rw; gtv[j] = gt[o] + 1.0f; gpv[j] = gpv[j] * gtv[j]; } }
        if (NEXT) { const f32x4* gp = (const f32x4*)gpre + 2 * lane; const f32x4* sh = (const f32x4*)(ss_base + (size_t)bidx * 9216) + 2 * lane; const f32x4* sc = sh + 256;
#pragma unroll
            for (int j = 0; j < 4; ++j) { const int o = 128 * (j >> 1) + (j & 1); gnv[j] = gp[o] * (sc[o] + 1.0f); shv[j] = sh[o]; } }
#pragma unroll 2
        for (int i = 0; i < rows_h; ++i) {
            const int r = r0 + 8 * i;
            f32x4 v[4]; u32x4 tw[2];
            if (IN32) { const f32x4* xr = (const f32x4*)(xin32 + (size_t)r * D) + 2 * lane;
#pragma unroll
                for (int j = 0; j < 2; ++j) { v[2 * j] = xr[128 * j]; v[2 * j + 1] = xr[128 * j + 1]; } }
            else { const h16x8* xr = (const h16x8*)(xin16 + (size_t)r * D) + lane; h16x8 hv[2];
#pragma unroll
                for (int j = 0; j < 2; ++j) hv[j] = __builtin_nontemporal_load(xr + 64 * j);
                if (PREV) { const u32x4* tr = (const u32x4*)(T + (size_t)r * D) + lane;
#pragma unroll
                    for (int j = 0; j < 2; ++j) tw[j] = __builtin_nontemporal_load(tr + 64 * j); }
#pragma unroll
                for (int j = 0; j < 2; ++j) { v[2 * j] = (f32x4){(float)hv[j][0], (float)hv[j][1], (float)hv[j][2], (float)hv[j][3]}; v[2 * j + 1] = (f32x4){(float)hv[j][4], (float)hv[j][5], (float)hv[j][6], (float)hv[j][7]}; } }
            if (PREV) {
                if (IN32) { const u32x4* tr = (const u32x4*)(T + (size_t)r * D) + lane;
#pragma unroll
                    for (int j = 0; j < 2; ++j) tw[j] = __builtin_nontemporal_load(tr + 64 * j); }
                f32x4 tv[4]; float ss = 0.f;
#pragma unroll
                for (int j = 0; j < 2; ++j) { const u32x4 w = tw[j];
                    tv[2 * j] = (f32x4){bf_lo(w.x), bf_hi(w.x), bf_lo(w.y), bf_hi(w.y)}; tv[2 * j + 1] = (f32x4){bf_lo(w.z), bf_hi(w.z), bf_lo(w.w), bf_hi(w.w)}; }
#pragma unroll
                for (int j = 0; j < 4; ++j) ss += (tv[j][0] * tv[j][0] + tv[j][1] * tv[j][1]) + (tv[j][2] * tv[j][2] + tv[j][3] * tv[j][3]);
                const float rstd = rsqrtf(wave_sum(ss) * (1.0f / D) + 1e-6f);
#pragma unroll
                for (int j = 0; j < 4; ++j) v[j] = v[j] + (tv[j] * rstd) * gpv[j];
                if (OUT32) { f32x4* xo = (f32x4*)(xout32 + (size_t)r * D) + 2 * lane;
#pragma unroll
                    for (int j = 0; j < 4; ++j) __builtin_nontemporal_store(v[j], xo + 128 * (j >> 1) + (j & 1)); }
                else { h16x8* xo = (h16x8*)(xout16 + (size_t)r * D) + lane;
#pragma unroll
                    for (int j = 0; j < 2; ++j) { h16x8 hv;
#pragma unroll
                        for (int k = 0; k < 4; ++k) { hv[k] = (_Float16)v[2 * j][k]; hv[4 + k] = (_Float16)v[2 * j + 1][k]; }
                        __builtin_nontemporal_store(hv, xo + 64 * j);
#pragma unroll
                        for (int k = 0; k < 4; ++k) { v[2 * j][k] = (float)hv[k]; v[2 * j + 1][k] = (float)hv[4 + k]; } } }
            }
            if (NEXT) {
                float ss = 0.f;
#pragma unroll
                for (int j = 0; j < 4; ++j) ss += (v[j][0] * v[j][0] + v[j][1] * v[j][1]) + (v[j][2] * v[j][2] + v[j][3] * v[j][3]);
                const float rstd = rsqrtf(wave_sum(ss) * (1.0f / D) + 1e-6f);
                u32x4* ho = (u32x4*)(H + (size_t)r * D) + lane;
#pragma unroll
                for (int j = 0; j < 2; ++j) { const f32x4 h0 = (v[2 * j] * rstd) * gnv[2 * j] + shv[2 * j], h1 = (v[2 * j + 1] * rstd) * gnv[2 * j + 1] + shv[2 * j + 1];
                    u32x4 w; w.x = pk2(h0[0], h0[1]); w.y = pk2(h0[2], h0[3]); w.z = pk2(h1[0], h1[1]); w.w = pk2(h1[2], h1[3]); st16_wt(ho + 64 * j, w); }
            }
        }
    }
}
DI void norm_phase(const float* xin32, const _Float16* xin16, float* xout32, _Float16* xout16, const bf16_t* T, bf16_t* H, bool has_prev, bool has_next,
                   const float* gate_base, const float* gpost, float rw, const float* ss_base, const float* gpre, int gi, int G, int wid, int lane) {
    if (!has_prev)        norm_phase_t<true, false, true, false>(xin32, xin16, xout32, xout16, T, H, gate_base, gpost, rw, ss_base, gpre, gi, G, wid, lane);
    else if (xin32)       norm_phase_t<true, true, true, false>(xin32, xin16, xout32, xout16, T, H, gate_base, gpost, rw, ss_base, gpre, gi, G, wid, lane);
    else if (has_next)    norm_phase_t<false, true, true, false>(xin32, xin16, xout32, xout16, T, H, gate_base, gpost, rw, ss_base, gpre, gi, G, wid, lane);
    else                  norm_phase_t<false, true, false, true>(xin32, xin16, xout32, xout16, T, H, gate_base, gpost, rw, ss_base, gpre, gi, G, wid, lane);
}

template <int GI>
DI void pool_group(const bf16_t* PR, bf16_t* YY, const bf16_t* WPT, const float* pool_scale, size_t tok0, int tl, int pos, int S, int fr, int fq) {
    constexpr int hw = 1 << GI, g = GI;
    const int lo = max(pos - hw, 0), hi = min(pos + hw, S); const float inv = 1.0f / (float)(hi - lo);
    f32x4 acc[8];
#pragma unroll
    for (int e = 0; e < 8; ++e) acc[e] = (f32x4){0.f, 0.f, 0.f, 0.f};
#pragma unroll 1
    for (int ks = 0; ks < 4; ++ks) {
        const bf16_t* zc = PR + (tok0 + tl) * PRP + 1024 + g * 128 + ks * 32 + fq * 8;
        u32x4 w[2 * hw];
#pragma unroll
        for (int j = 0; j < 2 * hw; ++j) { const int t2 = pos + j - hw; const bool ok = (t2 >= 0) && (t2 < S); w[j] = (u32x4){0u, 0u, 0u, 0u}; if (ok) w[j] = *(const u32x4*)(zc + (ptrdiff_t)(j - hw) * PRP); }
        bf16x8 wf[8];
#pragma unroll
        for (int et = 0; et < 8; ++et) wf[et] = *(const bf16x8*)(WPT + ((g * 128 + et * 16 + fr) * 128 + ks * 32 + fq * 8));
        f32x4 s0 = (f32x4){0.f, 0.f, 0.f, 0.f}, s1 = s0;
#pragma unroll
        for (int j = 0; j < 2 * hw; ++j) { s0 += (f32x4){bf_lo(w[j].x), bf_hi(w[j].x), bf_lo(w[j].y), bf_hi(w[j].y)}; s1 += (f32x4){bf_lo(w[j].z), bf_hi(w[j].z), bf_lo(w[j].w), bf_hi(w[j].w)}; }
        const u32x4 cw = w[hw];
        s0 = s0 * inv - (f32x4){bf_lo(cw.x), bf_hi(cw.x), bf_lo(cw.y), bf_hi(cw.y)}; s1 = s1 * inv - (f32x4){bf_lo(cw.z), bf_hi(cw.z), bf_lo(cw.w), bf_hi(cw.w)};
        u32x4 dw; dw.x = pk2(s0[0], s0[1]); dw.y = pk2(s0[2], s0[3]); dw.z = pk2(s1[0], s1[1]); dw.w = pk2(s1[2], s1[3]);
        const bf16x8 df = __builtin_bit_cast(bf16x8, dw);
#pragma unroll
        for (int et = 0; et < 8; ++et) acc[et] = mfma16(wf[et], df, acc[et]);
    }
#pragma unroll
    for (int et = 0; et < 8; ++et) { const int e = g * 128 + et * 16 + fq * 4; const f32x4 ps = *(const f32x4*)(pool_scale + e); const f32x4 y = acc[et] * ps;
        u32x2 o; o.x = pk2(y[0], y[1]); o.y = pk2(y[2], y[3]); *(u32x2*)(YY + (tok0 + tl) * 1024 + 512 + e) = o; }
}

constexpr int PL_ZOFF = 0, PL_WOFF = 144 * 272, PL_PITCH = 272;
struct PoolStage { u32x4 z[5]; u32x4 w[4]; };
DI void pool_stage_load(PoolStage& ps, const bf16_t* PR, const bf16_t* WPT, size_t tok0, int pos0, int S, int g, int tid) {
#pragma unroll
    for (int i = 0; i < 5; ++i) { const int idx = tid + NTHR * i, row = idx >> 4, c = idx & 15; const int p = pos0 - 8 + row;
        ps.z[i] = (u32x4){0u, 0u, 0u, 0u};
        if (idx < 144 * 16 && p >= 0 && p < S) ps.z[i] = *(const u32x4*)(PR + (size_t)((ptrdiff_t)tok0 - 8 + row) * PRP + 1024 + g * 128 + c * 8); }
#pragma unroll
    for (int i = 0; i < 4; ++i) { const int idx = tid + NTHR * i; ps.w[i] = *(const u32x4*)(WPT + (g * 128 + (idx >> 4)) * 128 + (idx & 15) * 8); }
}
DI void pool_stage_store(const PoolStage& ps, LAS unsigned char* lds, int tid) {
#pragma unroll
    for (int i = 0; i < 5; ++i) { const int idx = tid + NTHR * i; if (idx < 144 * 16) *(LAS u32x4*)(lds + PL_ZOFF + (idx >> 4) * PL_PITCH + (idx & 15) * 16) = ps.z[i]; }
#pragma unroll
    for (int i = 0; i < 4; ++i) { const int idx = tid + NTHR * i; *(LAS u32x4*)(lds + PL_WOFF + (idx >> 4) * PL_PITCH + (idx & 15) * 16) = ps.w[i]; }
}
template <int GI>
DI void pool_compute(LAS unsigned char* lds, bf16_t* YY, const float* pool_scale, size_t tok0, int tl, int pos, int S, int fr, int fq) {
    constexpr int hw = 1 << GI, g = GI;
    const int lo = max(pos - hw, 0), hi = min(pos + hw, S); const float inv = 1.0f / (float)(hi - lo);
    f32x4 acc[8];
#pragma unroll
    for (int e = 0; e < 8; ++e) acc[e] = (f32x4){0.f, 0.f, 0.f, 0.f};
#pragma unroll 2
    for (int ks = 0; ks < 4; ++ks) {
        const LAS unsigned char* zb = lds + PL_ZOFF + (tl + 8) * PL_PITCH + (ks * 32 + fq * 8) * 2;
        f32x4 s0 = (f32x4){0.f, 0.f, 0.f, 0.f}, s1 = s0;
#pragma unroll
        for (int j = -hw; j < hw; ++j) { const u32x4 x = *(const LAS u32x4*)(zb + j * PL_PITCH);
            s0 += (f32x4){bf_lo(x.x), bf_hi(x.x), bf_lo(x.y), bf_hi(x.y)}; s1 += (f32x4){bf_lo(x.z), bf_hi(x.z), bf_lo(x.w), bf_hi(x.w)}; }
        const u32x4 cw = *(const LAS u32x4*)zb;
        s0 = s0 * inv - (f32x4){bf_lo(cw.x), bf_hi(cw.x), bf_lo(cw.y), bf_hi(cw.y)}; s1 = s1 * inv - (f32x4){bf_lo(cw.z), bf_hi(cw.z), bf_lo(cw.w), bf_hi(cw.w)};
        u32x4 dw; dw.x = pk2(s0[0], s0[1]); dw.y = pk2(s0[2], s0[3]); dw.z = pk2(s1[0], s1[1]); dw.w = pk2(s1[2], s1[3]);
        const bf16x8 df = __builtin_bit_cast(bf16x8, dw);
#pragma unroll
        for (int et = 0; et < 8; ++et) { const bf16x8 wf = *(const LAS bf16x8*)(lds + PL_WOFF + (et * 16 + fr) * PL_PITCH + (ks * 32 + fq * 8) * 2); acc[et] = mfma16(wf, df, acc[et]); }
    }
#pragma unroll
    for (int et = 0; et < 8; ++et) { const int e = g * 128 + et * 16 + fq * 4; const f32x4 ps = *(const f32x4*)(pool_scale + e); const f32x4 y = acc[et] * ps;
        u32x2 o; o.x = pk2(y[0], y[1]); o.y = pk2(y[2], y[3]); *(u32x2*)(YY + (tok0 + tl) * 1024 + 512 + e) = o; }
}

DI void even_core(LAS unsigned char* lds, const bf16_t* PR, bf16_t* YY, const bf16_t* WSP, const bf16_t* WPT, const float* ln_g, const float* ln_b,
                  const float* b_sp, const float* pool_scale, int S, int G, int tid, int wid, int lane) {
    const int fr = lane & 15, fq = lane >> 4;
    constexpr int PITCH = 1056;
    for (int ch0 = blockIdx.x; ch0 < GROWS / 128; ch0 += G) {
        const int ch = (G == 256) ? 2 * (16 * (ch0 & 7) + 8 * (ch0 >> 7) + ((ch0 >> 3) & 7)) + ((ch0 >> 6) & 1) : ch0;
        const size_t tok0 = (size_t)ch * 128;
        {
            const f32x4 g0 = *(const f32x4*)(ln_g + lane * 8), g1 = *(const f32x4*)(ln_g + lane * 8 + 4), b0 = *(const f32x4*)(ln_b + lane * 8), b1 = *(const f32x4*)(ln_b + lane * 8 + 4);
#pragma unroll 8
            for (int i = 0; i < 16; ++i) {
                const int q = wid * 16 + i;
                const u32x4 w = *(const u32x4*)(PR + (tok0 + q) * PRP + 512 + lane * 8);
                f32x4 a = (f32x4){bf_lo(w.x), bf_hi(w.x), bf_lo(w.y), bf_hi(w.y)}, b = (f32x4){bf_lo(w.z), bf_hi(w.z), bf_lo(w.w), bf_hi(w.w)};
                const float mean = wave_sum((a[0] + a[1]) + (a[2] + a[3]) + (b[0] + b[1]) + (b[2] + b[3])) * (1.0f / 512.0f);
                a = a - mean; b = b - mean;
                const float var = wave_sum((a[0] * a[0] + a[1] * a[1]) + (a[2] * a[2] + a[3] * a[3]) + (b[0] * b[0] + b[1] * b[1]) + (b[2] * b[2] + b[3] * b[3])) * (1.0f / 512.0f);
                const float rstd = rsqrtf(var + 1e-5f);
                a = a * rstd * g0 + b0; b = b * rstd * g1 + b1;
                u32x4 o; o.x = pk2(a[0], a[1]); o.y = pk2(a[2], a[3]); o.z = pk2(b[0], b[1]); o.w = pk2(b[2], b[3]);
                *(LAS u32x4*)(lds + q * PITCH + lane * 16) = o;
            }
        }
        __syncthreads();
        {
            const int h = wid >> 1, cw0 = wid * 64;
            for (int ph = 0; ph < 2; ++ph) {
                f32x4 acc[4][4];
#pragma unroll
                for (int a = 0; a < 4; ++a)
#pragma unroll
                    for (int b = 0; b < 4; ++b) acc[a][b] = (f32x4){0.f, 0.f, 0.f, 0.f};
#pragma unroll 1
                for (int kp = 0; kp < 2; ++kp) {
                    bf16x8 bw[2][4];
#pragma unroll
                    for (int k2 = 0; k2 < 2; ++k2)
#pragma unroll
                        for (int pt = 0; pt < 4; ++pt) bw[k2][pt] = *(const bf16x8*)(WSP + ((h * 128 + (ph * 4 + pt) * 16 + fr) * 128 + (kp * 2 + k2) * 32 + fq * 8));
#pragma unroll
                    for (int k2 = 0; k2 < 2; ++k2) {
                        const int ks = kp * 2 + k2;
                        bf16x8 af[4];
#pragma unroll
                        for (int ct = 0; ct < 4; ++ct) af[ct] = tr_frag(lds + (ks * 32 + fq * 8 + (fr >> 2)) * PITCH + (cw0 + ct * 16 + 4 * (fr & 3)) * 2, 4 * PITCH);
#pragma unroll
                        for (int ct = 0; ct < 4; ++ct)
#pragma unroll
                            for (int pt = 0; pt < 4; ++pt) acc[ct][pt] = mfma16(af[ct], bw[k2][pt], acc[ct][pt]);
                    }
                }
#pragma unroll
                for (int pt = 0; pt < 4; ++pt) {
                    const int pp = (ph * 4 + pt) * 16 + fr; const float bs = b_sp[h * 128 + pp];
#pragma unroll
                    for (int ct = 0; ct < 4; ++ct) {
                        const int c = cw0 + ct * 16 + fq * 4;
                        const u32x2 uw = *(const u32x2*)(PR + (tok0 + pp) * PRP + c);
                        u32x2 o; o.x = pk2(bf_lo(uw.x) * (acc[ct][pt][0] + bs), bf_hi(uw.x) * (acc[ct][pt][1] + bs)); o.y = pk2(bf_lo(uw.y) * (acc[ct][pt][2] + bs), bf_hi(uw.y) * (acc[ct][pt][3] + bs));
                        *(u32x2*)(YY + (tok0 + pp) * 1024 + c) = o;
                    }
                }
            }
        }
        {
            const int tl = wid * 16 + fr; const int pos = (int)(tok0 % (size_t)S) + tl;
            const int pos0 = (int)(tok0 % (size_t)S);
            PoolStage ps;
            pool_stage_load(ps, PR, WPT, tok0, pos0, S, 0, tid);
            __syncthreads();
            pool_stage_store(ps, lds, tid); pool_stage_load(ps, PR, WPT, tok0, pos0, S, 1, tid);
            __syncthreads();
            pool_compute<0>(lds, YY, pool_scale, tok0, tl, pos, S, fr, fq);
            __syncthreads();
            pool_stage_store(ps, lds, tid); pool_stage_load(ps, PR, WPT, tok0, pos0, S, 2, tid);
            __syncthreads();
            pool_compute<1>(lds, YY, pool_scale, tok0, tl, pos, S, fr, fq);
            __syncthreads();
            pool_stage_store(ps, lds, tid); pool_stage_load(ps, PR, WPT, tok0, pos0, S, 3, tid);
            __syncthreads();
            pool_compute<2>(lds, YY, pool_scale, tok0, tl, pos, S, fr, fq);
            __syncthreads();
            pool_stage_store(ps, lds, tid);
            __syncthreads();
            pool_compute<3>(lds, YY, pool_scale, tok0, tl, pos, S, fr, fq);
        }
        __syncthreads();
    }
}

DI void conv_part(const bf16_t* PR, bf16_t* YY, const float* conv_w, int S, int G, int wid, int lane) {
    const int gw = blockIdx.x * 8 + wid, NGW = G * 8;
    f32x4 w[3][2];
#pragma unroll
    for (int k = 0; k < 3; ++k) { w[k][0] = *(const f32x4*)(conv_w + k * 512 + lane * 8); w[k][1] = *(const f32x4*)(conv_w + k * 512 + lane * 8 + 4); }
#pragma unroll 4
    for (int r = gw; r < GROWS; r += NGW) {
        const int pos = r % S;
        const bf16_t* cz = PR + (size_t)r * PRP + lane * 8;
        const float m0 = (pos > 0) ? 1.0f : 0.0f, m2 = (pos < S - 1) ? 1.0f : 0.0f;
        const u32x4 c1 = *(const u32x4*)cz, c0 = *(const u32x4*)(cz - (pos > 0 ? PRP : 0)), c2 = *(const u32x4*)(cz + (pos < S - 1 ? PRP : 0)), bg = *(const u32x4*)(cz + 512);
        const f32x4 w00 = w[0][0] * m0, w01 = w[0][1] * m0, w20 = w[2][0] * m2, w21 = w[2][1] * m2;
        f32x4 a0 = (f32x4){bf_lo(c0.x), bf_hi(c0.x), bf_lo(c0.y), bf_hi(c0.y)} * w00 + (f32x4){bf_lo(c1.x), bf_hi(c1.x), bf_lo(c1.y), bf_hi(c1.y)} * w[1][0] + (f32x4){bf_lo(c2.x), bf_hi(c2.x), bf_lo(c2.y), bf_hi(c2.y)} * w20;
        f32x4 a1 = (f32x4){bf_lo(c0.z), bf_hi(c0.z), bf_lo(c0.w), bf_hi(c0.w)} * w01 + (f32x4){bf_lo(c1.z), bf_hi(c1.z), bf_lo(c1.w), bf_hi(c1.w)} * w[1][1] + (f32x4){bf_lo(c2.z), bf_hi(c2.z), bf_lo(c2.w), bf_hi(c2.w)} * w21;
        a0 = a0 * (f32x4){bf_lo(bg.x), bf_hi(bg.x), bf_lo(bg.y), bf_hi(bg.y)}; a1 = a1 * (f32x4){bf_lo(bg.z), bf_hi(bg.z), bf_lo(bg.w), bf_hi(bg.w)};
        u32x4 o; o.x = pk2(a0[0], a0[1]); o.y = pk2(a0[2], a0[3]); o.z = pk2(a1[0], a1[1]); o.w = pk2(a1[2], a1[3]);
        *(u32x4*)(YY + (size_t)r * 1024 + lane * 8) = o;
    }
}

template <int R, int QB>
DI void four_stage1(const bf16_t* PR, bf16_t* UB, const bf16_t* WF, const bf16_t* FCp, const bf16_t* FSp, const f32x2* TW, int nb, int G, int wid, int lane) {
    constexpr int NT = R / 16, KS = (R + 31) / 32, KW = KS * 32, S = R * 128, NQB = 128 / QB;
    const int fr = lane & 15, fq = lane >> 4, e0 = wid * 16;
    const int nunits = nb * 4 * NQB;
    for (int un = blockIdx.x; un < nunits; un += G) {
        const int q0 = (un % NQB) * QB, g = (un / NQB) & 3, b = un / (4 * NQB);
        bf16x8 wP[4], wQ[4];
#pragma unroll
        for (int ks = 0; ks < 4; ++ks) { wP[ks] = *(const bf16x8*)(WF + ((g * 256 + e0 + fr) * 128 + ks * 32 + fq * 8)); wQ[ks] = *(const bf16x8*)(WF + ((g * 256 + 128 + e0 + fr) * 128 + ks * 32 + fq * 8)); }
        unsigned pP[QB][NT][2], pQ[QB][NT][2];
#pragma unroll
        for (int rt = 0; rt < NT; ++rt) {
#pragma unroll
            for (int qi = 0; qi < QB; ++qi) {
                const size_t tok = (size_t)b * S + 128 * (rt * 16 + fr) + q0 + qi;
                const bf16_t* zp = PR + tok * PRP + 1024 + g * 128 + fq * 8;
                bf16x8 a[4]; float ss = 0.f;
#pragma unroll
                for (int ks = 0; ks < 4; ++ks) a[ks] = *(const bf16x8*)(zp + ks * 32);
#pragma unroll
                for (int ks = 0; ks < 4; ++ks)
#pragma unroll
                    for (int k = 0; k < 8; ++k) { const float f = __uint_as_float(((unsigned)(unsigned short)a[ks][k]) << 16); ss += f * f; }
                ss += __shfl_xor(ss, 16); ss += __shfl_xor(ss, 32);
                const float rs = rsqrtf(ss * (1.0f / 128.0f) + 1e-6f);
                f32x4 dP = (f32x4){0.f, 0.f, 0.f, 0.f}, dQ = dP;
#pragma unroll
                for (int ks = 0; ks < 4; ++ks) { dP = mfma16(a[ks], wP[ks], dP); dQ = mfma16(a[ks], wQ[ks], dQ); }
#pragma unroll
                for (int j = 0; j < 4; ++j) { const float sj = __shfl(rs, fq * 4 + j); dP[j] *= sj; dQ[j] *= sj; }
                pP[qi][rt][0] = pk2(dP[0], dP[1]); pP[qi][rt][1] = pk2(dP[2], dP[3]); pQ[qi][rt][0] = pk2(dQ[0], dQ[1]); pQ[qi][rt][1] = pk2(dQ[2], dQ[3]);
            }
            if ((rt & 3) == 3) asm volatile("" ::: "memory");
        }
#pragma unroll 2
        for (int k1t = 0; k1t < NT; ++k1t) {
            bf16x8 aC[KS], aS[KS];
#pragma unroll
            for (int s = 0; s < KS; ++s) { aC[s] = *(const bf16x8*)(FCp + ((k1t * 16 + fr) * KW + s * 32 + fq * 8)); aS[s] = *(const bf16x8*)(FSp + ((k1t * 16 + fr) * KW + s * 32 + fq * 8)); }
#pragma unroll
            for (int qi = 0; qi < QB; ++qi) {
                f32x4 Ur = (f32x4){0.f, 0.f, 0.f, 0.f}, V = Ur;
#pragma unroll
                for (int s = 0; s < KS; ++s) {
                    u32x4 bp, bq;
                    bp.x = pP[qi][2 * s][0]; bp.y = pP[qi][2 * s][1]; bq.x = pQ[qi][2 * s][0]; bq.y = pQ[qi][2 * s][1];
                    if (2 * s + 1 < NT) { bp.z = pP[qi][(2 * s + 1) % NT][0]; bp.w = pP[qi][(2 * s + 1) % NT][1]; bq.z = pQ[qi][(2 * s + 1) % NT][0]; bq.w = pQ[qi][(2 * s + 1) % NT][1]; }
                    else { bp.z = 0u; bp.w = 0u; bq.z = 0u; bq.w = 0u; }
                    const u32x4 bnq = bq ^ 0x80008000u;
                    const bf16x8 BP = __builtin_bit_cast(bf16x8, bp), BQ = __builtin_bit_cast(bf16x8, bq), BNQ = __builtin_bit_cast(bf16x8, bnq);
                    Ur = mfma16(aC[s], BP, Ur); Ur = mfma16(aS[s], BNQ, Ur); V = mfma16(aS[s], BP, V); V = mfma16(aC[s], BQ, V);
                }
                const int q = q0 + qi;
#pragma unroll
                for (int j = 0; j < 4; ++j) {
                    const int k1 = k1t * 16 + fq * 4 + j; const f32x2 tw = TW[q * R + k1];
                    const float upr = Ur[j] * tw.x - V[j] * tw.y, upi = -(V[j] * tw.x + Ur[j] * tw.y);
                    bf16_t* o = UB + ((((size_t)b * R + k1) * 2) * 128 + q) * 512 + g * 128 + e0 + fr;
                    o[0] = (bf16_t)f2bf(upr); o[(size_t)128 * 512] = (bf16_t)f2bf(upi);
                }
            }
        }
    }
}

DI void four_stage1_p(LAS unsigned char* lds, const bf16_t* PR, bf16_t* UB, const bf16_t* WF, const bf16_t* FCp, const bf16_t* FSp, const f32x2* TW, int nb, int G, int tid, int wid, int lane) {
    constexpr int R = 128, S = R * 128, PT = 272, TC_OFF = 0, TS_OFF = 128 * PT, Z_OFF = 256 * PT, TW_OFF = 384 * PT;
    const int fr = lane & 15, fq = lane >> 4, e0 = wid * 16;
    const int nunits = nb * 4 * 128;
    {
#pragma unroll
        for (int i = 0; i < 4; ++i) { const int idx = tid + NTHR * i; const u32x4 c = *(const u32x4*)(FCp + (idx >> 4) * 128 + (idx & 15) * 8), sn = *(const u32x4*)(FSp + (idx >> 4) * 128 + (idx & 15) * 8);
            *(LAS u32x4*)(lds + TC_OFF + (idx >> 4) * PT + (idx & 15) * 16) = c; *(LAS u32x4*)(lds + TS_OFF + (idx >> 4) * PT + (idx & 15) * 16) = sn; }
    }
    u32x4 zr[4]; u32x4 twr = (u32x4){0u, 0u, 0u, 0u};
    int un = blockIdx.x;
    if (un < nunits) { const int q = un & 127, g = (un >> 7) & 3, b = un >> 9;
#pragma unroll
        for (int i = 0; i < 4; ++i) { const int idx = tid + NTHR * i; zr[i] = *(const u32x4*)(PR + ((size_t)b * S + 128 * (idx >> 4) + q) * PRP + 1024 + g * 128 + (idx & 15) * 8); }
        if (tid < 64) twr = *(const u32x4*)((const float*)(TW + q * R) + tid * 4); }
    for (; un < nunits; un += G) {
        const int q = un & 127, g = (un >> 7) & 3, b = un >> 9;
        bf16x8 wP[4], wQ[4];
#pragma unroll
        for (int ks = 0; ks < 4; ++ks) { wP[ks] = *(const bf16x8*)(WF + ((g * 256 + e0 + fr) * 128 + ks * 32 + fq * 8)); wQ[ks] = *(const bf16x8*)(WF + ((g * 256 + 128 + e0 + fr) * 128 + ks * 32 + fq * 8)); }
        __syncthreads();
#pragma unroll
        for (int i = 0; i < 4; ++i) { const int idx = tid + NTHR * i; *(LAS u32x4*)(lds + Z_OFF + (idx >> 4) * PT + (idx & 15) * 16) = zr[i]; }
        if (tid < 64) *(LAS u32x4*)(lds + TW_OFF + tid * 16) = twr;
        { const int un2 = un + G;
          if (un2 < nunits) { const int q2 = un2 & 127, g2 = (un2 >> 7) & 3, b2 = un2 >> 9;
#pragma unroll
            for (int i = 0; i < 4; ++i) { const int idx = tid + NTHR * i; zr[i] = *(const u32x4*)(PR + ((size_t)b2 * S + 128 * (idx >> 4) + q2) * PRP + 1024 + g2 * 128 + (idx & 15) * 8); }
            if (tid < 64) twr = *(const u32x4*)((const float*)(TW + q2 * R) + tid * 4); } }
        __syncthreads();
        unsigned pP[8][2], pQ[8][2];
#pragma unroll
        for (int rt = 0; rt < 8; ++rt) {
            bf16x8 a[4]; float ss = 0.f;
#pragma unroll
            for (int ks = 0; ks < 4; ++ks) a[ks] = *(const LAS bf16x8*)(lds + Z_OFF + (rt * 16 + fr) * PT + (ks * 32 + fq * 8) * 2);
#pragma unroll
            for (int ks = 0; ks < 4; ++ks)
#pragma unroll
                for (int k = 0; k < 8; ++k) { const float f = __uint_as_float(((unsigned)(unsigned short)a[ks][k]) << 16); ss += f * f; }
            ss += __shfl_xor(ss, 16); ss += __shfl_xor(ss, 32);
            const float rs = rsqrtf(ss * (1.0f / 128.0f) + 1e-6f);
            f32x4 dP = (f32x4){0.f, 0.f, 0.f, 0.f}, dQ = dP;
#pragma unroll
            for (int ks = 0; ks < 4; ++ks) { dP = mfma16(a[ks], wP[ks], dP); dQ = mfma16(a[ks], wQ[ks], dQ); }
#pragma unroll
            for (int j = 0; j < 4; ++j) { const float sj = __shfl(rs, fq * 4 + j); dP[j] *= sj; dQ[j] *= sj; }
            pP[rt][0] = pk2(dP[0], dP[1]); pP[rt][1] = pk2(dP[2], dP[3]); pQ[rt][0] = pk2(dQ[0], dQ[1]); pQ[rt][1] = pk2(dQ[2], dQ[3]);
            if ((rt & 3) == 3) asm volatile("" ::: "memory");
        }
#pragma unroll 2
        for (int k1t = 0; k1t < 8; ++k1t) {
            bf16x8 aC[4], aS[4];
#pragma unroll
            for (int sx = 0; sx < 4; ++sx) { aC[sx] = *(const LAS bf16x8*)(lds + TC_OFF + (k1t * 16 + fr) * PT + (sx * 32 + fq * 8) * 2); aS[sx] = *(const LAS bf16x8*)(lds + TS_OFF + (k1t * 16 + fr) * PT + (sx * 32 + fq * 8) * 2); }
            const f32x4 twa = *(const LAS f32x4*)(lds + TW_OFF + (k1t * 16 + fq * 4) * 8), twb = *(const LAS f32x4*)(lds + TW_OFF + (k1t * 16 + fq * 4) * 8 + 16);
            f32x4 Ur = (f32x4){0.f, 0.f, 0.f, 0.f}, V = Ur;
#pragma unroll
            for (int sx = 0; sx < 4; ++sx) {
                u32x4 bp, bq;
                bp.x = pP[2 * sx][0]; bp.y = pP[2 * sx][1]; bq.x = pQ[2 * sx][0]; bq.y = pQ[2 * sx][1];
                bp.z = pP[2 * sx + 1][0]; bp.w = pP[2 * sx + 1][1]; bq.z = pQ[2 * sx + 1][0]; bq.w = pQ[2 * sx + 1][1];
                const u32x4 bnq = bq ^ 0x80008000u;
                const bf16x8 BP = __builtin_bit_cast(bf16x8, bp), BQ = __builtin_bit_cast(bf16x8, bq), BNQ = __builtin_bit_cast(bf16x8, bnq);
                Ur = mfma16(aC[sx], BP, Ur); Ur = mfma16(aS[sx], BNQ, Ur); V = mfma16(aS[sx], BP, V); V = mfma16(aC[sx], BQ, V);
            }
            const float tcs[4] = {twa[0], twa[2], twb[0], twb[2]}, tsn[4] = {twa[1], twa[3], twb[1], twb[3]};
#pragma unroll
            for (int j = 0; j < 4; ++j) {
                const int k1 = k1t * 16 + fq * 4 + j;
                const float upr = Ur[j] * tcs[j] - V[j] * tsn[j], upi = -(V[j] * tcs[j] + Ur[j] * tsn[j]);
                bf16_t* o = UB + ((((size_t)b * R + k1) * 2) * 128 + q) * 512 + g * 128 + e0 + fr;
                o[0] = (bf16_t)f2bf(upr); o[(size_t)128 * 512] = (bf16_t)f2bf(upi);
            }
        }
    }
    __syncthreads();
}

DI void four_stage1_s(LAS unsigned char* lds, const bf16_t* PR, bf16_t* UB, const bf16_t* WF, const bf16_t* FCp, const bf16_t* FSp, const f32x2* TW, int nb, int G, int tid, int wid, int lane) {
    constexpr int R = 16, S = R * 128, QB = 4, NQB = 32, PT = 272;
    const int fr = lane & 15, fq = lane >> 4, e0 = wid * 16;
    const int nunits = nb * 4 * NQB;
    const bool uniform = (G % 128) == 0;
    int un = blockIdx.x;
    if (un >= nunits) return;
    int q0 = (un % NQB) * QB, g = (un / NQB) & 3;
    bf16x8 wP[4], wQ[4], aC, aS; f32x4 twv[QB][2];
    u32x4 zr[2];
#define S1S_CONST() do { _Pragma("unroll") for (int ks = 0; ks < 4; ++ks) { wP[ks] = *(const bf16x8*)(WF + ((g * 256 + e0 + fr) * 128 + ks * 32 + fq * 8)); wQ[ks] = *(const bf16x8*)(WF + ((g * 256 + 128 + e0 + fr) * 128 + ks * 32 + fq * 8)); } \
        _Pragma("unroll") for (int qi = 0; qi < QB; ++qi) { const f32x4* tp = (const f32x4*)(TW + (q0 + qi) * R + fq * 4); twv[qi][0] = tp[0]; twv[qi][1] = tp[1]; } } while (0)
    aC = *(const bf16x8*)(FCp + (fr * 32 + fq * 8)); aS = *(const bf16x8*)(FSp + (fr * 32 + fq * 8));
    S1S_CONST();
    { const int b = un / (4 * NQB);
#pragma unroll
      for (int i = 0; i < 2; ++i) { const int idx = tid + NTHR * i, row = idx >> 4; zr[i] = *(const u32x4*)(PR + ((size_t)b * S + 128 * (row & 15) + q0 + (row >> 4)) * PRP + 1024 + g * 128 + (idx & 15) * 8); } }
    for (; un < nunits; un += G) {
        const int b = un / (4 * NQB);
        __syncthreads();
#pragma unroll
        for (int i = 0; i < 2; ++i) { const int idx = tid + NTHR * i; *(LAS u32x4*)(lds + (idx >> 4) * PT + (idx & 15) * 16) = zr[i]; }
        const int un2 = un + G; int q0n = q0, gn = g;
        if (un2 < nunits) { const int b2 = un2 / (4 * NQB); q0n = (un2 % NQB) * QB; gn = (un2 / NQB) & 3;
#pragma unroll
            for (int i = 0; i < 2; ++i) { const int idx = tid + NTHR * i, row = idx >> 4; zr[i] = *(const u32x4*)(PR + ((size_t)b2 * S + 128 * (row & 15) + q0n + (row >> 4)) * PRP + 1024 + gn * 128 + (idx & 15) * 8); } }
        __syncthreads();
#pragma unroll
        for (int qi = 0; qi < QB; ++qi) {
            bf16x8 a[4]; float ss = 0.f;
#pragma unroll
            for (int ks = 0; ks < 4; ++ks) a[ks] = *(const LAS bf16x8*)(lds + (qi * 16 + fr) * PT + (ks * 32 + fq * 8) * 2);
#pragma unroll
            for (int ks = 0; ks < 4; ++ks)
#pragma unroll
                for (int k = 0; k < 8; ++k) { const float f = __uint_as_float(((unsigned)(unsigned short)a[ks][k]) << 16); ss += f * f; }
            ss += __shfl_xor(ss, 16); ss += __shfl_xor(ss, 32);
            const float rs = rsqrtf(ss * (1.0f / 128.0f) + 1e-6f);
            f32x4 dP = (f32x4){0.f, 0.f, 0.f, 0.f}, dQ = dP;
#pragma unroll
            for (int ks = 0; ks < 4; ++ks) { dP = mfma16(a[ks], wP[ks], dP); dQ = mfma16(a[ks], wQ[ks], dQ); }
#pragma unroll
            for (int j = 0; j < 4; ++j) { const float sj = __shfl(rs, fq * 4 + j); dP[j] *= sj; dQ[j] *= sj; }
            u32x4 bp, bq; bp.x = pk2(dP[0], dP[1]); bp.y = pk2(dP[2], dP[3]); bp.z = 0u; bp.w = 0u; bq.x = pk2(dQ[0], dQ[1]); bq.y = pk2(dQ[2], dQ[3]); bq.z = 0u; bq.w = 0u;
            const u32x4 bnq = bq ^ 0x80008000u;
            const bf16x8 BP = __builtin_bit_cast(bf16x8, bp), BQ = __builtin_bit_cast(bf16x8, bq), BNQ = __builtin_bit_cast(bf16x8, bnq);
            f32x4 Ur = (f32x4){0.f, 0.f, 0.f, 0.f}, V = Ur;
            Ur = mfma16(aC, BP, Ur); Ur = mfma16(aS, BNQ, Ur); V = mfma16(aS, BP, V); V = mfma16(aC, BQ, V);
            const int q = q0 + qi;
            const float tcs[4] = {twv[qi][0][0], twv[qi][0][2], twv[qi][1][0], twv[qi][1][2]}, tsn[4] = {twv[qi][0][1], twv[qi][0][3], twv[qi][1][1], twv[qi][1][3]};
#pragma unroll
            for (int j = 0; j < 4; ++j) {
                const int k1 = fq * 4 + j;
                const float upr = Ur[j] * tcs[j] - V[j] * tsn[j], upi = -(V[j] * tcs[j] + Ur[j] * tsn[j]);
                bf16_t* o = UB + ((((size_t)b * R + k1) * 2) * 128 + q) * 512 + g * 128 + e0 + fr;
                o[0] = (bf16_t)f2bf(upr); o[(size_t)128 * 512] = (bf16_t)f2bf(upi);
            }
        }
        if (!uniform && un2 < nunits) { q0 = q0n; g = gn; S1S_CONST(); }
    }
#undef S1S_CONST
    __syncthreads();
}

template <int R>
DI void four_stage2(LAS unsigned char* lds, const bf16_t* UB, bf16_t* YY, const bf16_t* FC2, const bf16_t* FS2, int nb, int G, int tid, int wid, int lane) {
    constexpr int PT = 272, S = R * 128, FC_OFF = 0, FS_OFF = 128 * PT, U_OFF = 256 * PT;
    const float norm = rsqrtf((float)S * 128.0f);
    const int fr = lane & 15, fq = lane >> 4, c0 = wid * 16;
    const int nunits = nb * R * 4;
#pragma unroll
    for (int i = 0; i < 4; ++i) { const int idx = tid + NTHR * i; const u32x4 c = *(const u32x4*)(FC2 + (idx >> 4) * 128 + (idx & 15) * 8), sn = *(const u32x4*)(FS2 + (idx >> 4) * 128 + (idx & 15) * 8);
        *(LAS u32x4*)(lds + FC_OFF + (idx >> 4) * PT + (idx & 15) * 16) = c; *(LAS u32x4*)(lds + FS_OFF + (idx >> 4) * PT + (idx & 15) * 16) = sn; }
    u32x4 tile[8];
    if ((int)blockIdx.x < nunits) { const int u0 = blockIdx.x; const bf16_t* src = UB + (((size_t)((u0 >> 2) / R) * R + ((u0 >> 2) % R)) * 2) * 128 * 512 + (u0 & 3) * 128;
#pragma unroll
        for (int i = 0; i < 8; ++i) { const int idx = tid + NTHR * i; tile[i] = *(const u32x4*)(src + (size_t)(idx >> 4) * 512 + (idx & 15) * 8); } }
    for (int un = blockIdx.x; un < nunits; un += G) {
        const int cq = un & 3, k1 = (un >> 2) % R, b = (un >> 2) / R;
        __syncthreads();
#pragma unroll
        for (int i = 0; i < 8; ++i) { const int idx = tid + NTHR * i; *(LAS u32x4*)(lds + U_OFF + (idx >> 4) * PT + (idx & 15) * 16) = tile[i]; }
        if (un + G < nunits) { const int u2 = un + G; const bf16_t* src = UB + (((size_t)((u2 >> 2) / R) * R + ((u2 >> 2) % R)) * 2) * 128 * 512 + (u2 & 3) * 128;
#pragma unroll
            for (int i = 0; i < 8; ++i) { const int idx = tid + NTHR * i; tile[i] = *(const u32x4*)(src + (size_t)(idx >> 4) * 512 + (idx & 15) * 8); } }
        __syncthreads();
        f32x4 acc[8];
#pragma unroll
        for (int k = 0; k < 8; ++k) acc[k] = (f32x4){0.f, 0.f, 0.f, 0.f};
#pragma unroll
        for (int it = 0; it < 8; ++it) {
            const int comp = it >> 2, ks = it & 3;
            const bf16x8 uf = tr_frag(lds + U_OFF + (comp * 128 + ks * 32 + fq * 8 + (fr >> 2)) * PT + (c0 + 4 * (fr & 3)) * 2, 4 * PT);
#pragma unroll
            for (int k2t = 0; k2t < 8; ++k2t) { const bf16x8 fa = *(const LAS bf16x8*)(lds + (comp ? FS_OFF : FC_OFF) + (k2t * 16 + fr) * PT + (ks * 32 + fq * 8) * 2); acc[k2t] = mfma16(uf, fa, acc[k2t]); }
        }
#pragma unroll
        for (int k2t = 0; k2t < 8; ++k2t) {
            const size_t tok = (size_t)b * S + (size_t)R * (k2t * 16 + fr) + k1;
            const f32x4 y = acc[k2t] * norm; u32x2 o; o.x = pk2(y[0], y[1]); o.y = pk2(y[2], y[3]);
            *(u32x2*)(YY + tok * 1024 + 512 + cq * 128 + c0 + fq * 4) = o;
        }
    }
    __syncthreads();
}

__global__ void __launch_bounds__(NTHR, 2) mega_fwd(Params p) {
    extern __shared__ __attribute__((aligned(16))) unsigned char lds_raw[];
    LAS unsigned char* lds = (LAS unsigned char*)lds_raw;
    cg::grid_group grid = cg::this_grid();
    const int tid = threadIdx.x, lane = tid & 63, wid = __builtin_amdgcn_readfirstlane(tid >> 6), G = gridDim.x;
    unsigned char* ws = p.ws;
    int pc = 0;
#define PH_BEGIN if (pc >= p.ph_lo && pc < p.ph_hi) {
    volatile LAS unsigned* bst = (volatile LAS unsigned*)(lds + LDS_BYTES - 64);
    if (tid < 2) bst[tid] = 0u;
    __syncthreads();
    if (p.ph_lo > p.ph_hi) grid.sync();
    XcdBarrier xbar = xcd_barrier_post((unsigned*)(ws + WS_BAR), bst);
    if (tid == 0) { (void)__hip_atomic_fetch_max(&xbar.bar[XB_CLS(blockIdx.x & 7u)], xbar.x + 1u, __ATOMIC_RELAXED, __HIP_MEMORY_SCOPE_AGENT); (void)__hip_atomic_fetch_max(&xbar.bar[XB_CLS(8u + (blockIdx.x & 7u))], 16u - xbar.x, __ATOMIC_RELAXED, __HIP_MEMORY_SCOPE_AGENT); }
    bool local_ok = false, seam_local = false, seam_noacq = false, seam_skip = false;
#define PH_END } ++pc; if (pc == 1) { xcd_barrier(xbar); \
        local_ok = (G == 256) && (bst[0] == 32u) && (bst[1] == 8u) && (xb_ld(&xbar.bar[XB_TMO]) == 0u); \
        for (unsigned cc = 0; cc < 8u; ++cc) local_ok = local_ok && (xb_ld(&xbar.bar[XB_CLS(cc)]) + xb_ld(&xbar.bar[XB_CLS(8u + cc)]) == 17u); } \
    else if (seam_skip && local_ok) { } else if (seam_local && local_ok) { team_barrier(xbar, !seam_noacq); } else { xcd_barrier(xbar); }

    PH_BEGIN
#if PHMASK & 1
#if PROBE & 16
 for (int rep = 0; rep < 2; ++rep)
#endif
 setup_phase(p, lds, G, tid, wid, lane);
#endif
 PH_END

    bf16_t* H = (bf16_t*)(ws + WS_H); bf16_t* T = (bf16_t*)(ws + WS_T); bf16_t* BIG = (bf16_t*)(ws + WS_BIG); bf16_t* UB = (bf16_t*)(ws + WS_T);     _Float16* XH = (_Float16*)(ws + WS_XH);
    const float* mod = (const float*)(ws + WS_MOD);
    for (int gi = 0; gi < 2; ++gi) {
        const int S = gi ? 2048 : 16384, nb = gi ? 16 : 2;
        const float* xsrc = p.in[gi];
        float* xo = p.out + (size_t)gi * GROWS * D;
        for (int ls = 0; ls < 7; ++ls) {
            const int l = ls / 3, sub = ls % 3;
            const bool odd = (l & 1), last = (ls == 6), first = (ls == 0);
            const int nsteps = last ? 1 : (sub != 1 ? 3 : (odd ? 5 : 4));
            for (int step = 0; step < nsteps; ++step) {
                int kind = 1;
                if (step == 0) kind = 0;
                else if (sub == 1 && step == 2) kind = odd ? 3 : 2;
                else if (sub == 1 && odd && step == 3) kind = 4;
                seam_noacq = (kind == 1 && sub != 1 && step == 2);
                seam_skip = (kind == 0 && last);
                seam_local = !((kind == 1 && sub == 1) || kind == 3 || kind == 4);
                PH_BEGIN
                int tid = threadIdx.x; asm volatile("" : "+v"(tid));
                const int lane = tid & 63, wid = __builtin_amdgcn_readfirstlane(tid >> 6);
                if (kind == 0) {
#if PHMASK & 2
#ifndef STAG2
#define STAG2 0
#endif
                    if (STAG2 && local_ok && ((gi == 0 && ls == 0) || sub == 2) && ((blockIdx.x >> 3) & 1)) { for (int zz = 0; zz < STAG2; ++zz) __builtin_amdgcn_s_sleep(127); }
                    const int lp = sub > 0 ? l : l - 1, sp = sub > 0 ? sub - 1 : 2, lpp = first ? 0 : lp, lc = last ? 0 : l;
#if PROBE & 4
                    norm_phase(ls <= 1 ? xsrc : nullptr, XH, last ? (float*)BIG : nullptr, (_Float16*)BIG, T, H, !first, !last,
                               mod + (size_t)lpp * 18 * 9216 + (sp * 3 + 2) * 1024, p.in[7] + (lpp * 3 + sp) * 1024, sp == 1 ? 1.0f : 0.5f,
                               mod + (size_t)lc * 18 * 9216 + (sub * 3) * 1024, p.in[6] + (lc * 3 + sub) * 1024, gi, G, wid, lane);
#endif
                    norm_phase(ls <= 1 ? xsrc : nullptr, XH, last ? xo : nullptr, XH, T, H, !first, !last,
                               mod + (size_t)lpp * 18 * 9216 + (sp * 3 + 2) * 1024, p.in[7] + (lpp * 3 + sp) * 1024, sp == 1 ? 1.0f : 0.5f,
                               mod + (size_t)lc * 18 * 9216 + (sub * 3) * 1024, p.in[6] + (lc * 3 + sub) * 1024, gi, G, wid, lane);
#endif
                } else if (kind == 1) {
                    const bf16_t* A; const bf16_t* Bt; bf16_t* O; int N, K, ldc, mode;
                    if (sub != 1) {
                        const int wi = l * 2 + (sub >> 1);
                        if (step == 1) { A = H; Bt = (const bf16_t*)(ws + WS_WUP) + (size_t)wi * 5632 * 1024; O = BIG; N = 5632; K = 1024; ldc = DFF; mode = 3; }
                        else { A = BIG; Bt = (const bf16_t*)(ws + WS_WDN) + (size_t)wi * 1024 * 2816; O = T; N = 1024; K = DFF; ldc = D; mode = 0; }
                    } else if (step == 1) { A = H; Bt = (const bf16_t*)(ws + (odd ? WS_ODIN : WS_EVIN)); O = BIG; N = odd ? 2048 : 1536; K = 1024; ldc = PRP; mode = odd ? 2 : 1; }
                    else { A = H; Bt = (const bf16_t*)(ws + (odd ? WS_ODOUT : WS_EVOUT)); O = T; N = 1024; K = 1024; ldc = D; mode = 0; }
#if PROBE & 2
                    for (int rep = 0; rep < 2; ++rep)
#endif
                    run_gemm(lds, A, Bt, GROWS, N, K, O, ldc, mode, G);
                } else if (kind == 2) {
#if PHMASK & 8
#if PROBE & (8 | 32)
                    for (int rep = 0; rep < 2; ++rep)
#endif
                    even_core(lds, BIG, H, (const bf16_t*)(ws + WS_WSP), (const bf16_t*)(ws + WS_WPT), p.in[13], p.in[14], p.in[16], p.in[18], S, G, tid, wid, lane);
#endif
                } else if (kind == 3) {
#if PHMASK & 16
#if PROBE & (8 | 64)
                    for (int rep = 0; rep < 2; ++rep) {
#else
                    {
#endif
                    conv_part(BIG, H, p.in[21], S, G, wid, lane);
                    if (gi == 0) four_stage1_p(lds, BIG, UB, (const bf16_t*)(ws + WS_WF), (const bf16_t*)(ws + WS_FC1), (const bf16_t*)(ws + WS_FS1), (const f32x2*)(ws + WS_TW128), nb, G, tid, wid, lane);
                    else four_stage1_s(lds, BIG, UB, (const bf16_t*)(ws + WS_WF), (const bf16_t*)(ws + WS_FC16), (const bf16_t*)(ws + WS_FS16), (const f32x2*)(ws + WS_TW16), nb, G, tid, wid, lane);
                    }
#endif
                } else {
#if PHMASK & 32
#if PROBE & (8 | 128)
                    for (int rep = 0; rep < 2; ++rep) {
#else
                    {
#endif
                    if (gi == 0) four_stage2<128>(lds, UB, H, (const bf16_t*)(ws + WS_FC2), (const bf16_t*)(ws + WS_FS2), nb, G, tid, wid, lane);
                    else four_stage2<16>(lds, UB, H, (const bf16_t*)(ws + WS_FC2), (const bf16_t*)(ws + WS_FS2), nb, G, tid, wid, lane);
                    }
#endif
                }
                PH_END
            }
        }
    }
}

extern "C" void kernel_launch(void* const* d_in, const int* in_sizes, int n_in, void* d_out, int out_size, void* d_ws, size_t ws_size, hipStream_t stream) {
    static int grid = 0;
    if (grid == 0) {
        if (n_in != 25 || ws_size < WS_END || out_size != 2 * GROWS * D) { fprintf(stderr, "kernel_launch: unexpected shapes (n_in %d, out %d, ws %zu)\n", n_in, out_size, ws_size); grid = -1; return; }
        int dev = 0, cus = 0, per_cu = 0;
        hipGetDevice(&dev); hipDeviceGetAttribute(&cus, hipDeviceAttributeMultiprocessorCount, dev);
        hipFuncSetAttribute((const void*)mega_fwd, hipFuncAttributeMaxDynamicSharedMemorySize, LDS_BYTES);
        if (hipOccupancyMaxActiveBlocksPerMultiprocessor(&per_cu, (const void*)mega_fwd, NTHR, LDS_BYTES) != hipSuccess || per_cu < 1) per_cu = 1;
        (void)hipGetLastError();
        grid = cus * 1;
    }
    if (grid < 0) return;
    Params p{};
    for (int i = 0; i < 25; ++i) p.in[i] = (const float*)d_in[i];
    p.out = (float*)d_out; p.ws = (unsigned char*)d_ws; p.ph_lo = 0; p.ph_hi = 1 << 20;
    (void)hipMemsetAsync((unsigned char*)d_ws + WS_BAR, 0, XB_WORDS_ALL * sizeof(unsigned), stream);
    void* args[] = {&p};
    hipError_t e = hipLaunchCooperativeKernel((const void*)mega_fwd, dim3(grid), dim3(NTHR), args, LDS_BYTES, stream);
    if (e != hipSuccess) fprintf(stderr, "cooperative launch failed: %s (grid %d)\n", hipGetErrorString(e), grid);
}
```

```cpp
#include <hip/hip_runtime.h>
#include <hip/hip_cooperative_groups.h>
#include <cstdio>
namespace cg = cooperative_groups;
namespace pg8 {
#define PG8_LAS __attribute__((address_space(3)))
typedef unsigned short bf16_t;
typedef short bf16x8 __attribute__((ext_vector_type(8)));
typedef float f32x4 __attribute__((ext_vector_type(4)));
typedef unsigned u32x4 __attribute__((ext_vector_type(4)));
constexpr int BM = 256, BK = 64, HALF = 128, HTB = HALF * BK * 2  , STAGE_BYTES = 8 * HTB, NXCD = 8, WGM = 8;

__host__ __device__ __forceinline__ int lds_byte(int r, int c) { const int st = (r >> 4) * 2 + (c >> 5), rr = r & 15, cc = c & 31, ob = rr * 64 + cc * 2; return st * 1024 + (ob ^ (((ob >> 9) & 1) << 5)); }
__host__ __device__ __forceinline__ void stage_rc(int b, int& R, int& C) { const int st = b / 1024, sb = b % 1024, swz = sb ^ (((sb >> 9) & 1) << 5); R = (st >> 1) * 16 + swz / 64; C = (st & 1) * 32 + (swz % 64) / 2; }
__host__ __device__ __forceinline__ int perm32(int rho) { const int n = rho >> 4, i = rho & 15; return 8 * (i >> 2) + 4 * n + (i & 3); }

struct Unit { int pm, pn; };
struct Gemm { const bf16_t* A; const bf16_t* Bt; int M, N, K; };

struct StaticOrder {
    int nM, nN, nwg, G, c;
    __host__ __device__ void init(int M, int N, int G_, int c_) { nM = M / BM; nN = N / BM; nwg = nM * nN; G = G_; c = c_; }
    __host__ __device__ bool next(int i, Unit& u) const {
        const long L = (long)i * G + c; if (L >= nwg) return false;
        int wgid = (int)L; { const int q = nwg / NXCD, r = nwg % NXCD, xcd = wgid % NXCD, off = wgid / NXCD; wgid = (xcd < r ? xcd * (q + 1) : r * (q + 1) + (xcd - r) * q) + off; }
        const int nig = WGM * nN, gid = wgid / nig, fm = gid * WGM, gsz = (nM - fm) < WGM ? (nM - fm) : WGM;
        u.pm = fm + ((wgid % nig) % gsz); u.pn = (wgid % nig) / gsz; return true;
    }
    __device__ __forceinline__ void a_ready(const Unit&) const {}
    __device__ __forceinline__ void done(const Unit&) const {}
};
__device__ __forceinline__ unsigned cvt_pk_bf16(float lo, float hi) { unsigned r; asm volatile("v_cvt_pk_bf16_f32 %0, %1, %2" : "=v"(r) : "v"(lo), "v"(hi)); return r; }
typedef float f32x2 __attribute__((ext_vector_type(2)));
__device__ __forceinline__ f32x2 gelu_pk(f32x2 v) {
    const f32x2 av = __builtin_elementwise_abs(v), d = av * 0.2316418882f + 1.0f;
    f32x2 t; t.x = __builtin_amdgcn_rcpf(d.x); t.y = __builtin_amdgcn_rcpf(d.y);
    f32x2 q = t * 0.5307027145f + (-0.7265760135f); q = q * t + 0.7107068705f; q = q * t + (-0.142248368f); q = q * t + 0.127414796f; q = q * t;
    const f32x2 s = (v * v) * (-0.72134752044f);
    f32x2 e; e.x = __builtin_amdgcn_exp2f(s.x); e.y = __builtin_amdgcn_exp2f(s.y);
    const f32x2 m = v * (q * e), r = v - m;
    f32x2 o; o.x = v.x < 0.f ? m.x : r.x; o.y = v.y < 0.f ? m.y : r.y; return o;
}
template <class Epi, class Sched, bool ALIGN_EPI = false, bool SP2 = false>
__device__ __forceinline__ void gemm_phase(PG8_LAS unsigned char* lds, const Gemm g, const Sched& S, const Epi& E) {
    int tid_o = threadIdx.x; asm volatile("" : "+v"(tid_o));
    const int tid = tid_o, wid = __builtin_amdgcn_readfirstlane(tid >> 6), lane = tid & 63, wr = wid >> 2, wc = wid & 3, fr = lane & 15, fq = lane >> 4;
    const int K = g.K, nt = K / BK;
    unsigned voffA[2], voffB[2];
#pragma unroll
    for (int i = 0; i < 2; ++i) { int R, C; stage_rc(tid * 16 + i * 8192, R, C); const int Rb = Epi::PERM ? ((R & ~31) + perm32(R & 31)) : R;
        voffA[i] = (unsigned)(R * K + C) * 2u; voffB[i] = (unsigned)(Rb * K + C) * 2u; }
    const size_t kstep = (size_t)(BK * 2);
    const size_t hstep = (size_t)HALF * K * 2;
    const size_t tstep = 2 * hstep;
    const unsigned ldsw = (unsigned)wid * 1024u;
    const int aoff = lds_byte(wr * 64 + fr, fq * 8), boff = lds_byte(wc * 32 + fr, fq * 8);
#define PG8_SA(b, h) (((b) * 2 + (h)) * HTB)
#define PG8_SB(b, h) ((4 + (b) * 2 + (h)) * HTB)
#define PG8_STAGE(bufoff, gbase, voff) do { _Pragma("unroll") for (int _i = 0; _i < 2; ++_i) \
        __builtin_amdgcn_global_load_lds((const unsigned*)((const char*)(gbase) + (voff)[_i]), (PG8_LAS unsigned*)(lds + (bufoff) + ldsw + _i * 8192), 16, 0, 0); } while (0)
#define PG8_LDA(dst, b, h) do { _Pragma("unroll") for (int m = 0; m < 4; ++m) _Pragma("unroll") for (int k = 0; k < 2; ++k) dst[m][k] = *(const PG8_LAS bf16x8*)(lds + PG8_SA(b, h) + aoff + m * 2048 + k * 1024); } while (0)
#define PG8_LDB(dst, b, h) do { _Pragma("unroll") for (int n = 0; n < 2; ++n) _Pragma("unroll") for (int k = 0; k < 2; ++k) dst[n][k] = *(const PG8_LAS bf16x8*)(lds + PG8_SB(b, h) + boff + n * 2048 + k * 1024); } while (0)
#define PG8_MMA(ai, bj, At, Bt) do { __builtin_amdgcn_s_setprio(1); _Pragma("unroll") for (int m = 0; m < 4; ++m) _Pragma("unroll") for (int n = 0; n < 2; ++n) _Pragma("unroll") for (int k = 0; k < 2; ++k) \
        acc[ai][bj][m][n] = __builtin_amdgcn_mfma_f32_16x16x32_bf16(Bt[n][k], At[m][k], acc[ai][bj][m][n], 0, 0, 0); __builtin_amdgcn_s_setprio(0); } while (0)
#define PG8_WAIT_V(n) asm volatile("s_waitcnt vmcnt(" #n ")" ::: "memory")
#define PG8_WAIT_L(n) asm volatile("s_waitcnt lgkmcnt(" #n ")" ::: "memory")
#define PG8_BAR __builtin_amdgcn_s_barrier()
#define PG8_SCHED __builtin_amdgcn_sched_barrier(0)
    Unit cur, nxt; int ui = 0;
    if (!S.next(0, cur)) return;
    f32x4 acc[2][2][4][2];
#pragma unroll
    for (int a = 0; a < 2; ++a)
#pragma unroll
        for (int b = 0; b < 2; ++b)
#pragma unroll
            for (int m = 0; m < 4; ++m)
#pragma unroll
                for (int n = 0; n < 2; ++n) acc[a][b][m][n] = (f32x4){0.f, 0.f, 0.f, 0.f};
    bf16x8 At[4][2], B0[2][2], B1[2][2];
    const char* cA = (const char*)g.A + (size_t)cur.pm * tstep; const char* cB = (const char*)g.Bt + (size_t)cur.pn * tstep;
    S.a_ready(cur);
    if constexpr (SP2) {
        PG8_STAGE(PG8_SB(0, 0), cB, voffB); PG8_STAGE(PG8_SB(0, 1), cB + hstep, voffB); PG8_STAGE(PG8_SA(0, 0), cA, voffA); PG8_STAGE(PG8_SA(0, 1), cA + hstep, voffA);
        if (wr == 1) PG8_BAR;
        PG8_WAIT_V(2); PG8_BAR;
        PG8_STAGE(PG8_SB(1, 0), cB + kstep, voffB); PG8_STAGE(PG8_SA(1, 0), cA + kstep, voffA); PG8_STAGE(PG8_SB(1, 1), cB + hstep + kstep, voffB);
        PG8_WAIT_V(6); PG8_BAR;
    } else {
        PG8_STAGE(PG8_SB(0, 0), cB, voffB); PG8_STAGE(PG8_SA(0, 0), cA, voffA); PG8_STAGE(PG8_SB(0, 1), cB + hstep, voffB); PG8_STAGE(PG8_SA(0, 1), cA + hstep, voffA);
        if (wr == 1) PG8_BAR;
        PG8_WAIT_V(4); PG8_BAR;
        PG8_STAGE(PG8_SB(1, 0), cB + kstep, voffB); PG8_STAGE(PG8_SA(1, 0), cA + kstep, voffA); PG8_STAGE(PG8_SB(1, 1), cB + hstep + kstep, voffB);
        PG8_WAIT_V(6); PG8_BAR;
    }
    for (;;) {
        const bool has_next = S.next(ui + 1, nxt);
        const char* nA = has_next ? (const char*)g.A + (size_t)nxt.pm * tstep : cA; const char* nB = has_next ? (const char*)g.Bt + (size_t)nxt.pn * tstep : cB;
        for (int t = 0; t < nt; t += 2) {
            const bool last = (t == nt - 2);
            const char* a1 = cA + (size_t)(t + 1) * kstep;
            const char* a2 = last ? nA : cA + (size_t)(t + 2) * kstep; const char* b2 = last ? nB : cB + (size_t)(t + 2) * kstep;
            const char* a3 = a2 + kstep; const char* b3 = b2 + kstep;
            if (last && has_next) S.a_ready(nxt);
            if constexpr (SP2) {
            PG8_LDB(B0, 0, 0); PG8_LDB(B1, 0, 1); PG8_SCHED; PG8_LDA(At, 0, 0); PG8_STAGE(PG8_SA(1, 1), a1 + hstep, voffA);
            PG8_WAIT_V(8); PG8_WAIT_L(0); PG8_BAR; PG8_MMA(0, 0, At, B0); PG8_MMA(0, 1, At, B1); PG8_BAR; PG8_SCHED;
            PG8_LDA(At, 0, 1); PG8_STAGE(PG8_SB(0, 0), b2, voffB); PG8_STAGE(PG8_SB(0, 1), b2 + hstep, voffB); PG8_STAGE(PG8_SA(0, 0), a2, voffA);
            PG8_WAIT_V(8); PG8_WAIT_L(0); PG8_BAR; PG8_MMA(1, 0, At, B0); PG8_MMA(1, 1, At, B1); PG8_BAR; PG8_SCHED;
            PG8_LDB(B0, 1, 0); PG8_LDB(B1, 1, 1); PG8_SCHED; PG8_LDA(At, 1, 0); PG8_STAGE(PG8_SA(0, 1), a2 + hstep, voffA);
            PG8_WAIT_V(8); PG8_WAIT_L(0); PG8_BAR; PG8_MMA(0, 0, At, B0); PG8_MMA(0, 1, At, B1); PG8_BAR; PG8_SCHED;
            PG8_LDA(At, 1, 1); PG8_STAGE(PG8_SB(1, 0), b3, voffB); PG8_STAGE(PG8_SB(1, 1), b3 + hstep, voffB); PG8_STAGE(PG8_SA(1, 0), a3, voffA);
            PG8_WAIT_V(8); PG8_WAIT_L(0); PG8_BAR; PG8_MMA(1, 0, At, B0); PG8_MMA(1, 1, At, B1); PG8_BAR; PG8_SCHED;
            } else {
            PG8_LDB(B0, 0, 0); PG8_SCHED; PG8_LDA(At, 0, 0); PG8_STAGE(PG8_SA(1, 1), a1 + hstep, voffA);
            PG8_WAIT_L(8); PG8_BAR; PG8_WAIT_L(0); PG8_MMA(0, 0, At, B0); PG8_BAR; PG8_SCHED;
            PG8_LDB(B1, 0, 1); PG8_STAGE(PG8_SB(0, 0), b2, voffB);
            PG8_BAR; PG8_WAIT_L(0); PG8_MMA(0, 1, At, B1); PG8_BAR;
            PG8_LDA(At, 0, 1); PG8_STAGE(PG8_SA(0, 0), a2, voffA);
            PG8_BAR; PG8_WAIT_L(0); PG8_MMA(1, 0, At, B0); PG8_BAR; PG8_SCHED;
            PG8_STAGE(PG8_SB(0, 1), b2 + hstep, voffB);
            PG8_WAIT_V(6); PG8_BAR; PG8_MMA(1, 1, At, B1); PG8_BAR;
            PG8_LDB(B0, 1, 0); PG8_SCHED; PG8_LDA(At, 1, 0); PG8_STAGE(PG8_SA(0, 1), a2 + hstep, voffA);
            PG8_WAIT_L(8); PG8_BAR; PG8_WAIT_L(0); PG8_MMA(0, 0, At, B0); PG8_BAR; PG8_SCHED;
            PG8_LDB(B1, 1, 1); PG8_STAGE(PG8_SB(1, 0), b3, voffB);
            PG8_BAR; PG8_WAIT_L(0); PG8_MMA(0, 1, At, B1); PG8_BAR;
            PG8_LDA(At, 1, 1); PG8_STAGE(PG8_SA(1, 0), a3, voffA);
            PG8_BAR; PG8_WAIT_L(0); PG8_MMA(1, 0, At, B0); PG8_BAR; PG8_SCHED;
            PG8_STAGE(PG8_SB(1, 1), b3 + hstep, voffB);
            PG8_WAIT_V(6); PG8_BAR; PG8_MMA(1, 1, At, B1); PG8_BAR;
            }
        }
        if constexpr (ALIGN_EPI) { if (wr == 0) PG8_BAR; }
        if constexpr (!Epi::AFTER_DRAIN) { E(acc, cur, wr, wc, fr, fq); S.done(cur); }
        if (!has_next) break;
#pragma unroll
        for (int a = 0; a < 2; ++a)
#pragma unroll
            for (int b = 0; b < 2; ++b)
#pragma unroll
                for (int m = 0; m < 4; ++m)
#pragma unroll
                    for (int n = 0; n < 2; ++n) acc[a][b][m][n] = (f32x4){0.f, 0.f, 0.f, 0.f};
        cur = nxt; cA = nA; cB = nB; ++ui;
        if constexpr (ALIGN_EPI) { if (wr == 1) PG8_BAR; }
    }
    PG8_WAIT_V(0);
    if constexpr (!ALIGN_EPI) { if (wr == 0) PG8_BAR; }
    PG8_BAR;
    if constexpr (Epi::AFTER_DRAIN) { E.fused(acc, cur, wr, wc, fr, fq, lds, wid, lane); S.done(cur); }
#undef PG8_SA
#undef PG8_SB
#undef PG8_STAGE
#undef PG8_LDA
#undef PG8_LDB
#undef PG8_MMA
#undef PG8_WAIT_V
#undef PG8_WAIT_L
#undef PG8_BAR
#undef PG8_SCHED
}
}


#ifndef PHMASK
#define PHMASK 63
#endif
#ifndef PROBE
#define PROBE 0
#endif
using pg8::bf16_t; using pg8::bf16x8; using pg8::f32x4; using pg8::u32x4;
typedef unsigned u32x2 __attribute__((ext_vector_type(2)));
typedef short s16x4 __attribute__((ext_vector_type(4)));
typedef float f32x2 __attribute__((ext_vector_type(2)));
#define LAS __attribute__((address_space(3)))
#define DI __device__ __forceinline__

#define XB_TMO      128
#define XB_XCNT(j)  (256  + 64 * (j))
#define XB_XSUB(j)  (1280 + 64 * (j))
#define XB_XGEN(j)  (2304 + 64 * (j))
#define XB_TOP      3328
#define XB_TOPGEN   3392
#define XCD_BAR_WORDS 3456
#define XB_SPIN_CAP (1u << 18)

__device__ __forceinline__ unsigned xb_ld(unsigned* p)              { return __hip_atomic_load(p, __ATOMIC_RELAXED, __HIP_MEMORY_SCOPE_AGENT); }
__device__ __forceinline__ unsigned xb_add(unsigned* p, unsigned v) { return __hip_atomic_fetch_add(p, v, __ATOMIC_RELAXED, __HIP_MEMORY_SCOPE_AGENT); }
__device__ __forceinline__ unsigned xb_xcc_id() { return (unsigned)__builtin_amdgcn_s_getreg((3 << 11) | 20) & 0xFu; }
#define XB_SPIN(cond, bar) do { unsigned _sp = 0; while (cond) { __builtin_amdgcn_s_sleep(1); \
    if ((++_sp & 255u) == 0u) { if (xb_ld(&(bar)[XB_TMO])) break; if (_sp > XB_SPIN_CAP) { atomicAdd(&(bar)[XB_TMO], 1u); break; } } } } while (0)

struct XcdBarrier {
    unsigned* bar; unsigned x;
    volatile LAS unsigned* st;
};

__device__ __forceinline__ XcdBarrier xcd_barrier_post(unsigned* bar, volatile LAS unsigned* st) {
    XcdBarrier b; b.bar = bar; b.x = xb_xcc_id(); b.st = st;
    if (threadIdx.x == 0) (void)xb_add(&bar[XB_XCNT(b.x)], 1u);
    return b;
}
__device__ __forceinline__ void xcd_barrier_complete(unsigned* bar, unsigned x, unsigned& nloc, unsigned& nx) {
    const unsigned G = gridDim.x * gridDim.y * gridDim.z;
    unsigned sum, cnt, mine, sp = 0u;
    for (;;) {
        sum = 0u; cnt = 0u; mine = 0u;
#pragma unroll
        for (unsigned j = 0; j < 16; ++j) { const unsigned c = xb_ld(&bar[XB_XCNT(j)]); sum += c; cnt += (c > 0u) ? 1u : 0u; mine = (j == x) ? c : mine; }
        if (sum == G) break;
        __builtin_amdgcn_s_sleep(1);
        if ((++sp & 255u) == 0u) { if (xb_ld(&bar[XB_TMO])) break; if (sp > XB_SPIN_CAP) { atomicAdd(&bar[XB_TMO], 1u); break; } }
    }
    nloc = mine > 0u ? mine : 1u; nx = cnt > 0u ? cnt : 1u;
}

__device__ __forceinline__ void xcd_barrier(const XcdBarrier& b) {
    asm volatile("s_waitcnt vmcnt(0)" ::: "memory");
    __syncthreads();
    if (threadIdx.x == 0) {
        unsigned* bar = b.bar;
        __builtin_amdgcn_s_waitcnt(0);
        unsigned nloc = b.st[0], nx = b.st[1];
        if (nloc == 0u) { xcd_barrier_complete(bar, b.x, nloc, nx); b.st[0] = nloc; b.st[1] = nx; }
        const unsigned old = xb_add(&bar[XB_XSUB(b.x)], 1u);
        const unsigned gen = old / nloc;
        if (old + 1u == (gen + 1u) * nloc) {
            __builtin_amdgcn_fence(__ATOMIC_RELEASE, "agent");
            asm volatile("s_waitcnt vmcnt(0)" ::: "memory");
            const unsigned og = xb_add(&bar[XB_TOP], 1u);
            const unsigned tg = og / nx;
            if (og + 1u == (tg + 1u) * nx) xb_add(&bar[XB_TOPGEN], 1u);
            else XB_SPIN(xb_ld(&bar[XB_TOPGEN]) == tg, bar);
            __builtin_amdgcn_fence(__ATOMIC_ACQUIRE, "agent");
            xb_add(&bar[XB_XGEN(b.x)], 1u);
            asm volatile("s_waitcnt vmcnt(0)" ::: "memory");
        } else {
            XB_SPIN(xb_ld(&bar[XB_XGEN(b.x)]) == gen, bar);
            __builtin_amdgcn_fence(__ATOMIC_ACQUIRE, "agent");
            asm volatile("s_waitcnt vmcnt(0)" ::: "memory");
        }
    }
    __syncthreads();
}


#define XB_LSUB(j)  (3456 + 64 * (j))
#define XB_LGEN(j)  (4480 + 64 * (j))
#define XB_CLS(j)   (5504 + 64 * (j))
#define XB_TSUB(k)  (6528 + 64 * (k))
#define XB_TGEN(k)  (10624 + 64 * (k))
#define XB_WORDS_ALL 14720
__device__ __forceinline__ void team_barrier(const XcdBarrier& b, bool acquire) {
    asm volatile("s_waitcnt vmcnt(0)" ::: "memory");
    __syncthreads();
    if (threadIdx.x == 0) {
        unsigned* bar = b.bar;
        __builtin_amdgcn_s_waitcnt(0);
        const unsigned team = (blockIdx.x & 7u) * 8u + ((blockIdx.x >> 3) & 7u);
        const unsigned old = xb_add(&bar[XB_TSUB(team)], 1u);
        const unsigned gen = old >> 2;
        if ((old & 3u) == 3u) xb_add(&bar[XB_TGEN(team)], 1u);
        else XB_SPIN(xb_ld(&bar[XB_TGEN(team)]) == gen, bar);
        if (acquire) {
            __builtin_amdgcn_fence(__ATOMIC_ACQUIRE, "agent");
            asm volatile("s_waitcnt vmcnt(0)" ::: "memory"); }
    }
    __syncthreads();
}

constexpr int D = 1024, DFF = 2816, GROWS = 32768, NTHR = 512;
constexpr int PRP = 2816;
constexpr int LDS_BYTES = 147456;
constexpr size_t MiB = 1u << 20, KiB = 1u << 10;
constexpr size_t WS_MODP = 0;
constexpr size_t WS_MOD = 6 * MiB;
constexpr size_t WS_BAR = 7 * MiB + 512 * KiB;
constexpr size_t WS_WSP = 8 * MiB;
constexpr size_t WS_WPT = WS_WSP + 256 * KiB;
constexpr size_t WS_WF = WS_WPT + 256 * KiB;
constexpr size_t WS_FC1 = WS_WF + 256 * KiB;
constexpr size_t WS_FS1 = WS_FC1 + 256 * KiB;
constexpr size_t WS_FC16 = WS_FS1 + 256 * KiB;
constexpr size_t WS_FS16 = WS_FC16 + 256 * KiB;
constexpr size_t WS_FC2 = WS_FS16 + 256 * KiB;
constexpr size_t WS_FS2 = WS_FC2 + 256 * KiB;
constexpr size_t WS_TW128 = WS_FS2 + 256 * KiB;
constexpr size_t WS_TW16 = WS_TW128 + 256 * KiB;
constexpr size_t WS_WUP = 16 * MiB;
constexpr size_t WS_WDN = 60 * MiB;
constexpr size_t WS_EVIN = 82 * MiB, WS_ODIN = 85 * MiB, WS_EVOUT = 89 * MiB, WS_ODOUT = 91 * MiB;
constexpr size_t WS_H = 96 * MiB;
constexpr size_t WS_T = 160 * MiB;
constexpr size_t WS_BIG = 224 * MiB;
constexpr size_t WS_UB = WS_BIG + 96 * MiB;
constexpr size_t WS_XH = 400 * MiB;
constexpr size_t WS_END = 464 * MiB;

typedef __bf16 nbf16x2 __attribute__((ext_vector_type(2)));
DI unsigned f2bf(float f) { return (unsigned)__builtin_bit_cast(unsigned short, (__bf16)f); }
DI unsigned pk2(float lo, float hi) { const f32x2 v = {lo, hi}; return __builtin_bit_cast(unsigned, __builtin_convertvector(v, nbf16x2)); }
DI float bf_lo(unsigned w) { return __uint_as_float(w << 16); }
DI float bf_hi(unsigned w) { return __uint_as_float(w & 0xffff0000u); }
template <int CTRL> DI float dpp_mov(float v) { return __builtin_bit_cast(float, __builtin_amdgcn_update_dpp(0, __builtin_bit_cast(int, v), CTRL, 0xF, 0xF, true)); }
DI float wave_sum(float v) {
    v += dpp_mov<0xB1>(v); v += dpp_mov<0x4E>(v); v += dpp_mov<0x141>(v); v += dpp_mov<0x140>(v);
    const int iv = __builtin_bit_cast(int, v);
    const float a = __builtin_bit_cast(float, __builtin_amdgcn_readlane(iv, 0)), b = __builtin_bit_cast(float, __builtin_amdgcn_readlane(iv, 16)),
                c = __builtin_bit_cast(float, __builtin_amdgcn_readlane(iv, 32)), d = __builtin_bit_cast(float, __builtin_amdgcn_readlane(iv, 48));
    return (a + b) + (c + d);
}
DI float silu_f(float x) { return x * __builtin_amdgcn_rcpf(1.0f + __builtin_amdgcn_exp2f(-1.4426950408889634f * x)); }
DI f32x4 mfma16(bf16x8 a, bf16x8 b, f32x4 c) { return __builtin_amdgcn_mfma_f32_16x16x32_bf16(a, b, c, 0, 0, 0); }
typedef short v4i16_t __attribute__((ext_vector_type(4)));
DI s16x4 tr_read(LAS unsigned char* p) { return __builtin_bit_cast(s16x4, __builtin_amdgcn_ds_read_tr16_b64_v4i16((LAS v4i16_t*)p)); }
DI bf16x8 tr_frag(LAS unsigned char* p, int pitch4) {
    const s16x4 lo = tr_read(p), hi = tr_read(p + pitch4);
    bf16x8 r; r[0] = lo[0]; r[1] = lo[1]; r[2] = lo[2]; r[3] = lo[3]; r[4] = hi[0]; r[5] = hi[1]; r[6] = hi[2]; r[7] = hi[3]; return r;
}

DI void st16_wt(void* p, u32x4 v) { *(u32x4*)p = v; }
struct Params { const float* in[25]; float* out; unsigned char* ws; int ph_lo, ph_hi; };

struct EpiGen {
    static constexpr bool PERM = true, AFTER_DRAIN = false;
    bf16_t* O; int ldc; int mode;
    __device__ __forceinline__ void operator()(const f32x4 (&acc)[2][2][4][2], const pg8::Unit& u, int wr, int wc, int fr, int fq) const {
        const int row0 = u.pm * 256 + wr * 64 + fr, cw = wc * 32 + 8 * fq;
        if (mode == 3) {
#pragma unroll
            for (int ai = 0; ai < 2; ++ai)
#pragma unroll
                for (int m = 0; m < 4; ++m) {
                    bf16_t* rowp = O + (size_t)(row0 + ai * 128 + m * 16) * ldc + 128 * u.pn + cw;
                    f32x4 g0 = acc[ai][0][m][0], g1 = acc[ai][0][m][1]; const f32x4 u0 = acc[ai][1][m][0], u1 = acc[ai][1][m][1];
#pragma unroll
                    for (int j = 0; j < 4; ++j) { g0[j] = silu_f(g0[j]); g1[j] = silu_f(g1[j]); }
                    const f32x4 v0 = g0 * u0, v1 = g1 * u1;
                    u32x4 w; w.x = pg8::cvt_pk_bf16(v0[0], v0[1]); w.y = pg8::cvt_pk_bf16(v0[2], v0[3]); w.z = pg8::cvt_pk_bf16(v1[0], v1[1]); w.w = pg8::cvt_pk_bf16(v1[2], v1[3]);
                    st16_wt(rowp, w);
                }
        } else if (mode == 2 && u.pn < 4) {
#pragma unroll
            for (int ai = 0; ai < 2; ++ai)
#pragma unroll
                for (int m = 0; m < 4; ++m) {
                    bf16_t* rowp = O + (size_t)(row0 + ai * 128 + m * 16) * ldc + 128 * u.pn + cw;
                    const f32x4 v0 = acc[ai][0][m][0] * acc[ai][1][m][0], v1 = acc[ai][0][m][1] * acc[ai][1][m][1];
                    u32x4 w; w.x = pg8::cvt_pk_bf16(v0[0], v0[1]); w.y = pg8::cvt_pk_bf16(v0[2], v0[3]); w.z = pg8::cvt_pk_bf16(v1[0], v1[1]); w.w = pg8::cvt_pk_bf16(v1[2], v1[3]);
                    st16_wt(rowp, w);
                }
        } else {
            const int colbase = (mode == 2) ? 512 + 256 * (u.pn - 4) : 256 * u.pn;
            if (mode == 1 && u.pn < 4) {
#pragma unroll
                for (int ai = 0; ai < 2; ++ai)
#pragma unroll
                    for (int m = 0; m < 4; ++m) {
                        bf16_t* rowp = O + (size_t)(row0 + ai * 128 + m * 16) * ldc + colbase + cw;
#pragma unroll
                        for (int bj = 0; bj < 2; ++bj) {
                            f32x4 v0 = acc[ai][bj][m][0], v1 = acc[ai][bj][m][1];
                            const pg8::f32x2 a = pg8::gelu_pk((pg8::f32x2){v0[0], v0[1]}), b = pg8::gelu_pk((pg8::f32x2){v0[2], v0[3]}), c = pg8::gelu_pk((pg8::f32x2){v1[0], v1[1]}), d = pg8::gelu_pk((pg8::f32x2){v1[2], v1[3]});
                            u32x4 w; w.x = pg8::cvt_pk_bf16(a.x, a.y); w.y = pg8::cvt_pk_bf16(b.x, b.y); w.z = pg8::cvt_pk_bf16(c.x, c.y); w.w = pg8::cvt_pk_bf16(d.x, d.y);
                            st16_wt(rowp + bj * 128, w);
                        }
                    }
            } else {
#pragma unroll
                for (int ai = 0; ai < 2; ++ai)
#pragma unroll
                    for (int m = 0; m < 4; ++m) {
                        bf16_t* rowp = O + (size_t)(row0 + ai * 128 + m * 16) * ldc + colbase + cw;
#pragma unroll
                        for (int bj = 0; bj < 2; ++bj) {
                            const f32x4 v0 = acc[ai][bj][m][0], v1 = acc[ai][bj][m][1];
                            u32x4 w; w.x = pg8::cvt_pk_bf16(v0[0], v0[1]); w.y = pg8::cvt_pk_bf16(v0[2], v0[3]); w.z = pg8::cvt_pk_bf16(v1[0], v1[1]); w.w = pg8::cvt_pk_bf16(v1[2], v1[3]);
                            st16_wt(rowp + bj * 128, w);
                        }
                    }
            }
        }
    }
};

DI void run_gemm(LAS unsigned char* lds, const bf16_t* A, const bf16_t* Bt, int M, int N, int K, bf16_t* O, int ldc, int mode, int G) {
#if PHMASK & 4
#ifndef STAG
#define STAG 0
#endif
    if (STAG && mode != 0) {
        const int d = ((int)blockIdx.x >> 3) & 3;
        for (int i = 0; i < d * STAG; ++i) __builtin_amdgcn_s_sleep(64);
    }
    pg8::Gemm g{A, Bt, M, N, K}; pg8::StaticOrder S; S.init(M, N, G, (int)blockIdx.x);
    EpiGen E{O, ldc, mode};
#ifndef G_ALIGN
#define G_ALIGN true
#endif
#ifndef G_SP2
#define G_SP2 true
#endif
    pg8::gemm_phase<EpiGen, pg8::StaticOrder, G_ALIGN, G_SP2>(lds, g, S, E);
#endif
}

DI int dest_row(int n0, int mode) {
    if (mode == 1) { const int half = n0 >= DFF ? 1 : 0, n = n0 - half * DFF; return 256 * (n >> 7) + 128 * half + (n & 127); }
    if (mode == 2) { if (n0 < 512) return 256 * (n0 >> 7) + (n0 & 127); if (n0 < 1024) return 1024 + (n0 - 512); if (n0 < 1536) { const int n = n0 - 1024; return 256 * (n >> 7) + 128 + (n & 127); } return n0; }
    return n0;
}
DI void transpose_item(const float* W, int K, int N, bf16_t* WT, int mode, LAS float* scr, int item, int lane) {
    const int nblk = N / 32, kb = item / nblk, nb = item % nblk, k0 = 64 * kb, n0 = 32 * nb;
#pragma unroll
    for (int i = 0; i < 32; ++i) { const int kk = 2 * i + (lane >> 5); scr[kk * 33 + (lane & 31)] = __builtin_nontemporal_load(W + (size_t)(k0 + kk) * N + n0 + (lane & 31)); }
    asm volatile("s_waitcnt lgkmcnt(0)" ::: "memory");
    const int c = lane & 7, dr = dest_row(n0, mode);
#pragma unroll
    for (int j = 0; j < 4; ++j) { const int n = (lane >> 3) + 8 * j; const LAS float* s = scr + (8 * c) * 33 + n;
        u32x4 o; o.x = pk2(s[0 * 33], s[1 * 33]); o.y = pk2(s[2 * 33], s[3 * 33]); o.z = pk2(s[4 * 33], s[5 * 33]); o.w = pk2(s[6 * 33], s[7 * 33]);
        *(u32x4*)(WT + (size_t)(dr + n) * K + k0 + 8 * c) = o; }
    asm volatile("s_waitcnt lgkmcnt(0)" ::: "memory");
}

DI void setup_phase(const Params& p, LAS unsigned char* lds, int G, int tid, int wid, int lane) {
    unsigned char* ws = p.ws;
    {
        LAS float* sc = (LAS float*)lds;
        LAS float* red = sc + 18 * 1024;
        for (int i = tid; i < 18 * 1024; i += NTHR) { const int b = i >> 10, k = i & 1023;
            const float c = (b < 2) ? p.in[2][b * 1024 + k] : p.in[3][(b - 2) * 1024 + k]; sc[i] = silu_f(c); }
        __syncthreads();
        for (int u = blockIdx.x; u < 288; u += G) {
            const int l = u / 144, cb = u % 144, col = cb * 64 + lane;
            float acc[18];
#pragma unroll
            for (int b = 0; b < 18; ++b) acc[b] = 0.f;
            const float* wp = p.in[4] + ((size_t)l * 1024 + wid * 128) * 9216 + col;
            const LAS f32x4* sc4 = (const LAS f32x4*)sc + wid * 32;
#pragma unroll 4
            for (int k4 = 0; k4 < 32; ++k4) {
                const float w0 = __builtin_nontemporal_load(wp + (size_t)(4 * k4) * 9216), w1 = __builtin_nontemporal_load(wp + (size_t)(4 * k4 + 1) * 9216), w2 = __builtin_nontemporal_load(wp + (size_t)(4 * k4 + 2) * 9216), w3 = __builtin_nontemporal_load(wp + (size_t)(4 * k4 + 3) * 9216);
#pragma unroll
                for (int b = 0; b < 18; ++b) { const f32x4 sv = sc4[b * 256 + k4]; acc[b] += (sv[0] * w0 + sv[1] * w1) + (sv[2] * w2 + sv[3] * w3); }
            }
#pragma unroll
            for (int b = 0; b < 18; ++b) red[(wid * 18 + b) * 64 + lane] = acc[b];
            __syncthreads();
            for (int i = tid; i < 18 * 64; i += NTHR) { const int b = i >> 6, c = i & 63; float sm = p.in[5][l * 9216 + cb * 64 + c];
#pragma unroll
                for (int w = 0; w < 8; ++w) sm += red[(w * 18 + b) * 64 + c];
                ((float*)(ws + WS_MOD))[((size_t)l * 18 + b) * 9216 + cb * 64 + c] = sm; }
            __syncthreads();
        }
    }
    {
        LAS float* scr = (LAS float*)(lds + wid * 16384);
        const int nskip = (G > 64 && 288 - G > 0 && 288 - G < G / 2) ? 288 - G : 0;
        const int gw = ((int)blockIdx.x - nskip) * 8 + wid, NGW = (G - nskip) * 8;
        constexpr int I_UP = 16 * 176, I_DN = 44 * 32, I_EI = 16 * 48, I_OI = 16 * 64, I_O = 16 * 32;
        constexpr int NITEMS = 4 * I_UP + 4 * I_DN + I_EI + I_OI + 2 * I_O;
        for (int it = gw; it < NITEMS && gw >= 0; it += NGW) {
            int r = it;
            if (r < 4 * I_UP) { const int i = r / I_UP; r -= i * I_UP; const int l = i >> 1, f = i & 1;
                transpose_item(p.in[f ? 10 : 8] + (size_t)l * 1024 * 5632, 1024, 5632, (bf16_t*)(ws + WS_WUP) + (size_t)i * 5632 * 1024, 1, scr, r, lane); continue; }
            r -= 4 * I_UP;
            if (r < 4 * I_DN) { const int i = r / I_DN; r -= i * I_DN; const int l = i >> 1, f = i & 1;
                transpose_item(p.in[f ? 11 : 9] + (size_t)l * 2816 * 1024, 2816, 1024, (bf16_t*)(ws + WS_WDN) + (size_t)i * 1024 * 2816, 0, scr, r, lane); continue; }
            r -= 4 * I_DN;
            if (r < I_EI) { transpose_item(p.in[12], 1024, 1536, (bf16_t*)(ws + WS_EVIN), 0, scr, r, lane); continue; }
            r -= I_EI;
            if (r < I_OI) { transpose_item(p.in[20], 1024, 2048, (bf16_t*)(ws + WS_ODIN), 2, scr, r, lane); continue; }
            r -= I_OI;
            if (r < I_O) { transpose_item(p.in[19], 1024, 1024, (bf16_t*)(ws + WS_EVOUT), 0, scr, r, lane); continue; }
            r -= I_O;
            transpose_item(p.in[24], 1024, 1024, (bf16_t*)(ws + WS_ODOUT), 0, scr, r, lane);
        }
    }
    {
        const int gt = blockIdx.x * NTHR + tid, NT = G * NTHR;
        bf16_t* WSP = (bf16_t*)(ws + WS_WSP); bf16_t* WPT = (bf16_t*)(ws + WS_WPT); bf16_t* WF = (bf16_t*)(ws + WS_WF);
        for (int i = gt; i < 65536; i += NT) {
            WSP[i] = (bf16_t)f2bf(p.in[15][i]);
            const int g = i >> 14, e = (i >> 7) & 127, d = i & 127;
            WPT[i] = (bf16_t)f2bf(p.in[17][(g * 128 + d) * 128 + e]);
        }
        {
            LAS float* tab = (LAS float*)(lds + 132 * 1024);
            if (tid < 128) { const float x = (float)tid * (1.0f / 64.0f); tab[tid] = cospif(x); tab[128 + tid] = sinpif(x); }
            __syncthreads();
            for (int i = gt; i < 131072; i += NT) {
                const int g = i >> 15, n = (i >> 7) & 255, d = i & 127, comp = n >> 7, e = n & 127;
                const float* fw = p.in[23] + (size_t)g * 16384 + e; const LAS float* tb = tab + comp * 128; float sm = 0.f;
#pragma unroll 8
                for (int m = 0; m < 128; ++m) sm += tb[(m * d) & 127] * fw[m * 128];
                WF[i] = (bf16_t)f2bf(sm * p.in[22][g * 128 + d]);
            }
        }
        bf16_t* FC1 = (bf16_t*)(ws + WS_FC1); bf16_t* FS1 = (bf16_t*)(ws + WS_FS1); bf16_t* FC2 = (bf16_t*)(ws + WS_FC2); bf16_t* FS2 = (bf16_t*)(ws + WS_FS2);
        f32x2* TW128 = (f32x2*)(ws + WS_TW128);
        for (int i = gt; i < 16384; i += NT) {
            const int k1 = i >> 7, col = i & 127, s = col >> 5, j = col & 31, fqq = j >> 3, ii = j & 7;
            const int r = 32 * s + (ii < 4 ? fqq * 4 + ii : 16 + fqq * 4 + ii - 4);
            const float x = (float)((k1 * r) & 127) * (1.0f / 64.0f);
            FC1[i] = (bf16_t)f2bf(cospif(x)); FS1[i] = (bf16_t)f2bf(sinpif(x));
            const float y = (float)((k1 * col) & 127) * (1.0f / 64.0f);
            FC2[i] = (bf16_t)f2bf(cospif(y)); FS2[i] = (bf16_t)f2bf(sinpif(y));
            const float z = (float)(k1 * col) * (1.0f / 8192.0f);
            TW128[i] = (f32x2){cospif(z), sinpif(z)};
        }
        bf16_t* FC16 = (bf16_t*)(ws + WS_FC16); bf16_t* FS16 = (bf16_t*)(ws + WS_FS16);
        for (int i = gt; i < 512; i += NT) {
            const int k1 = i >> 5, j = i & 31, fqq = j >> 3, ii = j & 7;
            float c = 0.f, s = 0.f;
            if (ii < 4) { const int r = fqq * 4 + ii; const float x = (float)((k1 * r) & 15) * (1.0f / 8.0f); c = cospif(x); s = sinpif(x); }
            FC16[i] = (bf16_t)f2bf(c); FS16[i] = (bf16_t)f2bf(s);
        }
        f32x2* TW16 = (f32x2*)(ws + WS_TW16);
        for (int i = gt; i < 2048; i += NT) { const int q = i >> 4, k1 = i & 15; const float z = (float)(k1 * q) * (1.0f / 1024.0f); TW16[i] = (f32x2){cospif(z), sinpif(z)}; }
    }
}

DI void modreduce_phase(const Params& p, int G, int tid) {
    const float* mp = (const float*)(p.ws + WS_MODP); float* mod = (float*)(p.ws + WS_MOD);
    for (int i = blockIdx.x * NTHR + tid; i < 2 * 18 * 9216; i += G * NTHR) {
        const int l = i / (18 * 9216), j = i % 9216;
        float s = p.in[5][l * 9216 + j];
#pragma unroll
        for (int ks = 0; ks < 4; ++ks) s += mp[(size_t)ks * (2 * 18 * 9216) + i];
        mod[i] = s;
    }
}

typedef _Float16 h16x4 __attribute__((ext_vector_type(4)));
typedef _Float16 h16x8 __attribute__((ext_vector_type(8)));
template <bool IN32, bool PREV, bool NEXT, bool OUT32>
DI void norm_phase_t(const float* xin32, const _Float16* xin16, float* xout32, _Float16* xout16, const bf16_t* T, bf16_t* H,
                     const float* gate_base, const float* gpost, float rw, const float* ss_base, const float* gpre, int gi, int G, int wid, int lane) {
    const bool teamed = (G == 256);
    const int bx = (int)blockIdx.x & 7, bj = (int)blockIdx.x >> 3;
    const int nh = teamed ? 2 : (GROWS + G * 8 - 1) / (G * 8), rows_h = teamed ? 8 : 1;
    for (int hh = 0; hh < nh; ++hh) {
        const int r0 = teamed ? 256 * (16 * bx + 8 * hh + (bj & 7)) + 64 * (bj >> 3) + wid : (int)blockIdx.x * 8 + wid + hh * G * 8;
        if (r0 >= GROWS) break;
        const int bidx = (gi == 0) ? (r0 >> 14) : 2 + (r0 >> 11);
        f32x4 gpv[4], gtv[4], shv[4], scv[4], gnv[4];
        if (PREV) { const f32x4* gp = (const f32x4*)gpost + 2 * lane; const f32x4* gt = (const f32x4*)(gate_base + (size_t)bidx * 9216) + 2 * lane;
#pragma unroll
            for (int j = 0; j < 4; ++j) { const int o = 128 * (j >> 1) + (j & 1); gpv[j] = gp[o] * rw; gtv[j] = gt[o] + 1.0f; gpv[j] = gpv[j] * gtv[j]; } }
        if (NEXT) { const f32x4* gp = (const f32x4*)gpre + 2 * lane; const f32x4* sh = (const f32x4*)(ss_base + (size_t)bidx * 9216) + 2 * lane; const f32x4* sc = sh + 256;
#pragma unroll
            for (int j = 0; j < 4; ++j) { const int o = 128 * (j >> 1) + (j & 1); gnv[j] = gp[o] * (sc[o] + 1.0f); shv[j] = sh[o]; } }
#pragma unroll 2
        for (int i = 0; i < rows_h; ++i) {
            const int r = r0 + 8 * i;
            f32x4 v[4]; u32x4 tw[2];
            if (IN32) { const f32x4* xr = (const f32x4*)(xin32 + (size_t)r * D) + 2 * lane;
#pragma unroll
                for (int j = 0; j < 2; ++j) { v[2 * j] = xr[128 * j]; v[2 * j + 1] = xr[128 * j + 1]; } }
            else { const h16x8* xr = (const h16x8*)(xin16 + (size_t)r * D) + lane; h16x8 hv[2];
#pragma unroll
                for (int j = 0; j < 2; ++j) hv[j] = __builtin_nontemporal_load(xr + 64 * j);
                if (PREV) { const u32x4* tr = (const u32x4*)(T + (size_t)r * D) + lane;
#pragma unroll
                    for (int j = 0; j < 2; ++j) tw[j] = __builtin_nontemporal_load(tr + 64 * j); }
#pragma unroll
                for (int j = 0; j < 2; ++j) { v[2 * j] = (f32x4){(float)hv[j][0], (float)hv[j][1], (float)hv[j][2], (float)hv[j][3]}; v[2 * j + 1] = (f32x4){(float)hv[j][4], (float)hv[j][5], (float)hv[j][6], (float)hv[j][7]}; } }
            if (PREV) {
                if (IN32) { const u32x4* tr = (const u32x4*)(T + (size_t)r * D) + lane;
#pragma unroll
                    for (int j = 0; j < 2; ++j) tw[j] = __builtin_nontemporal_load(tr + 64 * j); }
                f32x4 tv[4]; float ss = 0.f;
#pragma unroll
                for (int j = 0; j < 2; ++j) { const u32x4 w = tw[j];
                    tv[2 * j] = (f32x4){bf_lo(w.x), bf_hi(w.x), bf_lo(w.y), bf_hi(w.y)}; tv[2 * j + 1] = (f32x4){bf_lo(w.z), bf_hi(w.z), bf_lo(w.w), bf_hi(w.w)}; }
#pragma unroll
                for (int j = 0; j < 4; ++j) ss += (tv[j][0] * tv[j][0] + tv[j][1] * tv[j][1]) + (tv[j][2] * tv[j][2] + tv[j][3] * tv[j][3]);
                const float rstd = rsqrtf(wave_sum(ss) * (1.0f / D) + 1e-6f);
#pragma unroll
                for (int j = 0; j < 4; ++j) v[j] = v[j] + (tv[j] * rstd) * gpv[j];
                if (OUT32) { f32x4* xo = (f32x4*)(xout32 + (size_t)r * D) + 2 * lane;
#pragma unroll
                    for (int j = 0; j < 4; ++j) __builtin_nontemporal_store(v[j], xo + 128 * (j >> 1) + (j & 1)); }
                else { h16x8* xo = (h16x8*)(xout16 + (size_t)r * D) + lane;
#pragma unroll
                    for (int j = 0; j < 2; ++j) { h16x8 hv;
#pragma unroll
                        for (int k = 0; k < 4; ++k) { hv[k] = (_Float16)v[2 * j][k]; hv[4 + k] = (_Float16)v[2 * j + 1][k]; }
                        __builtin_nontemporal_store(hv, xo + 64 * j);
#pragma unroll
                        for (int k = 0; k < 4; ++k) { v[2 * j][k] = (float)hv[k]; v[2 * j + 1][k] = (float)hv[4 + k]; } } }
            }
            if (NEXT) {
                float ss = 0.f;
#pragma unroll
                for (int j = 0; j < 4; ++j) ss += (v[j][0] * v[j][0] + v[j][1] * v[j][1]) + (v[j][2] * v[j][2] + v[j][3] * v[j][3]);
                const float rstd = rsqrtf(wave_sum(ss) * (1.0f / D) + 1e-6f);
                u32x4* ho = (u32x4*)(H + (size_t)r * D) + lane;
#pragma unroll
                for (int j = 0; j < 2; ++j) { const f32x4 h0 = (v[2 * j] * rstd) * gnv[2 * j] + shv[2 * j], h1 = (v[2 * j + 1] * rstd) * gnv[2 * j + 1] + shv[2 * j + 1];
                    u32x4 w; w.x = pk2(h0[0], h0[1]); w.y = pk2(h0[2], h0[3]); w.z = pk2(h1[0], h1[1]); w.w = pk2(h1[2], h1[3]); st16_wt(ho + 64 * j, w); }
            }
        }
    }
}
DI void norm_phase(const float* xin32, const _Float16* xin16, float* xout32, _Float16* xout16, const bf16_t* T, bf16_t* H, bool has_prev, bool has_next,
                   const float* gate_base, const float* gpost, float rw, const float* ss_base, const float* gpre, int gi, int G, int wid, int lane) {
    if (!has_prev)        norm_phase_t<true, false, true, false>(xin32, xin16, xout32, xout16, T, H, gate_base, gpost, rw, ss_base, gpre, gi, G, wid, lane);
    else if (xin32)       norm_phase_t<true, true, true, false>(xin32, xin16, xout32, xout16, T, H, gate_base, gpost, rw, ss_base, gpre, gi, G, wid, lane);
    else if (has_next)    norm_phase_t<false, true, true, false>(xin32, xin16, xout32, xout16, T, H, gate_base, gpost, rw, ss_base, gpre, gi, G, wid, lane);
    else                  norm_phase_t<false, true, false, true>(xin32, xin16, xout32, xout16, T, H, gate_base, gpost, rw, ss_base, gpre, gi, G, wid, lane);
}

template <int GI>
DI void pool_group(const bf16_t* PR, bf16_t* YY, const bf16_t* WPT, const float* pool_scale, size_t tok0, int tl, int pos, int S, int fr, int fq) {
    constexpr int hw = 1 << GI, g = GI;
    const int lo = max(pos - hw, 0), hi = min(pos + hw, S); const float inv = 1.0f / (float)(hi - lo);
    f32x4 acc[8];
#pragma unroll
    for (int e = 0; e < 8; ++e) acc[e] = (f32x4){0.f, 0.f, 0.f, 0.f};
#pragma unroll 1
    for (int ks = 0; ks < 4; ++ks) {
        const bf16_t* zc = PR + (tok0 + tl) * PRP + 1024 + g * 128 + ks * 32 + fq * 8;
        u32x4 w[2 * hw];
#pragma unroll
        for (int j = 0; j < 2 * hw; ++j) { const int t2 = pos + j - hw; const bool ok = (t2 >= 0) && (t2 < S); w[j] = (u32x4){0u, 0u, 0u, 0u}; if (ok) w[j] = *(const u32x4*)(zc + (ptrdiff_t)(j - hw) * PRP); }
        bf16x8 wf[8];
#pragma unroll
        for (int et = 0; et < 8; ++et) wf[et] = *(const bf16x8*)(WPT + ((g * 128 + et * 16 + fr) * 128 + ks * 32 + fq * 8));
        f32x4 s0 = (f32x4){0.f, 0.f, 0.f, 0.f}, s1 = s0;
#pragma unroll
        for (int j = 0; j < 2 * hw; ++j) { s0 += (f32x4){bf_lo(w[j].x), bf_hi(w[j].x), bf_lo(w[j].y), bf_hi(w[j].y)}; s1 += (f32x4){bf_lo(w[j].z), bf_hi(w[j].z), bf_lo(w[j].w), bf_hi(w[j].w)}; }
        const u32x4 cw = w[hw];
        s0 = s0 * inv - (f32x4){bf_lo(cw.x), bf_hi(cw.x), bf_lo(cw.y), bf_hi(cw.y)}; s1 = s1 * inv - (f32x4){bf_lo(cw.z), bf_hi(cw.z), bf_lo(cw.w), bf_hi(cw.w)};
        u32x4 dw; dw.x = pk2(s0[0], s0[1]); dw.y = pk2(s0[2], s0[3]); dw.z = pk2(s1[0], s1[1]); dw.w = pk2(s1[2], s1[3]);
        const bf16x8 df = __builtin_bit_cast(bf16x8, dw);
#pragma unroll
        for (int et = 0; et < 8; ++et) acc[et] = mfma16(wf[et], df, acc[et]);
    }
#pragma unroll
    for (int et = 0; et < 8; ++et) { const int e = g * 128 + et * 16 + fq * 4; const f32x4 ps = *(const f32x4*)(pool_scale + e); const f32x4 y = acc[et] * ps;
        u32x2 o; o.x = pk2(y[0], y[1]); o.y = pk2(y[2], y[3]); *(u32x2*)(YY + (tok0 + tl) * 1024 + 512 + e) = o; }
}

constexpr int PL_ZOFF = 0, PL_WOFF = 144 * 272, PL_PITCH = 272;
struct PoolStage { u32x4 z[5]; u32x4 w[4]; };
DI void pool_stage_load(PoolStage& ps, const bf16_t* PR, const bf16_t* WPT, size_t tok0, int pos0, int S, int g, int tid) {
#pragma unroll
    for (int i = 0; i < 5; ++i) { const int idx = tid + NTHR * i, row = idx >> 4, c = idx & 15; const int p = pos0 - 8 + row;
        ps.z[i] = (u32x4){0u, 0u, 0u, 0u};
        if (idx < 144 * 16 && p >= 0 && p < S) ps.z[i] = *(const u32x4*)(PR + (size_t)((ptrdiff_t)tok0 - 8 + row) * PRP + 1024 + g * 128 + c * 8); }
#pragma unroll
    for (int i = 0; i < 4; ++i) { const int idx = tid + NTHR * i; ps.w[i] = *(const u32x4*)(WPT + (g * 128 + (idx >> 4)) * 128 + (idx & 15) * 8); }
}
DI void pool_stage_store(const PoolStage& ps, LAS unsigned char* lds, int tid) {
#pragma unroll
    for (int i = 0; i < 5; ++i) { const int idx = tid + NTHR * i; if (idx < 144 * 16) *(LAS u32x4*)(lds + PL_ZOFF + (idx >> 4) * PL_PITCH + (idx & 15) * 16) = ps.z[i]; }
#pragma unroll
    for (int i = 0; i < 4; ++i) { const int idx = tid + NTHR * i; *(LAS u32x4*)(lds + PL_WOFF + (idx >> 4) * PL_PITCH + (idx & 15) * 16) = ps.w[i]; }
}
template <int GI>
DI void pool_compute(LAS unsigned char* lds, bf16_t* YY, const float* pool_scale, size_t tok0, int tl, int pos, int S, int fr, int fq) {
    constexpr int hw = 1 << GI, g = GI;
    const int lo = max(pos - hw, 0), hi = min(pos + hw, S); const float inv = 1.0f / (float)(hi - lo);
    f32x4 acc[8];
#pragma unroll
    for (int e = 0; e < 8; ++e) acc[e] = (f32x4){0.f, 0.f, 0.f, 0.f};
#pragma unroll 2
    for (int ks = 0; ks < 4; ++ks) {
        const LAS unsigned char* zb = lds + PL_ZOFF + (tl + 8) * PL_PITCH + (ks * 32 + fq * 8) * 2;
        f32x4 s0 = (f32x4){0.f, 0.f, 0.f, 0.f}, s1 = s0;
#pragma unroll
        for (int j = -hw; j < hw; ++j) { const u32x4 x = *(const LAS u32x4*)(zb + j * PL_PITCH);
            s0 += (f32x4){bf_lo(x.x), bf_hi(x.x), bf_lo(x.y), bf_hi(x.y)}; s1 += (f32x4){bf_lo(x.z), bf_hi(x.z), bf_lo(x.w), bf_hi(x.w)}; }
        const u32x4 cw = *(const LAS u32x4*)zb;
        s0 = s0 * inv - (f32x4){bf_lo(cw.x), bf_hi(cw.x), bf_lo(cw.y), bf_hi(cw.y)}; s1 = s1 * inv - (f32x4){bf_lo(cw.z), bf_hi(cw.z), bf_lo(cw.w), bf_hi(cw.w)};
        u32x4 dw; dw.x = pk2(s0[0], s0[1]); dw.y = pk2(s0[2], s0[3]); dw.z = pk2(s1[0], s1[1]); dw.w = pk2(s1[2], s1[3]);
        const bf16x8 df = __builtin_bit_cast(bf16x8, dw);
#pragma unroll
        for (int et = 0; et < 8; ++et) { const bf16x8 wf = *(const LAS bf16x8*)(lds + PL_WOFF + (et * 16 + fr) * PL_PITCH + (ks * 32 + fq * 8) * 2); acc[et] = mfma16(wf, df, acc[et]); }
    }
#pragma unroll
    for (int et = 0; et < 8; ++et) { const int e = g * 128 + et * 16 + fq * 4; const f32x4 ps = *(const f32x4*)(pool_scale + e); const f32x4 y = acc[et] * ps;
        u32x2 o; o.x = pk2(y[0], y[1]); o.y = pk2(y[2], y[3]); *(u32x2*)(YY + (tok0 + tl) * 1024 + 512 + e) = o; }
}

DI void even_core(LAS unsigned char* lds, const bf16_t* PR, bf16_t* YY, const bf16_t* WSP, const bf16_t* WPT, const float* ln_g, const float* ln_b,
                  const float* b_sp, const float* pool_scale, int S, int G, int tid, int wid, int lane) {
    const int fr = lane & 15, fq = lane >> 4;
    constexpr int PITCH = 1056;
    for (int ch0 = blockIdx.x; ch0 < GROWS / 128; ch0 += G) {
        const int ch = (G == 256) ? 2 * (16 * (ch0 & 7) + 8 * (ch0 >> 7) + ((ch0 >> 3) & 7)) + ((ch0 >> 6) & 1) : ch0;
        const size_t tok0 = (size_t)ch * 128;
        {
            const f32x4 g0 = *(const f32x4*)(ln_g + lane * 8), g1 = *(const f32x4*)(ln_g + lane * 8 + 4), b0 = *(const f32x4*)(ln_b + lane * 8), b1 = *(const f32x4*)(ln_b + lane * 8 + 4);
#pragma unroll 8
            for (int i = 0; i < 16; ++i) {
                const int q = wid * 16 + i;
                const u32x4 w = *(const u32x4*)(PR + (tok0 + q) * PRP + 512 + lane * 8);
                f32x4 a = (f32x4){bf_lo(w.x), bf_hi(w.x), bf_lo(w.y), bf_hi(w.y)}, b = (f32x4){bf_lo(w.z), bf_hi(w.z), bf_lo(w.w), bf_hi(w.w)};
                const float mean = wave_sum((a[0] + a[1]) + (a[2] + a[3]) + (b[0] + b[1]) + (b[2] + b[3])) * (1.0f / 512.0f);
                a = a - mean; b = b - mean;
                const float var = wave_sum((a[0] * a[0] + a[1] * a[1]) + (a[2] * a[2] + a[3] * a[3]) + (b[0] * b[0] + b[1] * b[1]) + (b[2] * b[2] + b[3] * b[3])) * (1.0f / 512.0f);
                const float rstd = rsqrtf(var + 1e-5f);
                a = a * rstd * g0 + b0; b = b * rstd * g1 + b1;
                u32x4 o; o.x = pk2(a[0], a[1]); o.y = pk2(a[2], a[3]); o.z = pk2(b[0], b[1]); o.w = pk2(b[2], b[3]);
                *(LAS u32x4*)(lds + q * PITCH + lane * 16) = o;
            }
        }
        __syncthreads();
        {
            const int h = wid >> 1, cw0 = wid * 64;
            for (int ph = 0; ph < 2; ++ph) {
                f32x4 acc[4][4];
#pragma unroll
                for (int a = 0; a < 4; ++a)
#pragma unroll
                    for (int b = 0; b < 4; ++b) acc[a][b] = (f32x4){0.f, 0.f, 0.f, 0.f};
#pragma unroll 1
                for (int kp = 0; kp < 2; ++kp) {
                    bf16x8 bw[2][4];
#pragma unroll
                    for (int k2 = 0; k2 < 2; ++k2)
#pragma unroll
                        for (int pt = 0; pt < 4; ++pt) bw[k2][pt] = *(const bf16x8*)(WSP + ((h * 128 + (ph * 4 + pt) * 16 + fr) * 128 + (kp * 2 + k2) * 32 + fq * 8));
#pragma unroll
                    for (int k2 = 0; k2 < 2; ++k2) {
                        const int ks = kp * 2 + k2;
                        bf16x8 af[4];
#pragma unroll
                        for (int ct = 0; ct < 4; ++ct) af[ct] = tr_frag(lds + (ks * 32 + fq * 8 + (fr >> 2)) * PITCH + (cw0 + ct * 16 + 4 * (fr & 3)) * 2, 4 * PITCH);
#pragma unroll
                        for (int ct = 0; ct < 4; ++ct)
#pragma unroll
                            for (int pt = 0; pt < 4; ++pt) acc[ct][pt] = mfma16(af[ct], bw[k2][pt], acc[ct][pt]);
                    }
                }
#pragma unroll
                for (int pt = 0; pt < 4; ++pt) {
                    const int pp = (ph * 4 + pt) * 16 + fr; const float bs = b_sp[h * 128 + pp];
#pragma unroll
                    for (int ct = 0; ct < 4; ++ct) {
                        const int c = cw0 + ct * 16 + fq * 4;
                        const u32x2 uw = *(const u32x2*)(PR + (tok0 + pp) * PRP + c);
                        u32x2 o; o.x = pk2(bf_lo(uw.x) * (acc[ct][pt][0] + bs), bf_hi(uw.x) * (acc[ct][pt][1] + bs)); o.y = pk2(bf_lo(uw.y) * (acc[ct][pt][2] + bs), bf_hi(uw.y) * (acc[ct][pt][3] + bs));
                        *(u32x2*)(YY + (tok0 + pp) * 1024 + c) = o;
                    }
                }
            }
        }
        {
            const int tl = wid * 16 + fr; const int pos = (int)(tok0 % (size_t)S) + tl;
            const int pos0 = (int)(tok0 % (size_t)S);
            PoolStage ps;
            pool_stage_load(ps, PR, WPT, tok0, pos0, S, 0, tid);
            __syncthreads();
            pool_stage_store(ps, lds, tid); pool_stage_load(ps, PR, WPT, tok0, pos0, S, 1, tid);
            __syncthreads();
            pool_compute<0>(lds, YY, pool_scale, tok0, tl, pos, S, fr, fq);
            __syncthreads();
            pool_stage_store(ps, lds, tid); pool_stage_load(ps, PR, WPT, tok0, pos0, S, 2, tid);
            __syncthreads();
            pool_compute<1>(lds, YY, pool_scale, tok0, tl, pos, S, fr, fq);
            __syncthreads();
            pool_stage_store(ps, lds, tid); pool_stage_load(ps, PR, WPT, tok0, pos0, S, 3, tid);
            __syncthreads();
            pool_compute<2>(lds, YY, pool_scale, tok0, tl, pos, S, fr, fq);
            __syncthreads();
            pool_stage_store(ps, lds, tid);
            __syncthreads();
            pool_compute<3>(lds, YY, pool_scale, tok0, tl, pos, S, fr, fq);
        }
        __syncthreads();
    }
}

DI void conv_part(const bf16_t* PR, bf16_t* YY, const float* conv_w, int S, int G, int wid, int lane) {
    const int gw = blockIdx.x * 8 + wid, NGW = G * 8;
    f32x4 w[3][2];
#pragma unroll
    for (int k = 0; k < 3; ++k) { w[k][0] = *(const f32x4*)(conv_w + k * 512 + lane * 8); w[k][1] = *(const f32x4*)(conv_w + k * 512 + lane * 8 + 4); }
#pragma unroll 8
    for (int r = gw; r < GROWS; r += NGW) {
        const int pos = r % S;
        const bf16_t* cz = PR + (size_t)r * PRP + lane * 8;
        const float m0 = (pos > 0) ? 1.0f : 0.0f, m2 = (pos < S - 1) ? 1.0f : 0.0f;
        const u32x4 c1 = *(const u32x4*)cz, c0 = *(const u32x4*)(cz - (pos > 0 ? PRP : 0)), c2 = *(const u32x4*)(cz + (pos < S - 1 ? PRP : 0)), bg = *(const u32x4*)(cz + 512);
        const f32x4 w00 = w[0][0] * m0, w01 = w[0][1] * m0, w20 = w[2][0] * m2, w21 = w[2][1] * m2;
        f32x4 a0 = (f32x4){bf_lo(c0.x), bf_hi(c0.x), bf_lo(c0.y), bf_hi(c0.y)} * w00 + (f32x4){bf_lo(c1.x), bf_hi(c1.x), bf_lo(c1.y), bf_hi(c1.y)} * w[1][0] + (f32x4){bf_lo(c2.x), bf_hi(c2.x), bf_lo(c2.y), bf_hi(c2.y)} * w20;
        f32x4 a1 = (f32x4){bf_lo(c0.z), bf_hi(c0.z), bf_lo(c0.w), bf_hi(c0.w)} * w01 + (f32x4){bf_lo(c1.z), bf_hi(c1.z), bf_lo(c1.w), bf_hi(c1.w)} * w[1][1] + (f32x4){bf_lo(c2.z), bf_hi(c2.z), bf_lo(c2.w), bf_hi(c2.w)} * w21;
        a0 = a0 * (f32x4){bf_lo(bg.x), bf_hi(bg.x), bf_lo(bg.y), bf_hi(bg.y)}; a1 = a1 * (f32x4){bf_lo(bg.z), bf_hi(bg.z), bf_lo(bg.w), bf_hi(bg.w)};
        u32x4 o; o.x = pk2(a0[0], a0[1]); o.y = pk2(a0[2], a0[3]); o.z = pk2(a1[0], a1[1]); o.w = pk2(a1[2], a1[3]);
        *(u32x4*)(YY + (size_t)r * 1024 + lane * 8) = o;
    }
}

template <int R, int QB>
DI void four_stage1(const bf16_t* PR, bf16_t* UB, const bf16_t* WF, const bf16_t* FCp, const bf16_t* FSp, const f32x2* TW, int nb, int G, int wid, int lane) {
    constexpr int NT = R / 16, KS = (R + 31) / 32, KW = KS * 32, S = R * 128, NQB = 128 / QB;
    const int fr = lane & 15, fq = lane >> 4, e0 = wid * 16;
    const int nunits = nb * 4 * NQB;
    for (int un = blockIdx.x; un < nunits; un += G) {
        const int q0 = (un % NQB) * QB, g = (un / NQB) & 3, b = un / (4 * NQB);
        bf16x8 wP[4], wQ[4];
#pragma unroll
        for (int ks = 0; ks < 4; ++ks) { wP[ks] = *(const bf16x8*)(WF + ((g * 256 + e0 + fr) * 128 + ks * 32 + fq * 8)); wQ[ks] = *(const bf16x8*)(WF + ((g * 256 + 128 + e0 + fr) * 128 + ks * 32 + fq * 8)); }
        unsigned pP[QB][NT][2], pQ[QB][NT][2];
#pragma unroll
        for (int rt = 0; rt < NT; ++rt) {
#pragma unroll
            for (int qi = 0; qi < QB; ++qi) {
                const size_t tok = (size_t)b * S + 128 * (rt * 16 + fr) + q0 + qi;
                const bf16_t* zp = PR + tok * PRP + 1024 + g * 128 + fq * 8;
                bf16x8 a[4]; float ss = 0.f;
#pragma unroll
                for (int ks = 0; ks < 4; ++ks) a[ks] = *(const bf16x8*)(zp + ks * 32);
#pragma unroll
                for (int ks = 0; ks < 4; ++ks)
#pragma unroll
                    for (int k = 0; k < 8; ++k) { const float f = __uint_as_float(((unsigned)(unsigned short)a[ks][k]) << 16); ss += f * f; }
                ss += __shfl_xor(ss, 16); ss += __shfl_xor(ss, 32);
                const float rs = rsqrtf(ss * (1.0f / 128.0f) + 1e-6f);
                f32x4 dP = (f32x4){0.f, 0.f, 0.f, 0.f}, dQ = dP;
#pragma unroll
                for (int ks = 0; ks < 4; ++ks) { dP = mfma16(a[ks], wP[ks], dP); dQ = mfma16(a[ks], wQ[ks], dQ); }
#pragma unroll
                for (int j = 0; j < 4; ++j) { const float sj = __shfl(rs, fq * 4 + j); dP[j] *= sj; dQ[j] *= sj; }
                pP[qi][rt][0] = pk2(dP[0], dP[1]); pP[qi][rt][1] = pk2(dP[2], dP[3]); pQ[qi][rt][0] = pk2(dQ[0], dQ[1]); pQ[qi][rt][1] = pk2(dQ[2], dQ[3]);
            }
            if ((rt & 3) == 3) asm volatile("" ::: "memory");
        }
#pragma unroll 2
        for (int k1t = 0; k1t < NT; ++k1t) {
            bf16x8 aC[KS], aS[KS];
#pragma unroll
            for (int s = 0; s < KS; ++s) { aC[s] = *(const bf16x8*)(FCp + ((k1t * 16 + fr) * KW + s * 32 + fq * 8)); aS[s] = *(const bf16x8*)(FSp + ((k1t * 16 + fr) * KW + s * 32 + fq * 8)); }
#pragma unroll
            for (int qi = 0; qi < QB; ++qi) {
                f32x4 Ur = (f32x4){0.f, 0.f, 0.f, 0.f}, V = Ur;
#pragma unroll
                for (int s = 0; s < KS; ++s) {
                    u32x4 bp, bq;
                    bp.x = pP[qi][2 * s][0]; bp.y = pP[qi][2 * s][1]; bq.x = pQ[qi][2 * s][0]; bq.y = pQ[qi][2 * s][1];
                    if (2 * s + 1 < NT) { bp.z = pP[qi][(2 * s + 1) % NT][0]; bp.w = pP[qi][(2 * s + 1) % NT][1]; bq.z = pQ[qi][(2 * s + 1) % NT][0]; bq.w = pQ[qi][(2 * s + 1) % NT][1]; }
                    else { bp.z = 0u; bp.w = 0u; bq.z = 0u; bq.w = 0u; }
                    const u32x4 bnq = bq ^ 0x80008000u;
                    const bf16x8 BP = __builtin_bit_cast(bf16x8, bp), BQ = __builtin_bit_cast(bf16x8, bq), BNQ = __builtin_bit_cast(bf16x8, bnq);
                    Ur = mfma16(aC[s], BP, Ur); Ur = mfma16(aS[s], BNQ, Ur); V = mfma16(aS[s], BP, V); V = mfma16(aC[s], BQ, V);
                }
                const int q = q0 + qi;
#pragma unroll
                for (int j = 0; j < 4; ++j) {
                    const int k1 = k1t * 16 + fq * 4 + j; const f32x2 tw = TW[q * R + k1];
                    const float upr = Ur[j] * tw.x - V[j] * tw.y, upi = -(V[j] * tw.x + Ur[j] * tw.y);
                    bf16_t* o = UB + ((((size_t)b * R + k1) * 2) * 128 + q) * 512 + g * 128 + e0 + fr;
                    o[0] = (bf16_t)f2bf(upr); o[(size_t)128 * 512] = (bf16_t)f2bf(upi);
                }
            }
        }
    }
}

DI void four_stage1_p(LAS unsigned char* lds, const bf16_t* PR, bf16_t* UB, const bf16_t* WF, const bf16_t* FCp, const bf16_t* FSp, const f32x2* TW, int nb, int G, int tid, int wid, int lane) {
    constexpr int R = 128, S = R * 128, PT = 272, TC_OFF = 0, TS_OFF = 128 * PT, Z_OFF = 256 * PT, TW_OFF = 384 * PT;
    const int fr = lane & 15, fq = lane >> 4, e0 = wid * 16;
    const int nunits = nb * 4 * 128;
    {
#pragma unroll
        for (int i = 0; i < 4; ++i) { const int idx = tid + NTHR * i; const u32x4 c = *(const u32x4*)(FCp + (idx >> 4) * 128 + (idx & 15) * 8), sn = *(const u32x4*)(FSp + (idx >> 4) * 128 + (idx & 15) * 8);
            *(LAS u32x4*)(lds + TC_OFF + (idx >> 4) * PT + (idx & 15) * 16) = c; *(LAS u32x4*)(lds + TS_OFF + (idx >> 4) * PT + (idx & 15) * 16) = sn; }
    }
    u32x4 zr[4]; u32x4 twr = (u32x4){0u, 0u, 0u, 0u};
    int un = blockIdx.x;
    if (un < nunits) { const int q = un & 127, g = (un >> 7) & 3, b = un >> 9;
#pragma unroll
        for (int i = 0; i < 4; ++i) { const int idx = tid + NTHR * i; zr[i] = *(const u32x4*)(PR + ((size_t)b * S + 128 * (idx >> 4) + q) * PRP + 1024 + g * 128 + (idx & 15) * 8); }
        if (tid < 64) twr = *(const u32x4*)((const float*)(TW + q * R) + tid * 4); }
    for (; un < nunits; un += G) {
        const int q = un & 127, g = (un >> 7) & 3, b = un >> 9;
        bf16x8 wP[4], wQ[4];
#pragma unroll
        for (int ks = 0; ks < 4; ++ks) { wP[ks] = *(const bf16x8*)(WF + ((g * 256 + e0 + fr) * 128 + ks * 32 + fq * 8)); wQ[ks] = *(const bf16x8*)(WF + ((g * 256 + 128 + e0 + fr) * 128 + ks * 32 + fq * 8)); }
        __syncthreads();
#pragma unroll
        for (int i = 0; i < 4; ++i) { const int idx = tid + NTHR * i; *(LAS u32x4*)(lds + Z_OFF + (idx >> 4) * PT + (idx & 15) * 16) = zr[i]; }
        if (tid < 64) *(LAS u32x4*)(lds + TW_OFF + tid * 16) = twr;
        { const int un2 = un + G;
          if (un2 < nunits) { const int q2 = un2 & 127, g2 = (un2 >> 7) & 3, b2 = un2 >> 9;
#pragma unroll
            for (int i = 0; i < 4; ++i) { const int idx = tid + NTHR * i; zr[i] = *(const u32x4*)(PR + ((size_t)b2 * S + 128 * (idx >> 4) + q2) * PRP + 1024 + g2 * 128 + (idx & 15) * 8); }
            if (tid < 64) twr = *(const u32x4*)((const float*)(TW + q2 * R) + tid * 4); } }
        __syncthreads();
        unsigned pP[8][2], pQ[8][2];
#pragma unroll
        for (int rt = 0; rt < 8; ++rt) {
            bf16x8 a[4]; float ss = 0.f;
#pragma unroll
            for (int ks = 0; ks < 4; ++ks) a[ks] = *(const LAS bf16x8*)(lds + Z_OFF + (rt * 16 + fr) * PT + (ks * 32 + fq * 8) * 2);
#pragma unroll
            for (int ks = 0; ks < 4; ++ks)
#pragma unroll
                for (int k = 0; k < 8; ++k) { const float f = __uint_as_float(((unsigned)(unsigned short)a[ks][k]) << 16); ss += f * f; }
            ss += __shfl_xor(ss, 16); ss += __shfl_xor(ss, 32);
            const float rs = rsqrtf(ss * (1.0f / 128.0f) + 1e-6f);
            f32x4 dP = (f32x4){0.f, 0.f, 0.f, 0.f}, dQ = dP;
#pragma unroll
            for (int ks = 0; ks < 4; ++ks) { dP = mfma16(a[ks], wP[ks], dP); dQ = mfma16(a[ks], wQ[ks], dQ); }
#pragma unroll
            for (int j = 0; j < 4; ++j) { const float sj = __shfl(rs, fq * 4 + j); dP[j] *= sj; dQ[j] *= sj; }
            pP[rt][0] = pk2(dP[0], dP[1]); pP[rt][1] = pk2(dP[2], dP[3]); pQ[rt][0] = pk2(dQ[0], dQ[1]); pQ[rt][1] = pk2(dQ[2], dQ[3]);
            if ((rt & 3) == 3) asm volatile("" ::: "memory");
        }
#pragma unroll 2
        for (int k1t = 0; k1t < 8; ++k1t) {
            bf16x8 aC[4], aS[4];
#pragma unroll
            for (int sx = 0; sx < 4; ++sx) { aC[sx] = *(const LAS bf16x8*)(lds + TC_OFF + (k1t * 16 + fr) * PT + (sx * 32 + fq * 8) * 2); aS[sx] = *(const LAS bf16x8*)(lds + TS_OFF + (k1t * 16 + fr) * PT + (sx * 32 + fq * 8) * 2); }
            const f32x4 twa = *(const LAS f32x4*)(lds + TW_OFF + (k1t * 16 + fq * 4) * 8), twb = *(const LAS f32x4*)(lds + TW_OFF + (k1t * 16 + fq * 4) * 8 + 16);
            f32x4 Ur = (f32x4){0.f, 0.f, 0.f, 0.f}, V = Ur;
#pragma unroll
            for (int sx = 0; sx < 4; ++sx) {
                u32x4 bp, bq;
                bp.x = pP[2 * sx][0]; bp.y = pP[2 * sx][1]; bq.x = pQ[2 * sx][0]; bq.y = pQ[2 * sx][1];
                bp.z = pP[2 * sx + 1][0]; bp.w = pP[2 * sx + 1][1]; bq.z = pQ[2 * sx + 1][0]; bq.w = pQ[2 * sx + 1][1];
                const u32x4 bnq = bq ^ 0x80008000u;
                const bf16x8 BP = __builtin_bit_cast(bf16x8, bp), BQ = __builtin_bit_cast(bf16x8, bq), BNQ = __builtin_bit_cast(bf16x8, bnq);
                Ur = mfma16(aC[sx], BP, Ur); Ur = mfma16(aS[sx], BNQ, Ur); V = mfma16(aS[sx], BP, V); V = mfma16(aC[sx], BQ, V);
            }
            const float tcs[4] = {twa[0], twa[2], twb[0], twb[2]}, tsn[4] = {twa[1], twa[3], twb[1], twb[3]};
#pragma unroll
            for (int j = 0; j < 4; ++j) {
                const int k1 = k1t * 16 + fq * 4 + j;
                const float upr = Ur[j] * tcs[j] - V[j] * tsn[j], upi = -(V[j] * tcs[j] + Ur[j] * tsn[j]);
                bf16_t* o = UB + ((((size_t)b * R + k1) * 2) * 128 + q) * 512 + g * 128 + e0 + fr;
                o[0] = (bf16_t)f2bf(upr); o[(size_t)128 * 512] = (bf16_t)f2bf(upi);
            }
        }
    }
    __syncthreads();
}

DI void four_stage1_s(LAS unsigned char* lds, const bf16_t* PR, bf16_t* UB, const bf16_t* WF, const bf16_t* FCp, const bf16_t* FSp, const f32x2* TW, int nb, int G, int tid, int wid, int lane) {
    constexpr int R = 16, S = R * 128, QB = 4, NQB = 32, PT = 272;
    const int fr = lane & 15, fq = lane >> 4, e0 = wid * 16;
    const int nunits = nb * 4 * NQB;
    const bool uniform = (G % 128) == 0;
    int un = blockIdx.x;
    if (un >= nunits) return;
    int q0 = (un % NQB) * QB, g = (un / NQB) & 3;
    bf16x8 wP[4], wQ[4], aC, aS; f32x4 twv[QB][2];
    u32x4 zr[2];
#define S1S_CONST() do { _Pragma("unroll") for (int ks = 0; ks < 4; ++ks) { wP[ks] = *(const bf16x8*)(WF + ((g * 256 + e0 + fr) * 128 + ks * 32 + fq * 8)); wQ[ks] = *(const bf16x8*)(WF + ((g * 256 + 128 + e0 + fr) * 128 + ks * 32 + fq * 8)); } \
        _Pragma("unroll") for (int qi = 0; qi < QB; ++qi) { const f32x4* tp = (const f32x4*)(TW + (q0 + qi) * R + fq * 4); twv[qi][0] = tp[0]; twv[qi][1] = tp[1]; } } while (0)
    aC = *(const bf16x8*)(FCp + (fr * 32 + fq * 8)); aS = *(const bf16x8*)(FSp + (fr * 32 + fq * 8));
    S1S_CONST();
    { const int b = un / (4 * NQB);
#pragma unroll
      for (int i = 0; i < 2; ++i) { const int idx = tid + NTHR * i, row = idx >> 4; zr[i] = *(const u32x4*)(PR + ((size_t)b * S + 128 * (row & 15) + q0 + (row >> 4)) * PRP + 1024 + g * 128 + (idx & 15) * 8); } }
    for (; un < nunits; un += G) {
        const int b = un / (4 * NQB);
        __syncthreads();
#pragma unroll
        for (int i = 0; i < 2; ++i) { const int idx = tid + NTHR * i; *(LAS u32x4*)(lds + (idx >> 4) * PT + (idx & 15) * 16) = zr[i]; }
        const int un2 = un + G; int q0n = q0, gn = g;
        if (un2 < nunits) { const int b2 = un2 / (4 * NQB); q0n = (un2 % NQB) * QB; gn = (un2 / NQB) & 3;
#pragma unroll
            for (int i = 0; i < 2; ++i) { const int idx = tid + NTHR * i, row = idx >> 4; zr[i] = *(const u32x4*)(PR + ((size_t)b2 * S + 128 * (row & 15) + q0n + (row >> 4)) * PRP + 1024 + gn * 128 + (idx & 15) * 8); } }
        __syncthreads();
#pragma unroll
        for (int qi = 0; qi < QB; ++qi) {
            bf16x8 a[4]; float ss = 0.f;
#pragma unroll
            for (int ks = 0; ks < 4; ++ks) a[ks] = *(const LAS bf16x8*)(lds + (qi * 16 + fr) * PT + (ks * 32 + fq * 8) * 2);
#pragma unroll
            for (int ks = 0; ks < 4; ++ks)
#pragma unroll
                for (int k = 0; k < 8; ++k) { const float f = __uint_as_float(((unsigned)(unsigned short)a[ks][k]) << 16); ss += f * f; }
            ss += __shfl_xor(ss, 16); ss += __shfl_xor(ss, 32);
            const float rs = rsqrtf(ss * (1.0f / 128.0f) + 1e-6f);
            f32x4 dP = (f32x4){0.f, 0.f, 0.f, 0.f}, dQ = dP;
#pragma unroll
            for (int ks = 0; ks < 4; ++ks) { dP = mfma16(a[ks], wP[ks], dP); dQ = mfma16(a[ks], wQ[ks], dQ); }
#pragma unroll
            for (int j = 0; j < 4; ++j) { const float sj = __shfl(rs, fq * 4 + j); dP[j] *= sj; dQ[j] *= sj; }
            u32x4 bp, bq; bp.x = pk2(dP[0], dP[1]); bp.y = pk2(dP[2], dP[3]); bp.z = 0u; bp.w = 0u; bq.x = pk2(dQ[0], dQ[1]); bq.y = pk2(dQ[2], dQ[3]); bq.z = 0u; bq.w = 0u;
            const u32x4 bnq = bq ^ 0x80008000u;
            const bf16x8 BP = __builtin_bit_cast(bf16x8, bp), BQ = __builtin_bit_cast(bf16x8, bq), BNQ = __builtin_bit_cast(bf16x8, bnq);
            f32x4 Ur = (f32x4){0.f, 0.f, 0.f, 0.f}, V = Ur;
            Ur = mfma16(aC, BP, Ur); Ur = mfma16(aS, BNQ, Ur); V = mfma16(aS, BP, V); V = mfma16(aC, BQ, V);
            const int q = q0 + qi;
            const float tcs[4] = {twv[qi][0][0], twv[qi][0][2], twv[qi][1][0], twv[qi][1][2]}, tsn[4] = {twv[qi][0][1], twv[qi][0][3], twv[qi][1][1], twv[qi][1][3]};
#pragma unroll
            for (int j = 0; j < 4; ++j) {
                const int k1 = fq * 4 + j;
                const float upr = Ur[j] * tcs[j] - V[j] * tsn[j], upi = -(V[j] * tcs[j] + Ur[j] * tsn[j]);
                bf16_t* o = UB + ((((size_t)b * R + k1) * 2) * 128 + q) * 512 + g * 128 + e0 + fr;
                o[0] = (bf16_t)f2bf(upr); o[(size_t)128 * 512] = (bf16_t)f2bf(upi);
            }
        }
        if (!uniform && un2 < nunits) { q0 = q0n; g = gn; S1S_CONST(); }
    }
#undef S1S_CONST
    __syncthreads();
}

template <int R>
DI void four_stage2(LAS unsigned char* lds, const bf16_t* UB, bf16_t* YY, const bf16_t* FC2, const bf16_t* FS2, int nb, int G, int tid, int wid, int lane) {
    constexpr int PT = 272, S = R * 128, FC_OFF = 0, FS_OFF = 128 * PT, U_OFF = 256 * PT;
    const float norm = rsqrtf((float)S * 128.0f);
    const int fr = lane & 15, fq = lane >> 4, c0 = wid * 16;
    const int nunits = nb * R * 4;
#pragma unroll
    for (int i = 0; i < 4; ++i) { const int idx = tid + NTHR * i; const u32x4 c = *(const u32x4*)(FC2 + (idx >> 4) * 128 + (idx & 15) * 8), sn = *(const u32x4*)(FS2 + (idx >> 4) * 128 + (idx & 15) * 8);
        *(LAS u32x4*)(lds + FC_OFF + (idx >> 4) * PT + (idx & 15) * 16) = c; *(LAS u32x4*)(lds + FS_OFF + (idx >> 4) * PT + (idx & 15) * 16) = sn; }
    u32x4 tile[8];
    if ((int)blockIdx.x < nunits) { const int u0 = blockIdx.x; const bf16_t* src = UB + (((size_t)((u0 >> 2) / R) * R + ((u0 >> 2) % R)) * 2) * 128 * 512 + (u0 & 3) * 128;
#pragma unroll
        for (int i = 0; i < 8; ++i) { const int idx = tid + NTHR * i; tile[i] = *(const u32x4*)(src + (size_t)(idx >> 4) * 512 + (idx & 15) * 8); } }
    for (int un = blockIdx.x; un < nunits; un += G) {
        const int cq = un & 3, k1 = (un >> 2) % R, b = (un >> 2) / R;
        __syncthreads();
#pragma unroll
        for (int i = 0; i < 8; ++i) { const int idx = tid + NTHR * i; *(LAS u32x4*)(lds + U_OFF + (idx >> 4) * PT + (idx & 15) * 16) = tile[i]; }
        if (un + G < nunits) { const int u2 = un + G; const bf16_t* src = UB + (((size_t)((u2 >> 2) / R) * R + ((u2 >> 2) % R)) * 2) * 128 * 512 + (u2 & 3) * 128;
#pragma unroll
            for (int i = 0; i < 8; ++i) { const int idx = tid + NTHR * i; tile[i] = *(const u32x4*)(src + (size_t)(idx >> 4) * 512 + (idx & 15) * 8); } }
        __syncthreads();
        f32x4 acc[8];
#pragma unroll
        for (int k = 0; k < 8; ++k) acc[k] = (f32x4){0.f, 0.f, 0.f, 0.f};
#pragma unroll
        for (int it = 0; it < 8; ++it) {
            const int comp = it >> 2, ks = it & 3;
            const bf16x8 uf = tr_frag(lds + U_OFF + (comp * 128 + ks * 32 + fq * 8 + (fr >> 2)) * PT + (c0 + 4 * (fr & 3)) * 2, 4 * PT);
#pragma unroll
            for (int k2t = 0; k2t < 8; ++k2t) { const bf16x8 fa = *(const LAS bf16x8*)(lds + (comp ? FS_OFF : FC_OFF) + (k2t * 16 + fr) * PT + (ks * 32 + fq * 8) * 2); acc[k2t] = mfma16(uf, fa, acc[k2t]); }
        }
#pragma unroll
        for (int k2t = 0; k2t < 8; ++k2t) {
            const size_t tok = (size_t)b * S + (size_t)R * (k2t * 16 + fr) + k1;
            const f32x4 y = acc[k2t] * norm; u32x2 o; o.x = pk2(y[0], y[1]); o.y = pk2(y[2], y[3]);
            *(u32x2*)(YY + tok * 1024 + 512 + cq * 128 + c0 + fq * 4) = o;
        }
    }
    __syncthreads();
}

__global__ void __launch_bounds__(NTHR, 2) mega_fwd(Params p) {
    extern __shared__ __attribute__((aligned(16))) unsigned char lds_raw[];
    LAS unsigned char* lds = (LAS unsigned char*)lds_raw;
    cg::grid_group grid = cg::this_grid();
    const int tid = threadIdx.x, lane = tid & 63, wid = __builtin_amdgcn_readfirstlane(tid >> 6), G = gridDim.x;
    unsigned char* ws = p.ws;
    int pc = 0;
#define PH_BEGIN if (pc >= p.ph_lo && pc < p.ph_hi) {
    volatile LAS unsigned* bst = (volatile LAS unsigned*)(lds + LDS_BYTES - 64);
    if (tid < 2) bst[tid] = 0u;
    __syncthreads();
    if (p.ph_lo > p.ph_hi) grid.sync();
    XcdBarrier xbar = xcd_barrier_post((unsigned*)(ws + WS_BAR), bst);
    if (tid == 0) { (void)__hip_atomic_fetch_max(&xbar.bar[XB_CLS(blockIdx.x & 7u)], xbar.x + 1u, __ATOMIC_RELAXED, __HIP_MEMORY_SCOPE_AGENT); (void)__hip_atomic_fetch_max(&xbar.bar[XB_CLS(8u + (blockIdx.x & 7u))], 16u - xbar.x, __ATOMIC_RELAXED, __HIP_MEMORY_SCOPE_AGENT); }
    bool local_ok = false, seam_local = false, seam_noacq = false, seam_skip = false;
#define PH_END } ++pc; if (pc == 1) { xcd_barrier(xbar); \
        local_ok = (G == 256) && (bst[0] == 32u) && (bst[1] == 8u) && (xb_ld(&xbar.bar[XB_TMO]) == 0u); \
        for (unsigned cc = 0; cc < 8u; ++cc) local_ok = local_ok && (xb_ld(&xbar.bar[XB_CLS(cc)]) + xb_ld(&xbar.bar[XB_CLS(8u + cc)]) == 17u); } \
    else if (seam_skip && local_ok) { } else if (seam_local && local_ok) { team_barrier(xbar, !seam_noacq); } else { xcd_barrier(xbar); }

    PH_BEGIN
#if PHMASK & 1
#if PROBE & 16
 for (int rep = 0; rep < 2; ++rep)
#endif
 setup_phase(p, lds, G, tid, wid, lane);
#endif
 PH_END

    bf16_t* H = (bf16_t*)(ws + WS_H); bf16_t* T = (bf16_t*)(ws + WS_T); bf16_t* BIG = (bf16_t*)(ws + WS_BIG); bf16_t* UB = (bf16_t*)(ws + WS_T);     _Float16* XH = (_Float16*)(ws + WS_XH);
    const float* mod = (const float*)(ws + WS_MOD);
    for (int gi = 0; gi < 2; ++gi) {
        const int S = gi ? 2048 : 16384, nb = gi ? 16 : 2;
        const float* xsrc = p.in[gi];
        float* xo = p.out + (size_t)gi * GROWS * D;
        for (int ls = 0; ls < 7; ++ls) {
            const int l = ls / 3, sub = ls % 3;
            const bool odd = (l & 1), last = (ls == 6), first = (ls == 0);
            const int nsteps = last ? 1 : (sub != 1 ? 3 : (odd ? 5 : 4));
            for (int step = 0; step < nsteps; ++step) {
                int kind = 1;
                if (step == 0) kind = 0;
                else if (sub == 1 && step == 2) kind = odd ? 3 : 2;
                else if (sub == 1 && odd && step == 3) kind = 4;
                seam_noacq = (kind == 1 && sub != 1 && step == 2);
                seam_skip = (kind == 0 && last);
                seam_local = !((kind == 1 && sub == 1) || kind == 3 || kind == 4);
                PH_BEGIN
                int tid = threadIdx.x; asm volatile("" : "+v"(tid));
                const int lane = tid & 63, wid = __builtin_amdgcn_readfirstlane(tid >> 6);
                if (kind == 0) {
#if PHMASK & 2
#ifndef STAG2
#define STAG2 0
#endif
                    if (STAG2 && local_ok && ((gi == 0 && ls == 0) || sub == 2) && ((blockIdx.x >> 3) & 1)) { for (int zz = 0; zz < STAG2; ++zz) __builtin_amdgcn_s_sleep(127); }
                    const int lp = sub > 0 ? l : l - 1, sp = sub > 0 ? sub - 1 : 2, lpp = first ? 0 : lp, lc = last ? 0 : l;
#if PROBE & 4
                    norm_phase(ls <= 1 ? xsrc : nullptr, XH, last ? (float*)BIG : nullptr, (_Float16*)BIG, T, H, !first, !last,
                               mod + (size_t)lpp * 18 * 9216 + (sp * 3 + 2) * 1024, p.in[7] + (lpp * 3 + sp) * 1024, sp == 1 ? 1.0f : 0.5f,
                               mod + (size_t)lc * 18 * 9216 + (sub * 3) * 1024, p.in[6] + (lc * 3 + sub) * 1024, gi, G, wid, lane);
#endif
                    norm_phase(ls <= 1 ? xsrc : nullptr, XH, last ? xo : nullptr, XH, T, H, !first, !last,
                               mod + (size_t)lpp * 18 * 9216 + (sp * 3 + 2) * 1024, p.in[7] + (lpp * 3 + sp) * 1024, sp == 1 ? 1.0f : 0.5f,
                               mod + (size_t)lc * 18 * 9216 + (sub * 3) * 1024, p.in[6] + (lc * 3 + sub) * 1024, gi, G, wid, lane);
#endif
                } else if (kind == 1) {
                    const bf16_t* A; const bf16_t* Bt; bf16_t* O; int N, K, ldc, mode;
                    if (sub != 1) {
                        const int wi = l * 2 + (sub >> 1);
                        if (step == 1) { A = H; Bt = (const bf16_t*)(ws + WS_WUP) + (size_t)wi * 5632 * 1024; O = BIG; N = 5632; K = 1024; ldc = DFF; mode = 3; }
                        else { A = BIG; Bt = (const bf16_t*)(ws + WS_WDN) + (size_t)wi * 1024 * 2816; O = T; N = 1024; K = DFF; ldc = D; mode = 0; }
                    } else if (step == 1) { A = H; Bt = (const bf16_t*)(ws + (odd ? WS_ODIN : WS_EVIN)); O = BIG; N = odd ? 2048 : 1536; K = 1024; ldc = PRP; mode = odd ? 2 : 1; }
                    else { A = H; Bt = (const bf16_t*)(ws + (odd ? WS_ODOUT : WS_EVOUT)); O = T; N = 1024; K = 1024; ldc = D; mode = 0; }
#if PROBE & 2
                    for (int rep = 0; rep < 2; ++rep)
#endif
                    run_gemm(lds, A, Bt, GROWS, N, K, O, ldc, mode, G);
                } else if (kind == 2) {
#if PHMASK & 8
#if PROBE & (8 | 32)
                    for (int rep = 0; rep < 2; ++rep)
#endif
                    even_core(lds, BIG, H, (const bf16_t*)(ws + WS_WSP), (const bf16_t*)(ws + WS_WPT), p.in[13], p.in[14], p.in[16], p.in[18], S, G, tid, wid, lane);
#endif
                } else if (kind == 3) {
#if PHMASK & 16
#if PROBE & (8 | 64)
                    for (int rep = 0; rep < 2; ++rep) {
#else
                    {
#endif
                    conv_part(BIG, H, p.in[21], S, G, wid, lane);
                    if (gi == 0) four_stage1_p(lds, BIG, UB, (const bf16_t*)(ws + WS_WF), (const bf16_t*)(ws + WS_FC1), (const bf16_t*)(ws + WS_FS1), (const f32x2*)(ws + WS_TW128), nb, G, tid, wid, lane);
                    else four_stage1_s(lds, BIG, UB, (const bf16_t*)(ws + WS_WF), (const bf16_t*)(ws + WS_FC16), (const bf16_t*)(ws + WS_FS16), (const f32x2*)(ws + WS_TW16), nb, G, tid, wid, lane);
                    }
#endif
                } else {
#if PHMASK & 32
#if PROBE & (8 | 128)
                    for (int rep = 0; rep < 2; ++rep) {
#else
                    {
#endif
                    if (gi == 0) four_stage2<128>(lds, UB, H, (const bf16_t*)(ws + WS_FC2), (const bf16_t*)(ws + WS_FS2), nb, G, tid, wid, lane);
                    else four_stage2<16>(lds, UB, H, (const bf16_t*)(ws + WS_FC2), (const bf16_t*)(ws + WS_FS2), nb, G, tid, wid, lane);
                    }
#endif
                }
                PH_END
            }
        }
    }
}

extern "C" void kernel_launch(void* const* d_in, const int* in_sizes, int n_in, void* d_out, int out_size, void* d_ws, size_t ws_size, hipStream_t stream) {
    static int grid = 0;
    if (grid == 0) {
        if (n_in != 25 || ws_size < WS_END || out_size != 2 * GROWS * D) { fprintf(stderr, "kernel_launch: unexpected shapes (n_in %d, out %d, ws %zu)\n", n_in, out_size, ws_size); grid = -1; return; }
        int dev = 0, cus = 0, per_cu = 0;
        hipGetDevice(&dev); hipDeviceGetAttribute(&cus, hipDeviceAttributeMultiprocessorCount, dev);
        hipFuncSetAttribute((const void*)mega_fwd, hipFuncAttributeMaxDynamicSharedMemorySize, LDS_BYTES);
        if (hipOccupancyMaxActiveBlocksPerMultiprocessor(&per_cu, (const void*)mega_fwd, NTHR, LDS_BYTES) != hipSuccess || per_cu < 1) per_cu = 1;
        (void)hipGetLastError();
        grid = cus * 1;
    }
    if (grid < 0) return;
    Params p{};
    for (int i = 0; i < 25; ++i) p.in[i] = (const float*)d_in[i];
    p.out = (float*)d_out; p.ws = (unsigned char*)d_ws; p.ph_lo = 0; p.ph_hi = 1 << 20;
    (void)hipMemsetAsync((unsigned char*)d_ws + WS_BAR, 0, XB_WORDS_ALL * sizeof(unsigned), stream);
    void* args[] = {&p};
    hipError_t e = hipLaunchCooperativeKernel((const void*)mega_fwd, dim3(grid), dim3(NTHR), args, LDS_BYTES, stream);
    if (e != hipSuccess) fprintf(stderr, "cooperative launch failed: %s (grid %d)\n", hipGetErrorString(e), grid);
}
```

```cpp
#include <hip/hip_runtime.h>
#include <hip/hip_cooperative_groups.h>
#include <cstdio>
namespace cg = cooperative_groups;
namespace pg8 {
#define PG8_LAS __attribute__((address_space(3)))
typedef unsigned short bf16_t;
typedef short bf16x8 __attribute__((ext_vector_type(8)));
typedef float f32x4 __attribute__((ext_vector_type(4)));
typedef unsigned u32x4 __attribute__((ext_vector_type(4)));
constexpr int BM = 256, BK = 64, HALF = 128, HTB = HALF * BK * 2  , STAGE_BYTES = 8 * HTB, NXCD = 8, WGM = 8;

__host__ __device__ __forceinline__ int lds_byte(int r, int c) { const int st = (r >> 4) * 2 + (c >> 5), rr = r & 15, cc = c & 31, ob = rr * 64 + cc * 2; return st * 1024 + (ob ^ (((ob >> 9) & 1) << 5)); }
__host__ __device__ __forceinline__ void stage_rc(int b, int& R, int& C) { const int st = b / 1024, sb = b % 1024, swz = sb ^ (((sb >> 9) & 1) << 5); R = (st >> 1) * 16 + swz / 64; C = (st & 1) * 32 + (swz % 64) / 2; }
__host__ __device__ __forceinline__ int perm32(int rho) { const int n = rho >> 4, i = rho & 15; return 8 * (i >> 2) + 4 * n + (i & 3); }

struct Unit { int pm, pn; };
struct Gemm { const bf16_t* A; const bf16_t* Bt; int M, N, K; };

struct StaticOrder {
    int nM, nN, nwg, G, c;
    __host__ __device__ void init(int M, int N, int G_, int c_) { nM = M / BM; nN = N / BM; nwg = nM * nN; G = G_; c = c_; }
    __host__ __device__ bool next(int i, Unit& u) const {
        const long L = (long)i * G + c; if (L >= nwg) return false;
        int wgid = (int)L; { const int q = nwg / NXCD, r = nwg % NXCD, xcd = wgid % NXCD, off = wgid / NXCD; wgid = (xcd < r ? xcd * (q + 1) : r * (q + 1) + (xcd - r) * q) + off; }
        const int nig = WGM * nN, gid = wgid / nig, fm = gid * WGM, gsz = (nM - fm) < WGM ? (nM - fm) : WGM;
        u.pm = fm + ((wgid % nig) % gsz); u.pn = (wgid % nig) / gsz; return true;
    }
    __device__ __forceinline__ void a_ready(const Unit&) const {}
    __device__ __forceinline__ void done(const Unit&) const {}
};
__device__ __forceinline__ unsigned cvt_pk_bf16(float lo, float hi) { unsigned r; asm volatile("v_cvt_pk_bf16_f32 %0, %1, %2" : "=v"(r) : "v"(lo), "v"(hi)); return r; }
typedef float f32x2 __attribute__((ext_vector_type(2)));
__device__ __forceinline__ f32x2 gelu_pk(f32x2 v) {
    const f32x2 av = __builtin_elementwise_abs(v), d = av * 0.2316418882f + 1.0f;
    f32x2 t; t.x = __builtin_amdgcn_rcpf(d.x); t.y = __builtin_amdgcn_rcpf(d.y);
    f32x2 q = t * 0.5307027145f + (-0.7265760135f); q = q * t + 0.7107068705f; q = q * t + (-0.142248368f); q = q * t + 0.127414796f; q = q * t;
    const f32x2 s = (v * v) * (-0.72134752044f);
    f32x2 e; e.x = __builtin_amdgcn_exp2f(s.x); e.y = __builtin_amdgcn_exp2f(s.y);
    const f32x2 m = v * (q * e), r = v - m;
    f32x2 o; o.x = v.x < 0.f ? m.x : r.x; o.y = v.y < 0.f ? m.y : r.y; return o;
}
template <class Epi, class Sched, bool ALIGN_EPI = false, bool SP2 = false>
__device__ __forceinline__ void gemm_phase(PG8_LAS unsigned char* lds, const Gemm g, const Sched& S, const Epi& E) {
    int tid_o = threadIdx.x; asm volatile("" : "+v"(tid_o));
    const int tid = tid_o, wid = __builtin_amdgcn_readfirstlane(tid >> 6), lane = tid & 63, wr = wid >> 2, wc = wid & 3, fr = lane & 15, fq = lane >> 4;
    const int K = g.K, nt = K / BK;
    unsigned voffA[2], voffB[2];
#pragma unroll
    for (int i = 0; i < 2; ++i) { int R, C; stage_rc(tid * 16 + i * 8192, R, C); const int Rb = Epi::PERM ? ((R & ~31) + perm32(R & 31)) : R;
        voffA[i] = (unsigned)(R * K + C) * 2u; voffB[i] = (unsigned)(Rb * K + C) * 2u; }
    const size_t kstep = (size_t)(BK * 2);
    const size_t hstep = (size_t)HALF * K * 2;
    const size_t tstep = 2 * hstep;
    const unsigned ldsw = (unsigned)wid * 1024u;
    const int aoff = lds_byte(wr * 64 + fr, fq * 8), boff = lds_byte(wc * 32 + fr, fq * 8);
#define PG8_SA(b, h) (((b) * 2 + (h)) * HTB)
#define PG8_SB(b, h) ((4 + (b) * 2 + (h)) * HTB)
#define PG8_STAGE(bufoff, gbase, voff) do { _Pragma("unroll") for (int _i = 0; _i < 2; ++_i) \
        __builtin_amdgcn_global_load_lds((const unsigned*)((const char*)(gbase) + (voff)[_i]), (PG8_LAS unsigned*)(lds + (bufoff) + ldsw + _i * 8192), 16, 0, 0); } while (0)
#define PG8_LDA(dst, b, h) do { _Pragma("unroll") for (int m = 0; m < 4; ++m) _Pragma("unroll") for (int k = 0; k < 2; ++k) dst[m][k] = *(const PG8_LAS bf16x8*)(lds + PG8_SA(b, h) + aoff + m * 2048 + k * 1024); } while (0)
#define PG8_LDB(dst, b, h) do { _Pragma("unroll") for (int n = 0; n < 2; ++n) _Pragma("unroll") for (int k = 0; k < 2; ++k) dst[n][k] = *(const PG8_LAS bf16x8*)(lds + PG8_SB(b, h) + boff + n * 2048 + k * 1024); } while (0)
#define PG8_MMA(ai, bj, At, Bt) do { __builtin_amdgcn_s_setprio(1); _Pragma("unroll") for (int m = 0; m < 4; ++m) _Pragma("unroll") for (int n = 0; n < 2; ++n) _Pragma("unroll") for (int k = 0; k < 2; ++k) \
        acc[ai][bj][m][n] = __builtin_amdgcn_mfma_f32_16x16x32_bf16(Bt[n][k], At[m][k], acc[ai][bj][m][n], 0, 0, 0); __builtin_amdgcn_s_setprio(0); } while (0)
#define PG8_WAIT_V(n) asm volatile("s_waitcnt vmcnt(" #n ")" ::: "memory")
#define PG8_WAIT_L(n) asm volatile("s_waitcnt lgkmcnt(" #n ")" ::: "memory")
#define PG8_BAR __builtin_amdgcn_s_barrier()
#define PG8_SCHED __builtin_amdgcn_sched_barrier(0)
    Unit cur, nxt; int ui = 0;
    if (!S.next(0, cur)) return;
    f32x4 acc[2][2][4][2];
#pragma unroll
    for (int a = 0; a < 2; ++a)
#pragma unroll
        for (int b = 0; b < 2; ++b)
#pragma unroll
            for (int m = 0; m < 4; ++m)
#pragma unroll
                for (int n = 0; n < 2; ++n) acc[a][b][m][n] = (f32x4){0.f, 0.f, 0.f, 0.f};
    bf16x8 At[4][2], B0[2][2], B1[2][2];
    const char* cA = (const char*)g.A + (size_t)cur.pm * tstep; const char* cB = (const char*)g.Bt + (size_t)cur.pn * tstep;
    S.a_ready(cur);
    if constexpr (SP2) {
        PG8_STAGE(PG8_SB(0, 0), cB, voffB); PG8_STAGE(PG8_SB(0, 1), cB + hstep, voffB); PG8_STAGE(PG8_SA(0, 0), cA, voffA); PG8_STAGE(PG8_SA(0, 1), cA + hstep, voffA);
        if (wr == 1) PG8_BAR;
        PG8_WAIT_V(2); PG8_BAR;
        PG8_STAGE(PG8_SB(1, 0), cB + kstep, voffB); PG8_STAGE(PG8_SA(1, 0), cA + kstep, voffA); PG8_STAGE(PG8_SB(1, 1), cB + hstep + kstep, voffB);
        PG8_WAIT_V(6); PG8_BAR;
    } else {
        PG8_STAGE(PG8_SB(0, 0), cB, voffB); PG8_STAGE(PG8_SA(0, 0), cA, voffA); PG8_STAGE(PG8_SB(0, 1), cB + hstep, voffB); PG8_STAGE(PG8_SA(0, 1), cA + hstep, voffA);
        if (wr == 1) PG8_BAR;
        PG8_WAIT_V(4); PG8_BAR;
        PG8_STAGE(PG8_SB(1, 0), cB + kstep, voffB); PG8_STAGE(PG8_SA(1, 0), cA + kstep, voffA); PG8_STAGE(PG8_SB(1, 1), cB + hstep + kstep, voffB);
        PG8_WAIT_V(6); PG8_BAR;
    }
    for (;;) {
        const bool has_next = S.next(ui + 1, nxt);
        const char* nA = has_next ? (const char*)g.A + (size_t)nxt.pm * tstep : cA; const char* nB = has_next ? (const char*)g.Bt + (size_t)nxt.pn * tstep : cB;
        for (int t = 0; t < nt; t += 2) {
            const bool last = (t == nt - 2);
            const char* a1 = cA + (size_t)(t + 1) * kstep;
            const char* a2 = last ? nA : cA + (size_t)(t + 2) * kstep; const char* b2 = last ? nB : cB + (size_t)(t + 2) * kstep;
            const char* a3 = a2 + kstep; const char* b3 = b2 + kstep;
            if (last && has_next) S.a_ready(nxt);
            if constexpr (SP2) {
            PG8_LDB(B0, 0, 0); PG8_LDB(B1, 0, 1); PG8_SCHED; PG8_LDA(At, 0, 0); PG8_STAGE(PG8_SA(1, 1), a1 + hstep, voffA);
            PG8_WAIT_V(8); PG8_WAIT_L(0); PG8_BAR; PG8_MMA(0, 0, At, B0); PG8_MMA(0, 1, At, B1); PG8_BAR; PG8_SCHED;
            PG8_LDA(At, 0, 1); PG8_STAGE(PG8_SB(0, 0), b2, voffB); PG8_STAGE(PG8_SB(0, 1), b2 + hstep, voffB); PG8_STAGE(PG8_SA(0, 0), a2, voffA);
            PG8_WAIT_V(8); PG8_WAIT_L(0); PG8_BAR; PG8_MMA(1, 0, At, B0); PG8_MMA(1, 1, At, B1); PG8_BAR; PG8_SCHED;
            PG8_LDB(B0, 1, 0); PG8_LDB(B1, 1, 1); PG8_SCHED; PG8_LDA(At, 1, 0); PG8_STAGE(PG8_SA(0, 1), a2 + hstep, voffA);
            PG8_WAIT_V(8); PG8_WAIT_L(0); PG8_BAR; PG8_MMA(0, 0, At, B0); PG8_MMA(0, 1, At, B1); PG8_BAR; PG8_SCHED;
            PG8_LDA(At, 1, 1); PG8_STAGE(PG8_SB(1, 0), b3, voffB); PG8_STAGE(PG8_SB(1, 1), b3 + hstep, voffB); PG8_STAGE(PG8_SA(1, 0), a3, voffA);
            PG8_WAIT_V(8); PG8_WAIT_L(0); PG8_BAR; PG8_MMA(1, 0, At, B0); PG8_MMA(1, 1, At, B1); PG8_BAR; PG8_SCHED;
            } else {
            PG8_LDB(B0, 0, 0); PG8_SCHED; PG8_LDA(At, 0, 0); PG8_STAGE(PG8_SA(1, 1), a1 + hstep, voffA);
            PG8_WAIT_L(8); PG8_BAR; PG8_WAIT_L(0); PG8_MMA(0, 0, At, B0); PG8_BAR; PG8_SCHED;
            PG8_LDB(B1, 0, 1); PG8_STAGE(PG8_SB(0, 0), b2, voffB);
            PG8_BAR; PG8_WAIT_L(0); PG8_MMA(0, 1, At, B1); PG8_BAR;
            PG8_LDA(At, 0, 1); PG8_STAGE(PG8_SA(0, 0), a2, voffA);
            PG8_BAR; PG8_WAIT_L(0); PG8_MMA(1, 0, At, B0); PG8_BAR; PG8_SCHED;
            PG8_STAGE(PG8_SB(0, 1), b2 + hstep, voffB);
            PG8_WAIT_V(6); PG8_BAR; PG8_MMA(1, 1, At, B1); PG8_BAR;
            PG8_LDB(B0, 1, 0); PG8_SCHED; PG8_LDA(At, 1, 0); PG8_STAGE(PG8_SA(0, 1), a2 + hstep, voffA);
            PG8_WAIT_L(8); PG8_BAR; PG8_WAIT_L(0); PG8_MMA(0, 0, At, B0); PG8_BAR; PG8_SCHED;
            PG8_LDB(B1, 1, 1); PG8_STAGE(PG8_SB(1, 0), b3, voffB);
            PG8_BAR; PG8_WAIT_L(0); PG8_MMA(0, 1, At, B1); PG8_BAR;
            PG8_LDA(At, 1, 1); PG8_STAGE(PG8_SA(1, 0), a3, voffA);
            PG8_BAR; PG8_WAIT_L(0); PG8_MMA(1, 0, At, B0); PG8_BAR; PG8_SCHED;
            PG8_STAGE(PG8_SB(1, 1), b3 + hstep, voffB);
            PG8_WAIT_V(6); PG8_BAR; PG8_MMA(1, 1, At, B1); PG8_BAR;
            }
        }
        if constexpr (ALIGN_EPI) { if (wr == 0) PG8_BAR; }
        if constexpr (!Epi::AFTER_DRAIN) { E(acc, cur, wr, wc, fr, fq); S.done(cur); }
        if (!has_next) break;
#pragma unroll
        for (int a = 0; a < 2; ++a)
#pragma unroll
            for (int b = 0; b < 2; ++b)
#pragma unroll
                for (int m = 0; m < 4; ++m)
#pragma unroll
                    for (int n = 0; n < 2; ++n) acc[a][b][m][n] = (f32x4){0.f, 0.f, 0.f, 0.f};
        cur = nxt; cA = nA; cB = nB; ++ui;
        if constexpr (ALIGN_EPI) { if (wr == 1) PG8_BAR; }
    }
    PG8_WAIT_V(0);
    if constexpr (!ALIGN_EPI) { if (wr == 0) PG8_BAR; }
    PG8_BAR;
    if constexpr (Epi::AFTER_DRAIN) { E.fused(acc, cur, wr, wc, fr, fq, lds, wid, lane); S.done(cur); }
#undef PG8_SA
#undef PG8_SB
#undef PG8_STAGE
#undef PG8_LDA
#undef PG8_LDB
#undef PG8_MMA
#undef PG8_WAIT_V
#undef PG8_WAIT_L
#undef PG8_BAR
#undef PG8_SCHED
}
}


#ifndef PHMASK
#define PHMASK 63
#endif
#ifndef PROBE
#define PROBE 0
#endif
using pg8::bf16_t; using pg8::bf16x8; using pg8::f32x4; using pg8::u32x4;
typedef unsigned u32x2 __attribute__((ext_vector_type(2)));
typedef short s16x4 __attribute__((ext_vector_type(4)));
typedef float f32x2 __attribute__((ext_vector_type(2)));
#define LAS __attribute__((address_space(3)))
#define DI __device__ __forceinline__

#define XB_TMO      128
#define XB_XCNT(j)  (256  + 64 * (j))
#define XB_XSUB(j)  (1280 + 64 * (j))
#define XB_XGEN(j)  (2304 + 64 * (j))
#define XB_TOP      3328
#define XB_TOPGEN   3392
#define XCD_BAR_WORDS 3456
#define XB_SPIN_CAP (1u << 18)

__device__ __forceinline__ unsigned xb_ld(unsigned* p)              { return __hip_atomic_load(p, __ATOMIC_RELAXED, __HIP_MEMORY_SCOPE_AGENT); }
__device__ __forceinline__ unsigned xb_add(unsigned* p, unsigned v) { return __hip_atomic_fetch_add(p, v, __ATOMIC_RELAXED, __HIP_MEMORY_SCOPE_AGENT); }
__device__ __forceinline__ unsigned xb_xcc_id() { return (unsigned)__builtin_amdgcn_s_getreg((3 << 11) | 20) & 0xFu; }
#define XB_SPIN(cond, bar) do { unsigned _sp = 0; while (cond) { __builtin_amdgcn_s_sleep(1); \
    if ((++_sp & 255u) == 0u) { if (xb_ld(&(bar)[XB_TMO])) break; if (_sp > XB_SPIN_CAP) { atomicAdd(&(bar)[XB_TMO], 1u); break; } } } } while (0)

struct XcdBarrier {
    unsigned* bar; unsigned x;
    volatile LAS unsigned* st;
};

__device__ __forceinline__ XcdBarrier xcd_barrier_post(unsigned* bar, volatile LAS unsigned* st) {
    XcdBarrier b; b.bar = bar; b.x = xb_xcc_id(); b.st = st;
    if (threadIdx.x == 0) (void)xb_add(&bar[XB_XCNT(b.x)], 1u);
    return b;
}
__device__ __forceinline__ void xcd_barrier_complete(unsigned* bar, unsigned x, unsigned& nloc, unsigned& nx) {
    const unsigned G = gridDim.x * gridDim.y * gridDim.z;
    unsigned sum, cnt, mine, sp = 0u;
    for (;;) {
        sum = 0u; cnt = 0u; mine = 0u;
#pragma unroll
        for (unsigned j = 0; j < 16; ++j) { const unsigned c = xb_ld(&bar[XB_XCNT(j)]); sum += c; cnt += (c > 0u) ? 1u : 0u; mine = (j == x) ? c : mine; }
        if (sum == G) break;
        __builtin_amdgcn_s_sleep(1);
        if ((++sp & 255u) == 0u) { if (xb_ld(&bar[XB_TMO])) break; if (sp > XB_SPIN_CAP) { atomicAdd(&bar[XB_TMO], 1u); break; } }
    }
    nloc = mine > 0u ? mine : 1u; nx = cnt > 0u ? cnt : 1u;
}

__device__ __forceinline__ void xcd_barrier(const XcdBarrier& b) {
    asm volatile("s_waitcnt vmcnt(0)" ::: "memory");
    __syncthreads();
    if (threadIdx.x == 0) {
        unsigned* bar = b.bar;
        __builtin_amdgcn_s_waitcnt(0);
        unsigned nloc = b.st[0], nx = b.st[1];
        if (nloc == 0u) { xcd_barrier_complete(bar, b.x, nloc, nx); b.st[0] = nloc; b.st[1] = nx; }
        const unsigned old = xb_add(&bar[XB_XSUB(b.x)], 1u);
        const unsigned gen = old / nloc;
        if (old + 1u == (gen + 1u) * nloc) {
            __builtin_amdgcn_fence(__ATOMIC_RELEASE, "agent");
            asm volatile("s_waitcnt vmcnt(0)" ::: "memory");
            const unsigned og = xb_add(&bar[XB_TOP], 1u);
            const unsigned tg = og / nx;
            if (og + 1u == (tg + 1u) * nx) xb_add(&bar[XB_TOPGEN], 1u);
            else XB_SPIN(xb_ld(&bar[XB_TOPGEN]) == tg, bar);
            __builtin_amdgcn_fence(__ATOMIC_ACQUIRE, "agent");
            xb_add(&bar[XB_XGEN(b.x)], 1u);
            asm volatile("s_waitcnt vmcnt(0)" ::: "memory");
        } else {
            XB_SPIN(xb_ld(&bar[XB_XGEN(b.x)]) == gen, bar);
            __builtin_amdgcn_fence(__ATOMIC_ACQUIRE, "agent");
            asm volatile("s_waitcnt vmcnt(0)" ::: "memory");
        }
    }
    __syncthreads();
}


#define XB_LSUB(j)  (3456 + 64 * (j))
#define XB_LGEN(j)  (4480 + 64 * (j))
#define XB_CLS(j)   (5504 + 64 * (j))
#define XB_TSUB(k)  (6528 + 64 * (k))
#define XB_TGEN(k)  (10624 + 64 * (k))
#define XB_WORDS_ALL 14720
__device__ __forceinline__ void team_barrier(const XcdBarrier& b, bool acquire) {
    asm volatile("s_waitcnt vmcnt(0)" ::: "memory");
    __syncthreads();
    if (threadIdx.x == 0) {
        unsigned* bar = b.bar;
        __builtin_amdgcn_s_waitcnt(0);
        const unsigned team = (blockIdx.x & 7u) * 8u + ((blockIdx.x >> 3) & 7u);
        const unsigned old = xb_add(&bar[XB_TSUB(team)], 1u);
        const unsigned gen = old >> 2;
        if ((old & 3u) == 3u) xb_add(&bar[XB_TGEN(team)], 1u);
        else XB_SPIN(xb_ld(&bar[XB_TGEN(team)]) == gen, bar);
        if (acquire) {
            __builtin_amdgcn_fence(__ATOMIC_ACQUIRE, "agent");
            asm volatile("s_waitcnt vmcnt(0)" ::: "memory"); }
    }
    __syncthreads();
}

constexpr int D = 1024, DFF = 2816, GROWS = 32768, NTHR = 512;
constexpr int PRP = 2816;
constexpr int LDS_BYTES = 147456;
constexpr size_t MiB = 1u << 20, KiB = 1u << 10;
constexpr size_t WS_MODP = 0;
constexpr size_t WS_MOD = 6 * MiB;
constexpr size_t WS_BAR = 7 * MiB + 512 * KiB;
constexpr size_t WS_WSP = 8 * MiB;
constexpr size_t WS_WPT = WS_WSP + 256 * KiB;
constexpr size_t WS_WF = WS_WPT + 256 * KiB;
constexpr size_t WS_FC1 = WS_WF + 256 * KiB;
constexpr size_t WS_FS1 = WS_FC1 + 256 * KiB;
constexpr size_t WS_FC16 = WS_FS1 + 256 * KiB;
constexpr size_t WS_FS16 = WS_FC16 + 256 * KiB;
constexpr size_t WS_FC2 = WS_FS16 + 256 * KiB;
constexpr size_t WS_FS2 = WS_FC2 + 256 * KiB;
constexpr size_t WS_TW128 = WS_FS2 + 256 * KiB;
constexpr size_t WS_TW16 = WS_TW128 + 256 * KiB;
constexpr size_t WS_WUP = 16 * MiB;
constexpr size_t WS_WDN = 60 * MiB;
constexpr size_t WS_EVIN = 82 * MiB, WS_ODIN = 85 * MiB, WS_EVOUT = 89 * MiB, WS_ODOUT = 91 * MiB;
constexpr size_t WS_H = 96 * MiB;
constexpr size_t WS_T = 160 * MiB;
constexpr size_t WS_BIG = 224 * MiB;
constexpr size_t WS_UB = WS_BIG + 96 * MiB;
constexpr size_t WS_XH = 400 * MiB;
constexpr size_t WS_END = 464 * MiB;

typedef __bf16 nbf16x2 __attribute__((ext_vector_type(2)));
DI unsigned f2bf(float f) { return (unsigned)__builtin_bit_cast(unsigned short, (__bf16)f); }
DI unsigned pk2(float lo, float hi) { const f32x2 v = {lo, hi}; return __builtin_bit_cast(unsigned, __builtin_convertvector(v, nbf16x2)); }
DI float bf_lo(unsigned w) { return __uint_as_float(w << 16); }
DI float bf_hi(unsigned w) { return __uint_as_float(w & 0xffff0000u); }
template <int CTRL> DI float dpp_mov(float v) { return __builtin_bit_cast(float, __builtin_amdgcn_update_dpp(0, __builtin_bit_cast(int, v), CTRL, 0xF, 0xF, true)); }
DI float wave_sum(float v) {
    v += dpp_mov<0xB1>(v); v += dpp_mov<0x4E>(v); v += dpp_mov<0x141>(v); v += dpp_mov<0x140>(v);
    const int iv = __builtin_bit_cast(int, v);
    const float a = __builtin_bit_cast(float, __builtin_amdgcn_readlane(iv, 0)), b = __builtin_bit_cast(float, __builtin_amdgcn_readlane(iv, 16)),
                c = __builtin_bit_cast(float, __builtin_amdgcn_readlane(iv, 32)), d = __builtin_bit_cast(float, __builtin_amdgcn_readlane(iv, 48));
    return (a + b) + (c + d);
}
DI float silu_f(float x) { return x * __builtin_amdgcn_rcpf(1.0f + __builtin_amdgcn_exp2f(-1.4426950408889634f * x)); }
DI f32x4 mfma16(bf16x8 a, bf16x8 b, f32x4 c) { return __builtin_amdgcn_mfma_f32_16x16x32_bf16(a, b, c, 0, 0, 0); }
typedef short v4i16_t __attribute__((ext_vector_type(4)));
DI s16x4 tr_read(LAS unsigned char* p) { return __builtin_bit_cast(s16x4, __builtin_amdgcn_ds_read_tr16_b64_v4i16((LAS v4i16_t*)p)); }
DI bf16x8 tr_frag(LAS unsigned char* p, int pitch4) {
    const s16x4 lo = tr_read(p), hi = tr_read(p + pitch4);
    bf16x8 r; r[0] = lo[0]; r[1] = lo[1]; r[2] = lo[2]; r[3] = lo[3]; r[4] = hi[0]; r[5] = hi[1]; r[6] = hi[2]; r[7] = hi[3]; return r;
}

DI void st16_wt(void* p, u32x4 v) { *(u32x4*)p = v; }
struct Params { const float* in[25]; float* out; unsigned char* ws; int ph_lo, ph_hi; };

struct EpiGen {
    static constexpr bool PERM = true, AFTER_DRAIN = false;
    bf16_t* O; int ldc; int mode;
    __device__ __forceinline__ void operator()(const f32x4 (&acc)[2][2][4][2], const pg8::Unit& u, int wr, int wc, int fr, int fq) const {
        const int row0 = u.pm * 256 + wr * 64 + fr, cw = wc * 32 + 8 * fq;
        if (mode == 3) {
#pragma unroll
            for (int ai = 0; ai < 2; ++ai)
#pragma unroll
                for (int m = 0; m < 4; ++m) {
                    bf16_t* rowp = O + (size_t)(row0 + ai * 128 + m * 16) * ldc + 128 * u.pn + cw;
                    f32x4 g0 = acc[ai][0][m][0], g1 = acc[ai][0][m][1]; const f32x4 u0 = acc[ai][1][m][0], u1 = acc[ai][1][m][1];
#pragma unroll
                    for (int j = 0; j < 4; ++j) { g0[j] = silu_f(g0[j]); g1[j] = silu_f(g1[j]); }
                    const f32x4 v0 = g0 * u0, v1 = g1 * u1;
                    u32x4 w; w.x = pg8::cvt_pk_bf16(v0[0], v0[1]); w.y = pg8::cvt_pk_bf16(v0[2], v0[3]); w.z = pg8::cvt_pk_bf16(v1[0], v1[1]); w.w = pg8::cvt_pk_bf16(v1[2], v1[3]);
                    st16_wt(rowp, w);
                }
        } else if (mode == 2 && u.pn < 4) {
#pragma unroll
            for (int ai = 0; ai < 2; ++ai)
#pragma unroll
                for (int m = 0; m < 4; ++m) {
                    bf16_t* rowp = O + (size_t)(row0 + ai * 128 + m * 16) * ldc + 128 * u.pn + cw;
                    const f32x4 v0 = acc[ai][0][m][0] * acc[ai][1][m][0], v1 = acc[ai][0][m][1] * acc[ai][1][m][1];
                    u32x4 w; w.x = pg8::cvt_pk_bf16(v0[0], v0[1]); w.y = pg8::cvt_pk_bf16(v0[2], v0[3]); w.z = pg8::cvt_pk_bf16(v1[0], v1[1]); w.w = pg8::cvt_pk_bf16(v1[2], v1[3]);
                    st16_wt(rowp, w);
                }
        } else {
            const int colbase = (mode == 2) ? 512 + 256 * (u.pn - 4) : 256 * u.pn;
            if (mode == 1 && u.pn < 4) {
#pragma unroll
                for (int ai = 0; ai < 2; ++ai)
#pragma unroll
                    for (int m = 0; m < 4; ++m) {
                        bf16_t* rowp = O + (size_t)(row0 + ai * 128 + m * 16) * ldc + colbase + cw;
#pragma unroll
                        for (int bj = 0; bj < 2; ++bj) {
                            f32x4 v0 = acc[ai][bj][m][0], v1 = acc[ai][bj][m][1];
                            const pg8::f32x2 a = pg8::gelu_pk((pg8::f32x2){v0[0], v0[1]}), b = pg8::gelu_pk((pg8::f32x2){v0[2], v0[3]}), c = pg8::gelu_pk((pg8::f32x2){v1[0], v1[1]}), d = pg8::gelu_pk((pg8::f32x2){v1[2], v1[3]});
                            u32x4 w; w.x = pg8::cvt_pk_bf16(a.x, a.y); w.y = pg8::cvt_pk_bf16(b.x, b.y); w.z = pg8::cvt_pk_bf16(c.x, c.y); w.w = pg8::cvt_pk_bf16(d.x, d.y);
                            st16_wt(rowp + bj * 128, w);
                        }
                    }
            } else {
#pragma unroll
                for (int ai = 0; ai < 2; ++ai)
#pragma unroll
                    for (int m = 0; m < 4; ++m) {
                        bf16_t* rowp = O + (size_t)(row0 + ai * 128 + m * 16) * ldc + colbase + cw;
#pragma unroll
                        for (int bj = 0; bj < 2; ++bj) {
                            const f32x4 v0 = acc[ai][bj][m][0], v1 = acc[ai][bj][m][1];
                            u32x4 w; w.x = pg8::cvt_pk_bf16(v0[0], v0[1]); w.y = pg8::cvt_pk_bf16(v0[2], v0[3]); w.z = pg8::cvt_pk_bf16(v1[0], v1[1]); w.w = pg8::cvt_pk_bf16(v1[2], v1[3]);
                            st16_wt(rowp + bj * 128, w);
                        }
                    }
            }
        }
    }
};

DI void run_gemm(LAS unsigned char* lds, const bf16_t* A, const bf16_t* Bt, int M, int N, int K, bf16_t* O, int ldc, int mode, int G) {
#if PHMASK & 4
#ifndef STAG
#define STAG 0
#endif
    if (STAG && mode != 0) {
        const int d = ((int)blockIdx.x >> 3) & 3;
        for (int i = 0; i < d * STAG; ++i) __builtin_amdgcn_s_sleep(64);
    }
    pg8::Gemm g{A, Bt, M, N, K}; pg8::StaticOrder S; S.init(M, N, G, (int)blockIdx.x);
    EpiGen E{O, ldc, mode};
#ifndef G_ALIGN
#define G_ALIGN true
#endif
#ifndef G_SP2
#define G_SP2 true
#endif
    pg8::gemm_phase<EpiGen, pg8::StaticOrder, G_ALIGN, G_SP2>(lds, g, S, E);
#endif
}

DI int dest_row(int n0, int mode) {
    if (mode == 1) { const int half = n0 >= DFF ? 1 : 0, n = n0 - half * DFF; return 256 * (n >> 7) + 128 * half + (n & 127); }
    if (mode == 2) { if (n0 < 512) return 256 * (n0 >> 7) + (n0 & 127); if (n0 < 1024) return 1024 + (n0 - 512); if (n0 < 1536) { const int n = n0 - 1024; return 256 * (n >> 7) + 128 + (n & 127); } return n0; }
    return n0;
}
DI void transpose_item(const float* W, int K, int N, bf16_t* WT, int mode, LAS float* scr, int item, int lane) {
    const int nblk = N / 32, kb = item / nblk, nb = item % nblk, k0 = 64 * kb, n0 = 32 * nb;
#pragma unroll
    for (int i = 0; i < 32; ++i) { const int kk = 2 * i + (lane >> 5); scr[kk * 33 + (lane & 31)] = __builtin_nontemporal_load(W + (size_t)(k0 + kk) * N + n0 + (lane & 31)); }
    asm volatile("s_waitcnt lgkmcnt(0)" ::: "memory");
    const int c = lane & 7, dr = dest_row(n0, mode);
#pragma unroll
    for (int j = 0; j < 4; ++j) { const int n = (lane >> 3) + 8 * j; const LAS float* s = scr + (8 * c) * 33 + n;
        u32x4 o; o.x = pk2(s[0 * 33], s[1 * 33]); o.y = pk2(s[2 * 33], s[3 * 33]); o.z = pk2(s[4 * 33], s[5 * 33]); o.w = pk2(s[6 * 33], s[7 * 33]);
        *(u32x4*)(WT + (size_t)(dr + n) * K + k0 + 8 * c) = o; }
    asm volatile("s_waitcnt lgkmcnt(0)" ::: "memory");
}

DI void setup_phase(const Params& p, LAS unsigned char* lds, int G, int tid, int wid, int lane) {
    unsigned char* ws = p.ws;
    {
        LAS float* sc = (LAS float*)lds;
        LAS float* red = sc + 18 * 1024;
        for (int i = tid; i < 18 * 1024; i += NTHR) { const int b = i >> 10, k = i & 1023;
            const float c = (b < 2) ? p.in[2][b * 1024 + k] : p.in[3][(b - 2) * 1024 + k]; sc[i] = silu_f(c); }
        __syncthreads();
        for (int u = blockIdx.x; u < 288; u += G) {
            const int l = u / 144, cb = u % 144, col = cb * 64 + lane;
            float acc[18];
#pragma unroll
            for (int b = 0; b < 18; ++b) acc[b] = 0.f;
            const float* wp = p.in[4] + ((size_t)l * 1024 + wid * 128) * 9216 + col;
            const LAS f32x4* sc4 = (const LAS f32x4*)sc + wid * 32;
#pragma unroll 4
            for (int k4 = 0; k4 < 32; ++k4) {
                const float w0 = __builtin_nontemporal_load(wp + (size_t)(4 * k4) * 9216), w1 = __builtin_nontemporal_load(wp + (size_t)(4 * k4 + 1) * 9216), w2 = __builtin_nontemporal_load(wp + (size_t)(4 * k4 + 2) * 9216), w3 = __builtin_nontemporal_load(wp + (size_t)(4 * k4 + 3) * 9216);
#pragma unroll
                for (int b = 0; b < 18; ++b) { const f32x4 sv = sc4[b * 256 + k4]; acc[b] += (sv[0] * w0 + sv[1] * w1) + (sv[2] * w2 + sv[3] * w3); }
            }
#pragma unroll
            for (int b = 0; b < 18; ++b) red[(wid * 18 + b) * 64 + lane] = acc[b];
            __syncthreads();
            for (int i = tid; i < 18 * 64; i += NTHR) { const int b = i >> 6, c = i & 63; float sm = p.in[5][l * 9216 + cb * 64 + c];
#pragma unroll
                for (int w = 0; w < 8; ++w) sm += red[(w * 18 + b) * 64 + c];
                ((float*)(ws + WS_MOD))[((size_t)l * 18 + b) * 9216 + cb * 64 + c] = sm; }
            __syncthreads();
        }
    }
    {
        LAS float* scr = (LAS float*)(lds + wid * 16384);
        const int nskip = (G > 64 && 288 - G > 0 && 288 - G < G / 2) ? 288 - G : 0;
        const int gw = ((int)blockIdx.x - nskip) * 8 + wid, NGW = (G - nskip) * 8;
        constexpr int I_UP = 16 * 176, I_DN = 44 * 32, I_EI = 16 * 48, I_OI = 16 * 64, I_O = 16 * 32;
        constexpr int NITEMS = 4 * I_UP + 4 * I_DN + I_EI + I_OI + 2 * I_O;
        for (int it = gw; it < NITEMS && gw >= 0; it += NGW) {
            int r = it;
            if (r < 4 * I_UP) { const int i = r / I_UP; r -= i * I_UP; const int l = i >> 1, f = i & 1;
                transpose_item(p.in[f ? 10 : 8] + (size_t)l * 1024 * 5632, 1024, 5632, (bf16_t*)(ws + WS_WUP) + (size_t)i * 5632 * 1024, 1, scr, r, lane); continue; }
            r -= 4 * I_UP;
            if (r < 4 * I_DN) { const int i = r / I_DN; r -= i * I_DN; const int l = i >> 1, f = i & 1;
                transpose_item(p.in[f ? 11 : 9] + (size_t)l * 2816 * 1024, 2816, 1024, (bf16_t*)(ws + WS_WDN) + (size_t)i * 1024 * 2816, 0, scr, r, lane); continue; }
            r -= 4 * I_DN;
            if (r < I_EI) { transpose_item(p.in[12], 1024, 1536, (bf16_t*)(ws + WS_EVIN), 0, scr, r, lane); continue; }
            r -= I_EI;
            if (r < I_OI) { transpose_item(p.in[20], 1024, 2048, (bf16_t*)(ws + WS_ODIN), 2, scr, r, lane); continue; }
            r -= I_OI;
            if (r < I_O) { transpose_item(p.in[19], 1024, 1024, (bf16_t*)(ws + WS_EVOUT), 0, scr, r, lane); continue; }
            r -= I_O;
            transpose_item(p.in[24], 1024, 1024, (bf16_t*)(ws + WS_ODOUT), 0, scr, r, lane);
        }
    }
    {
        const int gt = blockIdx.x * NTHR + tid, NT = G * NTHR;
        bf16_t* WSP = (bf16_t*)(ws + WS_WSP); bf16_t* WPT = (bf16_t*)(ws + WS_WPT); bf16_t* WF = (bf16_t*)(ws + WS_WF);
        for (int i = gt; i < 65536; i += NT) {
            WSP[i] = (bf16_t)f2bf(p.in[15][i]);
            const int g = i >> 14, e = (i >> 7) & 127, d = i & 127;
            WPT[i] = (bf16_t)f2bf(p.in[17][(g * 128 + d) * 128 + e]);
        }
        {
            LAS float* tab = (LAS float*)(lds + 132 * 1024);
            if (tid < 128) { const float x = (float)tid * (1.0f / 64.0f); tab[tid] = cospif(x); tab[128 + tid] = sinpif(x); }
            __syncthreads();
            for (int i = gt; i < 131072; i += NT) {
                const int g = i >> 15, n = (i >> 7) & 255, d = i & 127, comp = n >> 7, e = n & 127;
                const float* fw = p.in[23] + (size_t)g * 16384 + e; const LAS float* tb = tab + comp * 128; float sm = 0.f;
#pragma unroll 8
                for (int m = 0; m < 128; ++m) sm += tb[(m * d) & 127] * fw[m * 128];
                WF[i] = (bf16_t)f2bf(sm * p.in[22][g * 128 + d]);
            }
        }
        bf16_t* FC1 = (bf16_t*)(ws + WS_FC1); bf16_t* FS1 = (bf16_t*)(ws + WS_FS1); bf16_t* FC2 = (bf16_t*)(ws + WS_FC2); bf16_t* FS2 = (bf16_t*)(ws + WS_FS2);
        f32x2* TW128 = (f32x2*)(ws + WS_TW128);
        for (int i = gt; i < 16384; i += NT) {
            const int k1 = i >> 7, col = i & 127, s = col >> 5, j = col & 31, fqq = j >> 3, ii = j & 7;
            const int r = 32 * s + (ii < 4 ? fqq * 4 + ii : 16 + fqq * 4 + ii - 4);
            const float x = (float)((k1 * r) & 127) * (1.0f / 64.0f);
            FC1[i] = (bf16_t)f2bf(cospif(x)); FS1[i] = (bf16_t)f2bf(sinpif(x));
            const float y = (float)((k1 * col) & 127) * (1.0f / 64.0f);
            FC2[i] = (bf16_t)f2bf(cospif(y)); FS2[i] = (bf16_t)f2bf(sinpif(y));
            const float z = (float)(k1 * col) * (1.0f / 8192.0f);
            TW128[i] = (f32x2){cospif(z), sinpif(z)};
        }
        bf16_t* FC16 = (bf16_t*)(ws + WS_FC16); bf16_t* FS16 = (bf16_t*)(ws + WS_FS16);
        for (int i = gt; i < 512; i += NT) {
            const int k1 = i >> 5, j = i & 31, fqq = j >> 3, ii = j & 7;
            float c = 0.f, s = 0.f;
            if (ii < 4) { const int r = fqq * 4 + ii; const float x = (float)((k1 * r) & 15) * (1.0f / 8.0f); c = cospif(x); s = sinpif(x); }
            FC16[i] = (bf16_t)f2bf(c); FS16[i] = (bf16_t)f2bf(s);
        }
        f32x2* TW16 = (f32x2*)(ws + WS_TW16);
        for (int i = gt; i < 2048; i += NT) { const int q = i >> 4, k1 = i & 15; const float z = (float)(k1 * q) * (1.0f / 1024.0f); TW16[i] = (f32x2){cospif(z), sinpif(z)}; }
    }
}

DI void modreduce_phase(const Params& p, int G, int tid) {
    const float* mp = (const float*)(p.ws + WS_MODP); float* mod = (float*)(p.ws + WS_MOD);
    for (int i = blockIdx.x * NTHR + tid; i < 2 * 18 * 9216; i += G * NTHR) {
        const int l = i / (18 * 9216), j = i % 9216;
        float s = p.in[5][l * 9216 + j];
#pragma unroll
        for (int ks = 0; ks < 4; ++ks) s += mp[(size_t)ks * (2 * 18 * 9216) + i];
        mod[i] = s;
    }
}

typedef _Float16 h16x4 __attribute__((ext_vector_type(4)));
typedef _Float16 h16x8 __attribute__((ext_vector_type(8)));
template <bool IN32, bool PREV, bool NEXT, bool OUT32>
DI void norm_phase_t(const float* xin32, const _Float16* xin16, float* xout32, _Float16* xout16, const bf16_t* T, bf16_t* H,
                     const float* gate_base, const float* gpost, float rw, const float* ss_base, const float* gpre, int gi, int G, int wid, int lane) {
    const bool teamed = (G == 256);
    const int bx = (int)blockIdx.x & 7, bj = (int)blockIdx.x >> 3;
    const int nh = teamed ? 2 : (GROWS + G * 8 - 1) / (G * 8), rows_h = teamed ? 8 : 1;
    for (int hh = 0; hh < nh; ++hh) {
        const int r0 = teamed ? 256 * (16 * bx + 8 * hh + (bj & 7)) + 64 * (bj >> 3) + wid : (int)blockIdx.x * 8 + wid + hh * G * 8;
        if (r0 >= GROWS) break;
        const int bidx = (gi == 0) ? (r0 >> 14) : 2 + (r0 >> 11);
        f32x4 gpv[4], gtv[4], shv[4], scv[4], gnv[4];
        if (PREV) { const f32x4* gp = (const f32x4*)gpost + 2 * lane; const f32x4* gt = (const f32x4*)(gate_base + (size_t)bidx * 9216) + 2 * lane;
#pragma unroll
            for (int j = 0; j < 4; ++j) { const int o = 128 * (j >> 1) + (j & 1); gpv[j] = gp[o] * rw; gtv[j] = gt[o] + 1.0f; gpv[j] = gpv[j] * gtv[j]; } }
        if (NEXT) { const f32x4* gp = (const f32x4*)gpre + 2 * lane; const f32x4* sh = (const f32x4*)(ss_base + (size_t)bidx * 9216) + 2 * lane; const f32x4* sc = sh + 256;
#pragma unroll
            for (int j = 0; j < 4; ++j) { const int o = 128 * (j >> 1) + (j & 1); gnv[j] = gp[o] * (sc[o] + 1.0f); shv[j] = sh[o]; } }
#pragma unroll 2
        for (int i = 0; i < rows_h; ++i) {
            const int r = r0 + 8 * i;
            f32x4 v[4]; u32x4 tw[2];
            if (IN32) { const f32x4* xr = (const f32x4*)(xin32 + (size_t)r * D) + 2 * lane;
#pragma unroll
                for (int j = 0; j < 2; ++j) { v[2 * j] = xr[128 * j]; v[2 * j + 1] = xr[128 * j + 1]; } }
            else { const h16x8* xr = (const h16x8*)(xin16 + (size_t)r * D) + lane; h16x8 hv[2];
#pragma unroll
                for (int j = 0; j < 2; ++j) hv[j] = __builtin_nontemporal_load(xr + 64 * j);
                if (PREV) { const u32x4* tr = (const u32x4*)(T + (size_t)r * D) + lane;
#pragma unroll
                    for (int j = 0; j < 2; ++j) tw[j] = __builtin_nontemporal_load(tr + 64 * j); }
#pragma unroll
                for (int j = 0; j < 2; ++j) { v[2 * j] = (f32x4){(float)hv[j][0], (float)hv[j][1], (float)hv[j][2], (float)hv[j][3]}; v[2 * j + 1] = (f32x4){(float)hv[j][4], (float)hv[j][5], (float)hv[j][6], (float)hv[j][7]}; } }
            if (PREV) {
                if (IN32) { const u32x4* tr = (const u32x4*)(T + (size_t)r * D) + lane;
#pragma unroll
                    for (int j = 0; j < 2; ++j) tw[j] = __builtin_nontemporal_load(tr + 64 * j); }
                f32x4 tv[4]; float ss = 0.f;
#pragma unroll
                for (int j = 0; j < 2; ++j) { const u32x4 w = tw[j];
                    tv[2 * j] = (f32x4){bf_lo(w.x), bf_hi(w.x), bf_lo(w.y), bf_hi(w.y)}; tv[2 * j + 1] = (f32x4){bf_lo(w.z), bf_hi(w.z), bf_lo(w.w), bf_hi(w.w)}; }
#pragma unroll
                for (int j = 0; j < 4; ++j) ss += (tv[j][0] * tv[j][0] + tv[j][1] * tv[j][1]) + (tv[j][2] * tv[j][2] + tv[j][3] * tv[j][3]);
                const float rstd = rsqrtf(wave_sum(ss) * (1.0f / D) + 1e-6f);
#pragma unroll
                for (int j = 0; j < 4; ++j) v[j] = v[j] + (tv[j] * rstd) * gpv[j];
                if (OUT32) { f32x4* xo = (f32x4*)(xout32 + (size_t)r * D) + 2 * lane;
#pragma unroll
                    for (int j = 0; j < 4; ++j) __builtin_nontemporal_store(v[j], xo + 128 * (j >> 1) + (j & 1)); }
                else { h16x8* xo = (h16x8*)(xout16 + (size_t)r * D) + lane;
#pragma unroll
                    for (int j = 0; j < 2; ++j) { h16x8 hv;
#pragma unroll
                        for (int k = 0; k < 4; ++k) { hv[k] = (_Float16)v[2 * j][k]; hv[4 + k] = (_Float16)v[2 * j + 1][k]; }
                        __builtin_nontemporal_store(hv, xo + 64 * j);
#pragma unroll
                        for (int k = 0; k < 4; ++k) { v[2 * j][k] = (float)hv[k]; v[2 * j + 1][k] = (float)hv[4 + k]; } } }
            }
            if (NEXT) {
                float ss = 0.f;
#pragma unroll
                for (int j = 0; j < 4; ++j) ss += (v[j][0] * v[j][0] + v[j][1] * v[j][1]) + (v[j][2] * v[j][2] + v[j][3] * v[j][3]);
                const float rstd = rsqrtf(wave_sum(ss) * (1.0f / D) + 1e-6f);
                u32x4* ho = (u32x4*)(H + (size_t)r * D) + lane;
#pragma unroll
                for (int j = 0; j < 2; ++j) { const f32x4 h0 = (v[2 * j] * rstd) * gnv[2 * j] + shv[2 * j], h1 = (v[2 * j + 1] * rstd) * gnv[2 * j + 1] + shv[2 * j + 1];
                    u32x4 w; w.x = pk2(h0[0], h0[1]); w.y = pk2(h0[2], h0[3]); w.z = pk2(h1[0], h1[1]); w.w = pk2(h1[2], h1[3]); st16_wt(ho + 64 * j, w); }
            }
        }
    }
}
DI void norm_phase(const float* xin32, const _Float16* xin16, float* xout32, _Float16* xout16, const bf16_t* T, bf16_t* H, bool has_prev, bool has_next,
                   const float* gate_base, const float* gpost, float rw, const float* ss_base, const float* gpre, int gi, int G, int wid, int lane) {
    if (!has_prev)        norm_phase_t<true, false, true, false>(xin32, xin16, xout32, xout16, T, H, gate_base, gpost, rw, ss_base, gpre, gi, G, wid, lane);
    else if (xin32)       norm_phase_t<true, true, true, false>(xin32, xin16, xout32, xout16, T, H, gate_base, gpost, rw, ss_base, gpre, gi, G, wid, lane);
    else if (has_next)    norm_phase_t<false, true, true, false>(xin32, xin16, xout32, xout16, T, H, gate_base, gpost, rw, ss_base, gpre, gi, G, wid, lane);
    else                  norm_phase_t<false, true, false, true>(xin32, xin16, xout32, xout16, T, H, gate_base, gpost, rw, ss_base, gpre, gi, G, wid, lane);
}

template <int GI>
DI void pool_group(const bf16_t* PR, bf16_t* YY, const bf16_t* WPT, const float* pool_scale, size_t tok0, int tl, int pos, int S, int fr, int fq) {
    constexpr int hw = 1 << GI, g = GI;
    const int lo = max(pos - hw, 0), hi = min(pos + hw, S); const float inv = 1.0f / (float)(hi - lo);
    f32x4 acc[8];
#pragma unroll
    for (int e = 0; e < 8; ++e) acc[e] = (f32x4){0.f, 0.f, 0.f, 0.f};
#pragma unroll 1
    for (int ks = 0; ks < 4; ++ks) {
        const bf16_t* zc = PR + (tok0 + tl) * PRP + 1024 + g * 128 + ks * 32 + fq * 8;
        u32x4 w[2 * hw];
#pragma unroll
        for (int j = 0; j < 2 * hw; ++j) { const int t2 = pos + j - hw; const bool ok = (t2 >= 0) && (t2 < S); w[j] = (u32x4){0u, 0u, 0u, 0u}; if (ok) w[j] = *(const u32x4*)(zc + (ptrdiff_t)(j - hw) * PRP); }
        bf16x8 wf[8];
#pragma unroll
        for (int et = 0; et < 8; ++et) wf[et] = *(const bf16x8*)(WPT + ((g * 128 + et * 16 + fr) * 128 + ks * 32 + fq * 8));
        f32x4 s0 = (f32x4){0.f, 0.f, 0.f, 0.f}, s1 = s0;
#pragma unroll
        for (int j = 0; j < 2 * hw; ++j) { s0 += (f32x4){bf_lo(w[j].x), bf_hi(w[j].x), bf_lo(w[j].y), bf_hi(w[j].y)}; s1 += (f32x4){bf_lo(w[j].z), bf_hi(w[j].z), bf_lo(w[j].w), bf_hi(w[j].w)}; }
        const u32x4 cw = w[hw];
        s0 = s0 * inv - (f32x4){bf_lo(cw.x), bf_hi(cw.x), bf_lo(cw.y), bf_hi(cw.y)}; s1 = s1 * inv - (f32x4){bf_lo(cw.z), bf_hi(cw.z), bf_lo(cw.w), bf_hi(cw.w)};
        u32x4 dw; dw.x = pk2(s0[0], s0[1]); dw.y = pk2(s0[2], s0[3]); dw.z = pk2(s1[0], s1[1]); dw.w = pk2(s1[2], s1[3]);
        const bf16x8 df = __builtin_bit_cast(bf16x8, dw);
#pragma unroll
        for (int et = 0; et < 8; ++et) acc[et] = mfma16(wf[et], df, acc[et]);
    }
#pragma unroll
    for (int et = 0; et < 8; ++et) { const int e = g * 128 + et * 16 + fq * 4; const f32x4 ps = *(const f32x4*)(pool_scale + e); const f32x4 y = acc[et] * ps;
        u32x2 o; o.x = pk2(y[0], y[1]); o.y = pk2(y[2], y[3]); *(u32x2*)(YY + (tok0 + tl) * 1024 + 512 + e) = o; }
}

constexpr int PL_ZOFF = 0, PL_WOFF = 144 * 272, PL_PITCH = 272;
struct PoolStage { u32x4 z[5]; u32x4 w[4]; };
DI void pool_stage_load(PoolStage& ps, const bf16_t* PR, const bf16_t* WPT, size_t tok0, int pos0, int S, int g, int tid) {
#pragma unroll
    for (int i = 0; i < 5; ++i) { const int idx = tid + NTHR * i, row = idx >> 4, c = idx & 15; const int p = pos0 - 8 + row;
        ps.z[i] = (u32x4){0u, 0u, 0u, 0u};
        if (idx < 144 * 16 && p >= 0 && p < S) ps.z[i] = *(const u32x4*)(PR + (size_t)((ptrdiff_t)tok0 - 8 + row) * PRP + 1024 + g * 128 + c * 8); }
#pragma unroll
    for (int i = 0; i < 4; ++i) { const int idx = tid + NTHR * i; ps.w[i] = *(const u32x4*)(WPT + (g * 128 + (idx >> 4)) * 128 + (idx & 15) * 8); }
}
DI void pool_stage_store(const PoolStage& ps, LAS unsigned char* lds, int tid) {
#pragma unroll
    for (int i = 0; i < 5; ++i) { const int idx = tid + NTHR * i; if (idx < 144 * 16) *(LAS u32x4*)(lds + PL_ZOFF + (idx >> 4) * PL_PITCH + (idx & 15) * 16) = ps.z[i]; }
#pragma unroll
    for (int i = 0; i < 4; ++i) { const int idx = tid + NTHR * i; *(LAS u32x4*)(lds + PL_WOFF + (idx >> 4) * PL_PITCH + (idx & 15) * 16) = ps.w[i]; }
}
template <int GI>
DI void pool_compute(LAS unsigned char* lds, bf16_t* YY, const float* pool_scale, size_t tok0, int tl, int pos, int S, int fr, int fq) {
    constexpr int hw = 1 << GI, g = GI;
    const int lo = max(pos - hw, 0), hi = min(pos + hw, S); const float inv = 1.0f / (float)(hi - lo);
    f32x4 acc[8];
#pragma unroll
    for (int e = 0; e < 8; ++e) acc[e] = (f32x4){0.f, 0.f, 0.f, 0.f};
#pragma unroll 2
    for (int ks = 0; ks < 4; ++ks) {
        const LAS unsigned char* zb = lds + PL_ZOFF + (tl + 8) * PL_PITCH + (ks * 32 + fq * 8) * 2;
        f32x4 s0 = (f32x4){0.f, 0.f, 0.f, 0.f}, s1 = s0;
#pragma unroll
        for (int j = -hw; j < hw; ++j) { const u32x4 x = *(const LAS u32x4*)(zb + j * PL_PITCH);
            s0 += (f32x4){bf_lo(x.x), bf_hi(x.x), bf_lo(x.y), bf_hi(x.y)}; s1 += (f32x4){bf_lo(x.z), bf_hi(x.z), bf_lo(x.w), bf_hi(x.w)}; }
        const u32x4 cw = *(const LAS u32x4*)zb;
        s0 = s0 * inv - (f32x4){bf_lo(cw.x), bf_hi(cw.x), bf_lo(cw.y), bf_hi(cw.y)}; s1 = s1 * inv - (f32x4){bf_lo(cw.z), bf_hi(cw.z), bf_lo(cw.w), bf_hi(cw.w)};
        u32x4 dw; dw.x = pk2(s0[0], s0[1]); dw.y = pk2(s0[2], s0[3]); dw.z = pk2(s1[0], s1[1]); dw.w = pk2(s1[2], s1[3]);
        const bf16x8 df = __builtin_bit_cast(bf16x8, dw);
#pragma unroll
        for (int et = 0; et < 8; ++et) { const bf16x8 wf = *(const LAS bf16x8*)(lds + PL_WOFF + (et * 16 + fr) * PL_PITCH + (ks * 32 + fq * 8) * 2); acc[et] = mfma16(wf, df, acc[et]); }
    }
#pragma unroll
    for (int et = 0; et < 8; ++et) { const int e = g * 128 + et * 16 + fq * 4; const f32x4 ps = *(const f32x4*)(pool_scale + e); const f32x4 y = acc[et] * ps;
        u32x2 o; o.x = pk2(y[0], y[1]); o.y = pk2(y[2], y[3]); *(u32x2*)(YY + (tok0 + tl) * 1024 + 512 + e) = o; }
}

DI void even_core(LAS unsigned char* lds, const bf16_t* PR, bf16_t* YY, const bf16_t* WSP, const bf16_t* WPT, const float* ln_g, const float* ln_b,
                  const float* b_sp, const float* pool_scale, int S, int G, int tid, int wid, int lane) {
    const int fr = lane & 15, fq = lane >> 4;
    constexpr int PITCH = 1056;
    for (int ch0 = blockIdx.x; ch0 < GROWS / 128; ch0 += G) {
        const int ch = (G == 256) ? 2 * (16 * (ch0 & 7) + 8 * (ch0 >> 7) + ((ch0 >> 3) & 7)) + ((ch0 >> 6) & 1) : ch0;
        const size_t tok0 = (size_t)ch * 128;
        {
            const f32x4 g0 = *(const f32x4*)(ln_g + lane * 8), g1 = *(const f32x4*)(ln_g + lane * 8 + 4), b0 = *(const f32x4*)(ln_b + lane * 8), b1 = *(const f32x4*)(ln_b + lane * 8 + 4);
#pragma unroll 8
            for (int i = 0; i < 16; ++i) {
                const int q = wid * 16 + i;
                const u32x4 w = *(const u32x4*)(PR + (tok0 + q) * PRP + 512 + lane * 8);
                f32x4 a = (f32x4){bf_lo(w.x), bf_hi(w.x), bf_lo(w.y), bf_hi(w.y)}, b = (f32x4){bf_lo(w.z), bf_hi(w.z), bf_lo(w.w), bf_hi(w.w)};
                const float mean = wave_sum((a[0] + a[1]) + (a[2] + a[3]) + (b[0] + b[1]) + (b[2] + b[3])) * (1.0f / 512.0f);
                a = a - mean; b = b - mean;
                const float var = wave_sum((a[0] * a[0] + a[1] * a[1]) + (a[2] * a[2] + a[3] * a[3]) + (b[0] * b[0] + b[1] * b[1]) + (b[2] * b[2] + b[3] * b[3])) * (1.0f / 512.0f);
                const float rstd = rsqrtf(var + 1e-5f);
                a = a * rstd * g0 + b0; b = b * rstd * g1 + b1;
                u32x4 o; o.x = pk2(a[0], a[1]); o.y = pk2(a[2], a[3]); o.z = pk2(b[0], b[1]); o.w = pk2(b[2], b[3]);
                *(LAS u32x4*)(lds + q * PITCH + lane * 16) = o;
            }
        }
        __syncthreads();
        {
            const int h = wid >> 1, cw0 = wid * 64;
            for (int ph = 0; ph < 2; ++ph) {
                f32x4 acc[4][4];
#pragma unroll
                for (int a = 0; a < 4; ++a)
#pragma unroll
                    for (int b = 0; b < 4; ++b) acc[a][b] = (f32x4){0.f, 0.f, 0.f, 0.f};
#pragma unroll 1
                for (int kp = 0; kp < 2; ++kp) {
                    bf16x8 bw[2][4];
#pragma unroll
                    for (int k2 = 0; k2 < 2; ++k2)
#pragma unroll
                        for (int pt = 0; pt < 4; ++pt) bw[k2][pt] = *(const bf16x8*)(WSP + ((h * 128 + (ph * 4 + pt) * 16 + fr) * 128 + (kp * 2 + k2) * 32 + fq * 8));
#pragma unroll
                    for (int k2 = 0; k2 < 2; ++k2) {
                        const int ks = kp * 2 + k2;
                        bf16x8 af[4];
#pragma unroll
                        for (int ct = 0; ct < 4; ++ct) af[ct] = tr_frag(lds + (ks * 32 + fq * 8 + (fr >> 2)) * PITCH + (cw0 + ct * 16 + 4 * (fr & 3)) * 2, 4 * PITCH);
#pragma unroll
                        for (int ct = 0; ct < 4; ++ct)
#pragma unroll
                            for (int pt = 0; pt < 4; ++pt) acc[ct][pt] = mfma16(af[ct], bw[k2][pt], acc[ct][pt]);
                    }
                }
#pragma unroll
                for (int pt = 0; pt < 4; ++pt) {
                    const int pp = (ph * 4 + pt) * 16 + fr; const float bs = b_sp[h * 128 + pp];
#pragma unroll
                    for (int ct = 0; ct < 4; ++ct) {
                        const int c = cw0 + ct * 16 + fq * 4;
                        const u32x2 uw = *(const u32x2*)(PR + (tok0 + pp) * PRP + c);
                        u32x2 o; o.x = pk2(bf_lo(uw.x) * (acc[ct][pt][0] + bs), bf_hi(uw.x) * (acc[ct][pt][1] + bs)); o.y = pk2(bf_lo(uw.y) * (acc[ct][pt][2] + bs), bf_hi(uw.y) * (acc[ct][pt][3] + bs));
                        *(u32x2*)(YY + (tok0 + pp) * 1024 + c) = o;
                    }
                }
            }
        }
        {
            const int tl = wid * 16 + fr; const int pos = (int)(tok0 % (size_t)S) + tl;
            const int pos0 = (int)(tok0 % (size_t)S);
            PoolStage ps;
            pool_stage_load(ps, PR, WPT, tok0, pos0, S, 0, tid);
            __syncthreads();
            pool_stage_store(ps, lds, tid); pool_stage_load(ps, PR, WPT, tok0, pos0, S, 1, tid);
            __syncthreads();
            pool_compute<0>(lds, YY, pool_scale, tok0, tl, pos, S, fr, fq);
            __syncthreads();
            pool_stage_store(ps, lds, tid); pool_stage_load(ps, PR, WPT, tok0, pos0, S, 2, tid);
            __syncthreads();
            pool_compute<1>(lds, YY, pool_scale, tok0, tl, pos, S, fr, fq);
            __syncthreads();
            pool_stage_store(ps, lds, tid); pool_stage_load(ps, PR, WPT, tok0, pos0, S, 3, tid);
            __syncthreads();
            pool_compute<2>(lds, YY, pool_scale, tok0, tl, pos, S, fr, fq);
            __syncthreads();
            pool_stage_store(ps, lds, tid);
            __syncthreads();
            pool_compute<3>(lds, YY, pool_scale, tok0, tl, pos, S, fr, fq);
        }
        __syncthreads();
    }
}

DI void conv_part(const bf16_t* PR, bf16_t* YY, const float* conv_w, int S, int G, int wid, int lane) {
    const int gw = blockIdx.x * 8 + wid, NGW = G * 8;
    f32x4 w[3][2];
#pragma unroll
    for (int k = 0; k < 3; ++k) { w[k][0] = *(const f32x4*)(conv_w + k * 512 + lane * 8); w[k][1] = *(const f32x4*)(conv_w + k * 512 + lane * 8 + 4); }
#pragma unroll 8
    for (int r = gw; r < GROWS; r += NGW) {
        const int pos = r % S;
        const bf16_t* cz = PR + (size_t)r * PRP + lane * 8;
        const float m0 = (pos > 0) ? 1.0f : 0.0f, m2 = (pos < S - 1) ? 1.0f : 0.0f;
        const u32x4 c1 = *(const u32x4*)cz, c0 = *(const u32x4*)(cz - (pos > 0 ? PRP : 0)), c2 = *(const u32x4*)(cz + (pos < S - 1 ? PRP : 0)), bg = *(const u32x4*)(cz + 512);
        const f32x4 w00 = w[0][0] * m0, w01 = w[0][1] * m0, w20 = w[2][0] * m2, w21 = w[2][1] * m2;
        f32x4 a0 = (f32x4){bf_lo(c0.x), bf_hi(c0.x), bf_lo(c0.y), bf_hi(c0.y)} * w00 + (f32x4){bf_lo(c1.x), bf_hi(c1.x), bf_lo(c1.y), bf_hi(c1.y)} * w[1][0] + (f32x4){bf_lo(c2.x), bf_hi(c2.x), bf_lo(c2.y), bf_hi(c2.y)} * w20;
        f32x4 a1 = (f32x4){bf_lo(c0.z), bf_hi(c0.z), bf_lo(c0.w), bf_hi(c0.w)} * w01 + (f32x4){bf_lo(c1.z), bf_hi(c1.z), bf_lo(c1.w), bf_hi(c1.w)} * w[1][1] + (f32x4){bf_lo(c2.z), bf_hi(c2.z), bf_lo(c2.w), bf_hi(c2.w)} * w21;
        a0 = a0 * (f32x4){bf_lo(bg.x), bf_hi(bg.x), bf_lo(bg.y), bf_hi(bg.y)}; a1 = a1 * (f32x4){bf_lo(bg.z), bf_hi(bg.z), bf_lo(bg.w), bf_hi(bg.w)};
        u32x4 o; o.x = pk2(a0[0], a0[1]); o.y = pk2(a0[2], a0[3]); o.z = pk2(a1[0], a1[1]); o.w = pk2(a1[2], a1[3]);
        *(u32x4*)(YY + (size_t)r * 1024 + lane * 8) = o;
    }
}

template <int R, int QB>
DI void four_stage1(const bf16_t* PR, bf16_t* UB, const bf16_t* WF, const bf16_t* FCp, const bf16_t* FSp, const f32x2* TW, int nb, int G, int wid, int lane) {
    constexpr int NT = R / 16, KS = (R + 31) / 32, KW = KS * 32, S = R * 128, NQB = 128 / QB;
    const int fr = lane & 15, fq = lane >> 4, e0 = wid * 16;
    const int nunits = nb * 4 * NQB;
    for (int un = blockIdx.x; un < nunits; un += G) {
        const int q0 = (un % NQB) * QB, g = (un / NQB) & 3, b = un / (4 * NQB);
        bf16x8 wP[4], wQ[4];
#pragma unroll
        for (int ks = 0; ks < 4; ++ks) { wP[ks] = *(const bf16x8*)(WF + ((g * 256 + e0 + fr) * 128 + ks * 32 + fq * 8)); wQ[ks] = *(const bf16x8*)(WF + ((g * 256 + 128 + e0 + fr) * 128 + ks * 32 + fq * 8)); }
        unsigned pP[QB][NT][2], pQ[QB][NT][2];
#pragma unroll
        for (int rt = 0; rt < NT; ++rt) {
#pragma unroll
            for (int qi = 0; qi < QB; ++qi) {
                const size_t tok = (size_t)b * S + 128 * (rt * 16 + fr) + q0 + qi;
                const bf16_t* zp = PR + tok * PRP + 1024 + g * 128 + fq * 8;
                bf16x8 a[4]; float ss = 0.f;
#pragma unroll
                for (int ks = 0; ks < 4; ++ks) a[ks] = *(const bf16x8*)(zp + ks * 32);
#pragma unroll
                for (int ks = 0; ks < 4; ++ks)
#pragma unroll
                    for (int k = 0; k < 8; ++k) { const float f = __uint_as_float(((unsigned)(unsigned short)a[ks][k]) << 16); ss += f * f; }
                ss += __shfl_xor(ss, 16); ss += __shfl_xor(ss, 32);
                const float rs = rsqrtf(ss * (1.0f / 128.0f) + 1e-6f);
                f32x4 dP = (f32x4){0.f, 0.f, 0.f, 0.f}, dQ = dP;
#pragma unroll
                for (int ks = 0; ks < 4; ++ks) { dP = mfma16(a[ks], wP[ks], dP); dQ = mfma16(a[ks], wQ[ks], dQ); }
#pragma unroll
                for (int j = 0; j < 4; ++j) { const float sj = __shfl(rs, fq * 4 + j); dP[j] *= sj; dQ[j] *= sj; }
                pP[qi][rt][0] = pk2(dP[0], dP[1]); pP[qi][rt][1] = pk2(dP[2], dP[3]); pQ[qi][rt][0] = pk2(dQ[0], dQ[1]); pQ[qi][rt][1] = pk2(dQ[2], dQ[3]);
            }
            if ((rt & 3) == 3) asm volatile("" ::: "memory");
        }
#pragma unroll 2
        for (int k1t = 0; k1t < NT; ++k1t) {
            bf16x8 aC[KS], aS[KS];
#pragma unroll
            for (int s = 0; s < KS; ++s) { aC[s] = *(const bf16x8*)(FCp + ((k1t * 16 + fr) * KW + s * 32 + fq * 8)); aS[s] = *(const bf16x8*)(FSp + ((k1t * 16 + fr) * KW + s * 32 + fq * 8)); }
#pragma unroll
            for (int qi = 0; qi < QB; ++qi) {
                f32x4 Ur = (f32x4){0.f, 0.f, 0.f, 0.f}, V = Ur;
#pragma unroll
                for (int s = 0; s < KS; ++s) {
                    u32x4 bp, bq;
                    bp.x = pP[qi][2 * s][0]; bp.y = pP[qi][2 * s][1]; bq.x = pQ[qi][2 * s][0]; bq.y = pQ[qi][2 * s][1];
                    if (2 * s + 1 < NT) { bp.z = pP[qi][(2 * s + 1) % NT][0]; bp.w = pP[qi][(2 * s + 1) % NT][1]; bq.z = pQ[qi][(2 * s + 1) % NT][0]; bq.w = pQ[qi][(2 * s + 1) % NT][1]; }
                    else { bp.z = 0u; bp.w = 0u; bq.z = 0u; bq.w = 0u; }
                    const u32x4 bnq = bq ^ 0x80008000u;
                    const bf16x8 BP = __builtin_bit_cast(bf16x8, bp), BQ = __builtin_bit_cast(bf16x8, bq), BNQ = __builtin_bit_cast(bf16x8, bnq);
                    Ur = mfma16(aC[s], BP, Ur); Ur = mfma16(aS[s], BNQ, Ur); V = mfma16(aS[s], BP, V); V = mfma16(aC[s], BQ, V);
                }
                const int q = q0 + qi;
#pragma unroll
                for (int j = 0; j < 4; ++j) {
                    const int k1 = k1t * 16 + fq * 4 + j; const f32x2 tw = TW[q * R + k1];
                    const float upr = Ur[j] * tw.x - V[j] * tw.y, upi = -(V[j] * tw.x + Ur[j] * tw.y);
                    bf16_t* o = UB + ((((size_t)b * R + k1) * 2) * 128 + q) * 512 + g * 128 + e0 + fr;
                    o[0] = (bf16_t)f2bf(upr); o[(size_t)128 * 512] = (bf16_t)f2bf(upi);
                }
            }
        }
    }
}

DI void four_stage1_p(LAS unsigned char* lds, const bf16_t* PR, bf16_t* UB, const bf16_t* WF, const bf16_t* FCp, const bf16_t* FSp, const f32x2* TW, int nb, int G, int tid, int wid, int lane) {
    constexpr int R = 128, S = R * 128, PT = 272, TC_OFF = 0, TS_OFF = 128 * PT, Z_OFF = 256 * PT, TW_OFF = 384 * PT;
    const int fr = lane & 15, fq = lane >> 4, e0 = wid * 16;
    const int nunits = nb * 4 * 128;
    {
#pragma unroll
        for (int i = 0; i < 4; ++i) { const int idx = tid + NTHR * i; const u32x4 c = *(const u32x4*)(FCp + (idx >> 4) * 128 + (idx & 15) * 8), sn = *(const u32x4*)(FSp + (idx >> 4) * 128 + (idx & 15) * 8);
            *(LAS u32x4*)(lds + TC_OFF + (idx >> 4) * PT + (idx & 15) * 16) = c; *(LAS u32x4*)(lds + TS_OFF + (idx >> 4) * PT + (idx & 15) * 16) = sn; }
    }
    u32x4 zr[4]; u32x4 twr = (u32x4){0u, 0u, 0u, 0u};
    int un = blockIdx.x;
    if (un < nunits) { const int q = un & 127, g = (un >> 7) & 3, b = un >> 9;
#pragma unroll
        for (int i = 0; i < 4; ++i) { const int idx = tid + NTHR * i; zr[i] = *(const u32x4*)(PR + ((size_t)b * S + 128 * (idx >> 4) + q) * PRP + 1024 + g * 128 + (idx & 15) * 8); }
        if (tid < 64) twr = *(const u32x4*)((const float*)(TW + q * R) + tid * 4); }
    for (; un < nunits; un += G) {
        const int q = un & 127, g = (un >> 7) & 3, b = un >> 9;
        bf16x8 wP[4], wQ[4];
#pragma unroll
        for (int ks = 0; ks < 4; ++ks) { wP[ks] = *(const bf16x8*)(WF + ((g * 256 + e0 + fr) * 128 + ks * 32 + fq * 8)); wQ[ks] = *(const bf16x8*)(WF + ((g * 256 + 128 + e0 + fr) * 128 + ks * 32 + fq * 8)); }
        __syncthreads();
#pragma unroll
        for (int i = 0; i < 4; ++i) { const int idx = tid + NTHR * i; *(LAS u32x4*)(lds + Z_OFF + (idx >> 4) * PT + (idx & 15) * 16) = zr[i]; }
        if (tid < 64) *(LAS u32x4*)(lds + TW_OFF + tid * 16) = twr;
        { const int un2 = un + G;
          if (un2 < nunits) { const int q2 = un2 & 127, g2 = (un2 >> 7) & 3, b2 = un2 >> 9;
#pragma unroll
            for (int i = 0; i < 4; ++i) { const int idx = tid + NTHR * i; zr[i] = *(const u32x4*)(PR + ((size_t)b2 * S + 128 * (idx >> 4) + q2) * PRP + 1024 + g2 * 128 + (idx & 15) * 8); }
            if (tid < 64) twr = *(const u32x4*)((const float*)(TW + q2 * R) + tid * 4); } }
        __syncthreads();
        unsigned pP[8][2], pQ[8][2];
#pragma unroll
        for (int rt = 0; rt < 8; ++rt) {
            bf16x8 a[4]; float ss = 0.f;
#pragma unroll
            for (int ks = 0; ks < 4; ++ks) a[ks] = *(const LAS bf16x8*)(lds + Z_OFF + (rt * 16 + fr) * PT + (ks * 32 + fq * 8) * 2);
#pragma unroll
            for (int ks = 0; ks < 4; ++ks)
#pragma unroll
                for (int k = 0; k < 8; ++k) { const float f = __uint_as_float(((unsigned)(unsigned short)a[ks][k]) << 16); ss += f * f; }
            ss += __shfl_xor(ss, 16); ss += __shfl_xor(ss, 32);
            const float rs = rsqrtf(ss * (1.0f / 128.0f) + 1e-6f);
            f32x4 dP = (f32x4){0.f, 0.f, 0.f, 0.f}, dQ = dP;
#pragma unroll
            for (int ks = 0; ks < 4; ++ks) { dP = mfma16(a[ks], wP[ks], dP); dQ = mfma16(a[ks], wQ[ks], dQ); }
#pragma unroll
            for (int j = 0; j < 4; ++j) { const float sj = __shfl(rs, fq * 4 + j); dP[j] *= sj; dQ[j] *= sj; }
            pP[rt][0] = pk2(dP[0], dP[1]); pP[rt][1] = pk2(dP[2], dP[3]); pQ[rt][0] = pk2(dQ[0], dQ[1]); pQ[rt][1] = pk2(dQ[2], dQ[3]);
            if ((rt & 3) == 3) asm volatile("" ::: "memory");
        }
#pragma unroll 2
        for (int k1t = 0; k1t < 8; ++k1t) {
            bf16x8 aC[4], aS[4];
#pragma unroll
            for (int sx = 0; sx < 4; ++sx) { aC[sx] = *(const LAS bf16x8*)(lds + TC_OFF + (k1t * 16 + fr) * PT + (sx * 32 + fq * 8) * 2); aS[sx] = *(const LAS bf16x8*)(lds + TS_OFF + (k1t * 16 + fr) * PT + (sx * 32 + fq * 8) * 2); }
            const f32x2 twl = *(const LAS f32x2*)(lds + TW_OFF + (k1t * 16 + fr) * 8);
            f32x4 Ur = (f32x4){0.f, 0.f, 0.f, 0.f}, V = Ur;
#pragma unroll
            for (int sx = 0; sx < 4; ++sx) {
                u32x4 bp, bq;
                bp.x = pP[2 * sx][0]; bp.y = pP[2 * sx][1]; bq.x = pQ[2 * sx][0]; bq.y = pQ[2 * sx][1];
                bp.z = pP[2 * sx + 1][0]; bp.w = pP[2 * sx + 1][1]; bq.z = pQ[2 * sx + 1][0]; bq.w = pQ[2 * sx + 1][1];
                const u32x4 bnq = bq ^ 0x80008000u;
                const bf16x8 BP = __builtin_bit_cast(bf16x8, bp), BQ = __builtin_bit_cast(bf16x8, bq), BNQ = __builtin_bit_cast(bf16x8, bnq);
                Ur = mfma16(BP, aC[sx], Ur); Ur = mfma16(BNQ, aS[sx], Ur); V = mfma16(BP, aS[sx], V); V = mfma16(BQ, aC[sx], V);
            }
            {
                const int k1 = k1t * 16 + fr;
                const f32x4 upr = Ur * twl.x - V * twl.y, upi = -(V * twl.x + Ur * twl.y);
                bf16_t* o = UB + ((((size_t)b * R + k1) * 2) * 128 + q) * 512 + g * 128 + e0 + fq * 4;
                u32x2 wr_, wi_; wr_.x = pk2(upr[0], upr[1]); wr_.y = pk2(upr[2], upr[3]); wi_.x = pk2(upi[0], upi[1]); wi_.y = pk2(upi[2], upi[3]);
                *(u32x2*)o = wr_; *(u32x2*)(o + (size_t)128 * 512) = wi_;
            }
        }
    }
    __syncthreads();
}

DI void four_stage1_s(LAS unsigned char* lds, const bf16_t* PR, bf16_t* UB, const bf16_t* WF, const bf16_t* FCp, const bf16_t* FSp, const f32x2* TW, int nb, int G, int tid, int wid, int lane) {
    constexpr int R = 16, S = R * 128, QB = 4, NQB = 32, PT = 272;
    const int fr = lane & 15, fq = lane >> 4, e0 = wid * 16;
    const int nunits = nb * 4 * NQB;
    const bool uniform = (G % 128) == 0;
    int un = blockIdx.x;
    if (un >= nunits) return;
    int q0 = (un % NQB) * QB, g = (un / NQB) & 3;
    bf16x8 wP[4], wQ[4], aC, aS; f32x2 twl[QB];
    u32x4 zr[2];
#define S1S_CONST() do { _Pragma("unroll") for (int ks = 0; ks < 4; ++ks) { wP[ks] = *(const bf16x8*)(WF + ((g * 256 + e0 + fr) * 128 + ks * 32 + fq * 8)); wQ[ks] = *(const bf16x8*)(WF + ((g * 256 + 128 + e0 + fr) * 128 + ks * 32 + fq * 8)); } \
        _Pragma("unroll") for (int qi = 0; qi < QB; ++qi) twl[qi] = TW[(q0 + qi) * R + fr]; } while (0)
    aC = *(const bf16x8*)(FCp + (fr * 32 + fq * 8)); aS = *(const bf16x8*)(FSp + (fr * 32 + fq * 8));
    S1S_CONST();
    { const int b = un / (4 * NQB);
#pragma unroll
      for (int i = 0; i < 2; ++i) { const int idx = tid + NTHR * i, row = idx >> 4; zr[i] = *(const u32x4*)(PR + ((size_t)b * S + 128 * (row & 15) + q0 + (row >> 4)) * PRP + 1024 + g * 128 + (idx & 15) * 8); } }
    for (; un < nunits; un += G) {
        const int b = un / (4 * NQB);
        __syncthreads();
#pragma unroll
        for (int i = 0; i < 2; ++i) { const int idx = tid + NTHR * i; *(LAS u32x4*)(lds + (idx >> 4) * PT + (idx & 15) * 16) = zr[i]; }
        const int un2 = un + G; int q0n = q0, gn = g;
        if (un2 < nunits) { const int b2 = un2 / (4 * NQB); q0n = (un2 % NQB) * QB; gn = (un2 / NQB) & 3;
#pragma unroll
            for (int i = 0; i < 2; ++i) { const int idx = tid + NTHR * i, row = idx >> 4; zr[i] = *(const u32x4*)(PR + ((size_t)b2 * S + 128 * (row & 15) + q0n + (row >> 4)) * PRP + 1024 + gn * 128 + (idx & 15) * 8); } }
        __syncthreads();
#pragma unroll
        for (int qi = 0; qi < QB; ++qi) {
            bf16x8 a[4]; float ss = 0.f;
#pragma unroll
            for (int ks = 0; ks < 4; ++ks) a[ks] = *(const LAS bf16x8*)(lds + (qi * 16 + fr) * PT + (ks * 32 + fq * 8) * 2);
#pragma unroll
            for (int ks = 0; ks < 4; ++ks)
#pragma unroll
                for (int k = 0; k < 8; ++k) { const float f = __uint_as_float(((unsigned)(unsigned short)a[ks][k]) << 16); ss += f * f; }
            ss += __shfl_xor(ss, 16); ss += __shfl_xor(ss, 32);
            const float rs = rsqrtf(ss * (1.0f / 128.0f) + 1e-6f);
            f32x4 dP = (f32x4){0.f, 0.f, 0.f, 0.f}, dQ = dP;
#pragma unroll
            for (int ks = 0; ks < 4; ++ks) { dP = mfma16(a[ks], wP[ks], dP); dQ = mfma16(a[ks], wQ[ks], dQ); }
#pragma unroll
            for (int j = 0; j < 4; ++j) { const float sj = __shfl(rs, fq * 4 + j); dP[j] *= sj; dQ[j] *= sj; }
            u32x4 bp, bq; bp.x = pk2(dP[0], dP[1]); bp.y = pk2(dP[2], dP[3]); bp.z = 0u; bp.w = 0u; bq.x = pk2(dQ[0], dQ[1]); bq.y = pk2(dQ[2], dQ[3]); bq.z = 0u; bq.w = 0u;
            const u32x4 bnq = bq ^ 0x80008000u;
            const bf16x8 BP = __builtin_bit_cast(bf16x8, bp), BQ = __builtin_bit_cast(bf16x8, bq), BNQ = __builtin_bit_cast(bf16x8, bnq);
            f32x4 Ur = (f32x4){0.f, 0.f, 0.f, 0.f}, V = Ur;
            Ur = mfma16(BP, aC, Ur); Ur = mfma16(BNQ, aS, Ur); V = mfma16(BP, aS, V); V = mfma16(BQ, aC, V);
            const int q = q0 + qi;
            {
                const int k1 = fr;
                const f32x4 upr = Ur * twl[qi].x - V * twl[qi].y, upi = -(V * twl[qi].x + Ur * twl[qi].y);
                bf16_t* o = UB + ((((size_t)b * R + k1) * 2) * 128 + q) * 512 + g * 128 + e0 + fq * 4;
                u32x2 wr_, wi_; wr_.x = pk2(upr[0], upr[1]); wr_.y = pk2(upr[2], upr[3]); wi_.x = pk2(upi[0], upi[1]); wi_.y = pk2(upi[2], upi[3]);
                *(u32x2*)o = wr_; *(u32x2*)(o + (size_t)128 * 512) = wi_;
            }
        }
        if (!uniform && un2 < nunits) { q0 = q0n; g = gn; S1S_CONST(); }
    }
#undef S1S_CONST
    __syncthreads();
}

template <int R>
DI void four_stage2(LAS unsigned char* lds, const bf16_t* UB, bf16_t* YY, const bf16_t* FC2, const bf16_t* FS2, int nb, int G, int tid, int wid, int lane) {
    constexpr int PT = 272, S = R * 128, FC_OFF = 0, FS_OFF = 128 * PT, U_OFF = 256 * PT;
    const float norm = rsqrtf((float)S * 128.0f);
    const int fr = lane & 15, fq = lane >> 4, c0 = wid * 16;
    const int nunits = nb * R * 4;
#pragma unroll
    for (int i = 0; i < 4; ++i) { const int idx = tid + NTHR * i; const u32x4 c = *(const u32x4*)(FC2 + (idx >> 4) * 128 + (idx & 15) * 8), sn = *(const u32x4*)(FS2 + (idx >> 4) * 128 + (idx & 15) * 8);
        *(LAS u32x4*)(lds + FC_OFF + (idx >> 4) * PT + (idx & 15) * 16) = c; *(LAS u32x4*)(lds + FS_OFF + (idx >> 4) * PT + (idx & 15) * 16) = sn; }
    u32x4 tile[8];
    if ((int)blockIdx.x < nunits) { const int u0 = blockIdx.x; const bf16_t* src = UB + (((size_t)((u0 >> 2) / R) * R + ((u0 >> 2) % R)) * 2) * 128 * 512 + (u0 & 3) * 128;
#pragma unroll
        for (int i = 0; i < 8; ++i) { const int idx = tid + NTHR * i; tile[i] = *(const u32x4*)(src + (size_t)(idx >> 4) * 512 + (idx & 15) * 8); } }
    for (int un = blockIdx.x; un < nunits; un += G) {
        const int cq = un & 3, k1 = (un >> 2) % R, b = (un >> 2) / R;
        __syncthreads();
#pragma unroll
        for (int i = 0; i < 8; ++i) { const int idx = tid + NTHR * i; *(LAS u32x4*)(lds + U_OFF + (idx >> 4) * PT + (idx & 15) * 16) = tile[i]; }
        if (un + G < nunits) { const int u2 = un + G; const bf16_t* src = UB + (((size_t)((u2 >> 2) / R) * R + ((u2 >> 2) % R)) * 2) * 128 * 512 + (u2 & 3) * 128;
#pragma unroll
            for (int i = 0; i < 8; ++i) { const int idx = tid + NTHR * i; tile[i] = *(const u32x4*)(src + (size_t)(idx >> 4) * 512 + (idx & 15) * 8); } }
        __syncthreads();
        f32x4 acc[8];
#pragma unroll
        for (int k = 0; k < 8; ++k) acc[k] = (f32x4){0.f, 0.f, 0.f, 0.f};
#pragma unroll
        for (int it = 0; it < 8; ++it) {
            const int comp = it >> 2, ks = it & 3;
            const bf16x8 uf = tr_frag(lds + U_OFF + (comp * 128 + ks * 32 + fq * 8 + (fr >> 2)) * PT + (c0 + 4 * (fr & 3)) * 2, 4 * PT);
#pragma unroll
            for (int k2t = 0; k2t < 8; ++k2t) { const bf16x8 fa = *(const LAS bf16x8*)(lds + (comp ? FS_OFF : FC_OFF) + (k2t * 16 + fr) * PT + (ks * 32 + fq * 8) * 2); acc[k2t] = mfma16(uf, fa, acc[k2t]); }
        }
#pragma unroll
        for (int k2t = 0; k2t < 8; ++k2t) {
            const size_t tok = (size_t)b * S + (size_t)R * (k2t * 16 + fr) + k1;
            const f32x4 y = acc[k2t] * norm; u32x2 o; o.x = pk2(y[0], y[1]); o.y = pk2(y[2], y[3]);
            *(u32x2*)(YY + tok * 1024 + 512 + cq * 128 + c0 + fq * 4) = o;
        }
    }
    __syncthreads();
}

__global__ void __launch_bounds__(NTHR, 2) mega_fwd(Params p) {
    extern __shared__ __attribute__((aligned(16))) unsigned char lds_raw[];
    LAS unsigned char* lds = (LAS unsigned char*)lds_raw;
    cg::grid_group grid = cg::this_grid();
    const int tid = threadIdx.x, lane = tid & 63, wid = __builtin_amdgcn_readfirstlane(tid >> 6), G = gridDim.x;
    unsigned char* ws = p.ws;
    int pc = 0;
#define PH_BEGIN if (pc >= p.ph_lo && pc < p.ph_hi) {
    volatile LAS unsigned* bst = (volatile LAS unsigned*)(lds + LDS_BYTES - 64);
    if (tid < 2) bst[tid] = 0u;
    __syncthreads();
    if (p.ph_lo > p.ph_hi) grid.sync();
    XcdBarrier xbar = xcd_barrier_post((unsigned*)(ws + WS_BAR), bst);
    if (tid == 0) { (void)__hip_atomic_fetch_max(&xbar.bar[XB_CLS(blockIdx.x & 7u)], xbar.x + 1u, __ATOMIC_RELAXED, __HIP_MEMORY_SCOPE_AGENT); (void)__hip_atomic_fetch_max(&xbar.bar[XB_CLS(8u + (blockIdx.x & 7u))], 16u - xbar.x, __ATOMIC_RELAXED, __HIP_MEMORY_SCOPE_AGENT); }
    bool local_ok = false, seam_local = false, seam_noacq = false, seam_skip = false;
#define PH_END } ++pc; if (pc == 1) { xcd_barrier(xbar); \
        local_ok = (G == 256) && (bst[0] == 32u) && (bst[1] == 8u) && (xb_ld(&xbar.bar[XB_TMO]) == 0u); \
        for (unsigned cc = 0; cc < 8u; ++cc) local_ok = local_ok && (xb_ld(&xbar.bar[XB_CLS(cc)]) + xb_ld(&xbar.bar[XB_CLS(8u + cc)]) == 17u); } \
    else if (seam_skip && local_ok) { } else if (seam_local && local_ok) { team_barrier(xbar, !seam_noacq); } else { xcd_barrier(xbar); }

    PH_BEGIN
#if PHMASK & 1
#if PROBE & 16
 for (int rep = 0; rep < 2; ++rep)
#endif
 setup_phase(p, lds, G, tid, wid, lane);
#endif
 PH_END

    bf16_t* H = (bf16_t*)(ws + WS_H); bf16_t* T = (bf16_t*)(ws + WS_T); bf16_t* BIG = (bf16_t*)(ws + WS_BIG); bf16_t* UB = (bf16_t*)(ws + WS_T);     _Float16* XH = (_Float16*)(ws + WS_XH);
    const float* mod = (const float*)(ws + WS_MOD);
    for (int gi = 0; gi < 2; ++gi) {
        const int S = gi ? 2048 : 16384, nb = gi ? 16 : 2;
        const float* xsrc = p.in[gi];
        float* xo = p.out + (size_t)gi * GROWS * D;
        for (int ls = 0; ls < 7; ++ls) {
            const int l = ls / 3, sub = ls % 3;
            const bool odd = (l & 1), last = (ls == 6), first = (ls == 0);
            const int nsteps = last ? 1 : (sub != 1 ? 3 : (odd ? 5 : 4));
            for (int step = 0; step < nsteps; ++step) {
                int kind = 1;
                if (step == 0) kind = 0;
                else if (sub == 1 && step == 2) kind = odd ? 3 : 2;
                else if (sub == 1 && odd && step == 3) kind = 4;
                seam_noacq = (kind == 1 && sub != 1 && step == 2);
                seam_skip = (kind == 0 && last);
                seam_local = !((kind == 1 && sub == 1) || kind == 3 || kind == 4);
                PH_BEGIN
                int tid = threadIdx.x; asm volatile("" : "+v"(tid));
                const int lane = tid & 63, wid = __builtin_amdgcn_readfirstlane(tid >> 6);
                if (kind == 0) {
#if PHMASK & 2
#ifndef STAG2
#define STAG2 0
#endif
                    if (STAG2 && local_ok && ((gi == 0 && ls == 0) || sub == 2) && ((blockIdx.x >> 3) & 1)) { for (int zz = 0; zz < STAG2; ++zz) __builtin_amdgcn_s_sleep(127); }
                    const int lp = sub > 0 ? l : l - 1, sp = sub > 0 ? sub - 1 : 2, lpp = first ? 0 : lp, lc = last ? 0 : l;
#if PROBE & 4
                    norm_phase(ls <= 1 ? xsrc : nullptr, XH, last ? (float*)BIG : nullptr, (_Float16*)BIG, T, H, !first, !last,
                               mod + (size_t)lpp * 18 * 9216 + (sp * 3 + 2) * 1024, p.in[7] + (lpp * 3 + sp) * 1024, sp == 1 ? 1.0f : 0.5f,
                               mod + (size_t)lc * 18 * 9216 + (sub * 3) * 1024, p.in[6] + (lc * 3 + sub) * 1024, gi, G, wid, lane);
#endif
                    norm_phase(ls <= 1 ? xsrc : nullptr, XH, last ? xo : nullptr, XH, T, H, !first, !last,
                               mod + (size_t)lpp * 18 * 9216 + (sp * 3 + 2) * 1024, p.in[7] + (lpp * 3 + sp) * 1024, sp == 1 ? 1.0f : 0.5f,
                               mod + (size_t)lc * 18 * 9216 + (sub * 3) * 1024, p.in[6] + (lc * 3 + sub) * 1024, gi, G, wid, lane);
#endif
                } else if (kind == 1) {
                    const bf16_t* A; const bf16_t* Bt; bf16_t* O; int N, K, ldc, mode;
                    if (sub != 1) {
                        const int wi = l * 2 + (sub >> 1);
                        if (step == 1) { A = H; Bt = (const bf16_t*)(ws + WS_WUP) + (size_t)wi * 5632 * 1024; O = BIG; N = 5632; K = 1024; ldc = DFF; mode = 3; }
                        else { A = BIG; Bt = (const bf16_t*)(ws + WS_WDN) + (size_t)wi * 1024 * 2816; O = T; N = 1024; K = DFF; ldc = D; mode = 0; }
                    } else if (step == 1) { A = H; Bt = (const bf16_t*)(ws + (odd ? WS_ODIN : WS_EVIN)); O = BIG; N = odd ? 2048 : 1536; K = 1024; ldc = PRP; mode = odd ? 2 : 1; }
                    else { A = H; Bt = (const bf16_t*)(ws + (odd ? WS_ODOUT : WS_EVOUT)); O = T; N = 1024; K = 1024; ldc = D; mode = 0; }
#if PROBE & 2
                    for (int rep = 0; rep < 2; ++rep)
#endif
                    run_gemm(lds, A, Bt, GROWS, N, K, O, ldc, mode, G);
                } else if (kind == 2) {
#if PHMASK & 8
#if PROBE & (8 | 32)
                    for (int rep = 0; rep < 2; ++rep)
#endif
                    even_core(lds, BIG, H, (const bf16_t*)(ws + WS_WSP), (const bf16_t*)(ws + WS_WPT), p.in[13], p.in[14], p.in[16], p.in[18], S, G, tid, wid, lane);
#endif
                } else if (kind == 3) {
#if PHMASK & 16
#if PROBE & (8 | 64)
                    for (int rep = 0; rep < 2; ++rep) {
#else
                    {
#endif
                    conv_part(BIG, H, p.in[21], S, G, wid, lane);
                    if (gi == 0) four_stage1_p(lds, BIG, UB, (const bf16_t*)(ws + WS_WF), (const bf16_t*)(ws + WS_FC1), (const bf16_t*)(ws + WS_FS1), (const f32x2*)(ws + WS_TW128), nb, G, tid, wid, lane);
                    else four_stage1_s(lds, BIG, UB, (const bf16_t*)(ws + WS_WF), (const bf16_t*)(ws + WS_FC16), (const bf16_t*)(ws + WS_FS16), (const f32x2*)(ws + WS_TW16), nb, G, tid, wid, lane);
                    }
#endif
                } else {
#if PHMASK & 32
#if PROBE & (8 | 128)
                    for (int rep = 0; rep < 2; ++rep) {
#else
                    {
#endif
                    if (gi == 0) four_stage2<128>(lds, UB, H, (const bf16_t*)(ws + WS_FC2), (const bf16_t*)(ws + WS_FS2), nb, G, tid, wid, lane);
                    else four_stage2<16>(lds, UB, H, (const bf16_t*)(ws + WS_FC2), (const bf16_t*)(ws + WS_FS2), nb, G, tid, wid, lane);
                    }
#endif
                }
                PH_END
            }
        }
    }
}

extern "C" void kernel_launch(void* const* d_in, const int* in_sizes, int n_in, void* d_out, int out_size, void* d_ws, size_t ws_size, hipStream_t stream) {
    static int grid = 0;
    if (grid == 0) {
        if (n_in != 25 || ws_size < WS_END || out_size != 2 * GROWS * D) { fprintf(stderr, "kernel_launch: unexpected shapes (n_in %d, out %d, ws %zu)\n", n_in, out_size, ws_size); grid = -1; return; }
        int dev = 0, cus = 0, per_cu = 0;
        hipGetDevice(&dev); hipDeviceGetAttribute(&cus, hipDeviceAttributeMultiprocessorCount, dev);
        hipFuncSetAttribute((const void*)mega_fwd, hipFuncAttributeMaxDynamicSharedMemorySize, LDS_BYTES);
        if (hipOccupancyMaxActiveBlocksPerMultiprocessor(&per_cu, (const void*)mega_fwd, NTHR, LDS_BYTES) != hipSuccess || per_cu < 1) per_cu = 1;
        (void)hipGetLastError();
        grid = cus * 1;
    }
    if (grid < 0) return;
    Params p{};
    for (int i = 0; i < 25; ++i) p.in[i] = (const float*)d_in[i];
    p.out = (float*)d_out; p.ws = (unsigned char*)d_ws; p.ph_lo = 0; p.ph_hi = 1 << 20;
    (void)hipMemsetAsync((unsigned char*)d_ws + WS_BAR, 0, XB_WORDS_ALL * sizeof(unsigned), stream);
    void* args[] = {&p};
    hipError_t e = hipLaunchCooperativeKernel((const void*)mega_fwd, dim3(grid), dim3(NTHR), args, LDS_BYTES, stream);
    if (e != hipSuccess) fprintf(stderr, "cooperative launch failed: %s (grid %d)\n", hipGetErrorString(e), grid);
}
```

```cpp
#include <hip/hip_runtime.h>
#include <hip/hip_cooperative_groups.h>
#include <cstdio>
namespace cg = cooperative_groups;
namespace pg8 {
#define PG8_LAS __attribute__((address_space(3)))
typedef unsigned short bf16_t;
typedef short bf16x8 __attribute__((ext_vector_type(8)));
typedef float f32x4 __attribute__((ext_vector_type(4)));
typedef unsigned u32x4 __attribute__((ext_vector_type(4)));
constexpr int BM = 256, BK = 64, HALF = 128, HTB = HALF * BK * 2  , STAGE_BYTES = 8 * HTB, NXCD = 8, WGM = 8;

__host__ __device__ __forceinline__ int lds_byte(int r, int c) { const int st = (r >> 4) * 2 + (c >> 5), rr = r & 15, cc = c & 31, ob = rr * 64 + cc * 2; return st * 1024 + (ob ^ (((ob >> 9) & 1) << 5)); }
__host__ __device__ __forceinline__ void stage_rc(int b, int& R, int& C) { const int st = b / 1024, sb = b % 1024, swz = sb ^ (((sb >> 9) & 1) << 5); R = (st >> 1) * 16 + swz / 64; C = (st & 1) * 32 + (swz % 64) / 2; }
__host__ __device__ __forceinline__ int perm32(int rho) { const int n = rho >> 4, i = rho & 15; return 8 * (i >> 2) + 4 * n + (i & 3); }

struct Unit { int pm, pn; };
struct Gemm { const bf16_t* A; const bf16_t* Bt; int M, N, K; };

struct StaticOrder {
    int nM, nN, nwg, G, c;
    __host__ __device__ void init(int M, int N, int G_, int c_) { nM = M / BM; nN = N / BM; nwg = nM * nN; G = G_; c = c_; }
    __host__ __device__ bool next(int i, Unit& u) const {
        const long L = (long)i * G + c; if (L >= nwg) return false;
        int wgid = (int)L; { const int q = nwg / NXCD, r = nwg % NXCD, xcd = wgid % NXCD, off = wgid / NXCD; wgid = (xcd < r ? xcd * (q + 1) : r * (q + 1) + (xcd - r) * q) + off; }
        const int nig = WGM * nN, gid = wgid / nig, fm = gid * WGM, gsz = (nM - fm) < WGM ? (nM - fm) : WGM;
        u.pm = fm + ((wgid % nig) % gsz); u.pn = (wgid % nig) / gsz; return true;
    }
    __device__ __forceinline__ void a_ready(const Unit&) const {}
    __device__ __forceinline__ void done(const Unit&) const {}
};
__device__ __forceinline__ unsigned cvt_pk_bf16(float lo, float hi) { unsigned r; asm volatile("v_cvt_pk_bf16_f32 %0, %1, %2" : "=v"(r) : "v"(lo), "v"(hi)); return r; }
typedef float f32x2 __attribute__((ext_vector_type(2)));
__device__ __forceinline__ f32x2 gelu_pk(f32x2 v) {
    const f32x2 av = __builtin_elementwise_abs(v), d = av * 0.2316418882f + 1.0f;
    f32x2 t; t.x = __builtin_amdgcn_rcpf(d.x); t.y = __builtin_amdgcn_rcpf(d.y);
    f32x2 q = t * 0.5307027145f + (-0.7265760135f); q = q * t + 0.7107068705f; q = q * t + (-0.142248368f); q = q * t + 0.127414796f; q = q * t;
    const f32x2 s = (v * v) * (-0.72134752044f);
    f32x2 e; e.x = __builtin_amdgcn_exp2f(s.x); e.y = __builtin_amdgcn_exp2f(s.y);
    const f32x2 m = v * (q * e), r = v - m;
    f32x2 o; o.x = v.x < 0.f ? m.x : r.x; o.y = v.y < 0.f ? m.y : r.y; return o;
}
template <class Epi, class Sched, bool ALIGN_EPI = false, bool SP2 = false>
__device__ __forceinline__ void gemm_phase(PG8_LAS unsigned char* lds, const Gemm g, const Sched& S, const Epi& E) {
    int tid_o = threadIdx.x; asm volatile("" : "+v"(tid_o));
    const int tid = tid_o, wid = __builtin_amdgcn_readfirstlane(tid >> 6), lane = tid & 63, wr = wid >> 2, wc = wid & 3, fr = lane & 15, fq = lane >> 4;
    const int K = g.K, nt = K / BK;
    unsigned voffA[2], voffB[2];
#pragma unroll
    for (int i = 0; i < 2; ++i) { int R, C; stage_rc(tid * 16 + i * 8192, R, C); const int Rb = Epi::PERM ? ((R & ~31) + perm32(R & 31)) : R;
        voffA[i] = (unsigned)(R * K + C) * 2u; voffB[i] = (unsigned)(Rb * K + C) * 2u; }
    const size_t kstep = (size_t)(BK * 2);
    const size_t hstep = (size_t)HALF * K * 2;
    const size_t tstep = 2 * hstep;
    const unsigned ldsw = (unsigned)wid * 1024u;
    const int aoff = lds_byte(wr * 64 + fr, fq * 8), boff = lds_byte(wc * 32 + fr, fq * 8);
#define PG8_SA(b, h) (((b) * 2 + (h)) * HTB)
#define PG8_SB(b, h) ((4 + (b) * 2 + (h)) * HTB)
#define PG8_STAGE(bufoff, gbase, voff) do { _Pragma("unroll") for (int _i = 0; _i < 2; ++_i) \
        __builtin_amdgcn_global_load_lds((const unsigned*)((const char*)(gbase) + (voff)[_i]), (PG8_LAS unsigned*)(lds + (bufoff) + ldsw + _i * 8192), 16, 0, 0); } while (0)
#define PG8_LDA(dst, b, h) do { _Pragma("unroll") for (int m = 0; m < 4; ++m) _Pragma("unroll") for (int k = 0; k < 2; ++k) dst[m][k] = *(const PG8_LAS bf16x8*)(lds + PG8_SA(b, h) + aoff + m * 2048 + k * 1024); } while (0)
#define PG8_LDB(dst, b, h) do { _Pragma("unroll") for (int n = 0; n < 2; ++n) _Pragma("unroll") for (int k = 0; k < 2; ++k) dst[n][k] = *(const PG8_LAS bf16x8*)(lds + PG8_SB(b, h) + boff + n * 2048 + k * 1024); } while (0)
#define PG8_MMA(ai, bj, At, Bt) do { __builtin_amdgcn_s_setprio(1); _Pragma("unroll") for (int m = 0; m < 4; ++m) _Pragma("unroll") for (int n = 0; n < 2; ++n) _Pragma("unroll") for (int k = 0; k < 2; ++k) \
        acc[ai][bj][m][n] = __builtin_amdgcn_mfma_f32_16x16x32_bf16(Bt[n][k], At[m][k], acc[ai][bj][m][n], 0, 0, 0); __builtin_amdgcn_s_setprio(0); } while (0)
#define PG8_WAIT_V(n) asm volatile("s_waitcnt vmcnt(" #n ")" ::: "memory")
#define PG8_WAIT_L(n) asm volatile("s_waitcnt lgkmcnt(" #n ")" ::: "memory")
#define PG8_BAR __builtin_amdgcn_s_barrier()
#define PG8_SCHED __builtin_amdgcn_sched_barrier(0)
    Unit cur, nxt; int ui = 0;
    if (!S.next(0, cur)) return;
    f32x4 acc[2][2][4][2];
#pragma unroll
    for (int a = 0; a < 2; ++a)
#pragma unroll
        for (int b = 0; b < 2; ++b)
#pragma unroll
            for (int m = 0; m < 4; ++m)
#pragma unroll
                for (int n = 0; n < 2; ++n) acc[a][b][m][n] = (f32x4){0.f, 0.f, 0.f, 0.f};
    bf16x8 At[4][2], B0[2][2], B1[2][2];
    const char* cA = (const char*)g.A + (size_t)cur.pm * tstep; const char* cB = (const char*)g.Bt + (size_t)cur.pn * tstep;
    S.a_ready(cur);
    if constexpr (SP2) {
        PG8_STAGE(PG8_SB(0, 0), cB, voffB); PG8_STAGE(PG8_SB(0, 1), cB + hstep, voffB); PG8_STAGE(PG8_SA(0, 0), cA, voffA); PG8_STAGE(PG8_SA(0, 1), cA + hstep, voffA);
        if (wr == 1) PG8_BAR;
        PG8_WAIT_V(2); PG8_BAR;
        PG8_STAGE(PG8_SB(1, 0), cB + kstep, voffB); PG8_STAGE(PG8_SA(1, 0), cA + kstep, voffA); PG8_STAGE(PG8_SB(1, 1), cB + hstep + kstep, voffB);
        PG8_WAIT_V(6); PG8_BAR;
    } else {
        PG8_STAGE(PG8_SB(0, 0), cB, voffB); PG8_STAGE(PG8_SA(0, 0), cA, voffA); PG8_STAGE(PG8_SB(0, 1), cB + hstep, voffB); PG8_STAGE(PG8_SA(0, 1), cA + hstep, voffA);
        if (wr == 1) PG8_BAR;
        PG8_WAIT_V(4); PG8_BAR;
        PG8_STAGE(PG8_SB(1, 0), cB + kstep, voffB); PG8_STAGE(PG8_SA(1, 0), cA + kstep, voffA); PG8_STAGE(PG8_SB(1, 1), cB + hstep + kstep, voffB);
        PG8_WAIT_V(6); PG8_BAR;
    }
    for (;;) {
        const bool has_next = S.next(ui + 1, nxt);
        const char* nA = has_next ? (const char*)g.A + (size_t)nxt.pm * tstep : cA; const char* nB = has_next ? (const char*)g.Bt + (size_t)nxt.pn * tstep : cB;
        for (int t = 0; t < nt; t += 2) {
            const bool last = (t == nt - 2);
            const char* a1 = cA + (size_t)(t + 1) * kstep;
            const char* a2 = last ? nA : cA + (size_t)(t + 2) * kstep; const char* b2 = last ? nB : cB + (size_t)(t + 2) * kstep;
            const char* a3 = a2 + kstep; const char* b3 = b2 + kstep;
            if (last && has_next) S.a_ready(nxt);
            if constexpr (SP2) {
            PG8_LDB(B0, 0, 0); PG8_LDB(B1, 0, 1); PG8_SCHED; PG8_LDA(At, 0, 0); PG8_STAGE(PG8_SA(1, 1), a1 + hstep, voffA);
            PG8_WAIT_V(8); PG8_WAIT_L(0); PG8_BAR; PG8_MMA(0, 0, At, B0); PG8_MMA(0, 1, At, B1); PG8_BAR; PG8_SCHED;
            PG8_LDA(At, 0, 1); PG8_STAGE(PG8_SB(0, 0), b2, voffB); PG8_STAGE(PG8_SB(0, 1), b2 + hstep, voffB); PG8_STAGE(PG8_SA(0, 0), a2, voffA);
            PG8_WAIT_V(8); PG8_WAIT_L(0); PG8_BAR; PG8_MMA(1, 0, At, B0); PG8_MMA(1, 1, At, B1); PG8_BAR; PG8_SCHED;
            PG8_LDB(B0, 1, 0); PG8_LDB(B1, 1, 1); PG8_SCHED; PG8_LDA(At, 1, 0); PG8_STAGE(PG8_SA(0, 1), a2 + hstep, voffA);
            PG8_WAIT_V(8); PG8_WAIT_L(0); PG8_BAR; PG8_MMA(0, 0, At, B0); PG8_MMA(0, 1, At, B1); PG8_BAR; PG8_SCHED;
            PG8_LDA(At, 1, 1); PG8_STAGE(PG8_SB(1, 0), b3, voffB); PG8_STAGE(PG8_SB(1, 1), b3 + hstep, voffB); PG8_STAGE(PG8_SA(1, 0), a3, voffA);
            PG8_WAIT_V(8); PG8_WAIT_L(0); PG8_BAR; PG8_MMA(1, 0, At, B0); PG8_MMA(1, 1, At, B1); PG8_BAR; PG8_SCHED;
            } else {
            PG8_LDB(B0, 0, 0); PG8_SCHED; PG8_LDA(At, 0, 0); PG8_STAGE(PG8_SA(1, 1), a1 + hstep, voffA);
            PG8_WAIT_L(8); PG8_BAR; PG8_WAIT_L(0); PG8_MMA(0, 0, At, B0); PG8_BAR; PG8_SCHED;
            PG8_LDB(B1, 0, 1); PG8_STAGE(PG8_SB(0, 0), b2, voffB);
            PG8_BAR; PG8_WAIT_L(0); PG8_MMA(0, 1, At, B1); PG8_BAR;
            PG8_LDA(At, 0, 1); PG8_STAGE(PG8_SA(0, 0), a2, voffA);
            PG8_BAR; PG8_WAIT_L(0); PG8_MMA(1, 0, At, B0); PG8_BAR; PG8_SCHED;
            PG8_STAGE(PG8_SB(0, 1), b2 + hstep, voffB);
            PG8_WAIT_V(6); PG8_BAR; PG8_MMA(1, 1, At, B1); PG8_BAR;
            PG8_LDB(B0, 1, 0); PG8_SCHED; PG8_LDA(At, 1, 0); PG8_STAGE(PG8_SA(0, 1), a2 + hstep, voffA);
            PG8_WAIT_L(8); PG8_BAR; PG8_WAIT_L(0); PG8_MMA(0, 0, At, B0); PG8_BAR; PG8_SCHED;
            PG8_LDB(B1, 1, 1); PG8_STAGE(PG8_SB(1, 0), b3, voffB);
            PG8_BAR; PG8_WAIT_L(0); PG8_MMA(0, 1, At, B1); PG8_BAR;
            PG8_LDA(At, 1, 1); PG8_STAGE(PG8_SA(1, 0), a3, voffA);
            PG8_BAR; PG8_WAIT_L(0); PG8_MMA(1, 0, At, B0); PG8_BAR; PG8_SCHED;
            PG8_STAGE(PG8_SB(1, 1), b3 + hstep, voffB);
            PG8_WAIT_V(6); PG8_BAR; PG8_MMA(1, 1, At, B1); PG8_BAR;
            }
        }
        if constexpr (ALIGN_EPI) { if (wr == 0) PG8_BAR; }
        if constexpr (!Epi::AFTER_DRAIN) { E(acc, cur, wr, wc, fr, fq); S.done(cur); }
        if (!has_next) break;
#pragma unroll
        for (int a = 0; a < 2; ++a)
#pragma unroll
            for (int b = 0; b < 2; ++b)
#pragma unroll
                for (int m = 0; m < 4; ++m)
#pragma unroll
                    for (int n = 0; n < 2; ++n) acc[a][b][m][n] = (f32x4){0.f, 0.f, 0.f, 0.f};
        cur = nxt; cA = nA; cB = nB; ++ui;
        if constexpr (ALIGN_EPI) { if (wr == 1) PG8_BAR; }
    }
    PG8_WAIT_V(0);
    if constexpr (!ALIGN_EPI) { if (wr == 0) PG8_BAR; }
    PG8_BAR;
    if constexpr (Epi::AFTER_DRAIN) { E.fused(acc, cur, wr, wc, fr, fq, lds, wid, lane); S.done(cur); }
#undef PG8_SA
#undef PG8_SB
#undef PG8_STAGE
#undef PG8_LDA
#undef PG8_LDB
#undef PG8_MMA
#undef PG8_WAIT_V
#undef PG8_WAIT_L
#undef PG8_BAR
#undef PG8_SCHED
}
}


#ifndef PHMASK
#define PHMASK 63
#endif
#ifndef PROBE
#define PROBE 0
#endif
using pg8::bf16_t; using pg8::bf16x8; using pg8::f32x4; using pg8::u32x4;
typedef unsigned u32x2 __attribute__((ext_vector_type(2)));
typedef short s16x4 __attribute__((ext_vector_type(4)));
typedef float f32x2 __attribute__((ext_vector_type(2)));
#define LAS __attribute__((address_space(3)))
#define DI __device__ __forceinline__

#define XB_TMO      128
#define XB_XCNT(j)  (256  + 64 * (j))
#define XB_XSUB(j)  (1280 + 64 * (j))
#define XB_XGEN(j)  (2304 + 64 * (j))
#define XB_TOP      3328
#define XB_TOPGEN   3392
#define XCD_BAR_WORDS 3456
#define XB_SPIN_CAP (1u << 18)

__device__ __forceinline__ unsigned xb_ld(unsigned* p)              { return __hip_atomic_load(p, __ATOMIC_RELAXED, __HIP_MEMORY_SCOPE_AGENT); }
__device__ __forceinline__ unsigned xb_add(unsigned* p, unsigned v) { return __hip_atomic_fetch_add(p, v, __ATOMIC_RELAXED, __HIP_MEMORY_SCOPE_AGENT); }
__device__ __forceinline__ unsigned xb_xcc_id() { return (unsigned)__builtin_amdgcn_s_getreg((3 << 11) | 20) & 0xFu; }
#define XB_SPIN(cond, bar) do { unsigned _sp = 0; while (cond) { __builtin_amdgcn_s_sleep(1); \
    if ((++_sp & 255u) == 0u) { if (xb_ld(&(bar)[XB_TMO])) break; if (_sp > XB_SPIN_CAP) { atomicAdd(&(bar)[XB_TMO], 1u); break; } } } } while (0)

struct XcdBarrier {
    unsigned* bar; unsigned x;
    volatile LAS unsigned* st;
};

__device__ __forceinline__ XcdBarrier xcd_barrier_post(unsigned* bar, volatile LAS unsigned* st) {
    XcdBarrier b; b.bar = bar; b.x = xb_xcc_id(); b.st = st;
    if (threadIdx.x == 0) (void)xb_add(&bar[XB_XCNT(b.x)], 1u);
    return b;
}
__device__ __forceinline__ void xcd_barrier_complete(unsigned* bar, unsigned x, unsigned& nloc, unsigned& nx) {
    const unsigned G = gridDim.x * gridDim.y * gridDim.z;
    unsigned sum, cnt, mine, sp = 0u;
    for (;;) {
        sum = 0u; cnt = 0u; mine = 0u;
#pragma unroll
        for (unsigned j = 0; j < 16; ++j) { const unsigned c = xb_ld(&bar[XB_XCNT(j)]); sum += c; cnt += (c > 0u) ? 1u : 0u; mine = (j == x) ? c : mine; }
        if (sum == G) break;
        __builtin_amdgcn_s_sleep(1);
        if ((++sp & 255u) == 0u) { if (xb_ld(&bar[XB_TMO])) break; if (sp > XB_SPIN_CAP) { atomicAdd(&bar[XB_TMO], 1u); break; } }
    }
    nloc = mine > 0u ? mine : 1u; nx = cnt > 0u ? cnt : 1u;
}

__device__ __forceinline__ void xcd_barrier(const XcdBarrier& b) {
    asm volatile("s_waitcnt vmcnt(0)" ::: "memory");
    __syncthreads();
    if (threadIdx.x == 0) {
        unsigned* bar = b.bar;
        __builtin_amdgcn_s_waitcnt(0);
        unsigned nloc = b.st[0], nx = b.st[1];
        if (nloc == 0u) { xcd_barrier_complete(bar, b.x, nloc, nx); b.st[0] = nloc; b.st[1] = nx; }
        const unsigned old = xb_add(&bar[XB_XSUB(b.x)], 1u);
        const unsigned gen = old / nloc;
        if (old + 1u == (gen + 1u) * nloc) {
            __builtin_amdgcn_fence(__ATOMIC_RELEASE, "agent");
            asm volatile("s_waitcnt vmcnt(0)" ::: "memory");
            const unsigned og = xb_add(&bar[XB_TOP], 1u);
            const unsigned tg = og / nx;
            if (og + 1u == (tg + 1u) * nx) xb_add(&bar[XB_TOPGEN], 1u);
            else XB_SPIN(xb_ld(&bar[XB_TOPGEN]) == tg, bar);
            __builtin_amdgcn_fence(__ATOMIC_ACQUIRE, "agent");
            xb_add(&bar[XB_XGEN(b.x)], 1u);
            asm volatile("s_waitcnt vmcnt(0)" ::: "memory");
        } else {
            XB_SPIN(xb_ld(&bar[XB_XGEN(b.x)]) == gen, bar);
            __builtin_amdgcn_fence(__ATOMIC_ACQUIRE, "agent");
            asm volatile("s_waitcnt vmcnt(0)" ::: "memory");
        }
    }
    __syncthreads();
}


#define XB_LSUB(j)  (3456 + 64 * (j))
#define XB_LGEN(j)  (4480 + 64 * (j))
#define XB_CLS(j)   (5504 + 64 * (j))
#define XB_TSUB(k)  (6528 + 64 * (k))
#define XB_TGEN(k)  (10624 + 64 * (k))
#define XB_WORDS_ALL 14720
__device__ __forceinline__ void team_barrier(const XcdBarrier& b, bool acquire) {
    asm volatile("s_waitcnt vmcnt(0)" ::: "memory");
    __syncthreads();
    if (threadIdx.x == 0) {
        unsigned* bar = b.bar;
        __builtin_amdgcn_s_waitcnt(0);
        const unsigned team = (blockIdx.x & 7u) * 8u + ((blockIdx.x >> 3) & 7u);
        const unsigned old = xb_add(&bar[XB_TSUB(team)], 1u);
        const unsigned gen = old >> 2;
        if ((old & 3u) == 3u) xb_add(&bar[XB_TGEN(team)], 1u);
        else XB_SPIN(xb_ld(&bar[XB_TGEN(team)]) == gen, bar);
        if (acquire) {
            __builtin_amdgcn_fence(__ATOMIC_ACQUIRE, "agent");
            asm volatile("s_waitcnt vmcnt(0)" ::: "memory"); }
    }
    __syncthreads();
}

constexpr int D = 1024, DFF = 2816, GROWS = 32768, NTHR = 512;
constexpr int PRP = 2816;
constexpr int LDS_BYTES = 147456;
constexpr size_t MiB = 1u << 20, KiB = 1u << 10;
constexpr size_t WS_MODP = 0;
constexpr size_t WS_MOD = 6 * MiB;
constexpr size_t WS_BAR = 7 * MiB + 512 * KiB;
constexpr size_t WS_WSP = 8 * MiB;
constexpr size_t WS_WPT = WS_WSP + 256 * KiB;
constexpr size_t WS_WF = WS_WPT + 256 * KiB;
constexpr size_t WS_FC1 = WS_WF + 256 * KiB;
constexpr size_t WS_FS1 = WS_FC1 + 256 * KiB;
constexpr size_t WS_FC16 = WS_FS1 + 256 * KiB;
constexpr size_t WS_FS16 = WS_FC16 + 256 * KiB;
constexpr size_t WS_FC2 = WS_FS16 + 256 * KiB;
constexpr size_t WS_FS2 = WS_FC2 + 256 * KiB;
constexpr size_t WS_TW128 = WS_FS2 + 256 * KiB;
constexpr size_t WS_TW16 = WS_TW128 + 256 * KiB;
constexpr size_t WS_WUP = 16 * MiB;
constexpr size_t WS_WDN = 60 * MiB;
constexpr size_t WS_EVIN = 82 * MiB, WS_ODIN = 85 * MiB, WS_EVOUT = 89 * MiB, WS_ODOUT = 91 * MiB;
constexpr size_t WS_H = 96 * MiB;
constexpr size_t WS_T = 160 * MiB;
constexpr size_t WS_BIG = 224 * MiB;
constexpr size_t WS_UB = WS_BIG + 96 * MiB;
constexpr size_t WS_XH = 400 * MiB;
constexpr size_t WS_END = 464 * MiB;

typedef __bf16 nbf16x2 __attribute__((ext_vector_type(2)));
DI unsigned f2bf(float f) { return (unsigned)__builtin_bit_cast(unsigned short, (__bf16)f); }
DI unsigned pk2(float lo, float hi) { const f32x2 v = {lo, hi}; return __builtin_bit_cast(unsigned, __builtin_convertvector(v, nbf16x2)); }
DI float bf_lo(unsigned w) { return __uint_as_float(w << 16); }
DI float bf_hi(unsigned w) { return __uint_as_float(w & 0xffff0000u); }
template <int CTRL> DI float dpp_mov(float v) { return __builtin_bit_cast(float, __builtin_amdgcn_update_dpp(0, __builtin_bit_cast(int, v), CTRL, 0xF, 0xF, true)); }
DI float wave_sum(float v) {
    v += dpp_mov<0xB1>(v); v += dpp_mov<0x4E>(v); v += dpp_mov<0x141>(v); v += dpp_mov<0x140>(v);
    const int iv = __builtin_bit_cast(int, v);
    const float a = __builtin_bit_cast(float, __builtin_amdgcn_readlane(iv, 0)), b = __builtin_bit_cast(float, __builtin_amdgcn_readlane(iv, 16)),
                c = __builtin_bit_cast(float, __builtin_amdgcn_readlane(iv, 32)), d = __builtin_bit_cast(float, __builtin_amdgcn_readlane(iv, 48));
    return (a + b) + (c + d);
}
DI float silu_f(float x) { return x * __builtin_amdgcn_rcpf(1.0f + __builtin_amdgcn_exp2f(-1.4426950408889634f * x)); }
DI f32x4 mfma16(bf16x8 a, bf16x8 b, f32x4 c) { return __builtin_amdgcn_mfma_f32_16x16x32_bf16(a, b, c, 0, 0, 0); }
typedef short v4i16_t __attribute__((ext_vector_type(4)));
DI s16x4 tr_read(LAS unsigned char* p) { return __builtin_bit_cast(s16x4, __builtin_amdgcn_ds_read_tr16_b64_v4i16((LAS v4i16_t*)p)); }
DI bf16x8 tr_frag(LAS unsigned char* p, int pitch4) {
    const s16x4 lo = tr_read(p), hi = tr_read(p + pitch4);
    bf16x8 r; r[0] = lo[0]; r[1] = lo[1]; r[2] = lo[2]; r[3] = lo[3]; r[4] = hi[0]; r[5] = hi[1]; r[6] = hi[2]; r[7] = hi[3]; return r;
}

DI void st16_wt(void* p, u32x4 v) { *(u32x4*)p = v; }
struct Params { const float* in[25]; float* out; unsigned char* ws; int ph_lo, ph_hi; };

struct EpiGen {
    static constexpr bool PERM = true, AFTER_DRAIN = false;
    bf16_t* O; int ldc; int mode;
    __device__ __forceinline__ void operator()(const f32x4 (&acc)[2][2][4][2], const pg8::Unit& u, int wr, int wc, int fr, int fq) const {
        const int row0 = u.pm * 256 + wr * 64 + fr, cw = wc * 32 + 8 * fq;
        if (mode == 3) {
#pragma unroll
            for (int ai = 0; ai < 2; ++ai)
#pragma unroll
                for (int m = 0; m < 4; ++m) {
                    bf16_t* rowp = O + (size_t)(row0 + ai * 128 + m * 16) * ldc + 128 * u.pn + cw;
                    f32x4 g0 = acc[ai][0][m][0], g1 = acc[ai][0][m][1]; const f32x4 u0 = acc[ai][1][m][0], u1 = acc[ai][1][m][1];
#pragma unroll
                    for (int j = 0; j < 4; ++j) { g0[j] = silu_f(g0[j]); g1[j] = silu_f(g1[j]); }
                    const f32x4 v0 = g0 * u0, v1 = g1 * u1;
                    u32x4 w; w.x = pg8::cvt_pk_bf16(v0[0], v0[1]); w.y = pg8::cvt_pk_bf16(v0[2], v0[3]); w.z = pg8::cvt_pk_bf16(v1[0], v1[1]); w.w = pg8::cvt_pk_bf16(v1[2], v1[3]);
                    st16_wt(rowp, w);
                }
        } else if (mode == 2 && u.pn < 4) {
#pragma unroll
            for (int ai = 0; ai < 2; ++ai)
#pragma unroll
                for (int m = 0; m < 4; ++m) {
                    bf16_t* rowp = O + (size_t)(row0 + ai * 128 + m * 16) * ldc + 128 * u.pn + cw;
                    const f32x4 v0 = acc[ai][0][m][0] * acc[ai][1][m][0], v1 = acc[ai][0][m][1] * acc[ai][1][m][1];
                    u32x4 w; w.x = pg8::cvt_pk_bf16(v0[0], v0[1]); w.y = pg8::cvt_pk_bf16(v0[2], v0[3]); w.z = pg8::cvt_pk_bf16(v1[0], v1[1]); w.w = pg8::cvt_pk_bf16(v1[2], v1[3]);
                    st16_wt(rowp, w);
                }
        } else {
            const int colbase = (mode == 2) ? 512 + 256 * (u.pn - 4) : 256 * u.pn;
            if (mode == 1 && u.pn < 4) {
#pragma unroll
                for (int ai = 0; ai < 2; ++ai)
#pragma unroll
                    for (int m = 0; m < 4; ++m) {
                        bf16_t* rowp = O + (size_t)(row0 + ai * 128 + m * 16) * ldc + colbase + cw;
#pragma unroll
                        for (int bj = 0; bj < 2; ++bj) {
                            f32x4 v0 = acc[ai][bj][m][0], v1 = acc[ai][bj][m][1];
                            const pg8::f32x2 a = pg8::gelu_pk((pg8::f32x2){v0[0], v0[1]}), b = pg8::gelu_pk((pg8::f32x2){v0[2], v0[3]}), c = pg8::gelu_pk((pg8::f32x2){v1[0], v1[1]}), d = pg8::gelu_pk((pg8::f32x2){v1[2], v1[3]});
                            u32x4 w; w.x = pg8::cvt_pk_bf16(a.x, a.y); w.y = pg8::cvt_pk_bf16(b.x, b.y); w.z = pg8::cvt_pk_bf16(c.x, c.y); w.w = pg8::cvt_pk_bf16(d.x, d.y);
                            st16_wt(rowp + bj * 128, w);
                        }
                    }
            } else {
#pragma unroll
                for (int ai = 0; ai < 2; ++ai)
#pragma unroll
                    for (int m = 0; m < 4; ++m) {
                        bf16_t* rowp = O + (size_t)(row0 + ai * 128 + m * 16) * ldc + colbase + cw;
#pragma unroll
                        for (int bj = 0; bj < 2; ++bj) {
                            const f32x4 v0 = acc[ai][bj][m][0], v1 = acc[ai][bj][m][1];
                            u32x4 w; w.x = pg8::cvt_pk_bf16(v0[0], v0[1]); w.y = pg8::cvt_pk_bf16(v0[2], v0[3]); w.z = pg8::cvt_pk_bf16(v1[0], v1[1]); w.w = pg8::cvt_pk_bf16(v1[2], v1[3]);
                            st16_wt(rowp + bj * 128, w);
                        }
                    }
            }
        }
    }
};

DI void run_gemm(LAS unsigned char* lds, const bf16_t* A, const bf16_t* Bt, int M, int N, int K, bf16_t* O, int ldc, int mode, int G) {
#if PHMASK & 4
#ifndef STAG
#define STAG 0
#endif
    if (STAG && mode != 0) {
        const int d = ((int)blockIdx.x >> 3) & 3;
        for (int i = 0; i < d * STAG; ++i) __builtin_amdgcn_s_sleep(64);
    }
    pg8::Gemm g{A, Bt, M, N, K}; pg8::StaticOrder S; S.init(M, N, G, (int)blockIdx.x);
    EpiGen E{O, ldc, mode};
#ifndef G_ALIGN
#define G_ALIGN true
#endif
#ifndef G_SP2
#define G_SP2 true
#endif
    pg8::gemm_phase<EpiGen, pg8::StaticOrder, G_ALIGN, G_SP2>(lds, g, S, E);
#endif
}

DI int dest_row(int n0, int mode) {
    if (mode == 1) { const int half = n0 >= DFF ? 1 : 0, n = n0 - half * DFF; return 256 * (n >> 7) + 128 * half + (n & 127); }
    if (mode == 2) { if (n0 < 512) return 256 * (n0 >> 7) + (n0 & 127); if (n0 < 1024) return 1024 + (n0 - 512); if (n0 < 1536) { const int n = n0 - 1024; return 256 * (n >> 7) + 128 + (n & 127); } return n0; }
    return n0;
}
DI void transpose_item(const float* W, int K, int N, bf16_t* WT, int mode, LAS float* scr, int item, int lane) {
    const int nblk = N / 32, kb = item / nblk, nb = item % nblk, k0 = 64 * kb, n0 = 32 * nb;
#pragma unroll
    for (int i = 0; i < 32; ++i) { const int kk = 2 * i + (lane >> 5); scr[kk * 33 + (lane & 31)] = __builtin_nontemporal_load(W + (size_t)(k0 + kk) * N + n0 + (lane & 31)); }
    asm volatile("s_waitcnt lgkmcnt(0)" ::: "memory");
    const int c = lane & 7, dr = dest_row(n0, mode);
#pragma unroll
    for (int j = 0; j < 4; ++j) { const int n = (lane >> 3) + 8 * j; const LAS float* s = scr + (8 * c) * 33 + n;
        u32x4 o; o.x = pk2(s[0 * 33], s[1 * 33]); o.y = pk2(s[2 * 33], s[3 * 33]); o.z = pk2(s[4 * 33], s[5 * 33]); o.w = pk2(s[6 * 33], s[7 * 33]);
        *(u32x4*)(WT + (size_t)(dr + n) * K + k0 + 8 * c) = o; }
    asm volatile("s_waitcnt lgkmcnt(0)" ::: "memory");
}

DI void setup_phase(const Params& p, LAS unsigned char* lds, int G, int tid, int wid, int lane) {
    unsigned char* ws = p.ws;
    {
        LAS float* sc = (LAS float*)lds;
        LAS float* red = sc + 18 * 1024;
        for (int i = tid; i < 18 * 1024; i += NTHR) { const int b = i >> 10, k = i & 1023;
            const float c = (b < 2) ? p.in[2][b * 1024 + k] : p.in[3][(b - 2) * 1024 + k]; sc[i] = silu_f(c); }
        __syncthreads();
        for (int u = blockIdx.x; u < 144; u += G) {
            const int l = u / 72, cb = u % 72, col = cb * 128 + 2 * lane;
            float acc0[18], acc1[18];
#pragma unroll
            for (int b = 0; b < 18; ++b) { acc0[b] = 0.f; acc1[b] = 0.f; }
            const float* wp = p.in[4] + ((size_t)l * 1024 + wid * 128) * 9216 + col;
            const LAS f32x4* sc4 = (const LAS f32x4*)sc + wid * 32;
#pragma unroll 4
            for (int k4 = 0; k4 < 32; ++k4) {
                const f32x2 w0 = __builtin_nontemporal_load((const f32x2*)(wp + (size_t)(4 * k4) * 9216)), w1 = __builtin_nontemporal_load((const f32x2*)(wp + (size_t)(4 * k4 + 1) * 9216)),
                            w2 = __builtin_nontemporal_load((const f32x2*)(wp + (size_t)(4 * k4 + 2) * 9216)), w3 = __builtin_nontemporal_load((const f32x2*)(wp + (size_t)(4 * k4 + 3) * 9216));
#pragma unroll
                for (int b = 0; b < 18; ++b) { const f32x4 sv = sc4[b * 256 + k4];
                    acc0[b] += (sv[0] * w0.x + sv[1] * w1.x) + (sv[2] * w2.x + sv[3] * w3.x); acc1[b] += (sv[0] * w0.y + sv[1] * w1.y) + (sv[2] * w2.y + sv[3] * w3.y); }
            }
#pragma unroll
            for (int par = 0; par < 2; ++par) {
#pragma unroll
                for (int b = 0; b < 18; ++b) red[(wid * 18 + b) * 64 + lane] = par ? acc1[b] : acc0[b];
                __syncthreads();
                for (int i = tid; i < 18 * 64; i += NTHR) { const int b = i >> 6, c = i & 63, cc = cb * 128 + 2 * c + par; float sm = p.in[5][l * 9216 + cc];
#pragma unroll
                    for (int w = 0; w < 8; ++w) sm += red[(w * 18 + b) * 64 + c];
                    ((float*)(ws + WS_MOD))[((size_t)l * 18 + b) * 9216 + cc] = sm; }
                __syncthreads();
            }
        }
    }
    {
        LAS float* scr = (LAS float*)(lds + wid * 16384);
        constexpr int I_UP = 16 * 176, I_DN = 44 * 32, I_EI = 16 * 48, I_OI = 16 * 64, I_O = 16 * 32;
        constexpr int NITEMS = 4 * I_UP + 4 * I_DN + I_EI + I_OI + 2 * I_O;
        int it0 = (int)blockIdx.x * 8 + wid, stride = G * 8, lim = NITEMS;
        if (G == 256) { if (blockIdx.x < 144) { stride = 144 * 8; lim = 5 * 144 * 8; } else { it0 = 5 * 144 * 8 + ((int)blockIdx.x - 144) * 8 + wid; stride = 112 * 8; } }
        for (int it = it0; it < lim; it += stride) {
            int r = it;
            if (r < 4 * I_UP) { const int i = r / I_UP; r -= i * I_UP; const int l = i >> 1, f = i & 1;
                transpose_item(p.in[f ? 10 : 8] + (size_t)l * 1024 * 5632, 1024, 5632, (bf16_t*)(ws + WS_WUP) + (size_t)i * 5632 * 1024, 1, scr, r, lane); continue; }
            r -= 4 * I_UP;
            if (r < 4 * I_DN) { const int i = r / I_DN; r -= i * I_DN; const int l = i >> 1, f = i & 1;
                transpose_item(p.in[f ? 11 : 9] + (size_t)l * 2816 * 1024, 2816, 1024, (bf16_t*)(ws + WS_WDN) + (size_t)i * 1024 * 2816, 0, scr, r, lane); continue; }
            r -= 4 * I_DN;
            if (r < I_EI) { transpose_item(p.in[12], 1024, 1536, (bf16_t*)(ws + WS_EVIN), 0, scr, r, lane); continue; }
            r -= I_EI;
            if (r < I_OI) { transpose_item(p.in[20], 1024, 2048, (bf16_t*)(ws + WS_ODIN), 2, scr, r, lane); continue; }
            r -= I_OI;
            if (r < I_O) { transpose_item(p.in[19], 1024, 1024, (bf16_t*)(ws + WS_EVOUT), 0, scr, r, lane); continue; }
            r -= I_O;
            transpose_item(p.in[24], 1024, 1024, (bf16_t*)(ws + WS_ODOUT), 0, scr, r, lane);
        }
    }
    {
        const int gt = blockIdx.x * NTHR + tid, NT = G * NTHR;
        bf16_t* WSP = (bf16_t*)(ws + WS_WSP); bf16_t* WPT = (bf16_t*)(ws + WS_WPT); bf16_t* WF = (bf16_t*)(ws + WS_WF);
        for (int i = gt; i < 65536; i += NT) {
            WSP[i] = (bf16_t)f2bf(p.in[15][i]);
            const int g = i >> 14, e = (i >> 7) & 127, d = i & 127;
            WPT[i] = (bf16_t)f2bf(p.in[17][(g * 128 + d) * 128 + e]);
        }
        {
            LAS float* tab = (LAS float*)(lds + 132 * 1024);
            if (tid < 128) { const float x = (float)tid * (1.0f / 64.0f); tab[tid] = cospif(x); tab[128 + tid] = sinpif(x); }
            __syncthreads();
            for (int i = gt; i < 131072; i += NT) {
                const int g = i >> 15, n = (i >> 7) & 255, d = i & 127, comp = n >> 7, e = n & 127;
                const float* fw = p.in[23] + (size_t)g * 16384 + e; const LAS float* tb = tab + comp * 128; float sm = 0.f;
#pragma unroll 8
                for (int m = 0; m < 128; ++m) sm += tb[(m * d) & 127] * fw[m * 128];
                WF[i] = (bf16_t)f2bf(sm * p.in[22][g * 128 + d]);
            }
        }
        bf16_t* FC1 = (bf16_t*)(ws + WS_FC1); bf16_t* FS1 = (bf16_t*)(ws + WS_FS1); bf16_t* FC2 = (bf16_t*)(ws + WS_FC2); bf16_t* FS2 = (bf16_t*)(ws + WS_FS2);
        f32x2* TW128 = (f32x2*)(ws + WS_TW128);
        for (int i = gt; i < 16384; i += NT) {
            const int k1 = i >> 7, col = i & 127, s = col >> 5, j = col & 31, fqq = j >> 3, ii = j & 7;
            const int r = 32 * s + (ii < 4 ? fqq * 4 + ii : 16 + fqq * 4 + ii - 4);
            const float x = (float)((k1 * r) & 127) * (1.0f / 64.0f);
            FC1[i] = (bf16_t)f2bf(cospif(x)); FS1[i] = (bf16_t)f2bf(sinpif(x));
            const float y = (float)((k1 * col) & 127) * (1.0f / 64.0f);
            FC2[i] = (bf16_t)f2bf(cospif(y)); FS2[i] = (bf16_t)f2bf(sinpif(y));
            const float z = (float)(k1 * col) * (1.0f / 8192.0f);
            TW128[i] = (f32x2){cospif(z), sinpif(z)};
        }
        bf16_t* FC16 = (bf16_t*)(ws + WS_FC16); bf16_t* FS16 = (bf16_t*)(ws + WS_FS16);
        for (int i = gt; i < 512; i += NT) {
            const int k1 = i >> 5, j = i & 31, fqq = j >> 3, ii = j & 7;
            float c = 0.f, s = 0.f;
            if (ii < 4) { const int r = fqq * 4 + ii; const float x = (float)((k1 * r) & 15) * (1.0f / 8.0f); c = cospif(x); s = sinpif(x); }
            FC16[i] = (bf16_t)f2bf(c); FS16[i] = (bf16_t)f2bf(s);
        }
        f32x2* TW16 = (f32x2*)(ws + WS_TW16);
        for (int i = gt; i < 2048; i += NT) { const int q = i >> 4, k1 = i & 15; const float z = (float)(k1 * q) * (1.0f / 1024.0f); TW16[i] = (f32x2){cospif(z), sinpif(z)}; }
    }
}

DI void modreduce_phase(const Params& p, int G, int tid) {
    const float* mp = (const float*)(p.ws + WS_MODP); float* mod = (float*)(p.ws + WS_MOD);
    for (int i = blockIdx.x * NTHR + tid; i < 2 * 18 * 9216; i += G * NTHR) {
        const int l = i / (18 * 9216), j = i % 9216;
        float s = p.in[5][l * 9216 + j];
#pragma unroll
        for (int ks = 0; ks < 4; ++ks) s += mp[(size_t)ks * (2 * 18 * 9216) + i];
        mod[i] = s;
    }
}

typedef _Float16 h16x4 __attribute__((ext_vector_type(4)));
typedef _Float16 h16x8 __attribute__((ext_vector_type(8)));
template <bool IN32, bool PREV, bool NEXT, bool OUT32>
DI void norm_phase_t(const float* xin32, const _Float16* xin16, float* xout32, _Float16* xout16, const bf16_t* T, bf16_t* H,
                     const float* gate_base, const float* gpost, float rw, const float* ss_base, const float* gpre, int gi, int G, int wid, int lane) {
    const bool teamed = (G == 256);
    const int bx = (int)blockIdx.x & 7, bj = (int)blockIdx.x >> 3;
    const int nh = teamed ? 2 : (GROWS + G * 8 - 1) / (G * 8), rows_h = teamed ? 8 : 1;
    for (int hh = 0; hh < nh; ++hh) {
        const int r0 = teamed ? 256 * (16 * bx + 8 * hh + (bj & 7)) + 64 * (bj >> 3) + wid : (int)blockIdx.x * 8 + wid + hh * G * 8;
        if (r0 >= GROWS) break;
        const int bidx = (gi == 0) ? (r0 >> 14) : 2 + (r0 >> 11);
        f32x4 gpv[4], gtv[4], shv[4], scv[4], gnv[4];
        if (PREV) { const f32x4* gp = (const f32x4*)gpost + 2 * lane; const f32x4* gt = (const f32x4*)(gate_base + (size_t)bidx * 9216) + 2 * lane;
#pragma unroll
            for (int j = 0; j < 4; ++j) { const int o = 128 * (j >> 1) + (j & 1); gpv[j] = gp[o] * rw; gtv[j] = gt[o] + 1.0f; gpv[j] = gpv[j] * gtv[j]; } }
        if (NEXT) { const f32x4* gp = (const f32x4*)gpre + 2 * lane; const f32x4* sh = (const f32x4*)(ss_base + (size_t)bidx * 9216) + 2 * lane; const f32x4* sc = sh + 256;
#pragma unroll
            for (int j = 0; j < 4; ++j) { const int o = 128 * (j >> 1) + (j & 1); gnv[j] = gp[o] * (sc[o] + 1.0f); shv[j] = sh[o]; } }
#pragma unroll 2
        for (int i = 0; i < rows_h; ++i) {
            const int r = r0 + 8 * i;
            f32x4 v[4]; u32x4 tw[2];
            if (IN32) { const f32x4* xr = (const f32x4*)(xin32 + (size_t)r * D) + 2 * lane;
#pragma unroll
                for (int j = 0; j < 2; ++j) { v[2 * j] = xr[128 * j]; v[2 * j + 1] = xr[128 * j + 1]; } }
            else { const h16x8* xr = (const h16x8*)(xin16 + (size_t)r * D) + lane; h16x8 hv[2];
#pragma unroll
                for (int j = 0; j < 2; ++j) hv[j] = __builtin_nontemporal_load(xr + 64 * j);
                if (PREV) { const u32x4* tr = (const u32x4*)(T + (size_t)r * D) + lane;
#pragma unroll
                    for (int j = 0; j < 2; ++j) tw[j] = __builtin_nontemporal_load(tr + 64 * j); }
#pragma unroll
                for (int j = 0; j < 2; ++j) { v[2 * j] = (f32x4){(float)hv[j][0], (float)hv[j][1], (float)hv[j][2], (float)hv[j][3]}; v[2 * j + 1] = (f32x4){(float)hv[j][4], (float)hv[j][5], (float)hv[j][6], (float)hv[j][7]}; } }
            if (PREV) {
                if (IN32) { const u32x4* tr = (const u32x4*)(T + (size_t)r * D) + lane;
#pragma unroll
                    for (int j = 0; j < 2; ++j) tw[j] = __builtin_nontemporal_load(tr + 64 * j); }
                f32x4 tv[4]; float ss = 0.f;
#pragma unroll
                for (int j = 0; j < 2; ++j) { const u32x4 w = tw[j];
                    tv[2 * j] = (f32x4){bf_lo(w.x), bf_hi(w.x), bf_lo(w.y), bf_hi(w.y)}; tv[2 * j + 1] = (f32x4){bf_lo(w.z), bf_hi(w.z), bf_lo(w.w), bf_hi(w.w)}; }
#pragma unroll
                for (int j = 0; j < 4; ++j) ss += (tv[j][0] * tv[j][0] + tv[j][1] * tv[j][1]) + (tv[j][2] * tv[j][2] + tv[j][3] * tv[j][3]);
                const float rstd = rsqrtf(wave_sum(ss) * (1.0f / D) + 1e-6f);
#pragma unroll
                for (int j = 0; j < 4; ++j) v[j] = v[j] + (tv[j] * rstd) * gpv[j];
                if (OUT32) { f32x4* xo = (f32x4*)(xout32 + (size_t)r * D) + 2 * lane;
#pragma unroll
                    for (int j = 0; j < 4; ++j) __builtin_nontemporal_store(v[j], xo + 128 * (j >> 1) + (j & 1)); }
                else { h16x8* xo = (h16x8*)(xout16 + (size_t)r * D) + lane;
#pragma unroll
                    for (int j = 0; j < 2; ++j) { h16x8 hv;
#pragma unroll
                        for (int k = 0; k < 4; ++k) { hv[k] = (_Float16)v[2 * j][k]; hv[4 + k] = (_Float16)v[2 * j + 1][k]; }
                        __builtin_nontemporal_store(hv, xo + 64 * j);
#pragma unroll
                        for (int k = 0; k < 4; ++k) { v[2 * j][k] = (float)hv[k]; v[2 * j + 1][k] = (float)hv[4 + k]; } } }
            }
            if (NEXT) {
                float ss = 0.f;
#pragma unroll
                for (int j = 0; j < 4; ++j) ss += (v[j][0] * v[j][0] + v[j][1] * v[j][1]) + (v[j][2] * v[j][2] + v[j][3] * v[j][3]);
                const float rstd = rsqrtf(wave_sum(ss) * (1.0f / D) + 1e-6f);
                u32x4* ho = (u32x4*)(H + (size_t)r * D) + lane;
#pragma unroll
                for (int j = 0; j < 2; ++j) { const f32x4 h0 = (v[2 * j] * rstd) * gnv[2 * j] + shv[2 * j], h1 = (v[2 * j + 1] * rstd) * gnv[2 * j + 1] + shv[2 * j + 1];
                    u32x4 w; w.x = pk2(h0[0], h0[1]); w.y = pk2(h0[2], h0[3]); w.z = pk2(h1[0], h1[1]); w.w = pk2(h1[2], h1[3]); st16_wt(ho + 64 * j, w); }
            }
        }
    }
}
DI void norm_phase(const float* xin32, const _Float16* xin16, float* xout32, _Float16* xout16, const bf16_t* T, bf16_t* H, bool has_prev, bool has_next,
                   const float* gate_base, const float* gpost, float rw, const float* ss_base, const float* gpre, int gi, int G, int wid, int lane) {
    if (!has_prev)        norm_phase_t<true, false, true, false>(xin32, xin16, xout32, xout16, T, H, gate_base, gpost, rw, ss_base, gpre, gi, G, wid, lane);
    else if (xin32)       norm_phase_t<true, true, true, false>(xin32, xin16, xout32, xout16, T, H, gate_base, gpost, rw, ss_base, gpre, gi, G, wid, lane);
    else if (has_next)    norm_phase_t<false, true, true, false>(xin32, xin16, xout32, xout16, T, H, gate_base, gpost, rw, ss_base, gpre, gi, G, wid, lane);
    else                  norm_phase_t<false, true, false, true>(xin32, xin16, xout32, xout16, T, H, gate_base, gpost, rw, ss_base, gpre, gi, G, wid, lane);
}

template <int GI>
DI void pool_group(const bf16_t* PR, bf16_t* YY, const bf16_t* WPT, const float* pool_scale, size_t tok0, int tl, int pos, int S, int fr, int fq) {
    constexpr int hw = 1 << GI, g = GI;
    const int lo = max(pos - hw, 0), hi = min(pos + hw, S); const float inv = 1.0f / (float)(hi - lo);
    f32x4 acc[8];
#pragma unroll
    for (int e = 0; e < 8; ++e) acc[e] = (f32x4){0.f, 0.f, 0.f, 0.f};
#pragma unroll 1
    for (int ks = 0; ks < 4; ++ks) {
        const bf16_t* zc = PR + (tok0 + tl) * PRP + 1024 + g * 128 + ks * 32 + fq * 8;
        u32x4 w[2 * hw];
#pragma unroll
        for (int j = 0; j < 2 * hw; ++j) { const int t2 = pos + j - hw; const bool ok = (t2 >= 0) && (t2 < S); w[j] = (u32x4){0u, 0u, 0u, 0u}; if (ok) w[j] = *(const u32x4*)(zc + (ptrdiff_t)(j - hw) * PRP); }
        bf16x8 wf[8];
#pragma unroll
        for (int et = 0; et < 8; ++et) wf[et] = *(const bf16x8*)(WPT + ((g * 128 + et * 16 + fr) * 128 + ks * 32 + fq * 8));
        f32x4 s0 = (f32x4){0.f, 0.f, 0.f, 0.f}, s1 = s0;
#pragma unroll
        for (int j = 0; j < 2 * hw; ++j) { s0 += (f32x4){bf_lo(w[j].x), bf_hi(w[j].x), bf_lo(w[j].y), bf_hi(w[j].y)}; s1 += (f32x4){bf_lo(w[j].z), bf_hi(w[j].z), bf_lo(w[j].w), bf_hi(w[j].w)}; }
        const u32x4 cw = w[hw];
        s0 = s0 * inv - (f32x4){bf_lo(cw.x), bf_hi(cw.x), bf_lo(cw.y), bf_hi(cw.y)}; s1 = s1 * inv - (f32x4){bf_lo(cw.z), bf_hi(cw.z), bf_lo(cw.w), bf_hi(cw.w)};
        u32x4 dw; dw.x = pk2(s0[0], s0[1]); dw.y = pk2(s0[2], s0[3]); dw.z = pk2(s1[0], s1[1]); dw.w = pk2(s1[2], s1[3]);
        const bf16x8 df = __builtin_bit_cast(bf16x8, dw);
#pragma unroll
        for (int et = 0; et < 8; ++et) acc[et] = mfma16(wf[et], df, acc[et]);
    }
#pragma unroll
    for (int et = 0; et < 8; ++et) { const int e = g * 128 + et * 16 + fq * 4; const f32x4 ps = *(const f32x4*)(pool_scale + e); const f32x4 y = acc[et] * ps;
        u32x2 o; o.x = pk2(y[0], y[1]); o.y = pk2(y[2], y[3]); *(u32x2*)(YY + (tok0 + tl) * 1024 + 512 + e) = o; }
}

constexpr int PL_ZOFF = 0, PL_WOFF = 144 * 272, PL_PITCH = 272;
struct PoolStage { u32x4 z[5]; u32x4 w[4]; };
DI void pool_stage_load(PoolStage& ps, const bf16_t* PR, const bf16_t* WPT, size_t tok0, int pos0, int S, int g, int tid) {
#pragma unroll
    for (int i = 0; i < 5; ++i) { const int idx = tid + NTHR * i, row = idx >> 4, c = idx & 15; const int p = pos0 - 8 + row;
        ps.z[i] = (u32x4){0u, 0u, 0u, 0u};
        if (idx < 144 * 16 && p >= 0 && p < S) ps.z[i] = *(const u32x4*)(PR + (size_t)((ptrdiff_t)tok0 - 8 + row) * PRP + 1024 + g * 128 + c * 8); }
#pragma unroll
    for (int i = 0; i < 4; ++i) { const int idx = tid + NTHR * i; ps.w[i] = *(const u32x4*)(WPT + (g * 128 + (idx >> 4)) * 128 + (idx & 15) * 8); }
}
DI void pool_stage_store(const PoolStage& ps, LAS unsigned char* lds, int tid) {
#pragma unroll
    for (int i = 0; i < 5; ++i) { const int idx = tid + NTHR * i; if (idx < 144 * 16) *(LAS u32x4*)(lds + PL_ZOFF + (idx >> 4) * PL_PITCH + (idx & 15) * 16) = ps.z[i]; }
#pragma unroll
    for (int i = 0; i < 4; ++i) { const int idx = tid + NTHR * i; *(LAS u32x4*)(lds + PL_WOFF + (idx >> 4) * PL_PITCH + (idx & 15) * 16) = ps.w[i]; }
}
template <int GI>
DI void pool_compute(LAS unsigned char* lds, bf16_t* YY, const float* pool_scale, size_t tok0, int tl, int pos, int S, int fr, int fq) {
    constexpr int hw = 1 << GI, g = GI;
    const int lo = max(pos - hw, 0), hi = min(pos + hw, S); const float inv = 1.0f / (float)(hi - lo);
    f32x4 acc[8];
#pragma unroll
    for (int e = 0; e < 8; ++e) acc[e] = (f32x4){0.f, 0.f, 0.f, 0.f};
#pragma unroll 2
    for (int ks = 0; ks < 4; ++ks) {
        const LAS unsigned char* zb = lds + PL_ZOFF + (tl + 8) * PL_PITCH + (ks * 32 + fq * 8) * 2;
        f32x4 s0 = (f32x4){0.f, 0.f, 0.f, 0.f}, s1 = s0;
#pragma unroll
        for (int j = -hw; j < hw; ++j) { const u32x4 x = *(const LAS u32x4*)(zb + j * PL_PITCH);
            s0 += (f32x4){bf_lo(x.x), bf_hi(x.x), bf_lo(x.y), bf_hi(x.y)}; s1 += (f32x4){bf_lo(x.z), bf_hi(x.z), bf_lo(x.w), bf_hi(x.w)}; }
        const u32x4 cw = *(const LAS u32x4*)zb;
        s0 = s0 * inv - (f32x4){bf_lo(cw.x), bf_hi(cw.x), bf_lo(cw.y), bf_hi(cw.y)}; s1 = s1 * inv - (f32x4){bf_lo(cw.z), bf_hi(cw.z), bf_lo(cw.w), bf_hi(cw.w)};
        u32x4 dw; dw.x = pk2(s0[0], s0[1]); dw.y = pk2(s0[2], s0[3]); dw.z = pk2(s1[0], s1[1]); dw.w = pk2(s1[2], s1[3]);
        const bf16x8 df = __builtin_bit_cast(bf16x8, dw);
#pragma unroll
        for (int et = 0; et < 8; ++et) { const bf16x8 wf = *(const LAS bf16x8*)(lds + PL_WOFF + (et * 16 + fr) * PL_PITCH + (ks * 32 + fq * 8) * 2); acc[et] = mfma16(wf, df, acc[et]); }
    }
#pragma unroll
    for (int et = 0; et < 8; ++et) { const int e = g * 128 + et * 16 + fq * 4; const f32x4 ps = *(const f32x4*)(pool_scale + e); const f32x4 y = acc[et] * ps;
        u32x2 o; o.x = pk2(y[0], y[1]); o.y = pk2(y[2], y[3]); *(u32x2*)(YY + (tok0 + tl) * 1024 + 512 + e) = o; }
}

DI void even_core(LAS unsigned char* lds, const bf16_t* PR, bf16_t* YY, const bf16_t* WSP, const bf16_t* WPT, const float* ln_g, const float* ln_b,
                  const float* b_sp, const float* pool_scale, int S, int G, int tid, int wid, int lane) {
    const int fr = lane & 15, fq = lane >> 4;
    constexpr int PITCH = 1056;
    for (int ch0 = blockIdx.x; ch0 < GROWS / 128; ch0 += G) {
        const int ch = (G == 256) ? 2 * (16 * (ch0 & 7) + 8 * (ch0 >> 7) + ((ch0 >> 3) & 7)) + ((ch0 >> 6) & 1) : ch0;
        const size_t tok0 = (size_t)ch * 128;
        {
            const f32x4 g0 = *(const f32x4*)(ln_g + lane * 8), g1 = *(const f32x4*)(ln_g + lane * 8 + 4), b0 = *(const f32x4*)(ln_b + lane * 8), b1 = *(const f32x4*)(ln_b + lane * 8 + 4);
#pragma unroll 8
            for (int i = 0; i < 16; ++i) {
                const int q = wid * 16 + i;
                const u32x4 w = *(const u32x4*)(PR + (tok0 + q) * PRP + 512 + lane * 8);
                f32x4 a = (f32x4){bf_lo(w.x), bf_hi(w.x), bf_lo(w.y), bf_hi(w.y)}, b = (f32x4){bf_lo(w.z), bf_hi(w.z), bf_lo(w.w), bf_hi(w.w)};
                const float mean = wave_sum((a[0] + a[1]) + (a[2] + a[3]) + (b[0] + b[1]) + (b[2] + b[3])) * (1.0f / 512.0f);
                a = a - mean; b = b - mean;
                const float var = wave_sum((a[0] * a[0] + a[1] * a[1]) + (a[2] * a[2] + a[3] * a[3]) + (b[0] * b[0] + b[1] * b[1]) + (b[2] * b[2] + b[3] * b[3])) * (1.0f / 512.0f);
                const float rstd = rsqrtf(var + 1e-5f);
                a = a * rstd * g0 + b0; b = b * rstd * g1 + b1;
                u32x4 o; o.x = pk2(a[0], a[1]); o.y = pk2(a[2], a[3]); o.z = pk2(b[0], b[1]); o.w = pk2(b[2], b[3]);
                *(LAS u32x4*)(lds + q * PITCH + lane * 16) = o;
            }
        }
        __syncthreads();
        {
            const int h = wid >> 1, cw0 = wid * 64;
            for (int ph = 0; ph < 2; ++ph) {
                f32x4 acc[4][4];
#pragma unroll
                for (int a = 0; a < 4; ++a)
#pragma unroll
                    for (int b = 0; b < 4; ++b) acc[a][b] = (f32x4){0.f, 0.f, 0.f, 0.f};
#pragma unroll 1
                for (int kp = 0; kp < 2; ++kp) {
                    bf16x8 bw[2][4];
#pragma unroll
                    for (int k2 = 0; k2 < 2; ++k2)
#pragma unroll
                        for (int pt = 0; pt < 4; ++pt) bw[k2][pt] = *(const bf16x8*)(WSP + ((h * 128 + (ph * 4 + pt) * 16 + fr) * 128 + (kp * 2 + k2) * 32 + fq * 8));
#pragma unroll
                    for (int k2 = 0; k2 < 2; ++k2) {
                        const int ks = kp * 2 + k2;
                        bf16x8 af[4];
#pragma unroll
                        for (int ct = 0; ct < 4; ++ct) af[ct] = tr_frag(lds + (ks * 32 + fq * 8 + (fr >> 2)) * PITCH + (cw0 + ct * 16 + 4 * (fr & 3)) * 2, 4 * PITCH);
#pragma unroll
                        for (int ct = 0; ct < 4; ++ct)
#pragma unroll
                            for (int pt = 0; pt < 4; ++pt) acc[ct][pt] = mfma16(af[ct], bw[k2][pt], acc[ct][pt]);
                    }
                }
#pragma unroll
                for (int pt = 0; pt < 4; ++pt) {
                    const int pp = (ph * 4 + pt) * 16 + fr; const float bs = b_sp[h * 128 + pp];
#pragma unroll
                    for (int ct = 0; ct < 4; ++ct) {
                        const int c = cw0 + ct * 16 + fq * 4;
                        const u32x2 uw = *(const u32x2*)(PR + (tok0 + pp) * PRP + c);
                        u32x2 o; o.x = pk2(bf_lo(uw.x) * (acc[ct][pt][0] + bs), bf_hi(uw.x) * (acc[ct][pt][1] + bs)); o.y = pk2(bf_lo(uw.y) * (acc[ct][pt][2] + bs), bf_hi(uw.y) * (acc[ct][pt][3] + bs));
                        *(u32x2*)(YY + (tok0 + pp) * 1024 + c) = o;
                    }
                }
            }
        }
        {
            const int tl = wid * 16 + fr; const int pos = (int)(tok0 % (size_t)S) + tl;
            const int pos0 = (int)(tok0 % (size_t)S);
            PoolStage ps;
            pool_stage_load(ps, PR, WPT, tok0, pos0, S, 0, tid);
            __syncthreads();
            pool_stage_store(ps, lds, tid); pool_stage_load(ps, PR, WPT, tok0, pos0, S, 1, tid);
            __syncthreads();
            pool_compute<0>(lds, YY, pool_scale, tok0, tl, pos, S, fr, fq);
            __syncthreads();
            pool_stage_store(ps, lds, tid); pool_stage_load(ps, PR, WPT, tok0, pos0, S, 2, tid);
            __syncthreads();
            pool_compute<1>(lds, YY, pool_scale, tok0, tl, pos, S, fr, fq);
            __syncthreads();
            pool_stage_store(ps, lds, tid); pool_stage_load(ps, PR, WPT, tok0, pos0, S, 3, tid);
            __syncthreads();
            pool_compute<2>(lds, YY, pool_scale, tok0, tl, pos, S, fr, fq);
            __syncthreads();
            pool_stage_store(ps, lds, tid);
            __syncthreads();
            pool_compute<3>(lds, YY, pool_scale, tok0, tl, pos, S, fr, fq);
        }
        __syncthreads();
    }
}

DI void conv_part(const bf16_t* PR, bf16_t* YY, const float* conv_w, int S, int G, int wid, int lane) {
    const int gw = blockIdx.x * 8 + wid, NGW = G * 8;
    f32x4 w[3][2];
#pragma unroll
    for (int k = 0; k < 3; ++k) { w[k][0] = *(const f32x4*)(conv_w + k * 512 + lane * 8); w[k][1] = *(const f32x4*)(conv_w + k * 512 + lane * 8 + 4); }
#pragma unroll 8
    for (int r = gw; r < GROWS; r += NGW) {
        const int pos = r % S;
        const bf16_t* cz = PR + (size_t)r * PRP + lane * 8;
        const float m0 = (pos > 0) ? 1.0f : 0.0f, m2 = (pos < S - 1) ? 1.0f : 0.0f;
        const u32x4 c1 = *(const u32x4*)cz, c0 = *(const u32x4*)(cz - (pos > 0 ? PRP : 0)), c2 = *(const u32x4*)(cz + (pos < S - 1 ? PRP : 0)), bg = *(const u32x4*)(cz + 512);
        const f32x4 w00 = w[0][0] * m0, w01 = w[0][1] * m0, w20 = w[2][0] * m2, w21 = w[2][1] * m2;
        f32x4 a0 = (f32x4){bf_lo(c0.x), bf_hi(c0.x), bf_lo(c0.y), bf_hi(c0.y)} * w00 + (f32x4){bf_lo(c1.x), bf_hi(c1.x), bf_lo(c1.y), bf_hi(c1.y)} * w[1][0] + (f32x4){bf_lo(c2.x), bf_hi(c2.x), bf_lo(c2.y), bf_hi(c2.y)} * w20;
        f32x4 a1 = (f32x4){bf_lo(c0.z), bf_hi(c0.z), bf_lo(c0.w), bf_hi(c0.w)} * w01 + (f32x4){bf_lo(c1.z), bf_hi(c1.z), bf_lo(c1.w), bf_hi(c1.w)} * w[1][1] + (f32x4){bf_lo(c2.z), bf_hi(c2.z), bf_lo(c2.w), bf_hi(c2.w)} * w21;
        a0 = a0 * (f32x4){bf_lo(bg.x), bf_hi(bg.x), bf_lo(bg.y), bf_hi(bg.y)}; a1 = a1 * (f32x4){bf_lo(bg.z), bf_hi(bg.z), bf_lo(bg.w), bf_hi(bg.w)};
        u32x4 o; o.x = pk2(a0[0], a0[1]); o.y = pk2(a0[2], a0[3]); o.z = pk2(a1[0], a1[1]); o.w = pk2(a1[2], a1[3]);
        *(u32x4*)(YY + (size_t)r * 1024 + lane * 8) = o;
    }
}

template <int R, int QB>
DI void four_stage1(const bf16_t* PR, bf16_t* UB, const bf16_t* WF, const bf16_t* FCp, const bf16_t* FSp, const f32x2* TW, int nb, int G, int wid, int lane) {
    constexpr int NT = R / 16, KS = (R + 31) / 32, KW = KS * 32, S = R * 128, NQB = 128 / QB;
    const int fr = lane & 15, fq = lane >> 4, e0 = wid * 16;
    const int nunits = nb * 4 * NQB;
    for (int un = blockIdx.x; un < nunits; un += G) {
        const int q0 = (un % NQB) * QB, g = (un / NQB) & 3, b = un / (4 * NQB);
        bf16x8 wP[4], wQ[4];
#pragma unroll
        for (int ks = 0; ks < 4; ++ks) { wP[ks] = *(const bf16x8*)(WF + ((g * 256 + e0 + fr) * 128 + ks * 32 + fq * 8)); wQ[ks] = *(const bf16x8*)(WF + ((g * 256 + 128 + e0 + fr) * 128 + ks * 32 + fq * 8)); }
        unsigned pP[QB][NT][2], pQ[QB][NT][2];
#pragma unroll
        for (int rt = 0; rt < NT; ++rt) {
#pragma unroll
            for (int qi = 0; qi < QB; ++qi) {
                const size_t tok = (size_t)b * S + 128 * (rt * 16 + fr) + q0 + qi;
                const bf16_t* zp = PR + tok * PRP + 1024 + g * 128 + fq * 8;
                bf16x8 a[4]; float ss = 0.f;
#pragma unroll
                for (int ks = 0; ks < 4; ++ks) a[ks] = *(const bf16x8*)(zp + ks * 32);
#pragma unroll
                for (int ks = 0; ks < 4; ++ks)
#pragma unroll
                    for (int k = 0; k < 8; ++k) { const float f = __uint_as_float(((unsigned)(unsigned short)a[ks][k]) << 16); ss += f * f; }
                ss += __shfl_xor(ss, 16); ss += __shfl_xor(ss, 32);
                const float rs = rsqrtf(ss * (1.0f / 128.0f) + 1e-6f);
                f32x4 dP = (f32x4){0.f, 0.f, 0.f, 0.f}, dQ = dP;
#pragma unroll
                for (int ks = 0; ks < 4; ++ks) { dP = mfma16(a[ks], wP[ks], dP); dQ = mfma16(a[ks], wQ[ks], dQ); }
#pragma unroll
                for (int j = 0; j < 4; ++j) { const float sj = __shfl(rs, fq * 4 + j); dP[j] *= sj; dQ[j] *= sj; }
                pP[qi][rt][0] = pk2(dP[0], dP[1]); pP[qi][rt][1] = pk2(dP[2], dP[3]); pQ[qi][rt][0] = pk2(dQ[0], dQ[1]); pQ[qi][rt][1] = pk2(dQ[2], dQ[3]);
            }
            if ((rt & 3) == 3) asm volatile("" ::: "memory");
        }
#pragma unroll 2
        for (int k1t = 0; k1t < NT; ++k1t) {
            bf16x8 aC[KS], aS[KS];
#pragma unroll
            for (int s = 0; s < KS; ++s) { aC[s] = *(const bf16x8*)(FCp + ((k1t * 16 + fr) * KW + s * 32 + fq * 8)); aS[s] = *(const bf16x8*)(FSp + ((k1t * 16 + fr) * KW + s * 32 + fq * 8)); }
#pragma unroll
            for (int qi = 0; qi < QB; ++qi) {
                f32x4 Ur = (f32x4){0.f, 0.f, 0.f, 0.f}, V = Ur;
#pragma unroll
                for (int s = 0; s < KS; ++s) {
                    u32x4 bp, bq;
                    bp.x = pP[qi][2 * s][0]; bp.y = pP[qi][2 * s][1]; bq.x = pQ[qi][2 * s][0]; bq.y = pQ[qi][2 * s][1];
                    if (2 * s + 1 < NT) { bp.z = pP[qi][(2 * s + 1) % NT][0]; bp.w = pP[qi][(2 * s + 1) % NT][1]; bq.z = pQ[qi][(2 * s + 1) % NT][0]; bq.w = pQ[qi][(2 * s + 1) % NT][1]; }
                    else { bp.z = 0u; bp.w = 0u; bq.z = 0u; bq.w = 0u; }
                    const u32x4 bnq = bq ^ 0x80008000u;
                    const bf16x8 BP = __builtin_bit_cast(bf16x8, bp), BQ = __builtin_bit_cast(bf16x8, bq), BNQ = __builtin_bit_cast(bf16x8, bnq);
                    Ur = mfma16(aC[s], BP, Ur); Ur = mfma16(aS[s], BNQ, Ur); V = mfma16(aS[s], BP, V); V = mfma16(aC[s], BQ, V);
                }
                const int q = q0 + qi;
#pragma unroll
                for (int j = 0; j < 4; ++j) {
                    const int k1 = k1t * 16 + fq * 4 + j; const f32x2 tw = TW[q * R + k1];
                    const float upr = Ur[j] * tw.x - V[j] * tw.y, upi = -(V[j] * tw.x + Ur[j] * tw.y);
                    bf16_t* o = UB + ((((size_t)b * R + k1) * 2) * 128 + q) * 512 + g * 128 + e0 + fr;
                    o[0] = (bf16_t)f2bf(upr); o[(size_t)128 * 512] = (bf16_t)f2bf(upi);
                }
            }
        }
    }
}

DI void four_stage1_p(LAS unsigned char* lds, const bf16_t* PR, bf16_t* UB, const bf16_t* WF, const bf16_t* FCp, const bf16_t* FSp, const f32x2* TW, int nb, int G, int tid, int wid, int lane) {
    constexpr int R = 128, S = R * 128, PT = 272, TC_OFF = 0, TS_OFF = 128 * PT, Z_OFF = 256 * PT, TW_OFF = 384 * PT;
    const int fr = lane & 15, fq = lane >> 4, e0 = wid * 16;
    const int nunits = nb * 4 * 128;
    {
#pragma unroll
        for (int i = 0; i < 4; ++i) { const int idx = tid + NTHR * i; const u32x4 c = *(const u32x4*)(FCp + (idx >> 4) * 128 + (idx & 15) * 8), sn = *(const u32x4*)(FSp + (idx >> 4) * 128 + (idx & 15) * 8);
            *(LAS u32x4*)(lds + TC_OFF + (idx >> 4) * PT + (idx & 15) * 16) = c; *(LAS u32x4*)(lds + TS_OFF + (idx >> 4) * PT + (idx & 15) * 16) = sn; }
    }
    u32x4 zr[4]; u32x4 twr = (u32x4){0u, 0u, 0u, 0u};
    int un = blockIdx.x;
    if (un < nunits) { const int q = un & 127, g = (un >> 7) & 3, b = un >> 9;
#pragma unroll
        for (int i = 0; i < 4; ++i) { const int idx = tid + NTHR * i; zr[i] = *(const u32x4*)(PR + ((size_t)b * S + 128 * (idx >> 4) + q) * PRP + 1024 + g * 128 + (idx & 15) * 8); }
        if (tid < 64) twr = *(const u32x4*)((const float*)(TW + q * R) + tid * 4); }
    for (; un < nunits; un += G) {
        const int q = un & 127, g = (un >> 7) & 3, b = un >> 9;
        bf16x8 wP[4], wQ[4];
#pragma unroll
        for (int ks = 0; ks < 4; ++ks) { wP[ks] = *(const bf16x8*)(WF + ((g * 256 + e0 + fr) * 128 + ks * 32 + fq * 8)); wQ[ks] = *(const bf16x8*)(WF + ((g * 256 + 128 + e0 + fr) * 128 + ks * 32 + fq * 8)); }
        __syncthreads();
#pragma unroll
        for (int i = 0; i < 4; ++i) { const int idx = tid + NTHR * i; *(LAS u32x4*)(lds + Z_OFF + (idx >> 4) * PT + (idx & 15) * 16) = zr[i]; }
        if (tid < 64) *(LAS u32x4*)(lds + TW_OFF + tid * 16) = twr;
        { const int un2 = un + G;
          if (un2 < nunits) { const int q2 = un2 & 127, g2 = (un2 >> 7) & 3, b2 = un2 >> 9;
#pragma unroll
            for (int i = 0; i < 4; ++i) { const int idx = tid + NTHR * i; zr[i] = *(const u32x4*)(PR + ((size_t)b2 * S + 128 * (idx >> 4) + q2) * PRP + 1024 + g2 * 128 + (idx & 15) * 8); }
            if (tid < 64) twr = *(const u32x4*)((const float*)(TW + q2 * R) + tid * 4); } }
        __syncthreads();
        unsigned pP[8][2], pQ[8][2];
#pragma unroll
        for (int rt = 0; rt < 8; ++rt) {
            bf16x8 a[4]; float ss = 0.f;
#pragma unroll
            for (int ks = 0; ks < 4; ++ks) a[ks] = *(const LAS bf16x8*)(lds + Z_OFF + (rt * 16 + fr) * PT + (ks * 32 + fq * 8) * 2);
#pragma unroll
            for (int ks = 0; ks < 4; ++ks)
#pragma unroll
                for (int k = 0; k < 8; ++k) { const float f = __uint_as_float(((unsigned)(unsigned short)a[ks][k]) << 16); ss += f * f; }
            ss += __shfl_xor(ss, 16); ss += __shfl_xor(ss, 32);
            const float rs = rsqrtf(ss * (1.0f / 128.0f) + 1e-6f);
            f32x4 dP = (f32x4){0.f, 0.f, 0.f, 0.f}, dQ = dP;
#pragma unroll
            for (int ks = 0; ks < 4; ++ks) { dP = mfma16(a[ks], wP[ks], dP); dQ = mfma16(a[ks], wQ[ks], dQ); }
#pragma unroll
            for (int j = 0; j < 4; ++j) { const float sj = __shfl(rs, fq * 4 + j); dP[j] *= sj; dQ[j] *= sj; }
            pP[rt][0] = pk2(dP[0], dP[1]); pP[rt][1] = pk2(dP[2], dP[3]); pQ[rt][0] = pk2(dQ[0], dQ[1]); pQ[rt][1] = pk2(dQ[2], dQ[3]);
            if ((rt & 3) == 3) asm volatile("" ::: "memory");
        }
#pragma unroll 2
        for (int k1t = 0; k1t < 8; ++k1t) {
            bf16x8 aC[4], aS[4];
#pragma unroll
            for (int sx = 0; sx < 4; ++sx) { aC[sx] = *(const LAS bf16x8*)(lds + TC_OFF + (k1t * 16 + fr) * PT + (sx * 32 + fq * 8) * 2); aS[sx] = *(const LAS bf16x8*)(lds + TS_OFF + (k1t * 16 + fr) * PT + (sx * 32 + fq * 8) * 2); }
            const f32x2 twl = *(const LAS f32x2*)(lds + TW_OFF + (k1t * 16 + fr) * 8);
            f32x4 Ur = (f32x4){0.f, 0.f, 0.f, 0.f}, V = Ur;
#pragma unroll
            for (int sx = 0; sx < 4; ++sx) {
                u32x4 bp, bq;
                bp.x = pP[2 * sx][0]; bp.y = pP[2 * sx][1]; bq.x = pQ[2 * sx][0]; bq.y = pQ[2 * sx][1];
                bp.z = pP[2 * sx + 1][0]; bp.w = pP[2 * sx + 1][1]; bq.z = pQ[2 * sx + 1][0]; bq.w = pQ[2 * sx + 1][1];
                const u32x4 bnq = bq ^ 0x80008000u;
                const bf16x8 BP = __builtin_bit_cast(bf16x8, bp), BQ = __builtin_bit_cast(bf16x8, bq), BNQ = __builtin_bit_cast(bf16x8, bnq);
                Ur = mfma16(BP, aC[sx], Ur); Ur = mfma16(BNQ, aS[sx], Ur); V = mfma16(BP, aS[sx], V); V = mfma16(BQ, aC[sx], V);
            }
            {
                const int k1 = k1t * 16 + fr;
                const f32x4 upr = Ur * twl.x - V * twl.y, upi = -(V * twl.x + Ur * twl.y);
                bf16_t* o = UB + ((((size_t)b * R + k1) * 2) * 128 + q) * 512 + g * 128 + e0 + fq * 4;
                u32x2 wr_, wi_; wr_.x = pk2(upr[0], upr[1]); wr_.y = pk2(upr[2], upr[3]); wi_.x = pk2(upi[0], upi[1]); wi_.y = pk2(upi[2], upi[3]);
                *(u32x2*)o = wr_; *(u32x2*)(o + (size_t)128 * 512) = wi_;
            }
        }
    }
    __syncthreads();
}

DI void four_stage1_s(LAS unsigned char* lds, const bf16_t* PR, bf16_t* UB, const bf16_t* WF, const bf16_t* FCp, const bf16_t* FSp, const f32x2* TW, int nb, int G, int tid, int wid, int lane) {
    constexpr int R = 16, S = R * 128, QB = 4, NQB = 32, PT = 272;
    const int fr = lane & 15, fq = lane >> 4, e0 = wid * 16;
    const int nunits = nb * 4 * NQB;
    const bool uniform = (G % 128) == 0;
    int un = blockIdx.x;
    if (un >= nunits) return;
    int q0 = (un % NQB) * QB, g = (un / NQB) & 3;
    bf16x8 wP[4], wQ[4], aC, aS; f32x2 twl[QB];
    u32x4 zr[2];
#define S1S_CONST() do { _Pragma("unroll") for (int ks = 0; ks < 4; ++ks) { wP[ks] = *(const bf16x8*)(WF + ((g * 256 + e0 + fr) * 128 + ks * 32 + fq * 8)); wQ[ks] = *(const bf16x8*)(WF + ((g * 256 + 128 + e0 + fr) * 128 + ks * 32 + fq * 8)); } \
        _Pragma("unroll") for (int qi = 0; qi < QB; ++qi) twl[qi] = TW[(q0 + qi) * R + fr]; } while (0)
    aC = *(const bf16x8*)(FCp + (fr * 32 + fq * 8)); aS = *(const bf16x8*)(FSp + (fr * 32 + fq * 8));
    S1S_CONST();
    { const int b = un / (4 * NQB);
#pragma unroll
      for (int i = 0; i < 2; ++i) { const int idx = tid + NTHR * i, row = idx >> 4; zr[i] = *(const u32x4*)(PR + ((size_t)b * S + 128 * (row & 15) + q0 + (row >> 4)) * PRP + 1024 + g * 128 + (idx & 15) * 8); } }
    for (; un < nunits; un += G) {
        const int b = un / (4 * NQB);
        __syncthreads();
#pragma unroll
        for (int i = 0; i < 2; ++i) { const int idx = tid + NTHR * i; *(LAS u32x4*)(lds + (idx >> 4) * PT + (idx & 15) * 16) = zr[i]; }
        const int un2 = un + G; int q0n = q0, gn = g;
        if (un2 < nunits) { const int b2 = un2 / (4 * NQB); q0n = (un2 % NQB) * QB; gn = (un2 / NQB) & 3;
#pragma unroll
            for (int i = 0; i < 2; ++i) { const int idx = tid + NTHR * i, row = idx >> 4; zr[i] = *(const u32x4*)(PR + ((size_t)b2 * S + 128 * (row & 15) + q0n + (row >> 4)) * PRP + 1024 + gn * 128 + (idx & 15) * 8); } }
        __syncthreads();
#pragma unroll
        for (int qi = 0; qi < QB; ++qi) {
            bf16x8 a[4]; float ss = 0.f;
#pragma unroll
            for (int ks = 0; ks < 4; ++ks) a[ks] = *(const LAS bf16x8*)(lds + (qi * 16 + fr) * PT + (ks * 32 + fq * 8) * 2);
#pragma unroll
            for (int ks = 0; ks < 4; ++ks)
#pragma unroll
                for (int k = 0; k < 8; ++k) { const float f = __uint_as_float(((unsigned)(unsigned short)a[ks][k]) << 16); ss += f * f; }
            ss += __shfl_xor(ss, 16); ss += __shfl_xor(ss, 32);
            const float rs = rsqrtf(ss * (1.0f / 128.0f) + 1e-6f);
            f32x4 dP = (f32x4){0.f, 0.f, 0.f, 0.f}, dQ = dP;
#pragma unroll
            for (int ks = 0; ks < 4; ++ks) { dP = mfma16(a[ks], wP[ks], dP); dQ = mfma16(a[ks], wQ[ks], dQ); }
#pragma unroll
            for (int j = 0; j < 4; ++j) { const float sj = __shfl(rs, fq * 4 + j); dP[j] *= sj; dQ[j] *= sj; }
            u32x4 bp, bq; bp.x = pk2(dP[0], dP[1]); bp.y = pk2(dP[2], dP[3]); bp.z = 0u; bp.w = 0u; bq.x = pk2(dQ[0], dQ[1]); bq.y = pk2(dQ[2], dQ[3]); bq.z = 0u; bq.w = 0u;
            const u32x4 bnq = bq ^ 0x80008000u;
            const bf16x8 BP = __builtin_bit_cast(bf16x8, bp), BQ = __builtin_bit_cast(bf16x8, bq), BNQ = __builtin_bit_cast(bf16x8, bnq);
            f32x4 Ur = (f32x4){0.f, 0.f, 0.f, 0.f}, V = Ur;
            Ur = mfma16(BP, aC, Ur); Ur = mfma16(BNQ, aS, Ur); V = mfma16(BP, aS, V); V = mfma16(BQ, aC, V);
            const int q = q0 + qi;
            {
                const int k1 = fr;
                const f32x4 upr = Ur * twl[qi].x - V * twl[qi].y, upi = -(V * twl[qi].x + Ur * twl[qi].y);
                bf16_t* o = UB + ((((size_t)b * R + k1) * 2) * 128 + q) * 512 + g * 128 + e0 + fq * 4;
                u32x2 wr_, wi_; wr_.x = pk2(upr[0], upr[1]); wr_.y = pk2(upr[2], upr[3]); wi_.x = pk2(upi[0], upi[1]); wi_.y = pk2(upi[2], upi[3]);
                *(u32x2*)o = wr_; *(u32x2*)(o + (size_t)128 * 512) = wi_;
            }
        }
        if (!uniform && un2 < nunits) { q0 = q0n; g = gn; S1S_CONST(); }
    }
#undef S1S_CONST
    __syncthreads();
}

template <int R>
DI void four_stage2(LAS unsigned char* lds, const bf16_t* UB, bf16_t* YY, const bf16_t* FC2, const bf16_t* FS2, int nb, int G, int tid, int wid, int lane) {
    constexpr int PT = 272, S = R * 128, FC_OFF = 0, FS_OFF = 128 * PT, U_OFF = 256 * PT;
    const float norm = rsqrtf((float)S * 128.0f);
    const int fr = lane & 15, fq = lane >> 4, c0 = wid * 16;
    const int nunits = nb * R * 4;
#pragma unroll
    for (int i = 0; i < 4; ++i) { const int idx = tid + NTHR * i; const u32x4 c = *(const u32x4*)(FC2 + (idx >> 4) * 128 + (idx & 15) * 8), sn = *(const u32x4*)(FS2 + (idx >> 4) * 128 + (idx & 15) * 8);
        *(LAS u32x4*)(lds + FC_OFF + (idx >> 4) * PT + (idx & 15) * 16) = c; *(LAS u32x4*)(lds + FS_OFF + (idx >> 4) * PT + (idx & 15) * 16) = sn; }
    u32x4 tile[8];
    if ((int)blockIdx.x < nunits) { const int u0 = blockIdx.x; const bf16_t* src = UB + (((size_t)((u0 >> 2) / R) * R + ((u0 >> 2) % R)) * 2) * 128 * 512 + (u0 & 3) * 128;
#pragma unroll
        for (int i = 0; i < 8; ++i) { const int idx = tid + NTHR * i; tile[i] = *(const u32x4*)(src + (size_t)(idx >> 4) * 512 + (idx & 15) * 8); } }
    for (int un = blockIdx.x; un < nunits; un += G) {
        const int cq = un & 3, k1 = (un >> 2) % R, b = (un >> 2) / R;
        __syncthreads();
#pragma unroll
        for (int i = 0; i < 8; ++i) { const int idx = tid + NTHR * i; *(LAS u32x4*)(lds + U_OFF + (idx >> 4) * PT + (idx & 15) * 16) = tile[i]; }
        if (un + G < nunits) { const int u2 = un + G; const bf16_t* src = UB + (((size_t)((u2 >> 2) / R) * R + ((u2 >> 2) % R)) * 2) * 128 * 512 + (u2 & 3) * 128;
#pragma unroll
            for (int i = 0; i < 8; ++i) { const int idx = tid + NTHR * i; tile[i] = *(const u32x4*)(src + (size_t)(idx >> 4) * 512 + (idx & 15) * 8); } }
        __syncthreads();
        f32x4 acc[8];
#pragma unroll
        for (int k = 0; k < 8; ++k) acc[k] = (f32x4){0.f, 0.f, 0.f, 0.f};
#pragma unroll
        for (int it = 0; it < 8; ++it) {
            const int comp = it >> 2, ks = it & 3;
            const bf16x8 uf = tr_frag(lds + U_OFF + (comp * 128 + ks * 32 + fq * 8 + (fr >> 2)) * PT + (c0 + 4 * (fr & 3)) * 2, 4 * PT);
#pragma unroll
            for (int k2t = 0; k2t < 8; ++k2t) { const bf16x8 fa = *(const LAS bf16x8*)(lds + (comp ? FS_OFF : FC_OFF) + (k2t * 16 + fr) * PT + (ks * 32 + fq * 8) * 2); acc[k2t] = mfma16(uf, fa, acc[k2t]); }
        }
#pragma unroll
        for (int k2t = 0; k2t < 8; ++k2t) {
            const size_t tok = (size_t)b * S + (size_t)R * (k2t * 16 + fr) + k1;
            const f32x4 y = acc[k2t] * norm; u32x2 o; o.x = pk2(y[0], y[1]); o.y = pk2(y[2], y[3]);
            *(u32x2*)(YY + tok * 1024 + 512 + cq * 128 + c0 + fq * 4) = o;
        }
    }
    __syncthreads();
}

__global__ void __launch_bounds__(NTHR, 2) mega_fwd(Params p) {
    extern __shared__ __attribute__((aligned(16))) unsigned char lds_raw[];
    LAS unsigned char* lds = (LAS unsigned char*)lds_raw;
    cg::grid_group grid = cg::this_grid();
    const int tid = threadIdx.x, lane = tid & 63, wid = __builtin_amdgcn_readfirstlane(tid >> 6), G = gridDim.x;
    unsigned char* ws = p.ws;
    int pc = 0;
#define PH_BEGIN if (pc >= p.ph_lo && pc < p.ph_hi) {
    volatile LAS unsigned* bst = (volatile LAS unsigned*)(lds + LDS_BYTES - 64);
    if (tid < 2) bst[tid] = 0u;
    __syncthreads();
    if (p.ph_lo > p.ph_hi) grid.sync();
    XcdBarrier xbar = xcd_barrier_post((unsigned*)(ws + WS_BAR), bst);
    if (tid == 0) { (void)__hip_atomic_fetch_max(&xbar.bar[XB_CLS(blockIdx.x & 7u)], xbar.x + 1u, __ATOMIC_RELAXED, __HIP_MEMORY_SCOPE_AGENT); (void)__hip_atomic_fetch_max(&xbar.bar[XB_CLS(8u + (blockIdx.x & 7u))], 16u - xbar.x, __ATOMIC_RELAXED, __HIP_MEMORY_SCOPE_AGENT); }
    bool local_ok = false, seam_local = false, seam_noacq = false, seam_skip = false;
#define PH_END } ++pc; if (pc == 1) { xcd_barrier(xbar); \
        local_ok = (G == 256) && (bst[0] == 32u) && (bst[1] == 8u) && (xb_ld(&xbar.bar[XB_TMO]) == 0u); \
        for (unsigned cc = 0; cc < 8u; ++cc) local_ok = local_ok && (xb_ld(&xbar.bar[XB_CLS(cc)]) + xb_ld(&xbar.bar[XB_CLS(8u + cc)]) == 17u); } \
    else if (seam_skip && local_ok) { } else if (seam_local && local_ok) { team_barrier(xbar, !seam_noacq); } else { xcd_barrier(xbar); }

    PH_BEGIN
#if PHMASK & 1
#if PROBE & 16
 for (int rep = 0; rep < 2; ++rep)
#endif
 setup_phase(p, lds, G, tid, wid, lane);
#endif
 PH_END

    bf16_t* H = (bf16_t*)(ws + WS_H); bf16_t* T = (bf16_t*)(ws + WS_T); bf16_t* BIG = (bf16_t*)(ws + WS_BIG); bf16_t* UB = (bf16_t*)(ws + WS_T);     _Float16* XH = (_Float16*)(ws + WS_XH);
    const float* mod = (const float*)(ws + WS_MOD);
    for (int gi = 0; gi < 2; ++gi) {
        const int S = gi ? 2048 : 16384, nb = gi ? 16 : 2;
        const float* xsrc = p.in[gi];
        float* xo = p.out + (size_t)gi * GROWS * D;
        for (int ls = 0; ls < 7; ++ls) {
            const int l = ls / 3, sub = ls % 3;
            const bool odd = (l & 1), last = (ls == 6), first = (ls == 0);
            const int nsteps = last ? 1 : (sub != 1 ? 3 : (odd ? 5 : 4));
            for (int step = 0; step < nsteps; ++step) {
                int kind = 1;
                if (step == 0) kind = 0;
                else if (sub == 1 && step == 2) kind = odd ? 3 : 2;
                else if (sub == 1 && odd && step == 3) kind = 4;
                seam_noacq = (kind == 1 && sub != 1 && step == 2);
                seam_skip = (kind == 0 && last);
                seam_local = !((kind == 1 && sub == 1) || kind == 3 || kind == 4);
                PH_BEGIN
                int tid = threadIdx.x; asm volatile("" : "+v"(tid));
                const int lane = tid & 63, wid = __builtin_amdgcn_readfirstlane(tid >> 6);
                if (kind == 0) {
#if PHMASK & 2
#ifndef STAG2
#define STAG2 0
#endif
                    if (STAG2 && local_ok && ((gi == 0 && ls == 0) || sub == 2) && ((blockIdx.x >> 3) & 1)) { for (int zz = 0; zz < STAG2; ++zz) __builtin_amdgcn_s_sleep(127); }
                    const int lp = sub > 0 ? l : l - 1, sp = sub > 0 ? sub - 1 : 2, lpp = first ? 0 : lp, lc = last ? 0 : l;
#if PROBE & 4
                    norm_phase(ls <= 1 ? xsrc : nullptr, XH, last ? (float*)BIG : nullptr, (_Float16*)BIG, T, H, !first, !last,
                               mod + (size_t)lpp * 18 * 9216 + (sp * 3 + 2) * 1024, p.in[7] + (lpp * 3 + sp) * 1024, sp == 1 ? 1.0f : 0.5f,
                               mod + (size_t)lc * 18 * 9216 + (sub * 3) * 1024, p.in[6] + (lc * 3 + sub) * 1024, gi, G, wid, lane);
#endif
                    norm_phase(ls <= 1 ? xsrc : nullptr, XH, last ? xo : nullptr, XH, T, H, !first, !last,
                               mod + (size_t)lpp * 18 * 9216 + (sp * 3 + 2) * 1024, p.in[7] + (lpp * 3 + sp) * 1024, sp == 1 ? 1.0f : 0.5f,
                               mod + (size_t)lc * 18 * 9216 + (sub * 3) * 1024, p.in[6] + (lc * 3 + sub) * 1024, gi, G, wid, lane);
#endif
                } else if (kind == 1) {
                    const bf16_t* A; const bf16_t* Bt; bf16_t* O; int N, K, ldc, mode;
                    if (sub != 1) {
                        const int wi = l * 2 + (sub >> 1);
                        if (step == 1) { A = H; Bt = (const bf16_t*)(ws + WS_WUP) + (size_t)wi * 5632 * 1024; O = BIG; N = 5632; K = 1024; ldc = DFF; mode = 3; }
                        else { A = BIG; Bt = (const bf16_t*)(ws + WS_WDN) + (size_t)wi * 1024 * 2816; O = T; N = 1024; K = DFF; ldc = D; mode = 0; }
                    } else if (step == 1) { A = H; Bt = (const bf16_t*)(ws + (odd ? WS_ODIN : WS_EVIN)); O = BIG; N = odd ? 2048 : 1536; K = 1024; ldc = PRP; mode = odd ? 2 : 1; }
                    else { A = H; Bt = (const bf16_t*)(ws + (odd ? WS_ODOUT : WS_EVOUT)); O = T; N = 1024; K = 1024; ldc = D; mode = 0; }
#if PROBE & 2
                    for (int rep = 0; rep < 2; ++rep)
#endif
                    run_gemm(lds, A, Bt, GROWS, N, K, O, ldc, mode, G);
                } else if (kind == 2) {
#if PHMASK & 8
#if PROBE & (8 | 32)
                    for (int rep = 0; rep < 2; ++rep)
#endif
                    even_core(lds, BIG, H, (const bf16_t*)(ws + WS_WSP), (const bf16_t*)(ws + WS_WPT), p.in[13], p.in[14], p.in[16], p.in[18], S, G, tid, wid, lane);
#endif
                } else if (kind == 3) {
#if PHMASK & 16
#if PROBE & (8 | 64)
                    for (int rep = 0; rep < 2; ++rep) {
#else
                    {
#endif
                    conv_part(BIG, H, p.in[21], S, G, wid, lane);
                    if (gi == 0) four_stage1_p(lds, BIG, UB, (const bf16_t*)(ws + WS_WF), (const bf16_t*)(ws + WS_FC1), (const bf16_t*)(ws + WS_FS1), (const f32x2*)(ws + WS_TW128), nb, G, tid, wid, lane);
                    else four_stage1_s(lds, BIG, UB, (const bf16_t*)(ws + WS_WF), (const bf16_t*)(ws + WS_FC16), (const bf16_t*)(ws + WS_FS16), (const f32x2*)(ws + WS_TW16), nb, G, tid, wid, lane);
                    }
#endif
                } else {
#if PHMASK & 32
#if PROBE & (8 | 128)
                    for (int rep = 0; rep < 2; ++rep) {
#else
                    {
#endif
                    if (gi == 0) four_stage2<128>(lds, UB, H, (const bf16_t*)(ws + WS_FC2), (const bf16_t*)(ws + WS_FS2), nb, G, tid, wid, lane);
                    else four_stage2<16>(lds, UB, H, (const bf16_t*)(ws + WS_FC2), (const bf16_t*)(ws + WS_FS2), nb, G, tid, wid, lane);
                    }
#endif
                }
                PH_END
            }
        }
    }
}

extern "C" void kernel_launch(void* const* d_in, const int* in_sizes, int n_in, void* d_out, int out_size, void* d_ws, size_t ws_size, hipStream_t stream) {
    static int grid = 0;
    if (grid == 0) {
        if (n_in != 25 || ws_size < WS_END || out_size != 2 * GROWS * D) { fprintf(stderr, "kernel_launch: unexpected shapes (n_in %d, out %d, ws %zu)\n", n_in, out_size, ws_size); grid = -1; return; }
        int dev = 0, cus = 0, per_cu = 0;
        hipGetDevice(&dev); hipDeviceGetAttribute(&cus, hipDeviceAttributeMultiprocessorCount, dev);
        hipFuncSetAttribute((const void*)mega_fwd, hipFuncAttributeMaxDynamicSharedMemorySize, LDS_BYTES);
        if (hipOccupancyMaxActiveBlocksPerMultiprocessor(&per_cu, (const void*)mega_fwd, NTHR, LDS_BYTES) != hipSuccess || per_cu < 1) per_cu = 1;
        (void)hipGetLastError();
        grid = cus * 1;
    }
    if (grid < 0) return;
    Params p{};
    for (int i = 0; i < 25; ++i) p.in[i] = (const float*)d_in[i];
    p.out = (float*)d_out; p.ws = (unsigned char*)d_ws; p.ph_lo = 0; p.ph_hi = 1 << 20;
    (void)hipMemsetAsync((unsigned char*)d_ws + WS_BAR, 0, XB_WORDS_ALL * sizeof(unsigned), stream);
    void* args[] = {&p};
    hipError_t e = hipLaunchCooperativeKernel((const void*)mega_fwd, dim3(grid), dim3(NTHR), args, LDS_BYTES, stream);
    if (e != hipSuccess) fprintf(stderr, "cooperative launch failed: %s (grid %d)\n", hipGetErrorString(e), grid);
}
```
